# Optimizing an MI355X kernel written in HIP

```python
import jax, jax.numpy as jnp
from jax import lax
import numpy as np


D_MODEL = 1024
BATCH = 8
SEQ = 4096
DEPTH = 2

D_MIX = D_MODEL
HEAD_DIM = 64
RWKV_WIDTH = D_MIX // 2
RWKV_HEADS = RWKV_WIDTH // HEAD_DIM
POOL_WIDTH = D_MIX // 4
POOL_WINDOWS = (2, 4, 8, 16)
POOL_GROUPS = len(POOL_WINDOWS)
POOL_GROUP_DIM = POOL_WIDTH // POOL_GROUPS
MLA_WIDTH = D_MIX - RWKV_WIDTH - POOL_WIDTH
MLA_V_DIM = HEAD_DIM
MLA_HEADS = MLA_WIDTH // MLA_V_DIM
MLA_QK_NOPE = 64
MLA_QK_ROPE = 32
MLA_QK_DIM = MLA_QK_NOPE + MLA_QK_ROPE
MLA_Q_LORA = 256
MLA_KV_LORA = 128
ROPE_BASE = 10000.0
Q_BLOCK = 128
RWKV_DECAY_LORA = 64
RWKV_ICLR_LORA = 64
RWKV_VRES_LORA = 32
RWKV_GATE_LORA = 160
RWKV_LNX_EPS = 64e-5
RWKV_SPLITS = (RWKV_WIDTH, 2 * RWKV_WIDTH, 3 * RWKV_WIDTH,
               3 * RWKV_WIDTH + RWKV_DECAY_LORA,
               3 * RWKV_WIDTH + RWKV_DECAY_LORA + RWKV_ICLR_LORA)
RWKV_SHIFT_COLS = 3 * RWKV_WIDTH + RWKV_DECAY_LORA + RWKV_ICLR_LORA + RWKV_GATE_LORA
OFF_POOL = RWKV_SHIFT_COLS
OFF_QLAT = OFF_POOL + POOL_WIDTH
OFF_KVLAT = OFF_QLAT + MLA_Q_LORA
OFF_KROPE = OFF_KVLAT + MLA_KV_LORA
N_IN_BASE = OFF_KROPE + MLA_QK_ROPE
N_IN_REST = N_IN_BASE + RWKV_VRES_LORA
D_FF = 2816
N_EXPERTS = 8
TOP_K = 2
D_FF_EXPERT = 3584
MOE_BLOCK = 512
N_DENSE = (DEPTH + 1) // 2
N_MOE = DEPTH // 2
NORM_EPS = 1e-6
NEG_INF = -1e30

kernel_name = "hymba_rwkv7_pool_mla_moe_adaln"


def rms_norm(x, gain):
    xf = x.astype(jnp.float32)
    xf = xf * lax.rsqrt(jnp.mean(xf * xf, axis=-1, keepdims=True) + NORM_EPS)
    return (xf * gain.astype(jnp.float32)).astype(x.dtype)


def token_shift(y, mu):
    y_prev = jnp.pad(y, ((0, 0), (1, 0), (0, 0)))[:, :-1]
    return y + mu * (y_prev - y)


def rope_tables(positions):
    inv_freq = ROPE_BASE ** (-jnp.arange(0, MLA_QK_ROPE, 2, dtype=jnp.float32) / MLA_QK_ROPE)
    ang = positions.astype(jnp.float32)[..., None] * inv_freq
    return jnp.cos(ang), jnp.sin(ang)


def apply_rope(x, cos, sin):
    cos = cos.astype(x.dtype)
    sin = sin.astype(x.dtype)
    x1, x2 = jnp.split(x, 2, axis=-1)
    return jnp.concatenate([x1 * cos - x2 * sin, x1 * sin + x2 * cos], axis=-1)


def wkv7_scan(r, w, k, v, a, b):
    B_, T_, H_, N_ = r.shape
    xs = tuple(jnp.moveaxis(t.astype(jnp.float32), 1, 0) for t in (r, w, k, v, a, b))

    def step(S, inp):
        r_t, w_t, k_t, v_t, a_t, b_t = inp
        sa = jnp.einsum('bhvk,bhk->bhv', S, a_t)
        S = (S * w_t[:, :, None, :] + sa[..., None] * b_t[:, :, None, :]
             + v_t[..., None] * k_t[:, :, None, :])
        return S, jnp.einsum('bhvk,bhk->bhv', S, r_t)

    S0 = jnp.zeros((B_, H_, N_, N_), jnp.float32)
    _, y = lax.scan(step, S0, xs)
    return jnp.moveaxis(y, 0, 1)


def rwkv7_time_mix(r, k, v, wd, ad, gd, vec, w2, a2, g2):
    w0, a0, k_k, k_a, r_k, lnx_gain, lnx_bias = (vec[i] for i in range(7))
    B_, T_, _ = r.shape

    def heads(t):
        return t.reshape(B_, T_, RWKV_HEADS, HEAD_DIM)

    w_log = -jax.nn.softplus(-(w0 + jnp.tanh(wd) @ w2)) - 0.5
    decay = jnp.exp(-jnp.exp(w_log.astype(jnp.float32)))
    a = jax.nn.sigmoid(a0 + ad @ a2)
    g = jax.nn.sigmoid(gd) @ g2
    kk = heads((k * k_k).astype(jnp.float32))
    kk = kk / jnp.maximum(jnp.sqrt(jnp.sum(kk * kk, axis=-1, keepdims=True)), 1e-12)
    k = k * (1 + (a - 1) * k_a)
    rh, kh, vh, ah = heads(r), heads(k), heads(v), heads(a)
    y = wkv7_scan(rh, heads(decay), kh, vh, -kk, kk * ah.astype(jnp.float32))
    mu = jnp.mean(y, axis=-1, keepdims=True)
    var = jnp.mean(jnp.square(y - mu), axis=-1, keepdims=True)
    y = ((y - mu) * lax.rsqrt(var + RWKV_LNX_EPS)).reshape(B_, T_, RWKV_WIDTH)
    y = (y * lnx_gain.astype(jnp.float32) + lnx_bias.astype(jnp.float32)).astype(r.dtype)
    bonus = jnp.sum(rh * kh * r_k.reshape(RWKV_HEADS, HEAD_DIM), axis=-1, keepdims=True) * vh
    y = y + bonus.reshape(B_, T_, RWKV_WIDTH)
    return y * g


def multiscale_pool(u, w_pool, scale):
    B_, T_, C_ = u.shape
    uf = u.astype(jnp.float32).reshape(B_, T_, POOL_GROUPS, POOL_GROUP_DIM)
    cs = jnp.cumsum(uf, axis=1)
    t_idx = jnp.arange(T_)
    outs = []
    for gi, win in enumerate(POOL_WINDOWS):
        csg = cs[:, :, gi]
        lag = jnp.pad(csg, ((0, 0), (win, 0), (0, 0)))[:, :T_]
        cnt = jnp.minimum(t_idx + 1, win).astype(jnp.float32)[None, :, None]
        outs.append((csg - lag) / cnt - uf[:, :, gi])
    p = jnp.stack(outs, axis=2).astype(u.dtype)
    y = jnp.einsum('btgc,gcd->btgd', p, w_pool)
    return y.reshape(B_, T_, C_) * scale


def causal_block_attention(q, k, v):
    B_, T_, H_, Dq = q.shape
    nb = T_ // Q_BLOCK
    scale = Dq ** -0.5
    qb = q.reshape(B_, nb, Q_BLOCK, H_, Dq).transpose(1, 0, 2, 3, 4)
    key_pos = jnp.arange(T_)

    def one_block(args):
        q_blk, blk = args
        s = jnp.einsum('bqhd,bkhd->bhqk', q_blk, k).astype(jnp.float32) * scale
        q_pos = blk * Q_BLOCK + jnp.arange(Q_BLOCK)
        s = jnp.where(key_pos[None, :] <= q_pos[:, None], s, NEG_INF)
        p = jax.nn.softmax(s, axis=-1).astype(v.dtype)
        return jnp.einsum('bhqk,bkhd->bqhd', p, v)

    o = lax.map(one_block, (qb, jnp.arange(nb)))
    return o.transpose(1, 0, 2, 3, 4).reshape(B_, T_, H_, v.shape[-1])


def mla_attention(q_lat, kv_lat, k_rope, cos, sin, q_lat_gain, kv_lat_gain, wq_up, wkv_up, qk_gain):
    B_, T_, _ = q_lat.shape
    q = (rms_norm(q_lat, q_lat_gain) @ wq_up).reshape(B_, T_, MLA_HEADS, MLA_QK_DIM)
    kv = (rms_norm(kv_lat, kv_lat_gain) @ wkv_up).reshape(B_, T_, MLA_HEADS, MLA_QK_NOPE + MLA_V_DIM)
    q_pe = apply_rope(q[..., MLA_QK_NOPE:], cos[:, :, None], sin[:, :, None])
    k_pe = apply_rope(k_rope, cos, sin)[:, :, None, :]
    q = jnp.concatenate([q[..., :MLA_QK_NOPE], q_pe], axis=-1)
    k = jnp.concatenate([kv[..., :MLA_QK_NOPE],
                         jnp.broadcast_to(k_pe, (B_, T_, MLA_HEADS, MLA_QK_ROPE))], axis=-1)
    v = kv[..., MLA_QK_NOPE:]
    q = rms_norm(q, qk_gain[0])
    k = rms_norm(k, qk_gain[1])
    o = causal_block_attention(q, k, v)
    return o.reshape(B_, T_, MLA_WIDTH)


def swiglu(h, w_in, w_out):
    g, u = jnp.split(h @ w_in, 2, axis=-1)
    return (jax.nn.silu(g) * u) @ w_out


def moe_swiglu(h, router, w_in, w_out):
    B_, T_, D_ = h.shape
    n_tok = B_ * T_
    hf = h.reshape(n_tok, D_)
    logits = (hf @ router).astype(jnp.float32)
    top_val, top_idx = lax.top_k(logits, TOP_K)
    gate = jax.nn.softmax(top_val, axis=-1)
    n_asg = n_tok * TOP_K
    exp_flat = top_idx.reshape(-1)
    tok_flat = (jnp.arange(n_asg) // TOP_K).astype(jnp.int32)
    gate_flat = gate.reshape(-1)
    order = jnp.argsort(exp_flat)
    exp_sorted = exp_flat[order]
    counts = jnp.bincount(exp_flat, length=N_EXPERTS)
    padded = (counts + MOE_BLOCK - 1) // MOE_BLOCK * MOE_BLOCK
    start = jnp.cumsum(counts) - counts
    pend = jnp.cumsum(padded)
    pstart = pend - padded
    dest = pstart[exp_sorted] + jnp.arange(n_asg) - start[exp_sorted]
    n_blocks = -(-n_asg // MOE_BLOCK) + N_EXPERTS
    n_rows = n_blocks * MOE_BLOCK
    row_tok = jnp.full((n_rows,), n_tok, jnp.int32).at[dest].set(tok_flat[order])
    row_gate = jnp.zeros((n_rows,), jnp.float32).at[dest].set(gate_flat[order])
    block_exp = jnp.clip(jnp.searchsorted(pend, jnp.arange(n_blocks) * MOE_BLOCK, side='right'),
                         0, N_EXPERTS - 1)
    x_pad = jnp.concatenate([hf, jnp.zeros((1, D_), hf.dtype)], axis=0)
    xb = x_pad[row_tok].reshape(n_blocks, MOE_BLOCK, D_)

    def expert_block(args):
        x_blk, e = args
        return swiglu(x_blk, w_in[e], w_out[e])

    yb = lax.map(expert_block, (xb, block_exp)).reshape(n_rows, D_)
    y = jax.ops.segment_sum(yb * row_gate[:, None].astype(yb.dtype), row_tok,
                            num_segments=n_tok + 1)[:n_tok]
    return y.reshape(B_, T_, D_)


def setup_inputs(seed: int = 0) -> dict:
    key = jax.random.key(seed)
    ks = iter(jax.random.split(key, 48))

    def nrm(shape, scale):
        return jax.random.normal(next(ks), shape, jnp.float32) * scale

    def near_one(shape):
        return 1.0 + nrm(shape, 0.1)

    L, Lr = DEPTH, DEPTH - 1
    x = nrm((BATCH, SEQ, D_MODEL), 1.0)
    c = nrm((BATCH, D_MODEL), 1.0)
    positions = (jax.random.randint(next(ks), (BATCH, 1), 0, 1024)
                 + jnp.arange(SEQ)[None, :]).astype(jnp.int32)
    w_ada = nrm((L, D_MODEL, 6 * D_MODEL), 0.5 * D_MODEL ** -0.5)
    b_ada = nrm((L, 6 * D_MODEL), 0.01)
    norm_gain = near_one((L, 2, D_MODEL))
    w_in_first = nrm((D_MODEL, N_IN_BASE), D_MODEL ** -0.5)
    w_in_rest = nrm((Lr, D_MODEL, N_IN_REST), D_MODEL ** -0.5)
    mu_shift = jax.random.uniform(next(ks), (L, RWKV_SHIFT_COLS), jnp.float32)
    mu_shift_v = jax.random.uniform(next(ks), (Lr, RWKV_VRES_LORA), jnp.float32)
    w0 = jax.random.uniform(next(ks), (L, RWKV_WIDTH), jnp.float32, -4.0, 0.0)
    rwkv_vec = jnp.stack([
        w0,
        nrm((L, RWKV_WIDTH), 0.1),
        0.85 + nrm((L, RWKV_WIDTH), 0.05),
        near_one((L, RWKV_WIDTH)),
        nrm((L, RWKV_WIDTH), 0.1),
        near_one((L, RWKV_WIDTH)),
        nrm((L, RWKV_WIDTH), 0.01),
    ], axis=1)
    rwkv_v0 = near_one((Lr, RWKV_WIDTH))
    rwkv_w2 = nrm((L, RWKV_DECAY_LORA, RWKV_WIDTH), 0.1)
    rwkv_a2 = nrm((L, RWKV_ICLR_LORA, RWKV_WIDTH), 0.1)
    rwkv_g2 = nrm((L, RWKV_GATE_LORA, RWKV_WIDTH), RWKV_GATE_LORA ** -0.5)
    rwkv_v2 = nrm((Lr, RWKV_VRES_LORA, RWKV_WIDTH), 0.1)
    pool_w = nrm((L, POOL_GROUPS, POOL_GROUP_DIM, POOL_GROUP_DIM), POOL_GROUP_DIM ** -0.5)
    pool_scale = near_one((L, POOL_WIDTH))
    mla_q_lat_gain = near_one((L, MLA_Q_LORA))
    mla_kv_lat_gain = near_one((L, MLA_KV_LORA))
    mla_wq_up = nrm((L, MLA_Q_LORA, MLA_HEADS * MLA_QK_DIM), MLA_Q_LORA ** -0.5)
    mla_wkv_up = nrm((L, MLA_KV_LORA, MLA_HEADS * (MLA_QK_NOPE + MLA_V_DIM)), MLA_KV_LORA ** -0.5)
    mla_qk_gain = near_one((L, 2, MLA_QK_DIM))
    w_out = nrm((L, D_MIX, D_MODEL), D_MIX ** -0.5)
    ffn_w_in = nrm((N_DENSE, D_MODEL, 2 * D_FF), D_MODEL ** -0.5)
    ffn_w_out = nrm((N_DENSE, D_FF, D_MODEL), D_FF ** -0.5)
    moe_router = nrm((N_MOE, D_MODEL, N_EXPERTS), D_MODEL ** -0.5)
    moe_w_in = nrm((N_MOE, N_EXPERTS, D_MODEL, 2 * D_FF_EXPERT), D_MODEL ** -0.5)
    moe_w_out = nrm((N_MOE, N_EXPERTS, D_FF_EXPERT, D_MODEL), D_FF_EXPERT ** -0.5)
    return {"x": x, "c": c, "positions": positions, "w_ada": w_ada, "b_ada": b_ada,
            "norm_gain": norm_gain, "w_in_first": w_in_first, "w_in_rest": w_in_rest,
            "mu_shift": mu_shift, "mu_shift_v": mu_shift_v, "rwkv_vec": rwkv_vec,
            "rwkv_v0": rwkv_v0, "rwkv_w2": rwkv_w2, "rwkv_a2": rwkv_a2, "rwkv_g2": rwkv_g2,
            "rwkv_v2": rwkv_v2, "pool_w": pool_w, "pool_scale": pool_scale,
            "mla_q_lat_gain": mla_q_lat_gain, "mla_kv_lat_gain": mla_kv_lat_gain,
            "mla_wq_up": mla_wq_up, "mla_wkv_up": mla_wkv_up, "mla_qk_gain": mla_qk_gain,
            "w_out": w_out, "ffn_w_in": ffn_w_in, "ffn_w_out": ffn_w_out,
            "moe_router": moe_router, "moe_w_in": moe_w_in, "moe_w_out": moe_w_out}


def reference(x, c, positions, w_ada, b_ada, norm_gain, w_in_first, w_in_rest, mu_shift,
              mu_shift_v, rwkv_vec, rwkv_v0, rwkv_w2, rwkv_a2, rwkv_g2, rwkv_v2, pool_w,
              pool_scale, mla_q_lat_gain, mla_kv_lat_gain, mla_wq_up, mla_wkv_up, mla_qk_gain,
              w_out, ffn_w_in, ffn_w_out, moe_router, moe_w_in, moe_w_out):
    cos, sin = rope_tables(positions)
    c_act = jax.nn.silu(c)
    v_first = None
    for l in range(DEPTH):
        mod = (c_act @ w_ada[l] + b_ada[l]).reshape(-1, 6, 1, D_MODEL)
        shift1, scale1, gate1, shift2, scale2, gate2 = (mod[:, i] for i in range(6))

        h = rms_norm(x, norm_gain[l, 0]) * (1 + scale1) + shift1
        z = h @ (w_in_first if l == 0 else w_in_rest[l - 1])
        zs = token_shift(z[..., :RWKV_SHIFT_COLS], mu_shift[l])
        r, k, v, wd, ad, gd = jnp.split(zs, RWKV_SPLITS, axis=-1)
        if l == 0:
            v_first = v
        else:
            vd = token_shift(z[..., N_IN_BASE:], mu_shift_v[l - 1])
            v = v + (v_first - v) * jax.nn.sigmoid(rwkv_v0[l - 1] + vd @ rwkv_v2[l - 1])
        y_rwkv = rwkv7_time_mix(r, k, v, wd, ad, gd, rwkv_vec[l], rwkv_w2[l], rwkv_a2[l], rwkv_g2[l])
        y_pool = multiscale_pool(z[..., OFF_POOL:OFF_QLAT], pool_w[l], pool_scale[l])
        y_mla = mla_attention(z[..., OFF_QLAT:OFF_KVLAT], z[..., OFF_KVLAT:OFF_KROPE],
                              z[..., OFF_KROPE:N_IN_BASE], cos, sin, mla_q_lat_gain[l],
                              mla_kv_lat_gain[l], mla_wq_up[l], mla_wkv_up[l], mla_qk_gain[l])
        mix = jnp.concatenate([y_rwkv, y_pool, y_mla], axis=-1) @ w_out[l]
        x = x + gate1 * mix

        h = rms_norm(x, norm_gain[l, 1]) * (1 + scale2) + shift2
        if l % 2 == 0:
            f = swiglu(h, ffn_w_in[l // 2], ffn_w_out[l // 2])
        else:
            f = moe_swiglu(h, moe_router[l // 2], moe_w_in[l // 2], moe_w_out[l // 2])
        x = x + gate2 * f
    return x
```

```cpp
#include <hip/hip_runtime.h>
#include <cstdio>
#include <cstdint>

extern __shared__ __attribute__((aligned(16))) unsigned char lds_raw[];
#define WMAP_OFF (131072 + 512)
__device__ __forceinline__ int hw_slot_() { return (int)__builtin_amdgcn_s_getreg((5 << 11) | (0 << 6) | 4); }
__device__ __forceinline__ int lane_id_() { int l; asm volatile("v_mbcnt_lo_u32_b32 %0, -1, 0\n\tv_mbcnt_hi_u32_b32 %0, -1, %0" : "=v"(l)); return l; }
__device__ __forceinline__ int wave_id_() { return __builtin_amdgcn_readfirstlane(((volatile __attribute__((address_space(3))) int*)((__attribute__((address_space(3))) unsigned char*)lds_raw + WMAP_OFF))[hw_slot_()]); }
__device__ __forceinline__ int tidx_() { return wave_id_() * 64 + lane_id_(); }
#define TIME_PHASE 5
namespace pg8 {
#define PG8_LAS __attribute__((address_space(3)))
typedef unsigned short bf16_t;
typedef short bf16x8 __attribute__((ext_vector_type(8)));
typedef float f32x4 __attribute__((ext_vector_type(4)));
typedef unsigned u32x4 __attribute__((ext_vector_type(4)));
constexpr int BM = 256, BK = 64, HALF = 128, HTB = HALF * BK * 2  , STAGE_BYTES = 8 * HTB, NXCD = 8, WGM = 8;

__host__ __device__ __forceinline__ int lds_byte(int r, int c) { const int st = (r >> 4) * 2 + (c >> 5), rr = r & 15, cc = c & 31, ob = rr * 64 + cc * 2; return st * 1024 + (ob ^ (((ob >> 9) & 1) << 5)); }
__host__ __device__ __forceinline__ void stage_rc(int b, int& R, int& C) { const int st = b / 1024, sb = b % 1024, swz = sb ^ (((sb >> 9) & 1) << 5); R = (st >> 1) * 16 + swz / 64; C = (st & 1) * 32 + (swz % 64) / 2; }
__host__ __device__ __forceinline__ int perm32(int rho) { const int n = rho >> 4, i = rho & 15; return 8 * (i >> 2) + 4 * n + (i & 3); }

struct Unit { int pm, pn; };
struct Gemm { const bf16_t* A; const bf16_t* Bt; int M, N, K; };

struct StaticOrder {
    int nM, nN, nwg, G, c;
    __host__ __device__ void init(int M, int N, int G_, int c_) { nM = M / BM; nN = N / BM; nwg = nM * nN; G = G_; c = c_; }
    __host__ __device__ bool next(int i, Unit& u) const {
        const long L = (long)i * G + c; if (L >= nwg) return false;
        int wgid = (int)L; { const int q = nwg / NXCD, r = nwg % NXCD, xcd = wgid % NXCD, off = wgid / NXCD; wgid = (xcd < r ? xcd * (q + 1) : r * (q + 1) + (xcd - r) * q) + off; }
        const int nig = WGM * nN, gid = wgid / nig, fm = gid * WGM, gsz = (nM - fm) < WGM ? (nM - fm) : WGM;
        u.pm = fm + ((wgid % nig) % gsz); u.pn = (wgid % nig) / gsz; return true;
    }
    __device__ __forceinline__ void a_ready(const Unit&) const {}
    __device__ __forceinline__ void done(const Unit&) const {}
};

__device__ __forceinline__ unsigned cvt_pk_bf16(float lo, float hi) { unsigned r; asm volatile("v_cvt_pk_bf16_f32 %0, %1, %2" : "=v"(r) : "v"(lo), "v"(hi)); return r; }
typedef float f32x2 __attribute__((ext_vector_type(2)));
__device__ __forceinline__ f32x2 gelu_pk(f32x2 v) {
    const f32x2 av = __builtin_elementwise_abs(v), d = av * 0.2316418882f + 1.0f;
    f32x2 t; t.x = __builtin_amdgcn_rcpf(d.x); t.y = __builtin_amdgcn_rcpf(d.y);
    f32x2 q = t * 0.5307027145f + (-0.7265760135f); q = q * t + 0.7107068705f; q = q * t + (-0.142248368f); q = q * t + 0.127414796f; q = q * t;
    const f32x2 s = (v * v) * (-0.72134752044f);
    f32x2 e; e.x = __builtin_amdgcn_exp2f(s.x); e.y = __builtin_amdgcn_exp2f(s.y);
    const f32x2 m = v * (q * e), r = v - m;
    f32x2 o; o.x = v.x < 0.f ? m.x : r.x; o.y = v.y < 0.f ? m.y : r.y; return o;
}

template <int ACT  > struct EpiBf16 {
    static constexpr bool PERM = true, AFTER_DRAIN = false; static_assert(ACT == 0 || ACT == 1, "EpiBf16: ACT is 0 (none) or 1 (gelu_pk)");
    bf16_t* O; int ldc; const float* bias; int split_cols; size_t split_stride; float scale0;
    __device__ __forceinline__ void operator()(const f32x4 (&acc)[2][2][4][2], const Unit& u, int wr, int wc, int fr, int fq) const {
        const int row0 = u.pm * BM + wr * 64 + fr; int colt = u.pn * BM; bf16_t* base = O;
        float sc = 1.f; if (split_cols) { const int t = colt / split_cols; base += (size_t)t * split_stride; colt -= t * split_cols; if (t == 0) sc = scale0; }
        const int col0 = colt + wc * 32 + 8 * fq, bcol0 = u.pn * BM + wc * 32 + 8 * fq;
        f32x4 bv[2][2];
#pragma unroll
        for (int bj = 0; bj < 2; ++bj)
#pragma unroll
            for (int n = 0; n < 2; ++n) bv[bj][n] = bias ? *(const f32x4*)(bias + bcol0 + bj * HALF + 4 * n) : (f32x4){0.f, 0.f, 0.f, 0.f};
#pragma unroll
        for (int ai = 0; ai < 2; ++ai)
#pragma unroll
            for (int m = 0; m < 4; ++m) { bf16_t* rowp = base + (size_t)(row0 + ai * HALF + m * 16) * ldc + col0;
#pragma unroll
                for (int bj = 0; bj < 2; ++bj) { f32x4 v0 = acc[ai][bj][m][0] + bv[bj][0], v1 = acc[ai][bj][m][1] + bv[bj][1];
                    if (ACT == 1) { f32x2 a = gelu_pk((f32x2){v0[0], v0[1]}), b = gelu_pk((f32x2){v0[2], v0[3]}), c = gelu_pk((f32x2){v1[0], v1[1]}), d = gelu_pk((f32x2){v1[2], v1[3]});
                        v0 = (f32x4){a.x, a.y, b.x, b.y}; v1 = (f32x4){c.x, c.y, d.x, d.y}; }
                    v0 = v0 * sc; v1 = v1 * sc; u32x4 w; w.x = cvt_pk_bf16(v0[0], v0[1]); w.y = cvt_pk_bf16(v0[2], v0[3]); w.z = cvt_pk_bf16(v1[0], v1[1]); w.w = cvt_pk_bf16(v1[2], v1[3]);
                    *(u32x4*)(rowp + bj * HALF) = w; } }
    }
};

template <class Epi, class Sched, bool ALIGN_EPI = false, bool SP2 = false>
__device__ __forceinline__ void gemm_phase(PG8_LAS unsigned char* lds, const Gemm g, const Sched& S, const Epi& E) {
    int tid_ = tidx_(); asm volatile("" : "+v"(tid_));
    const int tid = tid_, wid = __builtin_amdgcn_readfirstlane(tid >> 6), lane = tid & 63, wr = wid >> 2, wc = wid & 3, fr = lane & 15, fq = lane >> 4;
    const int K = g.K, nt = K / BK;
    unsigned voffA[2], voffB[2];
#pragma unroll
    for (int i = 0; i < 2; ++i) { int R, C; stage_rc(tid * 16 + i * 8192, R, C); const int Rb = Epi::PERM ? ((R & ~31) + perm32(R & 31)) : R;
        voffA[i] = (unsigned)(R * K + C) * 2u; voffB[i] = (unsigned)(Rb * K + C) * 2u; }
    const size_t kstep = (size_t)(BK * 2);
    const size_t hstep = (size_t)HALF * K * 2;
    const size_t tstep = 2 * hstep;
    const unsigned ldsw = (unsigned)wid * 1024u;
    const int aoff = lds_byte(wr * 64 + fr, fq * 8), boff = lds_byte(wc * 32 + fr, fq * 8);
#define PG8_SA(b, h) (((b) * 2 + (h)) * HTB)
#define PG8_SB(b, h) ((4 + (b) * 2 + (h)) * HTB)
#define PG8_STAGE(bufoff, gbase, voff) do { _Pragma("unroll") for (int _i = 0; _i < 2; ++_i) \
        __builtin_amdgcn_global_load_lds((const unsigned*)((const char*)(gbase) + (voff)[_i]), (PG8_LAS unsigned*)(lds + (bufoff) + ldsw + _i * 8192), 16, 0, 0); } while (0)
#define PG8_LDA(dst, b, h) do { _Pragma("unroll") for (int m = 0; m < 4; ++m) _Pragma("unroll") for (int k = 0; k < 2; ++k) dst[m][k] = *(const PG8_LAS bf16x8*)(lds + PG8_SA(b, h) + aoff + m * 2048 + k * 1024); } while (0)
#define PG8_LDB(dst, b, h) do { _Pragma("unroll") for (int n = 0; n < 2; ++n) _Pragma("unroll") for (int k = 0; k < 2; ++k) dst[n][k] = *(const PG8_LAS bf16x8*)(lds + PG8_SB(b, h) + boff + n * 2048 + k * 1024); } while (0)
#define PG8_MMA(ai, bj, At, Bt) do { __builtin_amdgcn_s_setprio(1); _Pragma("unroll") for (int m = 0; m < 4; ++m) _Pragma("unroll") for (int n = 0; n < 2; ++n) _Pragma("unroll") for (int k = 0; k < 2; ++k) \
        acc[ai][bj][m][n] = __builtin_amdgcn_mfma_f32_16x16x32_bf16(Bt[n][k], At[m][k], acc[ai][bj][m][n], 0, 0, 0); __builtin_amdgcn_s_setprio(0); } while (0)
#define PG8_WAIT_V(n) asm volatile("s_waitcnt vmcnt(" #n ")" ::: "memory")
#define PG8_WAIT_L(n) asm volatile("s_waitcnt lgkmcnt(" #n ")" ::: "memory")
#define PG8_BAR __builtin_amdgcn_s_barrier()
#define PG8_SCHED __builtin_amdgcn_sched_barrier(0)
    Unit cur, nxt; int ui = 0;
    if (!S.next(0, cur)) return;
    f32x4 acc[2][2][4][2];
#pragma unroll
    for (int a = 0; a < 2; ++a)
#pragma unroll
        for (int b = 0; b < 2; ++b)
#pragma unroll
            for (int m = 0; m < 4; ++m)
#pragma unroll
                for (int n = 0; n < 2; ++n) acc[a][b][m][n] = (f32x4){0.f, 0.f, 0.f, 0.f};
    bf16x8 At[4][2], B0[2][2], B1[2][2];
    const char* cA = (const char*)g.A + (size_t)cur.pm * tstep; const char* cB = (const char*)g.Bt + (size_t)cur.pn * tstep;
    S.a_ready(cur);
    if constexpr (SP2) {
        PG8_STAGE(PG8_SB(0, 0), cB, voffB); PG8_STAGE(PG8_SB(0, 1), cB + hstep, voffB); PG8_STAGE(PG8_SA(0, 0), cA, voffA); PG8_STAGE(PG8_SA(0, 1), cA + hstep, voffA);
        if (wr == 1) PG8_BAR;
        PG8_WAIT_V(2); PG8_BAR;
        PG8_STAGE(PG8_SB(1, 0), cB + kstep, voffB); PG8_STAGE(PG8_SA(1, 0), cA + kstep, voffA); PG8_STAGE(PG8_SB(1, 1), cB + hstep + kstep, voffB);
        PG8_WAIT_V(6); PG8_BAR;
    } else {
        PG8_STAGE(PG8_SB(0, 0), cB, voffB); PG8_STAGE(PG8_SA(0, 0), cA, voffA); PG8_STAGE(PG8_SB(0, 1), cB + hstep, voffB); PG8_STAGE(PG8_SA(0, 1), cA + hstep, voffA);
        if (wr == 1) PG8_BAR;
        PG8_WAIT_V(4); PG8_BAR;
        PG8_STAGE(PG8_SB(1, 0), cB + kstep, voffB); PG8_STAGE(PG8_SA(1, 0), cA + kstep, voffA); PG8_STAGE(PG8_SB(1, 1), cB + hstep + kstep, voffB);
        PG8_WAIT_V(6); PG8_BAR;
    }
    for (;;) {
        const bool has_next = S.next(ui + 1, nxt);
        const char* nA = has_next ? (const char*)g.A + (size_t)nxt.pm * tstep : cA; const char* nB = has_next ? (const char*)g.Bt + (size_t)nxt.pn * tstep : cB;
        for (int t = 0; t < nt; t += 2) {
            const bool last = (t == nt - 2);
            const char* a1 = cA + (size_t)(t + 1) * kstep;
            const char* a2 = last ? nA : cA + (size_t)(t + 2) * kstep; const char* b2 = last ? nB : cB + (size_t)(t + 2) * kstep;
            const char* a3 = a2 + kstep; const char* b3 = b2 + kstep;
            if (last && has_next) S.a_ready(nxt);
            if constexpr (SP2) {
            PG8_LDB(B0, 0, 0); PG8_LDB(B1, 0, 1); PG8_SCHED; PG8_LDA(At, 0, 0); PG8_STAGE(PG8_SA(1, 1), a1 + hstep, voffA);
            PG8_WAIT_V(8); PG8_WAIT_L(0); PG8_BAR; PG8_MMA(0, 0, At, B0); PG8_MMA(0, 1, At, B1); PG8_BAR; PG8_SCHED;
            PG8_LDA(At, 0, 1); PG8_STAGE(PG8_SB(0, 0), b2, voffB); PG8_STAGE(PG8_SB(0, 1), b2 + hstep, voffB); PG8_STAGE(PG8_SA(0, 0), a2, voffA);
            PG8_WAIT_V(8); PG8_WAIT_L(0); PG8_BAR; PG8_MMA(1, 0, At, B0); PG8_MMA(1, 1, At, B1); PG8_BAR; PG8_SCHED;
            PG8_LDB(B0, 1, 0); PG8_LDB(B1, 1, 1); PG8_SCHED; PG8_LDA(At, 1, 0); PG8_STAGE(PG8_SA(0, 1), a2 + hstep, voffA);
            PG8_WAIT_V(8); PG8_WAIT_L(0); PG8_BAR; PG8_MMA(0, 0, At, B0); PG8_MMA(0, 1, At, B1); PG8_BAR; PG8_SCHED;
            PG8_LDA(At, 1, 1); PG8_STAGE(PG8_SB(1, 0), b3, voffB); PG8_STAGE(PG8_SB(1, 1), b3 + hstep, voffB); PG8_STAGE(PG8_SA(1, 0), a3, voffA);
            PG8_WAIT_V(8); PG8_WAIT_L(0); PG8_BAR; PG8_MMA(1, 0, At, B0); PG8_MMA(1, 1, At, B1); PG8_BAR; PG8_SCHED;
            } else {
            PG8_LDB(B0, 0, 0); PG8_SCHED; PG8_LDA(At, 0, 0); PG8_STAGE(PG8_SA(1, 1), a1 + hstep, voffA);
            PG8_WAIT_L(8); PG8_BAR; PG8_WAIT_L(0); PG8_MMA(0, 0, At, B0); PG8_BAR; PG8_SCHED;
            PG8_LDB(B1, 0, 1); PG8_STAGE(PG8_SB(0, 0), b2, voffB);
            PG8_BAR; PG8_WAIT_L(0); PG8_MMA(0, 1, At, B1); PG8_BAR;
            PG8_LDA(At, 0, 1); PG8_STAGE(PG8_SA(0, 0), a2, voffA);
            PG8_BAR; PG8_WAIT_L(0); PG8_MMA(1, 0, At, B0); PG8_BAR; PG8_SCHED;
            PG8_STAGE(PG8_SB(0, 1), b2 + hstep, voffB);
            PG8_WAIT_V(6); PG8_BAR; PG8_MMA(1, 1, At, B1); PG8_BAR;
            PG8_LDB(B0, 1, 0); PG8_SCHED; PG8_LDA(At, 1, 0); PG8_STAGE(PG8_SA(0, 1), a2 + hstep, voffA);
            PG8_WAIT_L(8); PG8_BAR; PG8_WAIT_L(0); PG8_MMA(0, 0, At, B0); PG8_BAR; PG8_SCHED;
            PG8_LDB(B1, 1, 1); PG8_STAGE(PG8_SB(1, 0), b3, voffB);
            PG8_BAR; PG8_WAIT_L(0); PG8_MMA(0, 1, At, B1); PG8_BAR;
            PG8_LDA(At, 1, 1); PG8_STAGE(PG8_SA(1, 0), a3, voffA);
            PG8_BAR; PG8_WAIT_L(0); PG8_MMA(1, 0, At, B0); PG8_BAR; PG8_SCHED;
            PG8_STAGE(PG8_SB(1, 1), b3 + hstep, voffB);
            PG8_WAIT_V(6); PG8_BAR; PG8_MMA(1, 1, At, B1); PG8_BAR;
            }
        }
        if constexpr (ALIGN_EPI) { if (wr == 0) PG8_BAR; }
        if constexpr (!Epi::AFTER_DRAIN) { E(acc, cur, wr, wc, fr, fq); S.done(cur); }
        if (!has_next) break;
#pragma unroll
        for (int a = 0; a < 2; ++a)
#pragma unroll
            for (int b = 0; b < 2; ++b)
#pragma unroll
                for (int m = 0; m < 4; ++m)
#pragma unroll
                    for (int n = 0; n < 2; ++n) acc[a][b][m][n] = (f32x4){0.f, 0.f, 0.f, 0.f};
        cur = nxt; cA = nA; cB = nB; ++ui;
        if constexpr (ALIGN_EPI) { if (wr == 1) PG8_BAR; }
    }
    PG8_WAIT_V(0);
    if constexpr (!ALIGN_EPI) { if (wr == 0) PG8_BAR; }
    PG8_BAR;
    if constexpr (Epi::AFTER_DRAIN) { E.fused(acc, cur, wr, wc, fr, fq, lds, wid, lane); S.done(cur); }
#undef PG8_SA
#undef PG8_SB
#undef PG8_STAGE
#undef PG8_LDA
#undef PG8_LDB
#undef PG8_MMA
#undef PG8_WAIT_V
#undef PG8_WAIT_L
#undef PG8_BAR
#undef PG8_SCHED
}
typedef int v8i_t __attribute__((ext_vector_type(8)));
template <class Epi, class Sched, bool ALIGN_EPI = false, bool SP2 = false>
__device__ __forceinline__ void gemm_phase_f8(PG8_LAS unsigned char* lds, const Gemm g, const Sched& S, const Epi& E, int sexp_w, int sexp_a) {
    int tid_ = tidx_(); asm volatile("" : "+v"(tid_));
    const int tid = tid_, wid = __builtin_amdgcn_readfirstlane(tid >> 6), lane = tid & 63, wr = wid >> 2, wc = wid & 3, fr = lane & 15, fq = lane >> 4;
    const int K = g.K, nt = K / BK;
    unsigned voffA[2], voffB[2];
#pragma unroll
    for (int i = 0; i < 2; ++i) { int R, C; stage_rc(tid * 16 + i * 8192, R, C); const int Rb = Epi::PERM ? ((R & ~31) + perm32(R & 31)) : R;
        voffA[i] = (unsigned)(R * K + C) * 2u; voffB[i] = (unsigned)(Rb * K + C) * 2u; }
    const size_t kstep = (size_t)(BK * 2);
    const size_t hstep = (size_t)HALF * K * 2;
    const size_t tstep = 2 * hstep;
    const unsigned ldsw = (unsigned)wid * 1024u;
    const int sexp_both = sexp_w | (sexp_a << 8);
    const int fo8 = (fq >> 1) * 1024 + ((fr * 64 + 32 * (fq & 1)) ^ ((fr >> 3) << 5));
    const int sw8 = (fq & 1) << 4;
    const int aoff = wr * 8192 + fo8 + sw8, boff = wc * 4096 + fo8 + sw8, aoff2 = wr * 8192 + fo8 + (16 - sw8), boff2 = wc * 4096 + fo8 + (16 - sw8);
#define PG8_SA(b, h) (((b) * 2 + (h)) * HTB)
#define PG8_SB(b, h) ((4 + (b) * 2 + (h)) * HTB)
#define PG8_STAGE(bufoff, gbase, voff) do { _Pragma("unroll") for (int _i = 0; _i < 2; ++_i) \
        __builtin_amdgcn_global_load_lds((const unsigned*)((const char*)(gbase) + (voff)[_i]), (PG8_LAS unsigned*)(lds + (bufoff) + ldsw + _i * 8192), 16, 0, 0); } while (0)
#define PG8_LDA(dst, b, h) do { _Pragma("unroll") for (int m = 0; m < 4; ++m) { const u32x4 lo_ = *(const PG8_LAS u32x4*)(lds + PG8_SA(b, h) + aoff + m * 2048), hi_ = *(const PG8_LAS u32x4*)(lds + PG8_SA(b, h) + aoff2 + m * 2048); struct { u32x4 a_, b_; } pr_ = {lo_, hi_}; dst[m] = __builtin_bit_cast(v8i_t, pr_); } } while (0)
#define PG8_LDB(dst, b, h) do { _Pragma("unroll") for (int n = 0; n < 2; ++n) { const u32x4 lo_ = *(const PG8_LAS u32x4*)(lds + PG8_SB(b, h) + boff + n * 2048), hi_ = *(const PG8_LAS u32x4*)(lds + PG8_SB(b, h) + boff2 + n * 2048); struct { u32x4 a_, b_; } pr_ = {lo_, hi_}; dst[n] = __builtin_bit_cast(v8i_t, pr_); } } while (0)
#define PG8_MMA(ai, bj, At, Bt) do { __builtin_amdgcn_s_setprio(1); _Pragma("unroll") for (int m = 0; m < 4; ++m) _Pragma("unroll") for (int n = 0; n < 2; ++n) \
        asm volatile("v_mfma_scale_f32_16x16x128_f8f6f4 %0, %1, %2, %0, %3, %3 op_sel:[0,1,0] op_sel_hi:[0,0,0]" : "+v"(acc[ai][bj][m][n]) : "v"(Bt[n]), "v"(At[m]), "v"(sexp_both)); __builtin_amdgcn_s_setprio(0); } while (0)
#define PG8_WAIT_V(n) asm volatile("s_waitcnt vmcnt(" #n ")" ::: "memory")
#define PG8_WAIT_L(n) asm volatile("s_waitcnt lgkmcnt(" #n ")" ::: "memory")
#define PG8_BAR __builtin_amdgcn_s_barrier()
#define PG8_SCHED __builtin_amdgcn_sched_barrier(0)
    Unit cur, nxt; int ui = 0;
    if (!S.next(0, cur)) return;
    f32x4 acc[2][2][4][2];
#pragma unroll
    for (int a = 0; a < 2; ++a)
#pragma unroll
        for (int b = 0; b < 2; ++b)
#pragma unroll
            for (int m = 0; m < 4; ++m)
#pragma unroll
                for (int n = 0; n < 2; ++n) acc[a][b][m][n] = (f32x4){0.f, 0.f, 0.f, 0.f};
    v8i_t At[4], B0[2], B1[2];
    const char* cA = (const char*)g.A + (size_t)cur.pm * tstep; const char* cB = (const char*)g.Bt + (size_t)cur.pn * tstep;
    S.a_ready(cur);
    if constexpr (SP2) {
        PG8_STAGE(PG8_SB(0, 0), cB, voffB); PG8_STAGE(PG8_SB(0, 1), cB + hstep, voffB); PG8_STAGE(PG8_SA(0, 0), cA, voffA); PG8_STAGE(PG8_SA(0, 1), cA + hstep, voffA);
        if (wr == 1) PG8_BAR;
        PG8_WAIT_V(2); PG8_BAR;
        PG8_STAGE(PG8_SB(1, 0), cB + kstep, voffB); PG8_STAGE(PG8_SA(1, 0), cA + kstep, voffA); PG8_STAGE(PG8_SB(1, 1), cB + hstep + kstep, voffB);
        PG8_WAIT_V(6); PG8_BAR;
    } else {
        PG8_STAGE(PG8_SB(0, 0), cB, voffB); PG8_STAGE(PG8_SA(0, 0), cA, voffA); PG8_STAGE(PG8_SB(0, 1), cB + hstep, voffB); PG8_STAGE(PG8_SA(0, 1), cA + hstep, voffA);
        if (wr == 1) PG8_BAR;
        PG8_WAIT_V(4); PG8_BAR;
        PG8_STAGE(PG8_SB(1, 0), cB + kstep, voffB); PG8_STAGE(PG8_SA(1, 0), cA + kstep, voffA); PG8_STAGE(PG8_SB(1, 1), cB + hstep + kstep, voffB);
        PG8_WAIT_V(6); PG8_BAR;
    }
    for (;;) {
        const bool has_next = S.next(ui + 1, nxt);
        const char* nA = has_next ? (const char*)g.A + (size_t)nxt.pm * tstep : cA; const char* nB = has_next ? (const char*)g.Bt + (size_t)nxt.pn * tstep : cB;
#pragma nounroll
        for (int t = 0; t < nt; t += 2) {
            const bool last = (t == nt - 2);
            const char* a1 = cA + (size_t)(t + 1) * kstep;
            const char* a2 = last ? nA : cA + (size_t)(t + 2) * kstep; const char* b2 = last ? nB : cB + (size_t)(t + 2) * kstep;
            const char* a3 = a2 + kstep; const char* b3 = b2 + kstep;
            if (last && has_next) S.a_ready(nxt);
            if constexpr (SP2) {
            PG8_LDB(B0, 0, 0); PG8_LDB(B1, 0, 1); PG8_SCHED; PG8_LDA(At, 0, 0); PG8_STAGE(PG8_SA(1, 1), a1 + hstep, voffA);
            PG8_WAIT_V(8); PG8_WAIT_L(0); PG8_BAR; PG8_MMA(0, 0, At, B0); PG8_MMA(0, 1, At, B1); PG8_BAR; PG8_SCHED;
            PG8_LDA(At, 0, 1); PG8_STAGE(PG8_SB(0, 0), b2, voffB); PG8_STAGE(PG8_SB(0, 1), b2 + hstep, voffB); PG8_STAGE(PG8_SA(0, 0), a2, voffA);
            PG8_WAIT_V(8); PG8_WAIT_L(0); PG8_BAR; PG8_MMA(1, 0, At, B0); PG8_MMA(1, 1, At, B1); PG8_BAR; PG8_SCHED;
            PG8_LDB(B0, 1, 0); PG8_LDB(B1, 1, 1); PG8_SCHED; PG8_LDA(At, 1, 0); PG8_STAGE(PG8_SA(0, 1), a2 + hstep, voffA);
            PG8_WAIT_V(8); PG8_WAIT_L(0); PG8_BAR; PG8_MMA(0, 0, At, B0); PG8_MMA(0, 1, At, B1); PG8_BAR; PG8_SCHED;
            PG8_LDA(At, 1, 1); PG8_STAGE(PG8_SB(1, 0), b3, voffB); PG8_STAGE(PG8_SB(1, 1), b3 + hstep, voffB); PG8_STAGE(PG8_SA(1, 0), a3, voffA);
            PG8_WAIT_V(8); PG8_WAIT_L(0); PG8_BAR; PG8_MMA(1, 0, At, B0); PG8_MMA(1, 1, At, B1); PG8_BAR; PG8_SCHED;
            } else {
            PG8_LDB(B0, 0, 0); PG8_SCHED; PG8_LDA(At, 0, 0); PG8_STAGE(PG8_SA(1, 1), a1 + hstep, voffA);
            PG8_WAIT_L(8); PG8_BAR; PG8_WAIT_L(0); PG8_MMA(0, 0, At, B0); PG8_BAR; PG8_SCHED;
            PG8_LDB(B1, 0, 1); PG8_STAGE(PG8_SB(0, 0), b2, voffB);
            PG8_BAR; PG8_WAIT_L(0); PG8_MMA(0, 1, At, B1); PG8_BAR;
            PG8_LDA(At, 0, 1); PG8_STAGE(PG8_SA(0, 0), a2, voffA);
            PG8_BAR; PG8_WAIT_L(0); PG8_MMA(1, 0, At, B0); PG8_BAR; PG8_SCHED;
            PG8_STAGE(PG8_SB(0, 1), b2 + hstep, voffB);
            PG8_WAIT_V(6); PG8_BAR; PG8_MMA(1, 1, At, B1); PG8_BAR;
            PG8_LDB(B0, 1, 0); PG8_SCHED; PG8_LDA(At, 1, 0); PG8_STAGE(PG8_SA(0, 1), a2 + hstep, voffA);
            PG8_WAIT_L(8); PG8_BAR; PG8_WAIT_L(0); PG8_MMA(0, 0, At, B0); PG8_BAR; PG8_SCHED;
            PG8_LDB(B1, 1, 1); PG8_STAGE(PG8_SB(1, 0), b3, voffB);
            PG8_BAR; PG8_WAIT_L(0); PG8_MMA(0, 1, At, B1); PG8_BAR;
            PG8_LDA(At, 1, 1); PG8_STAGE(PG8_SA(1, 0), a3, voffA);
            PG8_BAR; PG8_WAIT_L(0); PG8_MMA(1, 0, At, B0); PG8_BAR; PG8_SCHED;
            PG8_STAGE(PG8_SB(1, 1), b3 + hstep, voffB);
            PG8_WAIT_V(6); PG8_BAR; PG8_MMA(1, 1, At, B1); PG8_BAR;
            }
        }
        if constexpr (ALIGN_EPI) { if (wr == 0) PG8_BAR; }
        asm volatile("s_nop 15\n\ts_nop 15" ::: "memory");
        if constexpr (!Epi::AFTER_DRAIN) { int t2_ = tidx_(); asm volatile("" : "+v"(t2_)); const int w2_ = __builtin_amdgcn_readfirstlane(t2_ >> 6), l2_ = t2_ & 63;
            E(acc, cur, w2_ >> 2, w2_ & 3, l2_ & 15, l2_ >> 4); S.done(cur); }
        if (!has_next) break;
#pragma unroll
        for (int a = 0; a < 2; ++a)
#pragma unroll
            for (int b = 0; b < 2; ++b)
#pragma unroll
                for (int m = 0; m < 4; ++m)
#pragma unroll
                    for (int n = 0; n < 2; ++n) acc[a][b][m][n] = (f32x4){0.f, 0.f, 0.f, 0.f};
        cur = nxt; cA = nA; cB = nB; ++ui;
        if constexpr (ALIGN_EPI) { if (wr == 1) PG8_BAR; }
    }
    PG8_WAIT_V(0);
    if constexpr (!ALIGN_EPI) { if (wr == 0) PG8_BAR; }
    PG8_BAR;
    if constexpr (Epi::AFTER_DRAIN) { E.fused(acc, cur, wr, wc, fr, fq, lds, wid, lane); S.done(cur); }
#undef PG8_SA
#undef PG8_SB
#undef PG8_STAGE
#undef PG8_LDA
#undef PG8_LDB
#undef PG8_MMA
#undef PG8_WAIT_V
#undef PG8_WAIT_L
#undef PG8_BAR
#undef PG8_SCHED
}
}

constexpr int NWAVES = 8;
constexpr int BATCH = 8, T = 4096, D = 1024, M = BATCH * T;
constexpr int RW = 512, NH = 8, HD = 64;
constexpr int NZ = 2560;
constexpr int OFF_WD = 1536, OFF_AD = 1600, OFF_GD = 1664, SHIFT_COLS = 1824;
constexpr int OFF_POOL = 1824, OFF_QLAT = 2080, OFF_KVLAT = 2336, OFF_KROPE = 2464, OFF_VD = 2496;
constexpr int N_IN0 = 2496, N_IN1 = 2528;
constexpr int DFF = 2816, NEXP = 8, DFFE = 3584;
constexpr int MLA_H = 4, QK = 96, VD = 64;
constexpr int MOE_CAP = M;
constexpr int MOE_MAXTILES = (2 * M) / 256 + NEXP;

constexpr size_t MiB = 1u << 20;
constexpr size_t WS_CTL = 0, CTL_ZERO_BYTES = 1 * MiB;
constexpr size_t WS_MOD = 1 * MiB;
constexpr size_t WS_COS = 2 * MiB, WS_SIN = 4 * MiB;
constexpr size_t WS_TOK = 8 * MiB;
constexpr size_t WS_GATE = 9 * MiB;
constexpr size_t WS_ASG = 10 * MiB;
constexpr size_t WS_WIN = 16 * MiB;
constexpr size_t WS_WOUT = 26 * MiB;
constexpr size_t WS_WFFI = 30 * MiB;
constexpr size_t WS_WFFO = 41 * MiB;
constexpr size_t WS_WMI = 48 * MiB;
constexpr size_t WS_XB = 112 * MiB;
constexpr size_t WS_WMO = 188 * MiB;
constexpr size_t WS_H = 216 * MiB;
constexpr size_t WS_VF = 280 * MiB;
constexpr size_t WS_BIG = 312 * MiB;
constexpr size_t WS_Z = WS_BIG;
constexpr size_t WS_R = WS_BIG + 160 * MiB;
constexpr size_t WS_K = WS_R + 32 * MiB, WS_V = WS_R + 64 * MiB, WS_KK = WS_R + 96 * MiB, WS_A = WS_R + 128 * MiB;
constexpr size_t WS_LW = WS_R + 160 * MiB;
constexpr size_t WS_G = WS_LW + 64 * MiB;
constexpr size_t WS_QM = WS_G + 32 * MiB;
constexpr size_t WS_KM = WS_QM + 24 * MiB;
constexpr size_t WS_VM = WS_KM + 24 * MiB;
constexpr size_t WS_MIX = WS_VM + 16 * MiB;
constexpr size_t WS_MIX_END = WS_MIX + 64 * MiB;
constexpr size_t WS_ACT = WS_BIG;
constexpr size_t WS_XG = WS_VF;
constexpr size_t WS_YR = WS_VF;
constexpr size_t WS_MACT = WS_VF + 132 * MiB;
constexpr size_t WS_END = WS_MACT + 462 * MiB;
static_assert(WS_MIX_END <= 896 * MiB && WS_END <= 896 * MiB, "d_ws map");
static_assert((size_t)MOE_MAXTILES * 256 * 1024 * 2 <= 132 * MiB && (size_t)MOE_MAXTILES * 256 * 3584 * 2 <= 462 * MiB, "moe buffers");
constexpr int CW_BAR = 4096;
constexpr int CW_MOE = 16384;
constexpr int CW_ATQ = 20480;
static_assert((CW_ATQ + 128) * 4 <= (int)CTL_ZERO_BYTES, "ctl map");

constexpr int RING_OFF = 0, RING_BYTES = 131072;
constexpr int LDSCTL_OFF = RING_BYTES, MISC_OFF = LDSCTL_OFF + 320;
constexpr int LDS_BYTES = 147456;

#define GAS __attribute__((address_space(1)))
#define LAS __attribute__((address_space(3)))
typedef unsigned short bf16;
typedef unsigned v4u __attribute__((ext_vector_type(4)));
typedef unsigned v2u __attribute__((ext_vector_type(2)));
typedef float f32x4 __attribute__((ext_vector_type(4)));
typedef short bf16x8 __attribute__((ext_vector_type(8)));
typedef GAS unsigned gu32;
#define RLX_AGENT __ATOMIC_RELAXED, __HIP_MEMORY_SCOPE_AGENT
#define LDS_WAIT() asm volatile("s_waitcnt lgkmcnt(0)" ::: "memory")
#define VM_WAIT() asm volatile("s_waitcnt vmcnt(0)" ::: "memory")
__device__ __forceinline__ unsigned cvtpk(float lo, float hi) { typedef float f2_t __attribute__((ext_vector_type(2))); typedef __bf16 b2_t __attribute__((ext_vector_type(2)));
    f2_t v = {lo, hi}; b2_t b = __builtin_convertvector(v, b2_t); return __builtin_bit_cast(unsigned, b); }
__device__ __forceinline__ unsigned f2bf(float f) { return cvtpk(f, f) & 0xffffu; }
__device__ __forceinline__ unsigned pk2(float lo, float hi) { return cvtpk(lo, hi); }
__device__ __forceinline__ float bf2f(bf16 v) { return __uint_as_float(((unsigned)v) << 16); }
__device__ __forceinline__ float bflo(unsigned w) { return __uint_as_float(w << 16); }
__device__ __forceinline__ float bfhi(unsigned w) { return __uint_as_float(w & 0xffff0000u); }
__device__ __forceinline__ unsigned f8pk2(float a, float b) { a = fminf(fmaxf(a, -448.f), 448.f); b = fminf(fmaxf(b, -448.f), 448.f); return (unsigned)__builtin_amdgcn_cvt_pk_fp8_f32(a, b, 0, false) & 0xffffu; }
__device__ __forceinline__ unsigned f8pk4(float a, float b, float c_, float d) { a = fminf(fmaxf(a, -448.f), 448.f); b = fminf(fmaxf(b, -448.f), 448.f); c_ = fminf(fmaxf(c_, -448.f), 448.f); d = fminf(fmaxf(d, -448.f), 448.f);
    int w = __builtin_amdgcn_cvt_pk_fp8_f32(a, b, 0, false); w = __builtin_amdgcn_cvt_pk_fp8_f32(c_, d, w, true); return (unsigned)w; }
constexpr float F8_WSCALE = 64.f, F8_HSCALE = 8.f, F8_ASCALE = 4.f;
constexpr int F8_WEXP = 127 - 6, F8_HEXP = 127 - 3, F8_AEXP = 127 - 2;
__device__ __forceinline__ float sigmoidf_(float x) { return __builtin_amdgcn_rcpf(1.f + __expf(-x)); }
__device__ __forceinline__ float tanhf_(float x) { const float e = __expf(2.f * x); return 1.f - 2.f * __builtin_amdgcn_rcpf(1.f + e); }
__device__ __forceinline__ float half_sum32(float v) {
    v += __int_as_float(__builtin_amdgcn_mov_dpp(__float_as_int(v), 0xB1, 0xF, 0xF, true));
    v += __int_as_float(__builtin_amdgcn_mov_dpp(__float_as_int(v), 0x4E, 0xF, 0xF, true));
    v += __int_as_float(__builtin_amdgcn_mov_dpp(__float_as_int(v), 0x141, 0xF, 0xF, true));
    v += __int_as_float(__builtin_amdgcn_mov_dpp(__float_as_int(v), 0x140, 0xF, 0xF, true));
    v += __int_as_float(__builtin_amdgcn_ds_swizzle(__float_as_int(v), 0x401F));
    return v;
}
__device__ __forceinline__ float other_half(float v) { const unsigned u = __float_as_uint(v); auto rr = __builtin_amdgcn_permlane32_swap(u, u, false, false); return __uint_as_float(rr[0] == u ? rr[1] : rr[0]); }
__device__ __forceinline__ float wave_sum(float v) { v = half_sum32(v); const unsigned u = __float_as_uint(v); auto rr = __builtin_amdgcn_permlane32_swap(u, u, false, false); return __uint_as_float(rr[0]) + __uint_as_float(rr[1]); }

__device__ __forceinline__ void st_put(LAS unsigned char* ST, int i, int col, float v) { *(LAS bf16*)(ST + i * 256 + col * 2) = (bf16)f2bf(v); }
template <int NCOLS> __device__ __forceinline__ void st_flush(LAS unsigned char* ST, bf16* gbase, int rowstride, int lane, bool dry) {
    constexpr int CPR = NCOLS / 8, TOTAL = 32 * CPR;
    LDS_WAIT();
#pragma unroll
    for (int k = 0; k < (TOTAL + 63) / 64; ++k) { const int c = lane + 64 * k;
        if (c < TOTAL) { const int row = c / CPR, ch = c % CPR; const v4u v = *(const LAS v4u*)(ST + row * 256 + ch * 16); if (!dry) *(v4u*)(gbase + (unsigned)(row * rowstride + ch * 8)) = v; } }
    LDS_WAIT();
}
__device__ __forceinline__ void st_flush_kimg(LAS unsigned char* ST, bf16* gtile, int lane, bool dry) {
    LDS_WAIT();
#pragma unroll
    for (int k = 0; k < 6; ++k) { const int c = (lane & 63) + 64 * k; const int ch = c >> 5, row = c & 31;
        const v4u v = *(const LAS v4u*)(ST + row * 256 + ch * 16); if (!dry) *(v4u*)(gtile + (unsigned)(ch * 512 + row * 8)) = v; }
    LDS_WAIT();
}
__device__ __forceinline__ int fresh_lane() { return lane_id_(); }
__device__ __forceinline__ float rsq_(float x) { return __builtin_amdgcn_rsqf(x); }
__device__ __forceinline__ float rcp_(float x) { return __builtin_amdgcn_rcpf(x); }
#define XB_TMO      128
#define XB_XCNT(j)  (256  + 64 * (j))
#define XB_XSUB(j)  (1280 + 64 * (j))
#define XB_XGEN(j)  (2304 + 64 * (j))
#define XB_TOP      3328
#define XB_TOPGEN   3392
#define XCD_BAR_WORDS 3456
#define XB_SPIN_CAP (1u << 18)
__device__ __forceinline__ unsigned xb_ld(unsigned* p)              { return __hip_atomic_load(p, __ATOMIC_RELAXED, __HIP_MEMORY_SCOPE_AGENT); }
__device__ __forceinline__ unsigned xb_add(unsigned* p, unsigned v) { return __hip_atomic_fetch_add(p, v, __ATOMIC_RELAXED, __HIP_MEMORY_SCOPE_AGENT); }
__device__ __forceinline__ unsigned xb_xcc_id() { return (unsigned)__builtin_amdgcn_s_getreg((3 << 11) | 20) & 0xFu; }
#define XB_SPIN(cond, bar) do { unsigned _sp = 0; while (cond) { __builtin_amdgcn_s_sleep(1); \
    if ((++_sp & 255u) == 0u) { if (xb_ld(&(bar)[XB_TMO])) break; if (_sp > XB_SPIN_CAP) { atomicAdd(&(bar)[XB_TMO], 1u); break; } } } } while (0)
struct XcdBarrier { unsigned* bar; unsigned x; volatile LAS unsigned* st; };
__device__ __forceinline__ XcdBarrier xcd_barrier_post(unsigned* bar, volatile LAS unsigned* st) {
    XcdBarrier b; b.bar = bar; b.x = xb_xcc_id(); b.st = st;
    if (tidx_() == 0) (void)xb_add(&bar[XB_XCNT(b.x)], 1u);
    return b;
}
__device__ __forceinline__ void xcd_barrier_complete(unsigned* bar, unsigned x, unsigned& nloc, unsigned& nx) {
    const unsigned G = gridDim.x * gridDim.y * gridDim.z;
    unsigned sum, cnt, mine, sp = 0u;
    for (;;) {
        sum = 0u; cnt = 0u; mine = 0u;
#pragma unroll
        for (unsigned j = 0; j < 16; ++j) { const unsigned c = xb_ld(&bar[XB_XCNT(j)]); sum += c; cnt += (c > 0u) ? 1u : 0u; mine = (j == x) ? c : mine; }
        if (sum == G) break;
        __builtin_amdgcn_s_sleep(1);
        if ((++sp & 255u) == 0u) { if (xb_ld(&bar[XB_TMO])) break; if (sp > XB_SPIN_CAP) { atomicAdd(&bar[XB_TMO], 1u); break; } }
    }
    nloc = mine > 0u ? mine : 1u; nx = cnt > 0u ? cnt : 1u;
}
__device__ __forceinline__ void xcd_barrier(const XcdBarrier& b) {
    asm volatile("s_waitcnt vmcnt(0)" ::: "memory");
    __syncthreads();
    if (tidx_() == 0) {
        unsigned* bar = b.bar;
        __builtin_amdgcn_s_waitcnt(0);
        unsigned nloc = b.st[0], nx = b.st[1];
        if (nloc == 0u) { xcd_barrier_complete(bar, b.x, nloc, nx); b.st[0] = nloc; b.st[1] = nx; }
        const unsigned old = xb_add(&bar[XB_XSUB(b.x)], 1u);
        const unsigned gen = old / nloc;
        if (old + 1u == (gen + 1u) * nloc) {
            __builtin_amdgcn_fence(__ATOMIC_RELEASE, "agent");
            asm volatile("s_waitcnt vmcnt(0)" ::: "memory");
            const unsigned og = xb_add(&bar[XB_TOP], 1u);
            const unsigned tg = og / nx;
            if (og + 1u == (tg + 1u) * nx) xb_add(&bar[XB_TOPGEN], 1u);
            else XB_SPIN(xb_ld(&bar[XB_TOPGEN]) == tg, bar);
            __builtin_amdgcn_fence(__ATOMIC_ACQUIRE, "agent");
            xb_add(&bar[XB_XGEN(b.x)], 1u);
            asm volatile("s_waitcnt vmcnt(0)" ::: "memory");
        } else {
            XB_SPIN(xb_ld(&bar[XB_XGEN(b.x)]) == gen, bar);
            __builtin_amdgcn_fence(__ATOMIC_ACQUIRE, "agent");
            asm volatile("s_waitcnt vmcnt(0)" ::: "memory");
        }
    }
    __syncthreads();
}

struct Args { const float* in[29]; float* out; unsigned char* ws; int ph_lo, ph_hi, li, pad; };
static_assert(sizeof(Args) == 29 * 8 + 8 + 8 + 16, "Args has no padding");
enum { I_X = 0, I_C, I_POS, I_WADA, I_BADA, I_NGAIN, I_WIN0, I_WIN1, I_MU, I_MUV, I_RVEC, I_RV0, I_RW2, I_RA2, I_RG2, I_RV2, I_POOLW, I_POOLS,
       I_QLG, I_KVLG, I_WQUP, I_WKVUP, I_QKG, I_WOUT, I_FFI, I_FFO, I_ROUTER, I_MOEI, I_MOEO };

namespace pg8 {
struct EpiRes {
    static constexpr bool PERM = false, AFTER_DRAIN = false;
    const float* xsrc; float* out; const float* gate;
    __device__ __forceinline__ void operator()(const f32x4 (&acc)[2][2][4][2], const Unit& u, int wr, int wc, int fr, int fq) const {
        const int row0 = u.pm * BM + wr * 64 + fr, col0 = u.pn * BM + wc * 32 + 4 * fq;
        const float* gb = gate + (size_t)((u.pm * BM) / T) * 6144;
        f32x4 gv[2][2];
#pragma unroll
        for (int bj = 0; bj < 2; ++bj)
#pragma unroll
            for (int n = 0; n < 2; ++n) gv[bj][n] = *(const f32x4*)(gb + col0 + bj * HALF + n * 16);
        f32x4 xs[2][2], xn[2][2];
        { const size_t off = (size_t)row0 * 1024 + col0;
#pragma unroll
          for (int bj = 0; bj < 2; ++bj)
#pragma unroll
              for (int n = 0; n < 2; ++n) xs[bj][n] = *(const f32x4*)(xsrc + off + bj * HALF + n * 16); }
#pragma unroll
        for (int g = 0; g < 8; ++g) { const int ai = g >> 2, m = g & 3;
            const size_t off = (size_t)(row0 + ai * HALF + m * 16) * 1024 + col0;
            if (g + 1 < 8) { const size_t offn = (size_t)(row0 + ((g + 1) >> 2) * HALF + ((g + 1) & 3) * 16) * 1024 + col0;
#pragma unroll
                for (int bj = 0; bj < 2; ++bj)
#pragma unroll
                    for (int n = 0; n < 2; ++n) xn[bj][n] = *(const f32x4*)(xsrc + offn + bj * HALF + n * 16); }
#pragma unroll
            for (int bj = 0; bj < 2; ++bj)
#pragma unroll
                for (int n = 0; n < 2; ++n) *(f32x4*)(out + off + bj * HALF + n * 16) = xs[bj][n] + gv[bj][n] * acc[ai][bj][m][n];
#pragma unroll
            for (int bj = 0; bj < 2; ++bj)
#pragma unroll
                for (int n = 0; n < 2; ++n) xs[bj][n] = xn[bj][n];
        }
    }
};
template <bool XF32> struct EpiResB {
    static constexpr bool PERM = true, AFTER_DRAIN = false;
    const void* xsrc; bf16_t* out; const float* gate;
    __device__ __forceinline__ void ldx(f32x4 (&d)[2][2], size_t off) const {
#pragma unroll
        for (int bj = 0; bj < 2; ++bj) {
            if constexpr (XF32) { d[bj][0] = *(const f32x4*)((const float*)xsrc + off + bj * HALF); d[bj][1] = *(const f32x4*)((const float*)xsrc + off + bj * HALF + 4); }
            else { const u32x4 r = *(const u32x4*)((const bf16_t*)xsrc + off + bj * HALF);
                   d[bj][0] = (f32x4){bflo(r.x), bfhi(r.x), bflo(r.y), bfhi(r.y)}; d[bj][1] = (f32x4){bflo(r.z), bfhi(r.z), bflo(r.w), bfhi(r.w)}; } }
    }
    __device__ __forceinline__ void operator()(const f32x4 (&acc)[2][2][4][2], const Unit& u, int wr, int wc, int fr, int fq) const {
        const int row0 = u.pm * BM + wr * 64 + fr, col0 = u.pn * BM + wc * 32 + 8 * fq;
        const float* gb = gate + (size_t)((u.pm * BM) / T) * 6144;
        f32x4 gv[2][2];
#pragma unroll
        for (int bj = 0; bj < 2; ++bj)
#pragma unroll
            for (int n = 0; n < 2; ++n) gv[bj][n] = *(const f32x4*)(gb + col0 + bj * HALF + 4 * n);
        f32x4 xs[2][2], xn[2][2];
        ldx(xs, (size_t)row0 * 1024 + col0);
#pragma unroll
        for (int g = 0; g < 8; ++g) { const int ai = g >> 2, m = g & 3;
            const size_t off = (size_t)(row0 + ai * HALF + m * 16) * 1024 + col0;
            if (g + 1 < 8) ldx(xn, (size_t)(row0 + ((g + 1) >> 2) * HALF + ((g + 1) & 3) * 16) * 1024 + col0);
#pragma unroll
            for (int bj = 0; bj < 2; ++bj) { const f32x4 y0 = xs[bj][0] + gv[bj][0] * acc[ai][bj][m][0], y1 = xs[bj][1] + gv[bj][1] * acc[ai][bj][m][1];
                u32x4 w; w.x = cvt_pk_bf16(y0[0], y0[1]); w.y = cvt_pk_bf16(y0[2], y0[3]); w.z = cvt_pk_bf16(y1[0], y1[1]); w.w = cvt_pk_bf16(y1[2], y1[3]);
                *(u32x4*)(out + off + bj * HALF) = w; }
#pragma unroll
            for (int bj = 0; bj < 2; ++bj)
#pragma unroll
                for (int n = 0; n < 2; ++n) xs[bj][n] = xn[bj][n];
        }
    }
};
struct EpiSwiglu {
    static constexpr bool PERM = true, AFTER_DRAIN = false;
    bf16_t* O; int ldo; int npn;
    __device__ __forceinline__ void operator()(const f32x4 (&acc)[2][2][4][2], const Unit& u, int wr, int wc, int fr, int fq) const {
        const int row0 = u.pm * BM + wr * 64 + fr, col0 = (u.pn % npn) * HALF + wc * 32 + 8 * fq;
#pragma unroll
        for (int ai = 0; ai < 2; ++ai)
#pragma unroll
            for (int m = 0; m < 4; ++m) { bf16_t* rowp = O + (size_t)(row0 + ai * HALF + m * 16) * ldo + col0;
                float o[8];
#pragma unroll
                for (int n = 0; n < 2; ++n)
#pragma unroll
                    for (int j = 0; j < 4; ++j) { const float g = acc[ai][0][m][n][j], uu = acc[ai][1][m][n][j]; o[n * 4 + j] = g * __builtin_amdgcn_rcpf(1.f + __expf(-g)) * uu; }
                u32x4 w; w.x = cvt_pk_bf16(o[0], o[1]); w.y = cvt_pk_bf16(o[2], o[3]); w.z = cvt_pk_bf16(o[4], o[5]); w.w = cvt_pk_bf16(o[6], o[7]);
                *(u32x4*)rowp = w; }
    }
};
struct EpiSwigluF8 {
    static constexpr bool PERM = true, AFTER_DRAIN = false;
    unsigned char* O; int ldo; int npn;
    __device__ __forceinline__ void operator()(const f32x4 (&acc)[2][2][4][2], const Unit& u, int wr, int wc, int fr, int fq) const {
        const int row0 = u.pm * BM + wr * 64 + fr, col0 = (u.pn % npn) * HALF + wc * 32 + 8 * fq;
#pragma unroll
        for (int ai = 0; ai < 2; ++ai)
#pragma unroll
            for (int m = 0; m < 4; ++m) { unsigned char* rowp = O + (size_t)(row0 + ai * HALF + m * 16) * ldo + col0;
                float o[8];
#pragma unroll
                for (int n = 0; n < 2; ++n)
#pragma unroll
                    for (int j = 0; j < 4; ++j) { const float g = acc[ai][0][m][n][j], uu = acc[ai][1][m][n][j]; o[n * 4 + j] = g * __builtin_amdgcn_rcpf(1.f + __expf(-g)) * uu * F8_ASCALE; }
                v2u w; w.x = f8pk4(o[0], o[1], o[2], o[3]); w.y = f8pk4(o[4], o[5], o[6], o[7]);
                asm volatile("" : "+v"(w.x), "+v"(w.y));
                *(v2u*)rowp = w; }
    }
};
struct EpiMoeOut {
    static constexpr bool PERM = true, AFTER_DRAIN = false;
    bf16_t* O;
    __device__ __forceinline__ void operator()(const f32x4 (&acc)[2][2][4][2], const Unit& u, int wr, int wc, int fr, int fq) const {
        const int row0 = u.pm * BM + wr * 64 + fr, col0 = (u.pn & 3) * BM + wc * 32 + 8 * fq;
#pragma unroll
        for (int ai = 0; ai < 2; ++ai)
#pragma unroll
            for (int m = 0; m < 4; ++m) { bf16_t* rowp = O + (size_t)(row0 + ai * HALF + m * 16) * 1024 + col0;
#pragma unroll
                for (int bj = 0; bj < 2; ++bj) { const f32x4 v0 = acc[ai][bj][m][0], v1 = acc[ai][bj][m][1];
                    u32x4 w; w.x = cvt_pk_bf16(v0[0], v0[1]); w.y = cvt_pk_bf16(v0[2], v0[3]); w.z = cvt_pk_bf16(v1[0], v1[1]); w.w = cvt_pk_bf16(v1[2], v1[3]);
                    *(u32x4*)(rowp + bj * HALF) = w; } }
    }
};
struct MoeOrder {
    int npn, nunits, G, c; int ts1, ts2, ts3, ts4, ts5, ts6, ts7;
    __device__ __forceinline__ bool next(int i, Unit& u) const {
        const int s = (c & 7) * (G >> 3) + (c >> 3);
        const int L = i * G + s; if (L >= nunits) return false;
        const int nrt = nunits / npn, nig = 8 * npn, gid = L / nig, fm = gid * 8, gsz = (nrt - fm) < 8 ? (nrt - fm) : 8, r = L % nig;
        const int rt = fm + r % gsz, pl = r / gsz;
        const int e = (rt >= ts1) + (rt >= ts2) + (rt >= ts3) + (rt >= ts4) + (rt >= ts5) + (rt >= ts6) + (rt >= ts7);
        u.pm = rt; u.pn = e * npn + pl; return true;
    }
    __device__ __forceinline__ void a_ready(const Unit&) const {}
    __device__ __forceinline__ void done(const Unit&) const {}
};
}

typedef float f32x16 __attribute__((ext_vector_type(16)));
constexpr int CHK = 32, NCHK = T / CHK;
constexpr size_t WS_SM = WS_R;
constexpr size_t WS_SNT = WS_R + 64 * MiB;
constexpr size_t WS_SRP = WS_R + 128 * MiB;
constexpr size_t WS_SYL = WS_H;
constexpr size_t WS_XV = WS_H + 32 * MiB;
constexpr size_t WS_BON = WS_MIX_END;
static_assert(WS_BON + 1 * MiB <= 896 * MiB, "ws");

__device__ __forceinline__ bf16x8 mkfrag(unsigned a, unsigned b, unsigned c, unsigned d) { v4u w = {a, b, c, d}; return __builtin_bit_cast(bf16x8, w); }
__device__ __forceinline__ bf16x8 accfrag(const f32x16& a, int s2) {
    return s2 == 0 ? mkfrag(cvtpk(a[0], a[1]), cvtpk(a[2], a[3]), cvtpk(a[4], a[5]), cvtpk(a[6], a[7]))
                   : mkfrag(cvtpk(a[8], a[9]), cvtpk(a[10], a[11]), cvtpk(a[12], a[13]), cvtpk(a[14], a[15]));
}
#define MFMA32(A, B, C) __builtin_amdgcn_mfma_f32_32x32x16_bf16((A), (B), (C), 0, 0, 0)
__device__ __forceinline__ int tm_addr(int row, int chunk) { return row * 128 + ((chunk ^ ((row >> 1) & 7)) << 4); }
__device__ __forceinline__ int cm_addr(int row, int chunk) { return row * 64 + ((chunk ^ ((row >> 2) & 3)) << 4); }
__device__ __forceinline__ int qrow(int r, int h) { return (r & 3) + 8 * (r >> 2) + 4 * h; }

template <int MODE>
__device__ __forceinline__ void scan_pass(const bf16* Rg, const bf16* Kg, const bf16* Vg, const bf16* KKg, const bf16* Ag, const float* LWg, size_t base,
                                          LAS unsigned char* L, LAS float* gC, int lane) {
    float cum = 0.f;
    if constexpr (MODE == 0) {
#pragma unroll 8
        for (int t = 0; t < CHK; ++t) {
            const size_t o = base + (size_t)t * RW + lane;
            const float kk = bf2f(KKg[o]), a = bf2f(Ag[o]), k = bf2f(Kg[o]), r = bf2f(Rg[o]), lw = LWg[o];
            const float cumx = cum; cum += lw;
            const float ea = __expf(cumx), eb = __expf(-cum), er = __expf(cum);
            const int ad = tm_addr(t, lane >> 3) + (lane & 7) * 2;
            *(LAS bf16*)(L + ad) = (bf16)f2bf(-kk * ea);
            *(LAS bf16*)(L + 4096 + ad) = (bf16)f2bf(kk * a * eb);
            *(LAS bf16*)(L + 8192 + ad) = (bf16)f2bf(k * eb);
            *(LAS bf16*)(L + 12288 + ad) = (bf16)f2bf(r * er);
        }
        gC[lane] = __expf(cum);
    } else {
#pragma unroll
        for (int s2 = 0; s2 < 2; ++s2) {
            float xa[16], xv[16], xb[16], xk[16];
#pragma unroll
            for (int u = 0; u < 16; ++u) {
                const size_t o = base + (size_t)(s2 * 16 + u) * RW + lane;
                const float kk = bf2f(KKg[o]), a = bf2f(Ag[o]), k = bf2f(Kg[o]), v = bf2f(Vg[o]), lw = LWg[o];
                const float cumx = cum; cum += lw;
                const float ea = __expf(cumx), eb = __expf(-cum);
                xa[u] = -kk * ea; xv[u] = v; xb[u] = kk * a * eb; xk[u] = k * eb;
            }
#pragma unroll
            for (int h = 0; h < 2; ++h) {
                const int ad = cm_addr(lane, 2 * s2 + h); const int u0 = 4 * h, u1 = 8 + 4 * h;
                *(LAS v4u*)(L + ad) = (v4u){cvtpk(xa[u0], xa[u0 + 1]), cvtpk(xa[u0 + 2], xa[u0 + 3]), cvtpk(xa[u1], xa[u1 + 1]), cvtpk(xa[u1 + 2], xa[u1 + 3])};
                *(LAS v4u*)(L + 4096 + ad) = (v4u){cvtpk(xv[u0], xv[u0 + 1]), cvtpk(xv[u0 + 2], xv[u0 + 3]), cvtpk(xv[u1], xv[u1 + 1]), cvtpk(xv[u1 + 2], xv[u1 + 3])};
                *(LAS v4u*)(L + 8192 + ad) = (v4u){cvtpk(xb[u0], xb[u0 + 1]), cvtpk(xb[u0 + 2], xb[u0 + 3]), cvtpk(xb[u1], xb[u1 + 1]), cvtpk(xb[u1 + 2], xb[u1 + 3])};
                *(LAS v4u*)(L + 12288 + ad) = (v4u){cvtpk(xk[u0], xk[u0 + 1]), cvtpk(xk[u0 + 2], xk[u0 + 3]), cvtpk(xk[u1], xk[u1 + 1]), cvtpk(xk[u1 + 2], xk[u1 + 3])};
            }
        }
    }
}

__device__ __forceinline__ void scan_local_item(unsigned char* ws, int item, LAS unsigned char* L, LAS float* gC, int lane) {
    const int hh = item % NH, bn = item / NH;
    const size_t base = (size_t)bn * CHK * RW + hh * 64;
    const bf16* Rg = (const bf16*)(ws + WS_R); const bf16* Kg = (const bf16*)(ws + WS_K); const bf16* Vg = (const bf16*)(ws + WS_V); const bf16* KKg = (const bf16*)(ws + WS_KK); const bf16* Ag = (const bf16*)(ws + WS_A);
    const float* LWg = (const float*)(ws + WS_LW);
    const int p = lane & 31, h = lane >> 5;
    const f32x16 zero16 = {0.f, 0.f, 0.f, 0.f, 0.f, 0.f, 0.f, 0.f, 0.f, 0.f, 0.f, 0.f, 0.f, 0.f, 0.f, 0.f};
    LDS_WAIT();
    scan_pass<0>(Rg, Kg, Vg, KKg, Ag, LWg, base, L, gC, lane);
    LDS_WAIT();
    f32x16 Aab = zero16, AabT = zero16, Aak = zero16, Arb = zero16, Ark = zero16;
#pragma unroll
    for (int s = 0; s < 4; ++s) {
        const int ad = tm_addr(p, 2 * s + h);
        const bf16x8 fa = *(const LAS bf16x8*)(L + ad), fb = *(const LAS bf16x8*)(L + 4096 + ad), fk = *(const LAS bf16x8*)(L + 8192 + ad), fr = *(const LAS bf16x8*)(L + 12288 + ad);
        Aab = MFMA32(fb, fa, Aab); AabT = MFMA32(fa, fb, AabT); Aak = MFMA32(fk, fa, Aak); Arb = MFMA32(fb, fr, Arb); Ark = MFMA32(fk, fr, Ark);
    }
    unsigned rin[2][8];
#pragma unroll
    for (int ct = 0; ct < 2; ++ct)
#pragma unroll
        for (int g = 0; g < 4; ++g) { const v2u w = *(const LAS v2u*)(L + 12288 + tm_addr(p, 4 * ct + g) + 8 * h); rin[ct][2 * g] = w.x; rin[ct][2 * g + 1] = w.y; }
#pragma unroll
    for (int r = 0; r < 16; ++r) { const int q = qrow(r, h);
        Aab[r] = (q < p) ? Aab[r] : 0.f;  Aak[r] = (q < p) ? Aak[r] : 0.f;
        AabT[r] = (p < q) ? AabT[r] : 0.f;
        Arb[r] = (q <= p) ? Arb[r] : 0.f; Ark[r] = (q <= p) ? Ark[r] : 0.f; }
    f32x16 Tm = Aab;
#pragma unroll
    for (int r = 0; r < 16; ++r) Tm[r] += (qrow(r, h) == p) ? 1.f : 0.f;
    bf16x8 X0 = accfrag(Aab, 0), X1 = accfrag(Aab, 1), XT0 = accfrag(AabT, 0), XT1 = accfrag(AabT, 1);
#pragma unroll
    for (int it = 0; it < 4; ++it) {
        f32x16 X2T = MFMA32(X0, XT0, zero16); X2T = MFMA32(X1, XT1, X2T);
        const bf16x8 T0 = accfrag(Tm, 0), T1 = accfrag(Tm, 1);
        const bf16x8 Y0 = accfrag(X2T, 0), Y1 = accfrag(X2T, 1);
        Tm = MFMA32(Y0, T0, Tm); Tm = MFMA32(Y1, T1, Tm);
        if (it < 3) { f32x16 X2 = MFMA32(XT0, X0, zero16); X2 = MFMA32(XT1, X1, X2);
            X0 = accfrag(X2, 0); X1 = accfrag(X2, 1); XT0 = Y0; XT1 = Y1; }
    }
    const bf16x8 Tf0 = accfrag(Tm, 0), Tf1 = accfrag(Tm, 1);
    const bf16x8 Akf0 = accfrag(Aak, 0), Akf1 = accfrag(Aak, 1), Abf0 = accfrag(Arb, 0), Abf1 = accfrag(Arb, 1), Arf0 = accfrag(Ark, 0), Arf1 = accfrag(Ark, 1);
    LDS_WAIT();
    scan_pass<1>(Rg, Kg, Vg, KKg, Ag, LWg, base, L, gC, lane);
    LDS_WAIT();
    bf16x8 fAT[2][2], fVT[2][2], fBT[2][2], fKT[2][2];
#pragma unroll
    for (int ct = 0; ct < 2; ++ct)
#pragma unroll
        for (int s2 = 0; s2 < 2; ++s2) { const int ad = cm_addr(32 * ct + p, 2 * s2 + h);
            fAT[ct][s2] = *(const LAS bf16x8*)(L + ad); fVT[ct][s2] = *(const LAS bf16x8*)(L + 4096 + ad); fBT[ct][s2] = *(const LAS bf16x8*)(L + 8192 + ad); fKT[ct][s2] = *(const LAS bf16x8*)(L + 12288 + ad); }
    bf16x8 fPT[2][2], fQT[2][2];
#pragma unroll
    for (int ct = 0; ct < 2; ++ct) {
        f32x16 a = MFMA32(Tf0, fAT[ct][0], zero16); a = MFMA32(Tf1, fAT[ct][1], a); fPT[ct][0] = accfrag(a, 0); fPT[ct][1] = accfrag(a, 1);
        f32x16 b = MFMA32(Akf0, fVT[ct][0], zero16); b = MFMA32(Akf1, fVT[ct][1], b);
        const bf16x8 av0 = accfrag(b, 0), av1 = accfrag(b, 1);
        f32x16 c = MFMA32(Tf0, av0, zero16); c = MFMA32(Tf1, av1, c); fQT[ct][0] = accfrag(c, 0); fQT[ct][1] = accfrag(c, 1);
    }
    bf16* RPo = (bf16*)(ws + WS_SRP) + (size_t)item * 2048; bf16* YLo = (bf16*)(ws + WS_SYL) + (size_t)item * 2048;
    bf16* Mo = (bf16*)(ws + WS_SM) + (size_t)item * 4096; bf16* NTo = (bf16*)(ws + WS_SNT) + (size_t)item * 4096;
#pragma unroll
    for (int ct = 0; ct < 2; ++ct) {
        f32x16 a;
#pragma unroll
        for (int g = 0; g < 8; ++g) { a[2 * g] = bflo(rin[ct][g]); a[2 * g + 1] = bfhi(rin[ct][g]); }
        a = MFMA32(fPT[ct][0], Abf0, a); a = MFMA32(fPT[ct][1], Abf1, a);
#pragma unroll
        for (int s2 = 0; s2 < 2; ++s2) *(bf16x8*)(RPo + p * 64 + (4 * ct + 2 * s2 + h) * 8) = accfrag(a, s2);
        f32x16 y = MFMA32(Abf0, fQT[ct][0], zero16); y = MFMA32(Abf1, fQT[ct][1], y); y = MFMA32(Arf0, fVT[ct][0], y); y = MFMA32(Arf1, fVT[ct][1], y);
#pragma unroll
        for (int s2 = 0; s2 < 2; ++s2) *(bf16x8*)(YLo + (32 * ct + p) * 32 + (2 * s2 + h) * 8) = accfrag(y, s2);
    }
#pragma unroll
    for (int ctp = 0; ctp < 2; ++ctp) {
        const float gl = gC[32 * ctp + p];
#pragma unroll
        for (int ct = 0; ct < 2; ++ct) {
            f32x16 m = MFMA32(fPT[ct][0], fBT[ctp][0], zero16); m = MFMA32(fPT[ct][1], fBT[ctp][1], m);
#pragma unroll
            for (int r = 0; r < 16; ++r) m[r] = (m[r] + ((ct == ctp && qrow(r, h) == p) ? 1.f : 0.f)) * gl;
#pragma unroll
            for (int s2 = 0; s2 < 2; ++s2) *(bf16x8*)(Mo + (32 * ctp + p) * 64 + (4 * ct + 2 * s2 + h) * 8) = accfrag(m, s2);
        }
    }
#pragma unroll
    for (int ctd = 0; ctd < 2; ++ctd)
#pragma unroll
        for (int ctp = 0; ctp < 2; ++ctp) {
            f32x16 n = MFMA32(fBT[ctp][0], fQT[ctd][0], zero16); n = MFMA32(fBT[ctp][1], fQT[ctd][1], n); n = MFMA32(fKT[ctp][0], fVT[ctd][0], n); n = MFMA32(fKT[ctp][1], fVT[ctd][1], n);
#pragma unroll
            for (int r = 0; r < 16; ++r) n[r] *= gC[32 * ctp + qrow(r, h)];
#pragma unroll
            for (int s2 = 0; s2 < 2; ++s2) *(bf16x8*)(NTo + (32 * ctd + p) * 64 + (4 * ctp + 2 * s2 + h) * 8) = accfrag(n, s2);
        }
}

__device__ __forceinline__ void ph_scan_local(unsigned char* ws, LAS unsigned char* lds, int gw, int NGW, int wave, int lane) {
    LAS unsigned char* L = lds + RING_OFF + wave * 16384;
    LAS float* gC = (LAS float*)(lds + LDSCTL_OFF + 4096) + wave * 64;
    for (int item = gw; item < BATCH * NCHK * NH; item += NGW) scan_local_item(ws, item, L, gC, lane);
}

__device__ __forceinline__ f32x16 ld_acc_bf16(const bf16* p0, const bf16* p1) {
    const v4u a = *(const v4u*)p0, b = *(const v4u*)p1; f32x16 r;
    r[0] = bflo(a.x); r[1] = bfhi(a.x); r[2] = bflo(a.y); r[3] = bfhi(a.y); r[4] = bflo(a.z); r[5] = bfhi(a.z); r[6] = bflo(a.w); r[7] = bfhi(a.w);
    r[8] = bflo(b.x); r[9] = bfhi(b.x); r[10] = bflo(b.y); r[11] = bfhi(b.y); r[12] = bflo(b.z); r[13] = bfhi(b.z); r[14] = bflo(b.w); r[15] = bfhi(b.w); return r;
}
constexpr size_t WS_SS = WS_LW;
__device__ __forceinline__ void scan_carry(unsigned char* ws, int bh, int ctd, int lane) {
    const int b = bh / NH, hh = bh % NH; const int p = lane & 31, h = lane >> 5;
    const bf16* Mb = (const bf16*)(ws + WS_SM); const bf16* NTb = (const bf16*)(ws + WS_SNT); bf16* Sg = (bf16*)(ws + WS_SS);
    const f32x16 zero16 = {0.f, 0.f, 0.f, 0.f, 0.f, 0.f, 0.f, 0.f, 0.f, 0.f, 0.f, 0.f, 0.f, 0.f, 0.f, 0.f};
    f32x16 S[2] = {zero16, zero16};
    v4u m0[2][4], n0[2][2], m1[2][4], n1[2][2], m2[2][4], n2[2][2];
#define CARRY_LOAD(MQ, NQ, nn) do { const int nc_ = (nn) < NCHK ? (nn) : NCHK - 1; const size_t it_ = (size_t)(b * NCHK + nc_) * NH + hh; const bf16* Mi_ = Mb + it_ * 4096; const bf16* NTi_ = NTb + it_ * 4096 + ctd * 2048; \
      _Pragma("unroll") for (int ctp = 0; ctp < 2; ++ctp) _Pragma("unroll") for (int s4 = 0; s4 < 4; ++s4) MQ[ctp][s4] = *(const v4u*)(Mi_ + ((4 * ctp + s4) * 64 + (lane & 63)) * 8); \
      _Pragma("unroll") for (int ctp = 0; ctp < 2; ++ctp) _Pragma("unroll") for (int s2 = 0; s2 < 2; ++s2) NQ[ctp][s2] = *(const v4u*)(NTi_ + ((2 * ctp + s2) * 64 + (lane & 63)) * 8); } while (0)
#define CARRY_STEP(nn, MC, NC, MQ2, NQ2) do { \
      CARRY_LOAD(MQ2, NQ2, (nn) + 2); \
      bf16* Si_ = Sg + ((size_t)(b * NCHK + (nn)) * NH + hh) * 4096 + ctd * 2048; bf16x8 Sf[4]; \
      _Pragma("unroll") for (int s4 = 0; s4 < 4; ++s4) { Sf[s4] = accfrag(S[s4 >> 1], s4 & 1); *(bf16x8*)(Si_ + (s4 * 64 + (lane & 63)) * 8) = Sf[s4]; } \
      _Pragma("unroll") for (int ctp = 0; ctp < 2; ++ctp) { const v4u x = NC[ctp][0], y = NC[ctp][1]; f32x16 sn; \
          sn[0] = bflo(x.x); sn[1] = bfhi(x.x); sn[2] = bflo(x.y); sn[3] = bfhi(x.y); sn[4] = bflo(x.z); sn[5] = bfhi(x.z); sn[6] = bflo(x.w); sn[7] = bfhi(x.w); \
          sn[8] = bflo(y.x); sn[9] = bfhi(y.x); sn[10] = bflo(y.y); sn[11] = bfhi(y.y); sn[12] = bflo(y.z); sn[13] = bfhi(y.z); sn[14] = bflo(y.w); sn[15] = bfhi(y.w); \
          _Pragma("unroll") for (int s4 = 0; s4 < 4; ++s4) sn = MFMA32(__builtin_bit_cast(bf16x8, MC[ctp][s4]), Sf[s4], sn); \
          S[ctp] = sn; } } while (0)
    CARRY_LOAD(m0, n0, 0); CARRY_LOAD(m1, n1, 1);
    static_assert(NCHK % 3 == 2, "carry loop tail");
#pragma unroll 1
    for (int n = 0; n + 2 < NCHK; n += 3) { CARRY_STEP(n, m0, n0, m2, n2); CARRY_STEP(n + 1, m1, n1, m0, n0); CARRY_STEP(n + 2, m2, n2, m1, n1); }
    CARRY_STEP(NCHK - 2, m0, n0, m2, n2); CARRY_STEP(NCHK - 1, m1, n1, m0, n0);
#undef CARRY_LOAD
#undef CARRY_STEP
}
__device__ __forceinline__ void scan_out_item(const Args& a, unsigned char* ws, LAS unsigned char* ST, int l, int item, int lane) {
    const int hh = item % NH, bn = item / NH; const int p = lane & 31, h = lane >> 5;
    const bf16* Si = (const bf16*)(ws + WS_SS) + (size_t)item * 4096; const bf16* RPi = (const bf16*)(ws + WS_SRP) + (size_t)item * 2048; const bf16* YLi = (const bf16*)(ws + WS_SYL) + (size_t)item * 2048;
    const float* BONu = (const float*)(ws + WS_BON) + (size_t)bn * CHK * 8 + hh; bf16* mixu = (bf16*)(ws + WS_MIX) + (size_t)bn * CHK * D + hh * 64;
    const float* rvec = a.in[I_RVEC] + l * 7 * RW;
    bf16x8 rp[4], sf[2][4]; v4u yl[2][2], xv[2][2], xg[2][2]; float bon[16];
#pragma unroll
    for (int s4 = 0; s4 < 4; ++s4) rp[s4] = *(const bf16x8*)(RPi + (s4 * 64 + (lane & 63)) * 8);
#pragma unroll
    for (int ctd = 0; ctd < 2; ++ctd)
#pragma unroll
        for (int s4 = 0; s4 < 4; ++s4) sf[ctd][s4] = *(const bf16x8*)(Si + ((4 * ctd + s4) * 64 + (lane & 63)) * 8);
    { const v4u* XV = (const v4u*)(ws + WS_XV) + ((size_t)item * 4) * 64 + lane; const v4u* XG = (const v4u*)(ws + WS_G) + ((size_t)item * 4) * 64 + lane;
#pragma unroll
      for (int ctd = 0; ctd < 2; ++ctd)
#pragma unroll
          for (int hq = 0; hq < 2; ++hq) { yl[ctd][hq] = *(const v4u*)(YLi + ((2 * ctd + hq) * 64 + (lane & 63)) * 8); xv[ctd][hq] = XV[(ctd * 2 + hq) * 64]; xg[ctd][hq] = XG[(ctd * 2 + hq) * 64]; } }
#pragma unroll
    for (int r = 0; r < 16; ++r) bon[r] = BONu[qrow(r, h) * 8];
    float lng[2], lnb[2];
#pragma unroll
    for (int ctd = 0; ctd < 2; ++ctd) { lng[ctd] = rvec[5 * RW + hh * 64 + 32 * ctd + p]; lnb[ctd] = rvec[6 * RW + hh * 64 + 32 * ctd + p]; }
    f32x16 Y[2];
#define UNPK(DST, W0, W1) do { DST[0] = bflo(W0.x); DST[1] = bfhi(W0.x); DST[2] = bflo(W0.y); DST[3] = bfhi(W0.y); DST[4] = bflo(W0.z); DST[5] = bfhi(W0.z); DST[6] = bflo(W0.w); DST[7] = bfhi(W0.w); \
        DST[8] = bflo(W1.x); DST[9] = bfhi(W1.x); DST[10] = bflo(W1.y); DST[11] = bfhi(W1.y); DST[12] = bflo(W1.z); DST[13] = bfhi(W1.z); DST[14] = bflo(W1.w); DST[15] = bfhi(W1.w); } while (0)
#pragma unroll
    for (int ctd = 0; ctd < 2; ++ctd) { UNPK(Y[ctd], yl[ctd][0], yl[ctd][1]);
#pragma unroll
        for (int s4 = 0; s4 < 4; ++s4) Y[ctd] = MFMA32(rp[s4], sf[ctd][s4], Y[ctd]); }
    float vv[2][16], gg[2][16];
#pragma unroll
    for (int ctd = 0; ctd < 2; ++ctd) { UNPK(vv[ctd], xv[ctd][0], xv[ctd][1]); UNPK(gg[ctd], xg[ctd][0], xg[ctd][1]); }
#undef UNPK
#pragma unroll
    for (int r = 0; r < 16; ++r) {
        const float y0 = Y[0][r], y1 = Y[1][r];
        const float s1 = half_sum32(y0 + y1), s2 = half_sum32(y0 * y0 + y1 * y1);
        const float mean = s1 * (1.f / 64.f), var = fmaxf(s2 * (1.f / 64.f) - mean * mean, 0.f), rstd = 1.f / sqrtf(var + 64e-5f);
        const int i = qrow(r, h);
        st_put(ST, i, p, ((y0 - mean) * rstd * lng[0] + lnb[0] + bon[r] * vv[0][r]) * gg[0][r]);
        st_put(ST, i, 32 + p, ((y1 - mean) * rstd * lng[1] + lnb[1] + bon[r] * vv[1][r]) * gg[1][r]);
    }
    st_flush<64>(ST, mixu, D, lane, false);
}
__device__ __forceinline__ void ph_scan_out(const Args& a, unsigned char* ws, LAS unsigned char* lds, int l, int gw, int NGW, int wave, int lane_in) {
    LAS unsigned char* ST = lds + RING_OFF + wave * 8192;
    for (int item = gw; item < BATCH * NCHK * NH; item += NGW) { const int lane = fresh_lane(); scan_out_item(a, ws, ST, l, item, lane); }
}

constexpr size_t WS_VT = WS_BON + 1 * MiB;
static_assert(WS_VT + 16 * MiB <= 896 * MiB, "ws");
constexpr int AT_KB = 0, AT_VB = 16384, AT_STAGE = 24576;
__device__ __forceinline__ int atk_addr(int row, int chunk) { return row * 256 + ((chunk ^ (row & 15)) << 4); }

__device__ __forceinline__ const bf16* at_ksrc(const bf16* KM, int b, int hq, int kt, int c) { const int row = c / 12, ch = c % 12; return KM + (size_t)(b * T + kt * 64 + row) * 384 + hq * 96 + ch * 8; }
__device__ __forceinline__ const bf16* at_vsrc(const bf16* VTg, int b, int hq, int kt, int v) { return VTg + ((size_t)((b * 4 + hq) * 128 + 2 * kt + (v >> 8)) * 64 + ((v >> 2) & 63)) * 32 + (v & 3) * 8; }
__device__ __forceinline__ int at_kdst(int c) { const int row = c / 12, ch = c % 12; return AT_KB + atk_addr(row, ch); }
__device__ __forceinline__ int at_vdst(int v) { return AT_VB + (v >> 8) * 4096 + cm_addr((v >> 2) & 63, v & 3); }
__device__ __forceinline__ void attn_stage_load(const bf16* KM, const bf16* VTg, int b, int hq, int kt, int tid, v4u& rg0, v4u& rg1, v4u& rg2) {
    rg0 = *(const v4u*)at_ksrc(KM, b, hq, kt, tid);
    const bf16* sb = tid < 256 ? at_ksrc(KM, b, hq, kt, 512 + tid) : at_vsrc(VTg, b, hq, kt, tid - 256);
    rg1 = *(const v4u*)sb;
    if (tid < 256) rg2 = *(const v4u*)at_vsrc(VTg, b, hq, kt, 256 + tid);
}
__device__ __forceinline__ void attn_stage_store(LAS unsigned char* S, int tid, const v4u& rg0, const v4u& rg1, const v4u& rg2) {
    *(LAS v4u*)(S + at_kdst(tid)) = rg0;
    const int db = tid < 256 ? at_kdst(512 + tid) : at_vdst(tid - 256);
    *(LAS v4u*)(S + db) = rg1;
    if (tid < 256) *(LAS v4u*)(S + at_vdst(256 + tid)) = rg2;
}

__device__ __forceinline__ void ph_attn_mfma(unsigned char* ws, LAS unsigned char* lds, int bh, int qb, int tid, int wave, int lane) {
    const int b = bh >> 2, hq = bh & 3;
    const bf16* QM = (const bf16*)(ws + WS_QM); const bf16* KM = (const bf16*)(ws + WS_KM); const bf16* VTg = (const bf16*)(ws + WS_VT); bf16* mix = (bf16*)(ws + WS_MIX);
    LAS unsigned char* L = lds + RING_OFF;
    const int p = lane & 31, h = lane >> 5;
    const f32x16 zero16 = {0.f, 0.f, 0.f, 0.f, 0.f, 0.f, 0.f, 0.f, 0.f, 0.f, 0.f, 0.f, 0.f, 0.f, 0.f, 0.f};
    {
        const int q0 = qb * 256; const int ntile = 4 * (qb + 1);
        const int qrow_ = q0 + wave * 32 + p;
        const int qmax_w = q0 + wave * 32 + 31, qmin_w = q0 + wave * 32;
        bf16x8 qf[6];
#pragma unroll
        for (int s = 0; s < 6; ++s) qf[s] = *(const bf16x8*)(QM + (size_t)(b * T + qrow_) * 384 + hq * 96 + 16 * s + 8 * h);
        f32x16 O[2] = {zero16, zero16}; float mrun = -1.0e30f, lrun = 0.f;
        v4u rg0, rg1, rg2 = (v4u){0u, 0u, 0u, 0u};
        __syncthreads();
        attn_stage_load(KM, VTg, b, hq, 0, tid, rg0, rg1, rg2); attn_stage_store(L, tid, rg0, rg1, rg2);
        __syncthreads();
#pragma unroll 1
        for (int kt = 0; kt < ntile; ++kt) {
            LAS unsigned char* S = L + (kt & 1) * AT_STAGE;
            if (kt + 1 < ntile) attn_stage_load(KM, VTg, b, hq, kt + 1, tid, rg0, rg1, rg2);
            if (kt * 64 <= qmax_w) {
                f32x16 s0 = zero16, s1 = zero16;
#pragma unroll
                for (int s = 0; s < 6; ++s) {
                    const bf16x8 k0 = *(const LAS bf16x8*)(S + AT_KB + atk_addr(p, 2 * s + h)), k1 = *(const LAS bf16x8*)(S + AT_KB + atk_addr(32 + p, 2 * s + h));
                    s0 = MFMA32(k0, qf[s], s0); s1 = MFMA32(k1, qf[s], s1);
                }
                if (kt * 64 + 63 > qmin_w) {
#pragma unroll
                    for (int r = 0; r < 16; ++r) { const int kv = kt * 64 + qrow(r, h); if (kv > qrow_) s0[r] = -1.0e30f; if (kv + 32 > qrow_) s1[r] = -1.0e30f; }
                }
                float rm = fmaxf(s0[0], s1[0]);
#pragma unroll
                for (int r = 1; r < 16; ++r) rm = fmaxf(rm, fmaxf(s0[r], s1[r]));
                { const unsigned u_ = __float_as_uint(rm); auto rr_ = __builtin_amdgcn_permlane32_swap(u_, u_, false, false); rm = fmaxf(__uint_as_float(rr_[0]), __uint_as_float(rr_[1])); }
                const float mnew = fmaxf(mrun, rm); const float alpha = __builtin_amdgcn_exp2f(mrun - mnew); mrun = mnew;
                float ls = 0.f;
#pragma unroll
                for (int r = 0; r < 16; ++r) { s0[r] = __builtin_amdgcn_exp2f(s0[r] - mnew); s1[r] = __builtin_amdgcn_exp2f(s1[r] - mnew); ls += s0[r] + s1[r]; }
                lrun = lrun * alpha + ls;
#pragma unroll
                for (int r = 0; r < 16; ++r) { O[0][r] *= alpha; O[1][r] *= alpha; }
                const bf16x8 p00 = accfrag(s0, 0), p01 = accfrag(s0, 1), p10 = accfrag(s1, 0), p11 = accfrag(s1, 1);
#pragma unroll
                for (int dvt = 0; dvt < 2; ++dvt) {
                    const bf16x8 v00 = *(const LAS bf16x8*)(S + AT_VB + cm_addr(32 * dvt + p, h)), v01 = *(const LAS bf16x8*)(S + AT_VB + cm_addr(32 * dvt + p, 2 + h));
                    const bf16x8 v10 = *(const LAS bf16x8*)(S + AT_VB + 4096 + cm_addr(32 * dvt + p, h)), v11 = *(const LAS bf16x8*)(S + AT_VB + 4096 + cm_addr(32 * dvt + p, 2 + h));
                    O[dvt] = MFMA32(v00, p00, O[dvt]); O[dvt] = MFMA32(v01, p01, O[dvt]); O[dvt] = MFMA32(v10, p10, O[dvt]); O[dvt] = MFMA32(v11, p11, O[dvt]);
                }
            }
            if (kt + 1 < ntile) attn_stage_store(L + ((kt + 1) & 1) * AT_STAGE, tid, rg0, rg1, rg2);
            __syncthreads();
        }
        float ltot; { const unsigned u_ = __float_as_uint(lrun); auto rr_ = __builtin_amdgcn_permlane32_swap(u_, u_, false, false); ltot = __uint_as_float(rr_[0]) + __uint_as_float(rr_[1]); } const float il = 1.f / ltot;
        bf16* orow = mix + (size_t)(b * T + qrow_) * D + 768 + hq * 64;
#pragma unroll
        for (int dvt = 0; dvt < 2; ++dvt)
#pragma unroll
            for (int g = 0; g < 4; ++g) { v2u w; w.x = cvtpk(O[dvt][4 * g] * il, O[dvt][4 * g + 1] * il); w.y = cvtpk(O[dvt][4 * g + 2] * il, O[dvt][4 * g + 3] * il);
                *(v2u*)(orow + 32 * dvt + 8 * g + 4 * h) = w; }
    }
}

constexpr int AT2_KSLOT = 12288, AT2_VSLOT = 8192, AT2_K = 0, AT2_V = 4 * AT2_KSLOT;
__device__ __forceinline__ void glds16(const void* g, unsigned lds_base) {
    unsigned sv; asm volatile("s_mov_b32 %0, m0\n\ts_mov_b32 m0, %2\n\ts_nop 0\n\tglobal_load_lds_dwordx4 %1, off\n\ts_mov_b32 m0, %0" : "=&s"(sv) : "v"(g), "s"(lds_base) : "memory"); }
#define AT_SBAR() __builtin_amdgcn_sched_barrier(0)
#define AT_PIN(x) asm volatile("" : "+v"(x))
#define AT_WB(N) asm volatile("s_waitcnt vmcnt(" #N ") lgkmcnt(0)\n\ts_barrier" ::: "memory")
#define AT_MX3(a, b, c) __builtin_fmaxf(__builtin_fmaxf((a), (b)), (c))
__device__ __forceinline__ float at_rowmax(const f32x16& p0, const f32x16& p1) {
    float a = AT_MX3(p0[0], p0[1], p1[0]), b = AT_MX3(p0[2], p0[3], p1[1]); a = AT_MX3(a, p1[2], p1[3]);
#pragma unroll
    for (int r = 4; r < 16; r += 4) { a = AT_MX3(a, p0[r], p0[r + 1]); b = AT_MX3(b, p0[r + 2], p0[r + 3]); a = AT_MX3(a, p1[r], p1[r + 1]); b = AT_MX3(b, p1[r + 2], p1[r + 3]); }
    const float m = __builtin_fmaxf(a, b); auto rr = __builtin_amdgcn_permlane32_swap(__float_as_uint(m), __float_as_uint(m), false, false);
    return __builtin_fmaxf(__uint_as_float(rr[0]), __uint_as_float(rr[1])); }
__device__ __forceinline__ void at_cmask(f32x16& p0, f32x16& p1, int jb, int qrel, int h) {
    int d = qrel - (64 * jb + 4 * h); asm volatile("" : "+v"(d));
#pragma unroll
    for (int r = 0; r < 16; ++r) { const int c = (r & 3) + 8 * (r >> 2); if (c > d) p0[r] = -INFINITY; if (c + 32 > d) p1[r] = -INFINITY; } }
__device__ __forceinline__ void at_kload2(bf16x8* kf, const LAS unsigned char* kp, int s) { kf[2 * s] = *(const LAS bf16x8*)(kp + s * 2048); kf[2 * s + 1] = *(const LAS bf16x8*)(kp + s * 2048 + 512); }
#ifndef ATTN_THR
#define ATTN_THR 8
#endif

__device__ __forceinline__ void ph_attn_pipe(unsigned char* ws, LAS unsigned char* lds, int bh, int qb, int wave, int lane) {
    const int b = bh >> 2, hq = bh & 3;
    const bf16* QM = (const bf16*)(ws + WS_QM); const bf16* KM = (const bf16*)(ws + WS_KM); const bf16* VTg = (const bf16*)(ws + WS_VT); bf16* mix = (bf16*)(ws + WS_MIX);
    LAS unsigned char* L = lds + RING_OFF;
    const int p = lane & 31, h = lane >> 5;
    const int q0 = qb * 256, NT = 4 * (qb + 1);
    const int qrel = wave * 32 + p; const bool wlo = wave < 4;
    const bf16* ksrc = KM + (size_t)((b * 4 + hq) * 64) * 6144 + wave * 512 + (lane & 63) * 8;
    const int vrow = (wave & 3) * 16 + (lane >> 2);
    const bf16* vsrc = VTg + (size_t)((b * 4 + hq) * 128 + (wave >> 2)) * 2048 + ((((vrow >> 5) * 4 + ((lane & 3) ^ ((vrow >> 2) & 3))) * 32 + (vrow & 31)) * 8);
    const unsigned lds0 = (unsigned)(size_t)L;
    const unsigned kdst = lds0 + AT2_K + wave * 1024, vdst = lds0 + AT2_V + wave * 1024;
#define RFL(x) ((unsigned)__builtin_amdgcn_readfirstlane((int)(x)))
#define DMA_K(t, slot) do { glds16(ksrc + (size_t)(t) * 6144, RFL(kdst + (slot) * AT2_KSLOT)); if (wlo) glds16(ksrc + (size_t)(t) * 6144 + 4096, RFL(kdst + (slot) * AT2_KSLOT + 8192)); } while (0)
#define DMA_V(t, slot) glds16(vsrc + (size_t)(t) * 4096, RFL(vdst + (slot) * AT2_VSLOT))
    const int vx = (h ^ ((p >> 2) & 3));
    const LAS unsigned char* vpA = L + AT2_V + p * 64 + (vx << 4);
    const LAS unsigned char* vpB = L + AT2_V + p * 64 + ((vx ^ 2) << 4);
    const LAS unsigned char* kp0 = L + AT2_K + h * 1024 + p * 16;
    DMA_K(0, 0); DMA_V(0, 0); DMA_K(1, 1); DMA_K(2, 2); DMA_K(3, 3); DMA_V(1, 1);
    bf16x8 qf[6];
    { const bf16* Qw = QM + (size_t)(b * T + q0 + qrel) * 384 + hq * 96 + 8 * h;
#pragma unroll
      for (int s = 0; s < 6; ++s) qf[s] = *(const bf16x8*)(Qw + 16 * s); }
    float mhat = 0.f, l_reg = 0.f, fres = 1.f; f32x16 o0, o1;
    const f32x16 zero16 = {0.f, 0.f, 0.f, 0.f, 0.f, 0.f, 0.f, 0.f, 0.f, 0.f, 0.f, 0.f, 0.f, 0.f, 0.f, 0.f};
    o0 = zero16; o1 = zero16; bool resc = false;
    f32x16 pA0, pA1, pB0, pB1; bf16x8 kf[12], vf[8]; v4u pw0, pw1, pw2, pw3;
    int sl_prev = 0, sl_cur = 0, sl_next = 1;
#define ROT() do { sl_prev = sl_cur; sl_cur = sl_next; sl_next = (sl_next + 1) & 3; } while (0)
#define EX(v) __builtin_amdgcn_exp2f((v) + nmh)
#define RESC() do { if (resc) { _Pragma("unroll") for (int r = 0; r < 16; ++r) { o0[r] *= fres; o1[r] *= fres; } } } while (0)
    AT_WB(0);
#pragma unroll
    for (int s = 0; s < 6; ++s) at_kload2(kf, kp0, s);
    pA0 = MFMA32(kf[0], qf[0], zero16); pA1 = MFMA32(kf[1], qf[0], zero16);
#pragma unroll
    for (int s = 1; s < 6; ++s) { pA0 = MFMA32(kf[2 * s], qf[s], pA0); pA1 = MFMA32(kf[2 * s + 1], qf[s], pA1); }
    if (NT == 4) at_cmask(pA0, pA1, 0, qrel, h);
    { mhat = at_rowmax(pA0, pA1); const float nmh = -mhat;
#pragma unroll
      for (int r = 0; r < 16; ++r) { pA0[r] = EX(pA0[r]); pA1[r] = EX(pA1[r]); } }
    AT_WB(0);
    if (4 < NT) DMA_K(4, 0); DMA_V(2, 2); ROT();
#pragma unroll
    for (int s = 0; s < 6; ++s) at_kload2(kf, kp0 + sl_cur * AT2_KSLOT, s);
    if (4 < NT) { if (wlo) { AT_WB(3); } else { AT_WB(2); } } else { AT_WB(1); }
#define PKW(P, i) cvtpk(P[i], P[i + 1])
#define PAF(k) __builtin_bit_cast(bf16x8, pw##k)
#define VOFF(j) ((((j) >> 1) >> 1) * 4096 + ((j) & 1) * 2048)
#define VRD(j) do { vf[j] = *(const LAS bf16x8*)(((((j) >> 1) & 1) ? vpB_ : vpA_) + VOFF(j)); } while (0)
#define KRD(G, s) do { if (G) { at_kload2(kf, kp0 + sl_next * AT2_KSLOT, s); AT_SBAR(); } } while (0)
#define GAPA3(MF, a0, a1, a2, W0, W1, PW) do { MF; sacc += a0; sacc += a1; sacc += a2; W0; W1; AT_PIN(PW); AT_PIN(sacc); AT_SBAR(); } while (0)
#define GAPB(MF, X, i) do { MF; X[i] = EX(X[i]); X[i + 1] = EX(X[i + 1]); X[i + 2] = EX(X[i + 2]); X[i + 3] = EX(X[i + 3]); AT_PIN(X); AT_SBAR(); } while (0)
#define WAIT2() do { if (wlo) { AT_WB(6); } else { AT_WB(4); } } while (0)
#define WAITN(GK, GV) do { if (GK) { if (GV) { if (wlo) { AT_WB(3); } else { AT_WB(2); } } else { if (wlo) { AT_WB(2); } else { AT_WB(1); } } } else { if (GV) { AT_WB(1); } else { AT_WB(0); } } } while (0)
#define STEP(C0, C1, P0, P1, t, MASK, GK, GV, GL) do { AT_SBAR(); \
    const LAS unsigned char* vpA_ = vpA + sl_prev * AT2_VSLOT; const LAS unsigned char* vpB_ = vpB + sl_prev * AT2_VSLOT; \
    float sacc = P0[0] + P0[1]; \
    VRD(0); AT_SBAR(); GAPA3(C0 = MFMA32(kf[0], qf[0], zero16), P0[2], P0[3], P0[4],    pw0[0] = PKW(P0, 0),  pw0[1] = PKW(P0, 2),  pw0); \
    VRD(1); AT_SBAR(); GAPA3(C1 = MFMA32(kf[1], qf[0], zero16), P0[5], P0[6], P0[7],    pw0[2] = PKW(P0, 4),  pw0[3] = PKW(P0, 6),  pw0); \
    VRD(2); AT_SBAR(); GAPA3(C0 = MFMA32(kf[2], qf[1], C0),     P0[8], P0[9], P0[10],   pw1[0] = PKW(P0, 8),  (void)0,              pw1); \
    VRD(3); AT_SBAR(); GAPA3(C1 = MFMA32(kf[3], qf[1], C1),     P0[11], P0[12], P0[13], pw1[1] = PKW(P0, 10), pw1[2] = PKW(P0, 12), pw1); \
    VRD(4); AT_SBAR(); GAPA3(C0 = MFMA32(kf[4], qf[2], C0),     P0[14], P0[15], P1[0],  pw1[3] = PKW(P0, 14), (void)0,              pw1); \
    VRD(5); AT_SBAR(); GAPA3(C1 = MFMA32(kf[5], qf[2], C1),     P1[1], P1[2], P1[3],    pw2[0] = PKW(P1, 0),  pw2[1] = PKW(P1, 2),  pw2); \
    VRD(6); AT_SBAR(); GAPA3(C0 = MFMA32(kf[6], qf[3], C0),     P1[4], P1[5], P1[6],    pw2[2] = PKW(P1, 4),  (void)0,              pw2); \
    VRD(7); AT_SBAR(); GAPA3(C1 = MFMA32(kf[7], qf[3], C1),     P1[7], P1[8], P1[9],    pw2[3] = PKW(P1, 6),  pw3[0] = PKW(P1, 8),  pw3); \
                       GAPA3(C0 = MFMA32(kf[8], qf[4], C0),     P1[10], P1[11], P1[12], pw3[1] = PKW(P1, 10), (void)0,              pw3); \
                       GAPA3(C1 = MFMA32(kf[9], qf[4], C1),     P1[13], P1[14], P1[15], pw3[2] = PKW(P1, 12), pw3[3] = PKW(P1, 14), pw3); \
    C0 = MFMA32(kf[10], qf[5], C0); C1 = MFMA32(kf[11], qf[5], C1); AT_SBAR(); \
    l_reg += sacc; \
    if (GK) DMA_K((t) + 4, sl_cur); if (GV) DMA_V((t) + 2, (sl_next + 1) & 3); \
    if (MASK) at_cmask(C0, C1, (t) - (NT - 4), qrel, h); \
    { const float rm = at_rowmax(C0, C1) - mhat; resc = false; \
      if (__builtin_expect(__any(rm > (float)ATTN_THR), 0)) { const float dl = __builtin_fmaxf(rm, 0.f); mhat += dl; fres = __builtin_amdgcn_exp2f(-dl); l_reg *= fres; resc = true; } } \
    const float nmh = -mhat; AT_SBAR(); \
    GAPB(o0 = MFMA32(vf[0], PAF(0), o0), C0, 0);               GAPB(o1 = MFMA32(vf[1], PAF(0), o1), C0, 4); \
    KRD(GL, 0); GAPB(o0 = MFMA32(vf[2], PAF(1), o0), C0, 8);   KRD(GL, 1); GAPB(o1 = MFMA32(vf[3], PAF(1), o1), C0, 12); \
    KRD(GL, 2); GAPB(o0 = MFMA32(vf[4], PAF(2), o0), C1, 0);   KRD(GL, 3); GAPB(o1 = MFMA32(vf[5], PAF(2), o1), C1, 4); \
    KRD(GL, 4); GAPB(o0 = MFMA32(vf[6], PAF(3), o0), C1, 8);   KRD(GL, 5); GAPB(o1 = MFMA32(vf[7], PAF(3), o1), C1, 12); \
    } while (0)
    int t = 1;
    for (; t + 5 < NT; t += 2) {
        STEP(pB0, pB1, pA0, pA1, t, false, true, true, true);     WAIT2(); RESC(); ROT();
        STEP(pA0, pA1, pB0, pB1, t + 1, false, true, true, true); WAIT2(); RESC(); ROT();
    }
#define ENDW(tt) do { if ((tt) + 4 < NT) { WAITN(true, true); } else if ((tt) + 2 < NT) { WAITN(false, true); } else { WAITN(false, false); } } while (0)
    for (; t + 1 < NT; t += 2) {
        STEP(pB0, pB1, pA0, pA1, t, true, (t + 4 < NT), (t + 2 < NT), (t + 1 < NT));         ENDW(t);     RESC(); ROT();
        STEP(pA0, pA1, pB0, pB1, t + 1, true, (t + 5 < NT), (t + 3 < NT), (t + 2 < NT));     ENDW(t + 1); RESC(); ROT();
    }
    STEP(pB0, pB1, pA0, pA1, NT - 1, true, false, false, false); RESC();
    { float sacc = pB0[0] + pB0[1];
#pragma unroll
      for (int r = 2; r < 16; ++r) sacc += pB0[r];
#pragma unroll
      for (int r = 0; r < 16; ++r) sacc += pB1[r];
      l_reg += sacc;
      pw0 = (v4u){PKW(pB0, 0), PKW(pB0, 2), PKW(pB0, 4), PKW(pB0, 6)}; pw1 = (v4u){PKW(pB0, 8), PKW(pB0, 10), PKW(pB0, 12), PKW(pB0, 14)};
      pw2 = (v4u){PKW(pB1, 0), PKW(pB1, 2), PKW(pB1, 4), PKW(pB1, 6)}; pw3 = (v4u){PKW(pB1, 8), PKW(pB1, 10), PKW(pB1, 12), PKW(pB1, 14)};
      const LAS unsigned char* vpA_ = vpA + sl_cur * AT2_VSLOT; const LAS unsigned char* vpB_ = vpB + sl_cur * AT2_VSLOT;
      VRD(0); VRD(1); VRD(2); VRD(3); VRD(4); VRD(5); VRD(6); VRD(7);
      o0 = MFMA32(vf[0], PAF(0), o0); o1 = MFMA32(vf[1], PAF(0), o1); o0 = MFMA32(vf[2], PAF(1), o0); o1 = MFMA32(vf[3], PAF(1), o1);
      o0 = MFMA32(vf[4], PAF(2), o0); o1 = MFMA32(vf[5], PAF(2), o1); o0 = MFMA32(vf[6], PAF(3), o0); o1 = MFMA32(vf[7], PAF(3), o1); }
    float ltot; { const unsigned u_ = __float_as_uint(l_reg); auto rr_ = __builtin_amdgcn_permlane32_swap(u_, u_, false, false); ltot = __uint_as_float(rr_[0]) + __uint_as_float(rr_[1]); }
    const float il = __builtin_amdgcn_rcpf(ltot);
    bf16* orow = mix + (size_t)(b * T + q0 + qrel) * D + 768 + hq * 64;
#pragma unroll
    for (int g = 0; g < 4; ++g) { v2u w; w.x = cvtpk(o0[4 * g] * il, o0[4 * g + 1] * il); w.y = cvtpk(o0[4 * g + 2] * il, o0[4 * g + 3] * il); *(v2u*)(orow + 8 * g + 4 * h) = w; }
#pragma unroll
    for (int g = 0; g < 4; ++g) { v2u w; w.x = cvtpk(o1[4 * g] * il, o1[4 * g + 1] * il); w.y = cvtpk(o1[4 * g + 2] * il, o1[4 * g + 3] * il); *(v2u*)(orow + 32 + 8 * g + 4 * h) = w; }
#undef RFL
#undef DMA_K
#undef DMA_V
#undef ROT
#undef EX
#undef RESC
#undef PKW
#undef PAF
#undef VOFF
#undef VRD
#undef KRD
#undef GAPA3
#undef GAPB
#undef WAITN
#undef WAIT2
#undef STEP
#undef ENDW
}

constexpr size_t WS_XA = WS_R;
constexpr size_t WS_XL = WS_LW;
constexpr size_t WS_SMALLW = 6 * MiB;
constexpr int O_W2T = 0, O_A2T = 32768, O_G2T = 65536, O_V2T = 147456, O_POOLT = 163840, O_WQT = 180224, O_WKVT = 278528, LAYER_SMALLW = 344064;
constexpr int PZ_XW = 0, PZ_XA = 4096, PZ_XG = 8192  , PZ_XV = 18432  , PZ_PP = 20480  , PZ_QN = 36864  , PZ_KVN = 53248  , PZ_END = 61440;
template <int PITCH> __device__ __forceinline__ int pz_addr(int row, int chunk) {
    if constexpr (PITCH == 128) return row * 128 + ((chunk ^ ((row >> 1) & 7)) << 4);
    else if constexpr (PITCH == 64 || PITCH == 320) return row * PITCH + ((chunk ^ ((row >> 2) & 3)) << 4);
    else return row * PITCH + ((chunk ^ (row & 15)) << 4);
}
template <int PITCH> __device__ __forceinline__ void pz_put(LAS unsigned char* tile, int row, int k, float v) { *(LAS bf16*)(tile + pz_addr<PITCH>(row, k >> 3) + (k & 7) * 2) = (bf16)f2bf(v); }

__device__ __forceinline__ unsigned wfrag_off(int n, int k8, int K) { return (unsigned)(((((n >> 5) * (K >> 4) + (k8 >> 1)) * 2 + (k8 & 1)) * 32 + (n & 31)) * 8); }
__device__ __forceinline__ void small_transpose(const float* src, int K, int N, bf16* dst, int gtid, int GT) {
    const int k8n = K / 8;
    for (int it = gtid; it < N * k8n; it += GT) { const int n = it / k8n, k0 = (it % k8n) * 8;
        v4u o; o.x = pk2(src[(size_t)(k0 + 0) * N + n], src[(size_t)(k0 + 1) * N + n]); o.y = pk2(src[(size_t)(k0 + 2) * N + n], src[(size_t)(k0 + 3) * N + n]);
        o.z = pk2(src[(size_t)(k0 + 4) * N + n], src[(size_t)(k0 + 5) * N + n]); o.w = pk2(src[(size_t)(k0 + 6) * N + n], src[(size_t)(k0 + 7) * N + n]);
        *(v4u*)(dst + wfrag_off(n, k0 >> 3, K)) = o; }
}
__device__ __forceinline__ void ph_small_weights(const Args& a, unsigned char* ws, int gtid, int GT) {
    for (int l = 0; l < 2; ++l) {
        bf16* base = (bf16*)(ws + WS_SMALLW) + (size_t)l * LAYER_SMALLW;
        small_transpose(a.in[I_RW2] + (size_t)l * 64 * RW, 64, RW, base + O_W2T, gtid, GT);
        small_transpose(a.in[I_RA2] + (size_t)l * 64 * RW, 64, RW, base + O_A2T, gtid, GT);
        small_transpose(a.in[I_RG2] + (size_t)l * 160 * RW, 160, RW, base + O_G2T, gtid, GT);
        if (l == 1) small_transpose(a.in[I_RV2], 32, RW, base + O_V2T, gtid, GT);
        for (int g = 0; g < 4; ++g) small_transpose(a.in[I_POOLW] + (size_t)(l * 4 + g) * 4096, 64, 64, base + O_POOLT + g * 4096, gtid, GT);
        small_transpose(a.in[I_WQUP] + (size_t)l * 256 * 384, 256, 384, base + O_WQT, gtid, GT);
        small_transpose(a.in[I_WKVUP] + (size_t)l * 128 * 512, 128, 512, base + O_WKVT, gtid, GT);
    }
}

template <int PITCH, int KSTEPS, int NTILES, int KG = 2>
__device__ __forceinline__ void pz_gemm(f32x16 (&acc)[NTILES], const LAS unsigned char* X, const bf16* WT, int K, int n0, int p, int h, int kc0 = 0) {
    constexpr int NG = KSTEPS / KG;
    static_assert(KSTEPS % KG == 0, "k-steps");
    bf16x8 wb[2][KG][NTILES];
#pragma unroll
    for (int q = 0; q < KG; ++q)
#pragma unroll
        for (int jt = 0; jt < NTILES; ++jt) wb[0][q][jt] = *(const bf16x8*)(WT + wfrag_off(n0 + 32 * jt + (p & 31), 2 * q + (h & 1), K));
#pragma unroll
    for (int g = 0; g < NG; ++g) {
        if (g + 1 < NG) {
#pragma unroll
            for (int q = 0; q < KG; ++q)
#pragma unroll
                for (int jt = 0; jt < NTILES; ++jt) wb[(g + 1) & 1][q][jt] = *(const bf16x8*)(WT + wfrag_off(n0 + 32 * jt + (p & 31), 2 * ((g + 1) * KG + q) + (h & 1), K));
        }
#pragma unroll
        for (int q = 0; q < KG; ++q) {
            const bf16x8 xa = *(const LAS bf16x8*)(X + pz_addr<PITCH>(p, kc0 + 2 * (g * KG + q) + h));
#pragma unroll
            for (int jt = 0; jt < NTILES; ++jt) acc[jt] = MFMA32(xa, wb[g & 1][q][jt], acc[jt]);
        }
        asm volatile("" ::: "memory");
    }
}


template <int WIN>
__device__ __forceinline__ void pool_wave(const bf16* zc, int tt0, int i0, LAS unsigned char* PP, int gi, int lane) {
    float u[16 + WIN - 1];
    bf16 raw[16 + WIN - 1];
#pragma unroll
    for (int k = 0; k < 16 + WIN - 1; ++k) { const int off = i0 + k - (WIN - 1); const int offc = (tt0 + off >= 0) ? off : -tt0; raw[k] = zc[(ptrdiff_t)offc * NZ]; }
    __builtin_amdgcn_sched_barrier(0);
#pragma unroll
    for (int k = 0; k < 16 + WIN - 1; ++k) { const int off = i0 + k - (WIN - 1); u[k] = (tt0 + off >= 0) ? bf2f(raw[k]) : 0.f; }
    float s = 0.f;
#pragma unroll
    for (int k = 0; k < WIN - 1; ++k) s += u[k];
#pragma unroll
    for (int j = 0; j < 16; ++j) { s += u[WIN - 1 + j]; const int tt = tt0 + i0 + j; const int cnt = (tt + 1) < WIN ? (tt + 1) : WIN;
        pz_put<512>(PP, i0 + j, gi * 64 + lane, s * rcp_((float)cnt) - u[WIN - 1 + j]); s -= u[j]; }
}

#ifndef PZ_ABL
#define PZ_ABL 0
#endif
#ifndef PZ_PART
#define PZ_PART 7
#endif
template <int l>
__device__ __forceinline__ void ph_postz_mfma(const Args& a, unsigned char* ws, LAS unsigned char* lds, int G, int tid, int wave, int lane_in, bool dry) {
    LAS unsigned char* L = lds + RING_OFF;
    const bf16* z = (const bf16*)(ws + WS_Z);
    const float* mu = a.in[I_MU] + l * SHIFT_COLS; const float* muv = a.in[I_MUV];
    const float* rvec = a.in[I_RVEC] + l * 7 * RW; const float* v0p = a.in[I_RV0];
    const bf16* SW = (const bf16*)(ws + WS_SMALLW) + (size_t)l * LAYER_SMALLW;
    bf16* Rr = (bf16*)(ws + WS_R); bf16* Kr = (bf16*)(ws + WS_K); bf16* Vr = (bf16*)(ws + WS_V); bf16* KKr = (bf16*)(ws + WS_KK); bf16* Ar = (bf16*)(ws + WS_A);
    float* LWr = (float*)(ws + WS_LW); bf16* Gr = (bf16*)(ws + WS_G); bf16* VF = (bf16*)(ws + WS_VF); bf16* mix = (bf16*)(ws + WS_MIX); float* BON = (float*)(ws + WS_BON);
    bf16* QM = (bf16*)(ws + WS_QM); bf16* KM = (bf16*)(ws + WS_KM); bf16* VM = (bf16*)(ws + WS_VM);
    const float* pools = a.in[I_POOLS] + l * 256; const float* qlg = a.in[I_QLG] + l * 256; const float* kvlg = a.in[I_KVLG] + l * 128;
    const float* qkg = a.in[I_QKG] + l * 2 * 96; const float* ct = (const float*)(ws + WS_COS); const float* st = (const float*)(ws + WS_SIN);
    const f32x16 zero16 = {0.f, 0.f, 0.f, 0.f, 0.f, 0.f, 0.f, 0.f, 0.f, 0.f, 0.f, 0.f, 0.f, 0.f, 0.f, 0.f};
    for (int unit = blockIdx.x; unit < M / 32; unit += G) {
        const int lane = fresh_lane();
        const int p = lane & 31, h = lane >> 5;
        LAS unsigned char* ST = L + PZ_END + wave * 8192;
        const int t0 = unit * 32; const int tt0 = t0 % T;
        const bf16* zu = z + (size_t)t0 * NZ;
        bf16* Ru = Rr + (size_t)t0 * RW; bf16* Ku = Kr + (size_t)t0 * RW; bf16* Vu = Vr + (size_t)t0 * RW; bf16* KKu = KKr + (size_t)t0 * RW; bf16* Au = Ar + (size_t)t0 * RW;
        float* LWu = LWr + (size_t)t0 * RW; bf16* Gu = Gr + (size_t)t0 * RW; bf16* VFu = VF + (size_t)t0 * RW; bf16* mixu = mix + (size_t)t0 * D; float* BONu = BON + (size_t)t0 * 8;
        bf16* QMu = QM + (size_t)t0 * 384; bf16* KMu = KM + (size_t)t0 * 384; bf16* VMu = VM + (size_t)t0 * 256; const float* ctu = ct + (size_t)t0 * 16; const float* stu = st + (size_t)t0 * 16;
        __syncthreads();
        if (dry && (PZ_ABL & 4)) {} else {
            { const int gi = wave & 3, i0 = (wave >> 2) * 16; const bf16* zc = z + (size_t)t0 * NZ + OFF_POOL + gi * 64 + lane;
              if (gi == 0) pool_wave<2>(zc, tt0, i0, L + PZ_PP, gi, lane); else if (gi == 1) pool_wave<4>(zc, tt0, i0, L + PZ_PP, gi, lane);
              else if (gi == 2) pool_wave<8>(zc, tt0, i0, L + PZ_PP, gi, lane); else pool_wave<16>(zc, tt0, i0, L + PZ_PP, gi, lane); }
            float cW[4], pW[4], cA[4], pA[4], cG0[4], pG0[4], cG1[4], pG1[4], cG2[4], pG2[4], cV[4], pV[4], q4[4][4], k2[4][2];
            int wv; asm volatile("v_mov_b32 %0, %1" : "=v"(wv) : "s"(wave));
#pragma unroll
            for (int t4 = 0; t4 < 4; ++t4) { const int i = wv * 4 + t4; const bool hp = (tt0 + i) > 0;
                const bf16* zb = zu - NZ;
                const unsigned oc = (unsigned)((i + 1) * NZ) + (unsigned)lane, op = hp ? oc - NZ : oc; const unsigned l31 = (unsigned)(lane & 31), oc31 = (unsigned)((i + 1) * NZ) + l31, op31 = hp ? oc31 - NZ : oc31;
                cW[t4] = bf2f(zb[oc + OFF_WD]); pW[t4] = bf2f(zb[op + OFF_WD]); cA[t4] = bf2f(zb[oc + OFF_AD]); pA[t4] = bf2f(zb[op + OFF_AD]);
                cG0[t4] = bf2f(zb[oc + OFF_GD]); pG0[t4] = bf2f(zb[op + OFF_GD]); cG1[t4] = bf2f(zb[oc + OFF_GD + 64]); pG1[t4] = bf2f(zb[op + OFF_GD + 64]);
                cG2[t4] = bf2f(zb[oc31 + OFF_GD + 128]); pG2[t4] = bf2f(zb[op31 + OFF_GD + 128]);
                if (l > 0) { cV[t4] = bf2f(zb[oc31 + OFF_VD]); pV[t4] = bf2f(zb[op31 + OFF_VD]); } else { cV[t4] = 0.f; pV[t4] = 0.f; }
#pragma unroll
                for (int j = 0; j < 4; ++j) q4[t4][j] = bf2f(zb[oc + OFF_QLAT + 64 * j]);
#pragma unroll
                for (int j = 0; j < 2; ++j) k2[t4][j] = bf2f(zb[oc + OFF_KVLAT + 64 * j]); }
            const float muW = mu[OFF_WD + lane], muA = mu[OFF_AD + lane], muG0 = mu[OFF_GD + lane], muG1 = mu[OFF_GD + 64 + lane], muG2 = mu[OFF_GD + 128 + (lane & 31)], muV = l > 0 ? muv[lane & 31] : 0.f;
#pragma unroll
            for (int t4 = 0; t4 < 4; ++t4) { const int i = wv * 4 + t4; const float pm = (tt0 + i) > 0 ? 1.f : 0.f;
#define SH(c_, p_, m_) ((c_) + (m_) * (pm * (p_) - (c_)))
                pz_put<128>(L + PZ_XW, i, lane, tanhf_(SH(cW[t4], pW[t4], muW))); pz_put<128>(L + PZ_XA, i, lane, SH(cA[t4], pA[t4], muA));
                pz_put<320>(L + PZ_XG, i, lane, sigmoidf_(SH(cG0[t4], pG0[t4], muG0))); pz_put<320>(L + PZ_XG, i, lane + 64, sigmoidf_(SH(cG1[t4], pG1[t4], muG1)));
                if (lane < 32) pz_put<320>(L + PZ_XG, i, lane + 128, sigmoidf_(SH(cG2[t4], pG2[t4], muG2)));
                if (l > 0 && lane < 32) pz_put<64>(L + PZ_XV, i, lane, SH(cV[t4], pV[t4], muV));
#undef SH
                float s = 0.f;
#pragma unroll
                for (int j = 0; j < 4; ++j) s += q4[t4][j] * q4[t4][j];
                const float rs = rsq_(wave_sum(s) * (1.f / 256.f) + 1e-6f);
#pragma unroll
                for (int j = 0; j < 4; ++j) pz_put<512>(L + PZ_QN, i, lane + 64 * j, q4[t4][j] * rs * qlg[lane + 64 * j]);
                s = 0.f;
#pragma unroll
                for (int j = 0; j < 2; ++j) s += k2[t4][j] * k2[t4][j];
                const float rk = rsq_(wave_sum(s) * (1.f / 128.f) + 1e-6f);
#pragma unroll
                for (int j = 0; j < 2; ++j) pz_put<256>(L + PZ_KVN, i, lane + 64 * j, k2[t4][j] * rk * kvlg[lane + 64 * j]);
            }
        }
        __syncthreads();
        if (dry && (PZ_ABL & 2)) {} else if ((PZ_PART & 2) && wave < 4) {
            const int hq = wave; const int fi = p & 15;
            { f32x16 aq[3] = {zero16, zero16, zero16};
              { f32x16 a01[2] = {zero16, zero16}; pz_gemm<512, 16, 2, 4>(a01, L + PZ_QN, SW + O_WQT, 256, hq * 96, p, h); aq[0] = a01[0]; aq[1] = a01[1]; }
              { f32x16 a2[1] = {zero16}; pz_gemm<512, 16, 1, 4>(a2, L + PZ_QN, SW + O_WQT, 256, hq * 96 + 64, p, h); aq[2] = a2[0]; }
              const float C2 = 0.10206207261596577f * 1.4426950408889634f; const float gq0 = qkg[p] * C2, gq1 = qkg[32 + p] * C2, gq2 = qkg[64 + p] * C2;
              float csv[16], snv[16];
#pragma unroll
              for (int r = 0; r < 16; ++r) { csv[r] = ctu[qrow(r, h) * 16 + fi]; snv[r] = stu[qrow(r, h) * 16 + fi]; }
#pragma unroll
              for (int r = 0; r < 16; ++r) {
                const int i = qrow(r, h);
                const float cs = csv[r], sn = snv[r];
                const float xq = aq[2][r], xqo = __int_as_float(__builtin_amdgcn_ds_swizzle(__float_as_int(xq), 0x401F));
                const float qpe = p < 16 ? xq * cs - xqo * sn : xqo * sn + xq * cs;
                const float q0 = aq[0][r], q1 = aq[1][r];
                const float rq = rsq_(half_sum32(q0 * q0 + q1 * q1 + qpe * qpe) * (1.f / 96.f) + 1e-6f);
                st_put(ST, i, p, q0 * rq * gq0); st_put(ST, i, 32 + p, q1 * rq * gq1); st_put(ST, i, 64 + p, qpe * rq * gq2);
                if ((r & 3) == 3) asm volatile("" ::: "memory");
              }
              st_flush<96>(ST, QMu + hq * 96, 384, lane, dry); }
        } else if (PZ_PART & 6) {
            const int hq = wave - 4, gi = wave - 4; const int fi = p & 15;
            { f32x16 ak[2] = {zero16, zero16};
              pz_gemm<256, 8, 2, 4>(ak, L + PZ_KVN, SW + O_WKVT, 128, hq * 128, p, h);
              const float gk0 = qkg[96 + p], gk1 = qkg[96 + 32 + p], gk2 = qkg[96 + 64 + p];
              float csv[16], snv[16]; bf16 xkv[16];
#pragma unroll
              for (int r = 0; r < 16; ++r) { csv[r] = ctu[qrow(r, h) * 16 + fi]; snv[r] = stu[qrow(r, h) * 16 + fi]; xkv[r] = zu[(unsigned)(qrow(r, h) * NZ + OFF_KROPE + p)]; }
#pragma unroll
              for (int r = 0; r < 16; ++r) {
                const int i = qrow(r, h);
                const float cs = csv[r], sn = snv[r];
                const float xk = bf2f(xkv[r]), xko = __int_as_float(__builtin_amdgcn_ds_swizzle(__float_as_int(xk), 0x401F));
                const float kpe = p < 16 ? xk * cs - xko * sn : xko * sn + xk * cs;
                const float k0 = ak[0][r], k1 = ak[1][r];
                const float rk = rsq_(half_sum32(k0 * k0 + k1 * k1 + kpe * kpe) * (1.f / 96.f) + 1e-6f);
                st_put(ST, i, p, k0 * rk * gk0); st_put(ST, i, 32 + p, k1 * rk * gk1); st_put(ST, i, 64 + p, kpe * rk * gk2);
                if ((r & 3) == 3) asm volatile("" ::: "memory");
              }
              st_flush_kimg(ST, KM + ((size_t)(((t0 / T) * 4 + hq) * 64 + (tt0 >> 6)) * 6144 + (unsigned)((tt0 & 63) * 8)), lane, dry); }
            { f32x16 av[2] = {zero16, zero16};
              pz_gemm<256, 8, 2, 4>(av, L + PZ_KVN, SW + O_WKVT, 128, hq * 128 + 64, p, h);
              { bf16* vt = (bf16*)(ws + WS_VT) + (size_t)(((t0 / T) * 4 + hq) * 128 + tt0 / 32) * 2048;
#pragma unroll
                for (int jt = 0; jt < 2; ++jt)
#pragma unroll
                    for (int s2 = 0; s2 < 2; ++s2) if (!dry) { *(bf16x8*)(vt + (unsigned)(((jt * 2 + s2) * 64 + (((h & 1) << 5) | p)) * 8)) = accfrag(av[jt], s2); } }
              asm volatile("" ::: "memory"); }

            f32x16 ap[2] = {zero16, zero16};
            pz_gemm<512, 4, 2>(ap, L + PZ_PP, SW + O_POOLT + gi * 4096, 64, 0, p, h, 8 * gi);
            const float ps0 = pools[gi * 64 + p], ps1 = pools[gi * 64 + 32 + p];
#pragma unroll
            for (int r = 0; r < 16; ++r) { st_put(ST, qrow(r, h), p, ap[0][r] * ps0); st_put(ST, qrow(r, h), 32 + p, ap[1][r] * ps1); }
            st_flush<64>(ST, mixu + 512 + gi * 64, D, lane, dry);
        }
        if (!(dry && (PZ_ABL & 1))) {
            const int hh = wave;
            { f32x16 aG[2] = {zero16, zero16};
              pz_gemm<320, 10, 2, 5>(aG, L + PZ_XG, SW + O_G2T, 160, hh * 64, p, h);
              { unsigned char* XGb = ws + WS_G + ((size_t)unit * NH + hh) * (4 * 64 * 16); const unsigned lo16 = (unsigned)lane * 16u;
#pragma unroll
                for (int jt = 0; jt < 2; ++jt)
#pragma unroll
                    for (int hq = 0; hq < 2; ++hq) if (!dry) *(v4u*)(XGb + (lo16 + (unsigned)((jt * 2 + hq) * 1024))) = (v4u){cvtpk(aG[jt][8 * hq], aG[jt][8 * hq + 1]), cvtpk(aG[jt][8 * hq + 2], aG[jt][8 * hq + 3]), cvtpk(aG[jt][8 * hq + 4], aG[jt][8 * hq + 5]), cvtpk(aG[jt][8 * hq + 6], aG[jt][8 * hq + 7])}; }
              asm volatile("" ::: "memory"); }
            float lwv[2][16]; unsigned pkk[2][8], paa[2][8], pkf[2][8], prr[2][8], pvv[2][8], pgv[2][8];
            { f32x16 aA[2] = {zero16, zero16};
              pz_gemm<128, 4, 2>(aA, L + PZ_XA, SW + O_A2T, 64, hh * 64, p, h);
#pragma unroll
              for (int jt = 0; jt < 2; ++jt) { const float a0 = rvec[RW + hh * 64 + 32 * jt + p];
#pragma unroll
                  for (int q = 0; q < 8; ++q) paa[jt][q] = cvtpk(sigmoidf_(a0 + aA[jt][2 * q]), sigmoidf_(a0 + aA[jt][2 * q + 1])); } }
            if (l > 0) { f32x16 aV[2] = {zero16, zero16};
              pz_gemm<64, 2, 2>(aV, L + PZ_XV, SW + O_V2T, 32, hh * 64, p, h);
#pragma unroll
              for (int jt = 0; jt < 2; ++jt) { const float v0c = v0p[hh * 64 + 32 * jt + p];
#pragma unroll
                  for (int q = 0; q < 8; ++q) pgv[jt][q] = cvtpk(sigmoidf_(v0c + aV[jt][2 * q]), sigmoidf_(v0c + aV[jt][2 * q + 1])); } }
            unsigned char* XAb = ws + WS_XV + ((size_t)unit * NH + hh) * (4 * 64 * 16);
            {
            LAS unsigned* stash = (LAS unsigned*)ST + lane;
            float mr[2], mk[2], mv[2], kkc[2], kac[2], rkc[2];
#pragma unroll
            for (int jt = 0; jt < 2; ++jt) { const int c = hh * 64 + 32 * jt + p; mr[jt] = mu[c]; mk[jt] = mu[512 + c]; mv[jt] = mu[1024 + c];
                kkc[jt] = rvec[2 * RW + c]; kac[jt] = rvec[3 * RW + c]; rkc[jt] = rvec[4 * RW + c]; }
            bf16 rw[2][2][7];
#define ZL_LOAD(BUF, R) do { int hv_ = h; asm volatile("" : "+v"(hv_)); const int i_ = qrow((R), hv_); const bool hp_ = (tt0 + i_) > 0; \
                const bf16* zc_ = zu + (i_ * NZ + hh * 64 + p); const bf16* zp_ = hp_ ? zc_ - NZ : zc_; const unsigned ov_ = (unsigned)(i_ * RW + hh * 64 + p); \
                _Pragma("unroll") for (int jt_ = 0; jt_ < 2; ++jt_) { rw[BUF][jt_][0] = zc_[32 * jt_]; rw[BUF][jt_][1] = zc_[512 + 32 * jt_]; rw[BUF][jt_][2] = zc_[1024 + 32 * jt_]; \
                    rw[BUF][jt_][3] = zp_[32 * jt_]; rw[BUF][jt_][4] = zp_[512 + 32 * jt_]; rw[BUF][jt_][5] = zp_[1024 + 32 * jt_]; rw[BUF][jt_][6] = l > 0 ? VFu[ov_ + 32u * jt_] : (bf16)0; } } while (0)
            ZL_LOAD(0, 0);
#pragma unroll
            for (int rp = 0; rp < 8; ++rp) {
                float kk2[2][2], k2[2][2], r2[2][2], v2[2][2];
#pragma unroll
                for (int rr = 0; rr < 2; ++rr) {
                    const int r = 2 * rp + rr;
                    if (r + 1 < 16) ZL_LOAD((r + 1) & 1, r + 1);
                    int hv = h; asm volatile("" : "+v"(hv));
                    const int i = qrow(r, hv); const bool hp = (tt0 + i) > 0;
                    const float pm = hp ? 1.f : 0.f;
                    const unsigned ov = (unsigned)(i * RW + hh * 64 + p);
                    float kkr[2]; float n2 = 0.f, bs = 0.f;
#pragma unroll
                    for (int jt = 0; jt < 2; ++jt) {
                        const bf16* w_ = rw[r & 1][jt];
                        const float zr_ = bf2f(w_[0]), zk_ = bf2f(w_[1]), zv_ = bf2f(w_[2]);
                        const float pr_ = pm * bf2f(w_[3]), pk_ = pm * bf2f(w_[4]), pv_ = pm * bf2f(w_[5]);
                        const float rv = zr_ + mr[jt] * (pr_ - zr_), k0 = zk_ + mk[jt] * (pk_ - zk_), v0 = zv_ + mv[jt] * (pv_ - zv_);
                        float v = v0;
                        if (l == 0) { if (!dry) { VFu[ov + 32u * jt] = (bf16)f2bf(v0); } }
                        else { const float vf = bf2f(w_[6]); v = v0 + (vf - v0) * (rr ? bfhi(pgv[jt][rp]) : bflo(pgv[jt][rp])); }
                        const float aa = rr ? bfhi(paa[jt][rp]) : bflo(paa[jt][rp]);
                        kkr[jt] = k0 * kkc[jt]; n2 += kkr[jt] * kkr[jt];
                        const float k = k0 * (1.f + (aa - 1.f) * kac[jt]);
                        r2[jt][rr] = bf2f((bf16)f2bf(rv)); k2[jt][rr] = bf2f((bf16)f2bf(k)); v2[jt][rr] = bf2f((bf16)f2bf(v));
                        bs += r2[jt][rr] * k2[jt][rr] * rkc[jt];
                    }
                    n2 = half_sum32(n2); bs = half_sum32(bs);
                    const float inv = rsq_(fmaxf(n2, 1e-24f));
                    kk2[0][rr] = kkr[0] * inv; kk2[1][rr] = kkr[1] * inv;
                    if (p == 0) if (!dry) { BONu[(unsigned)(i * 8 + hh)] = bs; }
                }
#pragma unroll
                for (int jt = 0; jt < 2; ++jt) { pkk[jt][rp] = cvtpk(kk2[jt][0], kk2[jt][1]); pkf[jt][rp] = cvtpk(k2[jt][0], k2[jt][1]);
                    prr[jt][rp] = cvtpk(r2[jt][0], r2[jt][1]); pvv[jt][rp] = cvtpk(v2[jt][0], v2[jt][1]); }
                asm volatile("" ::: "memory");
                if (rp == 3) {
#pragma unroll
                    for (int jt = 0; jt < 2; ++jt)
#pragma unroll
                        for (int q = 0; q < 4; ++q) { stash[((jt * 4 + q) * 4 + 0) * 64] = pkk[jt][q]; stash[((jt * 4 + q) * 4 + 1) * 64] = pkf[jt][q]; stash[((jt * 4 + q) * 4 + 2) * 64] = prr[jt][q]; stash[((jt * 4 + q) * 4 + 3) * 64] = pvv[jt][q]; }
                    asm volatile("" ::: "memory");
                }
            }
#undef ZL_LOAD
            LDS_WAIT();
#pragma unroll
            for (int jt = 0; jt < 2; ++jt)
#pragma unroll
                for (int q = 0; q < 4; ++q) { pkk[jt][q] = stash[((jt * 4 + q) * 4 + 0) * 64]; pkf[jt][q] = stash[((jt * 4 + q) * 4 + 1) * 64]; prr[jt][q] = stash[((jt * 4 + q) * 4 + 2) * 64]; pvv[jt][q] = stash[((jt * 4 + q) * 4 + 3) * 64]; }
#pragma unroll
            for (int jt = 0; jt < 2; ++jt) { if (!dry) { const unsigned lo16 = (unsigned)lane * 16u; *(v4u*)(XAb + (lo16 + (unsigned)((jt * 2) * 1024))) = (v4u){pvv[jt][0], pvv[jt][1], pvv[jt][2], pvv[jt][3]}; *(v4u*)(XAb + (lo16 + (unsigned)((jt * 2 + 1) * 1024))) = (v4u){pvv[jt][4], pvv[jt][5], pvv[jt][6], pvv[jt][7]}; } }
            }
            { f32x16 aW[2] = {zero16, zero16};
              int p_ = p, h_ = h; asm volatile("" : "+v"(p_), "+v"(h_));
              pz_gemm<128, 4, 2>(aW, L + PZ_XW, SW + O_W2T, 64, hh * 64, p_, h_);
#pragma unroll
              for (int jt = 0; jt < 2; ++jt) { const float w0 = rvec[hh * 64 + 32 * jt + p];
#pragma unroll
                  for (int r = 0; r < 16; ++r) lwv[jt][r] = -0.6065306597126334f * sigmoidf_(w0 + aW[jt][r]); } }
            __syncthreads();
            if (!dry) {
            const size_t item_ = (size_t)unit * NH + hh;
            LAS unsigned char* TT = L + wave * 16384; LAS float* gC = (LAS float*)(lds + LDSCTL_OFF + 4096) + wave * 64;
            bf16x8 fAT[2][2], fBT[2][2], fKT[2][2], fRT[2][2], fVT[2][2];
#pragma unroll
            for (int jt = 0; jt < 2; ++jt) {
                float cum[16], tot[4], oth[4];
#pragma unroll
                for (int g = 0; g < 4; ++g) { cum[4 * g] = lwv[jt][4 * g]; cum[4 * g + 1] = cum[4 * g] + lwv[jt][4 * g + 1]; cum[4 * g + 2] = cum[4 * g + 1] + lwv[jt][4 * g + 2]; cum[4 * g + 3] = cum[4 * g + 2] + lwv[jt][4 * g + 3];
                    tot[g] = cum[4 * g + 3]; oth[g] = other_half(tot[g]); }
                float run = 0.f;
#pragma unroll
                for (int g = 0; g < 4; ++g) { const float base = run + (h ? oth[g] : 0.f);
#pragma unroll
                    for (int b4 = 0; b4 < 4; ++b4) cum[4 * g + b4] += base;
                    run += tot[g] + oth[g]; }
                gC[32 * jt + p] = __expf(run);
#pragma unroll
                for (int s2 = 0; s2 < 2; ++s2) {
                    unsigned da[4], db[4], dk[4], dr[4];
#pragma unroll
                    for (int qq = 0; qq < 4; ++qq) { const int q = 4 * s2 + qq;
                        float at2[2], bt2[2], kt2[2], rt2[2];
#pragma unroll
                        for (int rr = 0; rr < 2; ++rr) { const int r = 2 * q + rr; const float cv = cum[r], cx = cv - lwv[jt][r];
                            const float ea = __expf(cx), eb = __expf(-cv), er = __expf(cv);
                            const float kk = rr ? bfhi(pkk[jt][q]) : bflo(pkk[jt][q]), aa = rr ? bfhi(paa[jt][q]) : bflo(paa[jt][q]);
                            const float kf = rr ? bfhi(pkf[jt][q]) : bflo(pkf[jt][q]), rv = rr ? bfhi(prr[jt][q]) : bflo(prr[jt][q]);
                            at2[rr] = -kk * ea; bt2[rr] = kk * aa * eb; kt2[rr] = kf * eb; rt2[rr] = rv * er; }
                        da[qq] = cvtpk(at2[0], at2[1]); db[qq] = cvtpk(bt2[0], bt2[1]); dk[qq] = cvtpk(kt2[0], kt2[1]); dr[qq] = cvtpk(rt2[0], rt2[1]); }
                    fAT[jt][s2] = mkfrag(da[0], da[1], da[2], da[3]); fBT[jt][s2] = mkfrag(db[0], db[1], db[2], db[3]); fKT[jt][s2] = mkfrag(dk[0], dk[1], dk[2], dk[3]); fRT[jt][s2] = mkfrag(dr[0], dr[1], dr[2], dr[3]);
                    fVT[jt][s2] = mkfrag(pvv[jt][4 * s2], pvv[jt][4 * s2 + 1], pvv[jt][4 * s2 + 2], pvv[jt][4 * s2 + 3]);
                }
            }
            const int wbase = h * 512 + p * 2, rbase = p * 128 + h * 16;
#define TM_PUT(TILE, ARR) do { _Pragma("unroll") for (int jt = 0; jt < 2; ++jt) _Pragma("unroll") for (int r = 0; r < 16; ++r) \
                *(LAS bf16*)(TT + wbase + ((TILE) * 4096 + ((r & 3) + 8 * (r >> 2)) * 128 + jt * 64)) = (bf16)ARR[jt][r >> 3][r & 7]; } while (0)
            LDS_WAIT();
            TM_PUT(0, fAT); TM_PUT(1, fBT); TM_PUT(2, fKT); TM_PUT(3, fRT);
            LDS_WAIT();
#undef TM_PUT
            f32x16 Aab = zero16, AabT = zero16, Aak = zero16, Arb = zero16, Ark = zero16;
#pragma unroll
            for (int s4 = 0; s4 < 4; ++s4) {
                const bf16x8 fa = *(const LAS bf16x8*)(TT + rbase + s4 * 32), fb = *(const LAS bf16x8*)(TT + rbase + 4096 + s4 * 32), fk = *(const LAS bf16x8*)(TT + rbase + 8192 + s4 * 32), fr = *(const LAS bf16x8*)(TT + rbase + 12288 + s4 * 32);
                Aab = MFMA32(fb, fa, Aab); AabT = MFMA32(fa, fb, AabT); Aak = MFMA32(fk, fa, Aak); Arb = MFMA32(fb, fr, Arb); Ark = MFMA32(fk, fr, Ark);
            }
#pragma unroll
            for (int r = 0; r < 16; ++r) { const int q = qrow(r, h);
                Aab[r] = (q < p) ? Aab[r] : 0.f;  Aak[r] = (q < p) ? Aak[r] : 0.f; AabT[r] = (p < q) ? AabT[r] : 0.f;
                Arb[r] = (q <= p) ? Arb[r] : 0.f; Ark[r] = (q <= p) ? Ark[r] : 0.f; }
            f32x16 Tm = Aab;
#pragma unroll
            for (int r = 0; r < 16; ++r) Tm[r] += (qrow(r, h) == p) ? 1.f : 0.f;
            bf16x8 X0 = accfrag(Aab, 0), X1 = accfrag(Aab, 1), XT0 = accfrag(AabT, 0), XT1 = accfrag(AabT, 1);
#pragma unroll
            for (int it = 0; it < 4; ++it) {
                f32x16 X2T = MFMA32(X0, XT0, zero16); X2T = MFMA32(X1, XT1, X2T);
                const bf16x8 T0 = accfrag(Tm, 0), T1 = accfrag(Tm, 1);
                const bf16x8 Y0 = accfrag(X2T, 0), Y1 = accfrag(X2T, 1);
                Tm = MFMA32(Y0, T0, Tm); Tm = MFMA32(Y1, T1, Tm);
                if (it < 3) { f32x16 X2 = MFMA32(XT0, X0, zero16); X2 = MFMA32(XT1, X1, X2); X0 = accfrag(X2, 0); X1 = accfrag(X2, 1); XT0 = Y0; XT1 = Y1; }
            }
            const bf16x8 Tf0 = accfrag(Tm, 0), Tf1 = accfrag(Tm, 1);
            const bf16x8 Akf0 = accfrag(Aak, 0), Akf1 = accfrag(Aak, 1), Abf0 = accfrag(Arb, 0), Abf1 = accfrag(Arb, 1), Arf0 = accfrag(Ark, 0), Arf1 = accfrag(Ark, 1);
            bf16x8 fPT[2][2], fQT[2][2];
#pragma unroll
            for (int ct = 0; ct < 2; ++ct) {
                f32x16 a_ = MFMA32(Tf0, fAT[ct][0], zero16); a_ = MFMA32(Tf1, fAT[ct][1], a_); fPT[ct][0] = accfrag(a_, 0); fPT[ct][1] = accfrag(a_, 1);
                f32x16 b_ = MFMA32(Akf0, fVT[ct][0], zero16); b_ = MFMA32(Akf1, fVT[ct][1], b_);
                const bf16x8 av0 = accfrag(b_, 0), av1 = accfrag(b_, 1);
                f32x16 c_ = MFMA32(Tf0, av0, zero16); c_ = MFMA32(Tf1, av1, c_); fQT[ct][0] = accfrag(c_, 0); fQT[ct][1] = accfrag(c_, 1);
            }
            const int ln_ = ((h & 1) << 5) | p;
            bf16* RPo = (bf16*)(ws + WS_SRP) + item_ * 2048; bf16* YLo = (bf16*)(ws + WS_SYL) + item_ * 2048;
            bf16* Mo = (bf16*)(ws + WS_SM) + item_ * 4096; bf16* NTo = (bf16*)(ws + WS_SNT) + item_ * 4096;
#pragma unroll
            for (int ct = 0; ct < 2; ++ct) {
                f32x16 a_;
#pragma unroll
                for (int g = 0; g < 4; ++g) { const v2u w = *(const LAS v2u*)(TT + (p * 128 + 8 * h) + (12288 + (4 * ct + g) * 16));
                    a_[4 * g] = bflo(w.x); a_[4 * g + 1] = bfhi(w.x); a_[4 * g + 2] = bflo(w.y); a_[4 * g + 3] = bfhi(w.y); }
                a_ = MFMA32(fPT[ct][0], Abf0, a_); a_ = MFMA32(fPT[ct][1], Abf1, a_);
#pragma unroll
                for (int s2 = 0; s2 < 2; ++s2) *(bf16x8*)(RPo + (unsigned)(((2 * ct + s2) * 64 + ln_) * 8)) = accfrag(a_, s2);
                f32x16 y_ = MFMA32(Abf0, fQT[ct][0], zero16); y_ = MFMA32(Abf1, fQT[ct][1], y_); y_ = MFMA32(Arf0, fVT[ct][0], y_); y_ = MFMA32(Arf1, fVT[ct][1], y_);
#pragma unroll
                for (int s2 = 0; s2 < 2; ++s2) *(bf16x8*)(YLo + (unsigned)(((2 * ct + s2) * 64 + ln_) * 8)) = accfrag(y_, s2);
            }
            LDS_WAIT();
#pragma unroll
            for (int ctp = 0; ctp < 2; ++ctp) {
                const float gl = gC[32 * ctp + p];
#pragma unroll
                for (int ct = 0; ct < 2; ++ct) {
                    f32x16 m_ = MFMA32(fPT[ct][0], fBT[ctp][0], zero16); m_ = MFMA32(fPT[ct][1], fBT[ctp][1], m_);
#pragma unroll
                    for (int r = 0; r < 16; ++r) m_[r] = (m_[r] + ((ct == ctp && qrow(r, h) == p) ? 1.f : 0.f)) * gl;
#pragma unroll
                    for (int s2 = 0; s2 < 2; ++s2) *(bf16x8*)(Mo + (unsigned)(((4 * ctp + 2 * ct + s2) * 64 + ln_) * 8)) = accfrag(m_, s2);
                    __builtin_amdgcn_sched_barrier(0);
                }
            }
#pragma unroll
            for (int ctd = 0; ctd < 2; ++ctd)
#pragma unroll
                for (int ctp = 0; ctp < 2; ++ctp) {
                    f32x16 n_ = MFMA32(fBT[ctp][0], fQT[ctd][0], zero16); n_ = MFMA32(fBT[ctp][1], fQT[ctd][1], n_); n_ = MFMA32(fKT[ctp][0], fVT[ctd][0], n_); n_ = MFMA32(fKT[ctp][1], fVT[ctd][1], n_);
#pragma unroll
                    for (int g = 0; g < 4; ++g) { const f32x4 gv = *(const LAS f32x4*)(gC + 4 * h + (32 * ctp + 8 * g)); n_[4 * g] *= gv.x; n_[4 * g + 1] *= gv.y; n_[4 * g + 2] *= gv.z; n_[4 * g + 3] *= gv.w; }
#pragma unroll
                    for (int s2 = 0; s2 < 2; ++s2) *(bf16x8*)(NTo + (unsigned)(((4 * ctd + 2 * ctp + s2) * 64 + ln_) * 8)) = accfrag(n_, s2);
                    __builtin_amdgcn_sched_barrier(0);
                }

            }
        }
    }
}

__device__ __forceinline__ void scan_local2_item(unsigned char* ws, int item_i, LAS unsigned char* TT, LAS float* gC, int lane) {
    const size_t item = (size_t)item_i; const int p = lane & 31, h = lane >> 5;
    const f32x16 zero16 = {0.f, 0.f, 0.f, 0.f, 0.f, 0.f, 0.f, 0.f, 0.f, 0.f, 0.f, 0.f, 0.f, 0.f, 0.f, 0.f};
    float lwv[2][16]; unsigned pkk[2][8], paa[2][8], pkf[2][8], prr[2][8], pvv[2][8];
    { const v4u* XA = (const v4u*)(ws + WS_XA) + (item * 20) * 64 + lane; const v4u* XL = (const v4u*)(ws + WS_XL) + (item * 8) * 64 + lane;
#pragma unroll
      for (int jt = 0; jt < 2; ++jt)
#pragma unroll
          for (int hq = 0; hq < 2; ++hq) {
              { const v4u w = XA[(0 * 4 + jt * 2 + hq) * 64]; pkk[jt][4 * hq] = w.x; pkk[jt][4 * hq + 1] = w.y; pkk[jt][4 * hq + 2] = w.z; pkk[jt][4 * hq + 3] = w.w; }
              { const v4u w = XA[(1 * 4 + jt * 2 + hq) * 64]; paa[jt][4 * hq] = w.x; paa[jt][4 * hq + 1] = w.y; paa[jt][4 * hq + 2] = w.z; paa[jt][4 * hq + 3] = w.w; }
              { const v4u w = XA[(2 * 4 + jt * 2 + hq) * 64]; pkf[jt][4 * hq] = w.x; pkf[jt][4 * hq + 1] = w.y; pkf[jt][4 * hq + 2] = w.z; pkf[jt][4 * hq + 3] = w.w; }
              { const v4u w = XA[(3 * 4 + jt * 2 + hq) * 64]; prr[jt][4 * hq] = w.x; prr[jt][4 * hq + 1] = w.y; prr[jt][4 * hq + 2] = w.z; prr[jt][4 * hq + 3] = w.w; }
              { const v4u w = XA[(4 * 4 + jt * 2 + hq) * 64]; pvv[jt][4 * hq] = w.x; pvv[jt][4 * hq + 1] = w.y; pvv[jt][4 * hq + 2] = w.z; pvv[jt][4 * hq + 3] = w.w; } }
#pragma unroll
      for (int jt = 0; jt < 2; ++jt)
#pragma unroll
          for (int g = 0; g < 4; ++g) { const v4u w = XL[(jt * 4 + g) * 64]; lwv[jt][4 * g] = __uint_as_float(w.x); lwv[jt][4 * g + 1] = __uint_as_float(w.y); lwv[jt][4 * g + 2] = __uint_as_float(w.z); lwv[jt][4 * g + 3] = __uint_as_float(w.w); } }
    {
            bf16x8 fAT[2][2], fBT[2][2], fKT[2][2], fRT[2][2], fVT[2][2];
#pragma unroll
            for (int jt = 0; jt < 2; ++jt) {
                float cum[16], tot[4], oth[4];
#pragma unroll
                for (int g = 0; g < 4; ++g) { cum[4 * g] = lwv[jt][4 * g]; cum[4 * g + 1] = cum[4 * g] + lwv[jt][4 * g + 1]; cum[4 * g + 2] = cum[4 * g + 1] + lwv[jt][4 * g + 2]; cum[4 * g + 3] = cum[4 * g + 2] + lwv[jt][4 * g + 3];
                    tot[g] = cum[4 * g + 3]; oth[g] = other_half(tot[g]); }
                float run = 0.f;
#pragma unroll
                for (int g = 0; g < 4; ++g) { const float base = run + (h ? oth[g] : 0.f);
#pragma unroll
                    for (int b4 = 0; b4 < 4; ++b4) cum[4 * g + b4] += base;
                    run += tot[g] + oth[g]; }
                gC[32 * jt + p] = __expf(run);
#pragma unroll
                for (int s2 = 0; s2 < 2; ++s2) {
                    unsigned da[4], db[4], dk[4], dr[4];
#pragma unroll
                    for (int qq = 0; qq < 4; ++qq) { const int q = 4 * s2 + qq;
                        float at2[2], bt2[2], kt2[2], rt2[2];
#pragma unroll
                        for (int rr = 0; rr < 2; ++rr) { const int r = 2 * q + rr; const float cv = cum[r], cx = cv - lwv[jt][r];
                            const float ea = __expf(cx), eb = __expf(-cv), er = __expf(cv);
                            const float kk = rr ? bfhi(pkk[jt][q]) : bflo(pkk[jt][q]), aa = rr ? bfhi(paa[jt][q]) : bflo(paa[jt][q]);
                            const float kf = rr ? bfhi(pkf[jt][q]) : bflo(pkf[jt][q]), rv = rr ? bfhi(prr[jt][q]) : bflo(prr[jt][q]);
                            at2[rr] = -kk * ea; bt2[rr] = kk * aa * eb; kt2[rr] = kf * eb; rt2[rr] = rv * er; }
                        da[qq] = cvtpk(at2[0], at2[1]); db[qq] = cvtpk(bt2[0], bt2[1]); dk[qq] = cvtpk(kt2[0], kt2[1]); dr[qq] = cvtpk(rt2[0], rt2[1]); }
                    fAT[jt][s2] = mkfrag(da[0], da[1], da[2], da[3]); fBT[jt][s2] = mkfrag(db[0], db[1], db[2], db[3]); fKT[jt][s2] = mkfrag(dk[0], dk[1], dk[2], dk[3]); fRT[jt][s2] = mkfrag(dr[0], dr[1], dr[2], dr[3]);
                    fVT[jt][s2] = mkfrag(pvv[jt][4 * s2], pvv[jt][4 * s2 + 1], pvv[jt][4 * s2 + 2], pvv[jt][4 * s2 + 3]);
                }
            }
            const int wbase = h * 512 + p * 2, rbase = p * 128 + h * 16;
#define TM_PUT(TILE, ARR) do { _Pragma("unroll") for (int jt = 0; jt < 2; ++jt) _Pragma("unroll") for (int r = 0; r < 16; ++r) \
                *(LAS bf16*)(TT + wbase + ((TILE) * 4096 + ((r & 3) + 8 * (r >> 2)) * 128 + jt * 64)) = (bf16)ARR[jt][r >> 3][r & 7]; } while (0)
            LDS_WAIT();
            TM_PUT(0, fAT); TM_PUT(1, fBT); TM_PUT(2, fKT); TM_PUT(3, fRT);
            LDS_WAIT();
#undef TM_PUT
            f32x16 Aab = zero16, AabT = zero16, Aak = zero16, Arb = zero16, Ark = zero16;
#pragma unroll
            for (int s4 = 0; s4 < 4; ++s4) {
                const bf16x8 fa = *(const LAS bf16x8*)(TT + rbase + s4 * 32), fb = *(const LAS bf16x8*)(TT + rbase + 4096 + s4 * 32), fk = *(const LAS bf16x8*)(TT + rbase + 8192 + s4 * 32), fr = *(const LAS bf16x8*)(TT + rbase + 12288 + s4 * 32);
                Aab = MFMA32(fb, fa, Aab); AabT = MFMA32(fa, fb, AabT); Aak = MFMA32(fk, fa, Aak); Arb = MFMA32(fb, fr, Arb); Ark = MFMA32(fk, fr, Ark);
            }
#pragma unroll
            for (int r = 0; r < 16; ++r) { const int q = qrow(r, h);
                Aab[r] = (q < p) ? Aab[r] : 0.f;  Aak[r] = (q < p) ? Aak[r] : 0.f; AabT[r] = (p < q) ? AabT[r] : 0.f;
                Arb[r] = (q <= p) ? Arb[r] : 0.f; Ark[r] = (q <= p) ? Ark[r] : 0.f; }
            f32x16 Tm = Aab;
#pragma unroll
            for (int r = 0; r < 16; ++r) Tm[r] += (qrow(r, h) == p) ? 1.f : 0.f;
            bf16x8 X0 = accfrag(Aab, 0), X1 = accfrag(Aab, 1), XT0 = accfrag(AabT, 0), XT1 = accfrag(AabT, 1);
#pragma unroll
            for (int it = 0; it < 4; ++it) {
                f32x16 X2T = MFMA32(X0, XT0, zero16); X2T = MFMA32(X1, XT1, X2T);
                const bf16x8 T0 = accfrag(Tm, 0), T1 = accfrag(Tm, 1);
                const bf16x8 Y0 = accfrag(X2T, 0), Y1 = accfrag(X2T, 1);
                Tm = MFMA32(Y0, T0, Tm); Tm = MFMA32(Y1, T1, Tm);
                if (it < 3) { f32x16 X2 = MFMA32(XT0, X0, zero16); X2 = MFMA32(XT1, X1, X2); X0 = accfrag(X2, 0); X1 = accfrag(X2, 1); XT0 = Y0; XT1 = Y1; }
            }
            const bf16x8 Tf0 = accfrag(Tm, 0), Tf1 = accfrag(Tm, 1);
            const bf16x8 Akf0 = accfrag(Aak, 0), Akf1 = accfrag(Aak, 1), Abf0 = accfrag(Arb, 0), Abf1 = accfrag(Arb, 1), Arf0 = accfrag(Ark, 0), Arf1 = accfrag(Ark, 1);
            bf16x8 fPT[2][2], fQT[2][2];
#pragma unroll
            for (int ct = 0; ct < 2; ++ct) {
                f32x16 a_ = MFMA32(Tf0, fAT[ct][0], zero16); a_ = MFMA32(Tf1, fAT[ct][1], a_); fPT[ct][0] = accfrag(a_, 0); fPT[ct][1] = accfrag(a_, 1);
                f32x16 b_ = MFMA32(Akf0, fVT[ct][0], zero16); b_ = MFMA32(Akf1, fVT[ct][1], b_);
                const bf16x8 av0 = accfrag(b_, 0), av1 = accfrag(b_, 1);
                f32x16 c_ = MFMA32(Tf0, av0, zero16); c_ = MFMA32(Tf1, av1, c_); fQT[ct][0] = accfrag(c_, 0); fQT[ct][1] = accfrag(c_, 1);
            }
            bf16* RPo = (bf16*)(ws + WS_SRP) + item * 2048; bf16* YLo = (bf16*)(ws + WS_SYL) + item * 2048;
            bf16* Mo = (bf16*)(ws + WS_SM) + item * 4096; bf16* NTo = (bf16*)(ws + WS_SNT) + item * 4096;
#pragma unroll
            for (int ct = 0; ct < 2; ++ct) {
                f32x16 a_;
#pragma unroll
                for (int g = 0; g < 4; ++g) { const v2u w = *(const LAS v2u*)(TT + (p * 128 + 8 * h) + (12288 + (4 * ct + g) * 16));
                    a_[4 * g] = bflo(w.x); a_[4 * g + 1] = bfhi(w.x); a_[4 * g + 2] = bflo(w.y); a_[4 * g + 3] = bfhi(w.y); }
                a_ = MFMA32(fPT[ct][0], Abf0, a_); a_ = MFMA32(fPT[ct][1], Abf1, a_);
#pragma unroll
                for (int s2 = 0; s2 < 2; ++s2) *(bf16x8*)(RPo + (unsigned)(p * 64 + (4 * ct + 2 * s2 + h) * 8)) = accfrag(a_, s2);
                f32x16 y_ = MFMA32(Abf0, fQT[ct][0], zero16); y_ = MFMA32(Abf1, fQT[ct][1], y_); y_ = MFMA32(Arf0, fVT[ct][0], y_); y_ = MFMA32(Arf1, fVT[ct][1], y_);
#pragma unroll
                for (int s2 = 0; s2 < 2; ++s2) *(bf16x8*)(YLo + (unsigned)((32 * ct + p) * 32 + (2 * s2 + h) * 8)) = accfrag(y_, s2);
            }
            LDS_WAIT();
#pragma unroll
            for (int ctp = 0; ctp < 2; ++ctp) {
                const float gl = gC[32 * ctp + p];
#pragma unroll
                for (int ct = 0; ct < 2; ++ct) {
                    f32x16 m_ = MFMA32(fPT[ct][0], fBT[ctp][0], zero16); m_ = MFMA32(fPT[ct][1], fBT[ctp][1], m_);
#pragma unroll
                    for (int r = 0; r < 16; ++r) m_[r] = (m_[r] + ((ct == ctp && qrow(r, h) == p) ? 1.f : 0.f)) * gl;
#pragma unroll
                    for (int s2 = 0; s2 < 2; ++s2) *(bf16x8*)(Mo + (unsigned)((32 * ctp + p) * 64 + (4 * ct + 2 * s2 + h) * 8)) = accfrag(m_, s2);
                    __builtin_amdgcn_sched_barrier(0);
                }
            }
#pragma unroll
            for (int ctd = 0; ctd < 2; ++ctd)
#pragma unroll
                for (int ctp = 0; ctp < 2; ++ctp) {
                    f32x16 n_ = MFMA32(fBT[ctp][0], fQT[ctd][0], zero16); n_ = MFMA32(fBT[ctp][1], fQT[ctd][1], n_); n_ = MFMA32(fKT[ctp][0], fVT[ctd][0], n_); n_ = MFMA32(fKT[ctp][1], fVT[ctd][1], n_);
#pragma unroll
                    for (int g = 0; g < 4; ++g) { const f32x4 gv = *(const LAS f32x4*)(gC + 4 * h + (32 * ctp + 8 * g)); n_[4 * g] *= gv.x; n_[4 * g + 1] *= gv.y; n_[4 * g + 2] *= gv.z; n_[4 * g + 3] *= gv.w; }
#pragma unroll
                    for (int s2 = 0; s2 < 2; ++s2) *(bf16x8*)(NTo + (unsigned)((32 * ctd + p) * 64 + (4 * ctp + 2 * s2 + h) * 8)) = accfrag(n_, s2);
                    __builtin_amdgcn_sched_barrier(0);
                }
    }
}
__device__ __forceinline__ void ph_scan_local2(unsigned char* ws, LAS unsigned char* lds, int gw, int NGW, int wave, int lane_in) {
    LAS unsigned char* TT = lds + RING_OFF + wave * 16384;
    LAS float* gC = (LAS float*)(lds + LDSCTL_OFF + 4096) + wave * 64;
    for (int item = gw; item < BATCH * NCHK * NH; item += NGW) { int lane = lane_in; asm volatile("" : "+v"(lane)); scan_local2_item(ws, item, TT, gC, lane); }
}
#ifndef DRY_REP
#define DRY_REP 0
#endif
#ifndef CARRY_ONLY_REP
#define CARRY_ONLY_REP 0
#endif
#ifndef ATTN_ONLY_REP
#define ATTN_ONLY_REP 0
#endif


__device__ __forceinline__ double rope_inv_freq(int i) {
    const double q = (i & 3) == 0 ? 1.0 : (i & 3) == 1 ? 0.5623413251903491 : (i & 3) == 2 ? 0.31622776601683794 : 0.1778279410038923;
    const double p = (i >> 2) == 0 ? 1.0 : (i >> 2) == 1 ? 0.1 : (i >> 2) == 2 ? 0.01 : 0.001;
    return q * p;
}
__device__ __forceinline__ void ph_mod_rope(const Args& a, unsigned char* ws, LAS unsigned char* lds, int gw, int NGW, int tid, int lane, int gtid, int GT) {
    const float* c = a.in[I_C]; const float* wada = a.in[I_WADA]; const float* bada = a.in[I_BADA];
    float* mod = (float*)(ws + WS_MOD);
    LAS float* cs = (LAS float*)(lds + RING_OFF);
    for (int i = tid; i < 8 * 1024; i += NWAVES * 64) { const float cv = c[i]; cs[i] = cv * sigmoidf_(cv); }
    __syncthreads();
    LAS float* red = cs + 8 * 1024;
    const int wave = tid >> 6;
    for (int it = blockIdx.x; it < 2 * 96; it += gridDim.x) {
        const int l = it / 96, jb = it % 96, kc = wave; const int j0 = jb * 64 + lane;
        float acc[8];
#pragma unroll
        for (int b = 0; b < 8; ++b) acc[b] = 0.f;
        const float* wp = wada + ((size_t)l * 1024 + kc * 128) * 6144 + j0;
#pragma unroll 16
        for (int k = 0; k < 128; ++k) { const float w = wp[(size_t)k * 6144];
#pragma unroll
            for (int b = 0; b < 8; ++b) acc[b] += w * cs[b * 1024 + kc * 128 + k]; }
        __syncthreads();
#pragma unroll
        for (int b = 0; b < 8; ++b) red[(wave * 8 + b) * 64 + lane] = acc[b];
        __syncthreads();
        { const int b = tid >> 6, j = tid & 63; float s = bada[l * 6144 + jb * 64 + j];
#pragma unroll
          for (int w = 0; w < 8; ++w) s += red[(w * 8 + b) * 64 + j];
          mod[(size_t)(l * 8 + b) * 6144 + jb * 64 + j] = s; }
    }
    const int* pos = (const int*)a.in[I_POS];
    float* ct = (float*)(ws + WS_COS); float* st = (float*)(ws + WS_SIN);
    for (int it = gtid; it < M * 16; it += GT) {
        const int t = it >> 4, i = it & 15;
        const double inv = rope_inv_freq(i);
        double rev = (double)pos[t] * inv * 0.15915494309189535;
        rev -= floor(rev);
        const float rf = (float)rev;
        ct[it] = __builtin_amdgcn_cosf(rf); st[it] = __builtin_amdgcn_sinf(rf);
    }
}

__device__ __forceinline__ void cvt_item(const float* W, int Nsrc, int K, bf16* WT, int dst_row0, int src_col0, int k0, LAS float* scr, int lane) {
    if (src_col0 >= 0) {
        const int lr = lane >> 3, lc = (lane & 7) * 4; f32x4 v[8];
        const float* src = W + (size_t)(k0 + lr) * Nsrc + src_col0 + lc;
#pragma unroll
        for (int i = 0; i < 8; ++i) v[i] = *(const f32x4*)(src + (size_t)(8 * i) * Nsrc);
#pragma unroll
        for (int i = 0; i < 8; ++i) { LAS float* dd = scr + (8 * i + lr) * 33 + lc; dd[0] = v[i].x; dd[1] = v[i].y; dd[2] = v[i].z; dd[3] = v[i].w; }
    } else {
#pragma unroll 8
        for (int i = 0; i < 32; ++i) { const int kk = 2 * i + (lane >> 5); scr[kk * 33 + (lane & 31)] = 0.f; }
    }
    LDS_WAIT();
    const int c = lane & 7;
#pragma unroll
    for (int j = 0; j < 4; ++j) { const int n = (lane >> 3) + 8 * j; const LAS float* s = scr + (8 * c) * 33 + n;
        v4u o; o.x = pk2(s[0 * 33], s[1 * 33]); o.y = pk2(s[2 * 33], s[3 * 33]); o.z = pk2(s[4 * 33], s[5 * 33]); o.w = pk2(s[6 * 33], s[7 * 33]);
        *(v4u*)(WT + (size_t)(dst_row0 + n) * K + k0 + 8 * c) = o; }
    LDS_WAIT();
}
__device__ __forceinline__ int swiglu_src_col(int nrow, int F) { const int pn = nrow >> 8, within = nrow & 255; return (within >> 7) * F + pn * 128 + (within & 127); }

__device__ __forceinline__ void cvt_item_f8(const float* W, int Nsrc, int K, unsigned char* WT, int dst_row0, int src_col0, int k0, LAS float* scr, int lane) {
    { const int lr = lane >> 3, lc = (lane & 7) * 4; f32x4 v[8];
      const float* src = W + (size_t)(k0 + lr) * Nsrc + src_col0 + lc;
#pragma unroll
      for (int i = 0; i < 8; ++i) v[i] = *(const f32x4*)(src + (size_t)(8 * i) * Nsrc);
#pragma unroll
      for (int i = 0; i < 8; ++i) { LAS float* dd = scr + (8 * i + lr) * 33 + lc; dd[0] = v[i].x * F8_WSCALE; dd[1] = v[i].y * F8_WSCALE; dd[2] = v[i].z * F8_WSCALE; dd[3] = v[i].w * F8_WSCALE; } }
    LDS_WAIT();
    const int c = lane & 3;
#pragma unroll
    for (int j = 0; j < 2; ++j) { const int n = (lane >> 2) + 16 * j; const LAS float* s = scr + (16 * c) * 33 + n;
        v4u o; o.x = f8pk4(s[0 * 33], s[1 * 33], s[2 * 33], s[3 * 33]); o.y = f8pk4(s[4 * 33], s[5 * 33], s[6 * 33], s[7 * 33]);
        o.z = f8pk4(s[8 * 33], s[9 * 33], s[10 * 33], s[11 * 33]); o.w = f8pk4(s[12 * 33], s[13 * 33], s[14 * 33], s[15 * 33]);
        *(v4u*)(WT + (size_t)(dst_row0 + n) * K + k0 + 16 * c) = o; }
    LDS_WAIT();
}
__device__ __forceinline__ void cvt_f8_load(f32x4 (&v)[8], const float* W, int Nsrc, int src_col0, int k0, int lane) {
    const int lr = lane >> 3, lc = (lane & 7) * 4; const float* src = W + (size_t)(k0 + lr) * Nsrc + src_col0 + lc;
#pragma unroll
    for (int i = 0; i < 8; ++i) v[i] = *(const f32x4*)(src + (size_t)(8 * i) * Nsrc);
}
__device__ __forceinline__ void cvt_f8_finish(const f32x4 (&v)[8], int K, unsigned char* WT, int dst_row0, int k0, LAS float* scr, int lane) {
    { const int lr = lane >> 3, lc = (lane & 7) * 4;
#pragma unroll
      for (int i = 0; i < 8; ++i) { LAS float* dd = scr + (8 * i + lr) * 33 + lc; dd[0] = v[i].x * F8_WSCALE; dd[1] = v[i].y * F8_WSCALE; dd[2] = v[i].z * F8_WSCALE; dd[3] = v[i].w * F8_WSCALE; } }
    LDS_WAIT();
    const int c = lane & 3;
#pragma unroll
    for (int j = 0; j < 2; ++j) { const int n = (lane >> 2) + 16 * j; const LAS float* s = scr + (16 * c) * 33 + n;
        v4u o; o.x = f8pk4(s[0 * 33], s[1 * 33], s[2 * 33], s[3 * 33]); o.y = f8pk4(s[4 * 33], s[5 * 33], s[6 * 33], s[7 * 33]);
        o.z = f8pk4(s[8 * 33], s[9 * 33], s[10 * 33], s[11 * 33]); o.w = f8pk4(s[12 * 33], s[13 * 33], s[14 * 33], s[15 * 33]);
        *(v4u*)(WT + (size_t)(dst_row0 + n) * K + k0 + 16 * c) = o; }
    LDS_WAIT();
}
__device__ __forceinline__ void ph_convert(const Args& a, unsigned char* ws, LAS unsigned char* lds, int gw, int NGW, int wave, int lane, int part) {
    LAS float* scr = (LAS float*)(lds + RING_OFF + wave * 16384);
    constexpr int I_WIN = 80 * 16;
    constexpr int I_WO = 32 * 16;
    constexpr int I_FI = 176 * 16;
    constexpr int I_FO = 32 * 44;
    constexpr int I_MI = 224 * 16;
    constexpr int I_MO = 32 * 56;
    constexpr int NITEMS = 2 * I_WIN + 2 * I_WO + I_FI + I_FO + 8 * I_MI + 8 * I_MO;
    constexpr int NDENSE = 2 * I_WIN + 2 * I_WO + I_FI + I_FO, HALFMOE = (NITEMS - NDENSE) / 2;
    static_assert((NITEMS - NDENSE) % 2 == 0, "MoE items");
    const int lo = part == 0 ? 0 : NDENSE + (part - 1) * HALFMOE, hi = part == 0 ? NDENSE : lo + HALFMOE;
    if (part != 0) {
        const float* Wc; int Nc, Kc, drc, scc, k0c; unsigned char* WTc;
#define MOE_DECODE(it_, W_, N_, K_, WT_, dr_, sc_, k0_) do { int r_ = (it_) - NDENSE; \
            if (r_ < 8 * I_MI) { const int e_ = r_ / I_MI; r_ %= I_MI; const int nb_ = r_ / 16, kb_ = r_ % 16; W_ = a.in[I_MOEI] + (size_t)e_ * 1024 * 2 * DFFE; N_ = 2 * DFFE; K_ = 1024; \
                WT_ = ws + WS_WMI + (size_t)e_ * 2 * DFFE * 1024; dr_ = nb_ * 32; sc_ = swiglu_src_col(nb_ * 32, DFFE); k0_ = kb_ * 64; } \
            else { r_ -= 8 * I_MI; const int e_ = r_ / I_MO; r_ %= I_MO; const int nb_ = r_ / 56, kb_ = r_ % 56; W_ = a.in[I_MOEO] + (size_t)e_ * DFFE * 1024; N_ = 1024; K_ = DFFE; \
                WT_ = ws + WS_WMO + (size_t)e_ * 1024 * DFFE; dr_ = nb_ * 32; sc_ = nb_ * 32; k0_ = kb_ * 64; } } while (0)
        int it = lo + gw; if (it >= hi) return;
        f32x4 va[8], vb[8];
        MOE_DECODE(it, Wc, Nc, Kc, WTc, drc, scc, k0c); cvt_f8_load(va, Wc, Nc, scc, k0c, lane);
        for (;;) {
            const int itn = it + NGW; const bool more = itn < hi;
            const float* Wn = Wc; int Nn = Nc, Kn = Kc, drn = drc, scn = scc, k0n = k0c; unsigned char* WTn = WTc;
            if (more) { MOE_DECODE(itn, Wn, Nn, Kn, WTn, drn, scn, k0n); cvt_f8_load(vb, Wn, Nn, scn, k0n, lane); }
            cvt_f8_finish(va, Kc, WTc, drc, k0c, scr, lane);
            if (!more) break;
#pragma unroll
            for (int i = 0; i < 8; ++i) va[i] = vb[i];
            Wc = Wn; Nc = Nn; Kc = Kn; WTc = WTn; drc = drn; scc = scn; k0c = k0n; it = itn;
        }
#undef MOE_DECODE
        return;
    }
    for (int it = lo + gw; it < hi; it += NGW) {
        int r = it;
        if (r < 2 * I_WIN) { const int l = r / I_WIN; r %= I_WIN; const int nb = r / 16, kb = r % 16;
            const int nvalid = l == 0 ? N_IN0 / 32 : N_IN1 / 32;
            cvt_item(a.in[l == 0 ? I_WIN0 : I_WIN1], l == 0 ? N_IN0 : N_IN1, 1024, (bf16*)(ws + WS_WIN) + (size_t)l * NZ * 1024, nb * 32, nb < nvalid ? nb * 32 : -1, kb * 64, scr, lane); continue; }
        r -= 2 * I_WIN;
        if (r < 2 * I_WO) { const int l = r / I_WO; r %= I_WO; const int nb = r / 16, kb = r % 16;
            cvt_item(a.in[I_WOUT] + (size_t)l * 1024 * 1024, 1024, 1024, (bf16*)(ws + WS_WOUT) + (size_t)l * 1024 * 1024, nb * 32, nb * 32, kb * 64, scr, lane); continue; }
        r -= 2 * I_WO;
        if (r < I_FI) { const int nb = r / 16, kb = r % 16;
            cvt_item(a.in[I_FFI], 2 * DFF, 1024, (bf16*)(ws + WS_WFFI), nb * 32, swiglu_src_col(nb * 32, DFF), kb * 64, scr, lane); continue; }
        r -= I_FI;
        if (r < I_FO) { const int nb = r / 44, kb = r % 44;
            cvt_item(a.in[I_FFO], 1024, DFF, (bf16*)(ws + WS_WFFO), nb * 32, nb * 32, kb * 64, scr, lane); continue; }
        r -= I_FO;
        if (r < 8 * I_MI) { const int e = r / I_MI; r %= I_MI; const int nb = r / 16, kb = r % 16;
            cvt_item_f8(a.in[I_MOEI] + (size_t)e * 1024 * 2 * DFFE, 2 * DFFE, 1024, ws + WS_WMI + (size_t)e * 2 * DFFE * 1024, nb * 32, swiglu_src_col(nb * 32, DFFE), kb * 64, scr, lane); continue; }
        r -= 8 * I_MI;
        { const int e = r / I_MO; r %= I_MO; const int nb = r / 56, kb = r % 56;
            cvt_item_f8(a.in[I_MOEO] + (size_t)e * DFFE * 1024, 1024, DFFE, ws + WS_WMO + (size_t)e * 1024 * DFFE, nb * 32, nb * 32, kb * 64, scr, lane); }
    }
}

template <bool XB16> __device__ __forceinline__ f32x4 ld_x4(const void* x, size_t row, int idx) {
    if constexpr (XB16) { const v2u r = ((const v2u*)((const bf16*)x + row * D))[idx]; return (f32x4){bflo(r.x), bfhi(r.x), bflo(r.y), bfhi(r.y)}; }
    else return ((const f32x4*)((const float*)x + row * D))[idx];
}
template <bool ROUTE, bool F8OUT = false, bool XB16 = false>
__device__ __forceinline__ void ph_norm(const void* x, const float* gain, const float* mod_shift  , bf16* h,
                                        const float* router, unsigned char* ws, int gw, int NGW, int lane, LAS unsigned char* lds = nullptr) {
    if constexpr (!ROUTE) {
        for (int m0 = gw; m0 < M; m0 += 2 * NGW) {
            const int m1 = m0 + NGW < M ? m0 + NGW : m0;
            f32x4 v0[4], v1[4]; float s0 = 0.f, s1 = 0.f;
#pragma unroll
            for (int j = 0; j < 4; ++j) { v0[j] = ld_x4<XB16>(x, (size_t)m0, lane + 64 * j); v1[j] = ld_x4<XB16>(x, (size_t)m1, lane + 64 * j); }
#pragma unroll
            for (int j = 0; j < 4; ++j) { s0 += (v0[j].x * v0[j].x + v0[j].y * v0[j].y) + (v0[j].z * v0[j].z + v0[j].w * v0[j].w); s1 += (v1[j].x * v1[j].x + v1[j].y * v1[j].y) + (v1[j].z * v1[j].z + v1[j].w * v1[j].w); }
            const int b0 = m0 / T, b1 = m1 / T;
            const f32x4* gp = (const f32x4*)gain + lane;
            const f32x4* sh0 = (const f32x4*)(mod_shift + (size_t)b0 * 6144) + lane; const f32x4* sc0 = (const f32x4*)(mod_shift + (size_t)b0 * 6144 + 1024) + lane;
            const f32x4* sh1 = (const f32x4*)(mod_shift + (size_t)b1 * 6144) + lane; const f32x4* sc1 = (const f32x4*)(mod_shift + (size_t)b1 * 6144 + 1024) + lane;
            f32x4 gq[4], h0[4], c0[4], h1[4], c1[4];
#pragma unroll
            for (int j = 0; j < 4; ++j) { gq[j] = gp[64 * j]; h0[j] = sh0[64 * j]; c0[j] = sc0[64 * j]; h1[j] = sh1[64 * j]; c1[j] = sc1[64 * j]; }
            const float rs0 = 1.f / sqrtf(wave_sum(s0) * (1.f / D) + 1e-6f), rs1 = 1.f / sqrtf(wave_sum(s1) * (1.f / D) + 1e-6f);
            unsigned long long* o0 = (unsigned long long*)(h + (size_t)m0 * D) + lane; unsigned long long* o1 = (unsigned long long*)(h + (size_t)m1 * D) + lane;
#pragma unroll
            for (int j = 0; j < 4; ++j) { const f32x4 g = gq[j];
                const f32x4 a0 = (v0[j] * rs0) * g * (c0[j] + 1.f) + h0[j], a1 = (v1[j] * rs1) * g * (c1[j] + 1.f) + h1[j];
                if constexpr (F8OUT) { ((unsigned*)((unsigned char*)h + (size_t)m0 * D))[lane + 64 * j] = f8pk4(a0.x * F8_HSCALE, a0.y * F8_HSCALE, a0.z * F8_HSCALE, a0.w * F8_HSCALE);
                                       ((unsigned*)((unsigned char*)h + (size_t)m1 * D))[lane + 64 * j] = f8pk4(a1.x * F8_HSCALE, a1.y * F8_HSCALE, a1.z * F8_HSCALE, a1.w * F8_HSCALE); }
                else {
                o0[64 * j] = (unsigned long long)pk2(a0.x, a0.y) | ((unsigned long long)pk2(a0.z, a0.w) << 32);
                o1[64 * j] = (unsigned long long)pk2(a1.x, a1.y) | ((unsigned long long)pk2(a1.z, a1.w) << 32); } }
        }
        return;
    }
    int se0 = 0, se1 = 0, sm = 0, nb = 0; float sg0 = 0.f, sg1 = 0.f;
    LAS float* rt = (LAS float*)(lds + RING_OFF);
    for (int i = tidx_(); i < 1024 * 8 / 4; i += NWAVES * 64) ((LAS f32x4*)rt)[i] = ((const f32x4*)router)[i];
    __syncthreads();
    for (int m = gw; m < M; m += NGW) {
        const int b = m / T;
        const f32x4* gp = (const f32x4*)gain + lane; const f32x4* shp = (const f32x4*)(mod_shift + (size_t)b * 6144) + lane; const f32x4* scp = (const f32x4*)(mod_shift + (size_t)b * 6144 + 1024) + lane;
        f32x4 v[4], gq[4], hq_[4], cq[4]; float s = 0.f;
#pragma unroll
        for (int j = 0; j < 4; ++j) { v[j] = ld_x4<XB16>(x, (size_t)m, lane + 64 * j); gq[j] = gp[64 * j]; hq_[j] = shp[64 * j]; cq[j] = scp[64 * j]; }
#pragma unroll
        for (int j = 0; j < 4; ++j) s += (v[j].x * v[j].x + v[j].y * v[j].y) + (v[j].z * v[j].z + v[j].w * v[j].w);
        const float rs = 1.f / sqrtf(wave_sum(s) * (1.f / D) + 1e-6f);
        unsigned long long* o8 = (unsigned long long*)(h + (size_t)m * D) + lane;
#pragma unroll
        for (int j = 0; j < 4; ++j) { const f32x4 g = gq[j], sh = hq_[j], sc = cq[j];
            v[j] = (v[j] * rs) * g * (sc + 1.f) + sh;
            if constexpr (F8OUT) ((unsigned*)((unsigned char*)h + (size_t)m * D))[lane + 64 * j] = f8pk4(v[j].x * F8_HSCALE, v[j].y * F8_HSCALE, v[j].z * F8_HSCALE, v[j].w * F8_HSCALE);
            else o8[64 * j] = (unsigned long long)pk2(v[j].x, v[j].y) | ((unsigned long long)pk2(v[j].z, v[j].w) << 32); }
        if constexpr (ROUTE) {
            float lg[8];
#pragma unroll
            for (int e = 0; e < 8; ++e) lg[e] = 0.f;
#pragma unroll
            for (int j = 0; j < 4; ++j)
#pragma unroll
                for (int q = 0; q < 4; ++q) { const int d = 256 * j + 4 * lane + q; const f32x4 r0 = *(const LAS f32x4*)(rt + d * 8), r1 = *(const LAS f32x4*)(rt + d * 8 + 4); const float hv = v[j][q];
                    lg[0] += hv * r0.x; lg[1] += hv * r0.y; lg[2] += hv * r0.z; lg[3] += hv * r0.w; lg[4] += hv * r1.x; lg[5] += hv * r1.y; lg[6] += hv * r1.z; lg[7] += hv * r1.w; }
#pragma unroll
            for (int e = 0; e < 8; ++e) lg[e] = wave_sum(lg[e]);
            int i0 = 0; float v0 = lg[0];
#pragma unroll
            for (int e = 1; e < 8; ++e) if (lg[e] > v0) { v0 = lg[e]; i0 = e; }
            int i1 = -1; float v1 = -3.0e38f;
#pragma unroll
            for (int e = 0; e < 8; ++e) if (e != i0 && lg[e] > v1) { v1 = lg[e]; i1 = e; }
            const float e1 = __expf(v1 - v0), g0 = 1.f / (1.f + e1), g1 = e1 / (1.f + e1);
            if (lane == nb) { se0 = i0; se1 = i1; sg0 = g0; sg1 = g1; sm = m; }
            ++nb;
        }
        if constexpr (ROUTE) {
            if (nb == 16 || m + NGW >= M) {
                const bool act = lane < nb; const unsigned long long lt = (1ull << lane) - 1ull;
                unsigned long long m0[8], m1[8]; unsigned myc = 0;
#pragma unroll
                for (int e = 0; e < 8; ++e) { m0[e] = __ballot(act && se0 == e); m1[e] = __ballot(act && se1 == e); const unsigned ce = (unsigned)(__popcll(m0[e]) + __popcll(m1[e])); myc = (lane == e) ? ce : myc; }
                unsigned base = 0;
                if (lane < 8) base = __hip_atomic_fetch_add((unsigned*)ws + CW_MOE + 64 * lane, myc, RLX_AGENT);
                int p0 = 0, p1 = 0;
#pragma unroll
                for (int e = 0; e < 8; ++e) { const unsigned be = (unsigned)__shfl((int)base, e);
                    if (se0 == e) p0 = (int)(be + (unsigned)__popcll(m0[e] & lt));
                    if (se1 == e) p1 = (int)(be + (unsigned)__popcll(m0[e]) + (unsigned)__popcll(m1[e] & lt)); }
                if (act) { ((int*)(ws + WS_TOK))[se0 * MOE_CAP + p0] = sm; ((float*)(ws + WS_GATE))[se0 * MOE_CAP + p0] = sg0; ((int*)(ws + WS_ASG))[sm * 2] = se0 * MOE_CAP + p0;
                           ((int*)(ws + WS_TOK))[se1 * MOE_CAP + p1] = sm; ((float*)(ws + WS_GATE))[se1 * MOE_CAP + p1] = sg1; ((int*)(ws + WS_ASG))[sm * 2 + 1] = se1 * MOE_CAP + p1; }
                nb = 0;
            }
        }
    }
}

__device__ __forceinline__ void ph_postz(const Args& a, unsigned char* ws, LAS unsigned char* lds, int l, int gw, int NGW, int wave, int lane) {
    LAS float* S = (LAS float*)(lds + RING_OFF + wave * 16384);
    LAS float* xw = S, *xa = S + 64, *xg = S + 128, *xv = S + 288, *pp = S + 320, *qn = S + 576, *kvn = S + 832, *qb = S + 960, *kvb = S + 1344, *kpe = S + 1856, *qpe = S + 1888;
    const bf16* z = (const bf16*)(ws + WS_Z);
    const float* mu = a.in[I_MU] + l * SHIFT_COLS; const float* muv = a.in[I_MUV];
    const float* rvec = a.in[I_RVEC] + l * 7 * RW; const float* w2 = a.in[I_RW2] + (size_t)l * 64 * RW; const float* a2 = a.in[I_RA2] + (size_t)l * 64 * RW;
    const float* g2 = a.in[I_RG2] + (size_t)l * 160 * RW; const float* v2 = a.in[I_RV2]; const float* v0p = a.in[I_RV0];
    bf16* Rr = (bf16*)(ws + WS_R); bf16* Kr = (bf16*)(ws + WS_K); bf16* Vr = (bf16*)(ws + WS_V); bf16* KKr = (bf16*)(ws + WS_KK); bf16* Ar = (bf16*)(ws + WS_A);
    float* LWr = (float*)(ws + WS_LW); bf16* Gr = (bf16*)(ws + WS_G); bf16* VF = (bf16*)(ws + WS_VF); bf16* mix = (bf16*)(ws + WS_MIX);
    bf16* QM = (bf16*)(ws + WS_QM); bf16* KM = (bf16*)(ws + WS_KM); bf16* VM = (bf16*)(ws + WS_VM);
    const float* poolw = a.in[I_POOLW] + (size_t)l * 4 * 64 * 64; const float* pools = a.in[I_POOLS] + l * 256;
    const float* qlg = a.in[I_QLG] + l * 256; const float* kvlg = a.in[I_KVLG] + l * 128; const float* wqup = a.in[I_WQUP] + (size_t)l * 256 * 384; const float* wkvup = a.in[I_WKVUP] + (size_t)l * 128 * 512;
    const float* qkg = a.in[I_QKG] + l * 2 * 96; const float* ct = (const float*)(ws + WS_COS); const float* st = (const float*)(ws + WS_SIN);
    for (int m = gw; m < M; m += NGW) {
        const int tt = m % T; const bool hp = tt > 0;
        const bf16* zr = z + (size_t)m * NZ; const bf16* zp = zr - NZ;
#define ZS(col) ({ const int c_ = (col); const float zc_ = bf2f(zr[c_]); const float zq_ = hp ? bf2f(zp[c_]) : 0.f; zc_ + mu[c_] * (zq_ - zc_); })
        LDS_WAIT();
        xw[lane] = tanhf_(ZS(OFF_WD + lane)); xa[lane] = ZS(OFF_AD + lane);
        xg[lane] = sigmoidf_(ZS(OFF_GD + lane)); xg[lane + 64] = sigmoidf_(ZS(OFF_GD + 64 + lane)); if (lane < 32) xg[lane + 128] = sigmoidf_(ZS(OFF_GD + 128 + lane));
        if (l > 0 && lane < 32) { const float zc = bf2f(zr[OFF_VD + lane]); const float zq = hp ? bf2f(zp[OFF_VD + lane]) : 0.f; xv[lane] = zc + muv[lane] * (zq - zc); }
#pragma unroll
        for (int gi = 0; gi < 4; ++gi) { const int win = 2 << gi; const int cnt = (tt + 1) < win ? (tt + 1) : win; const int col = OFF_POOL + gi * 64 + lane;
            float s = 0.f; for (int q = 0; q < cnt; ++q) s += bf2f(zr[col - q * NZ]);
            pp[gi * 64 + lane] = s / (float)cnt - bf2f(zr[col]); }
        { float q4[4]; float s = 0.f;
#pragma unroll
          for (int j = 0; j < 4; ++j) { q4[j] = bf2f(zr[OFF_QLAT + lane + 64 * j]); s += q4[j] * q4[j]; }
          const float rs = 1.f / sqrtf(wave_sum(s) * (1.f / 256.f) + 1e-6f);
#pragma unroll
          for (int j = 0; j < 4; ++j) qn[lane + 64 * j] = q4[j] * rs * qlg[lane + 64 * j];
          float k2[2]; s = 0.f;
#pragma unroll
          for (int j = 0; j < 2; ++j) { k2[j] = bf2f(zr[OFF_KVLAT + lane + 64 * j]); s += k2[j] * k2[j]; }
          const float rk = 1.f / sqrtf(wave_sum(s) * (1.f / 128.f) + 1e-6f);
#pragma unroll
          for (int j = 0; j < 2; ++j) kvn[lane + 64 * j] = k2[j] * rk * kvlg[lane + 64 * j];
          if (lane < 16) { const float x1 = bf2f(zr[OFF_KROPE + lane]), x2 = bf2f(zr[OFF_KROPE + 16 + lane]); const float cs = ct[m * 16 + lane], sn = st[m * 16 + lane];
              kpe[lane] = x1 * cs - x2 * sn; kpe[lane + 16] = x1 * sn + x2 * cs; } }
        LDS_WAIT();
#pragma nounroll
        for (int hh = 0; hh < NH; ++hh) {
            const int c = hh * 64 + lane;
            const float r = ZS(c), k0 = ZS(512 + c), v0 = ZS(1024 + c);
            float wlo = 0.f, alo = 0.f, gg = 0.f;
#pragma unroll 4
            for (int i = 0; i < 64; ++i) { wlo += xw[i] * w2[i * RW + c]; alo += xa[i] * a2[i * RW + c]; }
#pragma unroll 4
            for (int i = 0; i < 160; ++i) gg += xg[i] * g2[i * RW + c];
            float v = v0;
            if (l == 0) { VF[(size_t)m * RW + c] = (bf16)f2bf(v0); }
            else { float vlo = 0.f;
#pragma unroll 4
                for (int i = 0; i < 32; ++i) vlo += xv[i] * v2[i * RW + c]; const float vf = bf2f(VF[(size_t)m * RW + c]); v = v0 + (vf - v0) * sigmoidf_(v0p[c] + vlo); }
            const float lw = -0.6065306597126334f * sigmoidf_(rvec[0 * RW + c] + wlo);
            const float aa = sigmoidf_(rvec[1 * RW + c] + alo);
            const float kkr = k0 * rvec[2 * RW + c];
            const float nrm = sqrtf(wave_sum(kkr * kkr));
            const float kk = kkr / fmaxf(nrm, 1e-12f);
            const float k = k0 * (1.f + (aa - 1.f) * rvec[3 * RW + c]);
            { const float bsum = wave_sum(bf2f((bf16)f2bf(r)) * bf2f((bf16)f2bf(k)) * rvec[4 * RW + c]); if (lane == 0) ((float*)(ws + WS_BON))[(size_t)m * 8 + hh] = bsum; }
            const size_t o = (size_t)m * RW + c;
            Rr[o] = (bf16)f2bf(r); Kr[o] = (bf16)f2bf(k); Vr[o] = (bf16)f2bf(v); KKr[o] = (bf16)f2bf(kk); Ar[o] = (bf16)f2bf(aa); LWr[o] = lw; Gr[o] = (bf16)f2bf(gg);
        }
#pragma nounroll
        for (int gi = 0; gi < 4; ++gi) { float y = 0.f; const float* wp = poolw + gi * 4096 + lane;
#pragma unroll 4
            for (int c = 0; c < 64; ++c) y += pp[gi * 64 + c] * wp[c * 64];
            mix[(size_t)m * D + 512 + gi * 64 + lane] = (bf16)f2bf(y * pools[gi * 64 + lane]); }
        { float ac[6];
#pragma unroll
          for (int j = 0; j < 6; ++j) ac[j] = 0.f;
#pragma unroll 2
          for (int i = 0; i < 256; ++i) { const float xv_ = qn[i];
#pragma unroll
              for (int j = 0; j < 6; ++j) ac[j] += xv_ * wqup[i * 384 + lane + 64 * j]; }
#pragma unroll
          for (int j = 0; j < 6; ++j) qb[lane + 64 * j] = ac[j]; }
        { float ac[8];
#pragma unroll
          for (int j = 0; j < 8; ++j) ac[j] = 0.f;
#pragma unroll 2
          for (int i = 0; i < 128; ++i) { const float xv_ = kvn[i];
#pragma unroll
              for (int j = 0; j < 8; ++j) ac[j] += xv_ * wkvup[i * 512 + lane + 64 * j]; }
#pragma unroll
          for (int j = 0; j < 8; ++j) kvb[lane + 64 * j] = ac[j]; }
        LDS_WAIT();
        { const int hq = lane >> 4, i = lane & 15; const float x1 = qb[hq * 96 + 64 + i], x2 = qb[hq * 96 + 80 + i]; const float cs = ct[m * 16 + i], sn = st[m * 16 + i];
          qpe[hq * 32 + i] = x1 * cs - x2 * sn; qpe[hq * 32 + 16 + i] = x1 * sn + x2 * cs; }
        LDS_WAIT();
#pragma unroll
        for (int hq = 0; hq < MLA_H; ++hq) {
            const float qa = qb[hq * 96 + lane], qr_ = lane < 32 ? qpe[hq * 32 + lane] : 0.f;
            const float ka = kvb[hq * 128 + lane], kr_ = lane < 32 ? kpe[lane] : 0.f;
            const float rq = 1.f / sqrtf(wave_sum(qa * qa + qr_ * qr_) * (1.f / 96.f) + 1e-6f);
            const float rk = 1.f / sqrtf(wave_sum(ka * ka + kr_ * kr_) * (1.f / 96.f) + 1e-6f);
            QM[(size_t)m * 384 + hq * 96 + lane] = (bf16)f2bf(qa * rq * qkg[lane]); KM[(size_t)m * 384 + hq * 96 + lane] = (bf16)f2bf(ka * rk * qkg[96 + lane]);
            if (lane < 32) { QM[(size_t)m * 384 + hq * 96 + 64 + lane] = (bf16)f2bf(qr_ * rq * qkg[64 + lane]); KM[(size_t)m * 384 + hq * 96 + 64 + lane] = (bf16)f2bf(kr_ * rk * qkg[96 + 64 + lane]); }
            VM[(size_t)m * 256 + hq * 64 + lane] = (bf16)f2bf(kvb[hq * 128 + 64 + lane]);
        }
#undef ZS
    }
}

__device__ __forceinline__ void ph_scan_naive(const Args& a, unsigned char* ws, int l, int bh, int lane) {
    const int b = bh / NH, hh = bh % NH; const int c = hh * 64 + lane;
    const bf16* Rr = (const bf16*)(ws + WS_R); const bf16* Kr = (const bf16*)(ws + WS_K); const bf16* Vr = (const bf16*)(ws + WS_V); const bf16* KKr = (const bf16*)(ws + WS_KK); const bf16* Ar = (const bf16*)(ws + WS_A);
    const float* LWr = (const float*)(ws + WS_LW); const bf16* Gr = (const bf16*)(ws + WS_G); bf16* mix = (bf16*)(ws + WS_MIX);
    const float* rvec = a.in[I_RVEC] + l * 7 * RW; const float rk_ = rvec[4 * RW + c], lng = rvec[5 * RW + c], lnb = rvec[6 * RW + c];
    float S[64];
#pragma unroll
    for (int j = 0; j < 64; ++j) S[j] = 0.f;
    size_t o = (size_t)(b * T) * RW + c;
    float r = bf2f(Rr[o]), k = bf2f(Kr[o]), v = bf2f(Vr[o]), kk = bf2f(KKr[o]), aa = bf2f(Ar[o]), lw = LWr[o], g = bf2f(Gr[o]);
    for (int t = 0; t < T; ++t) {
        const size_t on = o + (t + 1 < T ? RW : 0);
        const float rn = bf2f(Rr[on]), kn = bf2f(Kr[on]), vn = bf2f(Vr[on]), kkn = bf2f(KKr[on]), aan = bf2f(Ar[on]), lwn = LWr[on], gn = bf2f(Gr[on]);
        const float w = __expf(lw), na = -kk, bb = kk * aa;
        float sa = 0.f;
#pragma unroll
        for (int j = 0; j < 64; ++j) sa += S[j] * __int_as_float(__builtin_amdgcn_readlane(__float_as_int(na), j));
        float y = 0.f;
#pragma unroll
        for (int j = 0; j < 64; ++j) {
            const float wj = __int_as_float(__builtin_amdgcn_readlane(__float_as_int(w), j)), bj = __int_as_float(__builtin_amdgcn_readlane(__float_as_int(bb), j));
            const float kj = __int_as_float(__builtin_amdgcn_readlane(__float_as_int(k), j)), rj = __int_as_float(__builtin_amdgcn_readlane(__float_as_int(r), j));
            S[j] = S[j] * wj + sa * bj + v * kj; y += S[j] * rj; }
        const float mu = wave_sum(y) * (1.f / 64.f); const float dy = y - mu; const float var = wave_sum(dy * dy) * (1.f / 64.f);
        const float yn = dy * (1.f / sqrtf(var + 64e-5f)) * lng + lnb;
        const float bon = wave_sum(r * k * rk_) * v;
        mix[(size_t)(b * T + t) * D + c] = (bf16)f2bf((yn + bon) * g);
        o = on; r = rn; k = kn; v = vn; kk = kkn; aa = aan; lw = lwn; g = gn;
    }
}

__device__ __forceinline__ void ph_attn_naive(unsigned char* ws, LAS unsigned char* lds, int unit, int tid) {
    const int bh = unit >> 3, qb = unit & 7; const int b = bh >> 2, hq = bh & 3;
    const bf16* QM = (const bf16*)(ws + WS_QM); const bf16* KM = (const bf16*)(ws + WS_KM); const bf16* VM = (const bf16*)(ws + WS_VM); bf16* mix = (bf16*)(ws + WS_MIX);
    LAS float* Ks = (LAS float*)(lds + RING_OFF);
    LAS float* Vs = Ks + 64 * 96;
    const int qpos = qb * 512 + tid; const size_t qrow = (size_t)(b * T + qpos);
    float q[96];
    const float sc = 1.f;
#pragma unroll
    for (int d = 0; d < 96; ++d) q[d] = bf2f(QM[qrow * 384 + hq * 96 + d]) * sc;
    float o[64];
#pragma unroll
    for (int d = 0; d < 64; ++d) o[d] = 0.f;
    float mx = -3.0e38f, lsum = 0.f;
    const int ntile = (qb * 512 + 511) / 64 + 1;
    const int wave_qmax = qb * 512 + (tid | 63);
    for (int kt = 0; kt < ntile; ++kt) {
        __syncthreads();
        for (int i = tid; i < 64 * 96; i += 512) { const int kr = i / 96, d = i % 96; Ks[i] = bf2f(KM[(size_t)(b * T + kt * 64 + kr) * 384 + hq * 96 + d]); }
        for (int i = tid; i < 64 * 64; i += 512) { const int kr = i >> 6, d = i & 63; Vs[i] = bf2f(VM[(size_t)(b * T + kt * 64 + kr) * 256 + hq * 64 + d]); }
        __syncthreads();
        if (kt * 64 > wave_qmax) continue;
        for (int j = 0; j < 64; ++j) {
            const int kpos = kt * 64 + j;
            float s = 0.f;
#pragma unroll
            for (int d = 0; d < 96; d += 4) { const f32x4 kv = *(const LAS f32x4*)(Ks + j * 96 + d); s += q[d] * kv.x + q[d + 1] * kv.y + q[d + 2] * kv.z + q[d + 3] * kv.w; }
            if (kpos > qpos) s = -3.0e38f;
            const float mn = fmaxf(mx, s); const float corr = exp2f(mx - mn), p = exp2f(s - mn);
            lsum = lsum * corr + p; mx = mn;
#pragma unroll
            for (int d = 0; d < 64; d += 4) { const f32x4 vv = *(const LAS f32x4*)(Vs + j * 64 + d); o[d] = o[d] * corr + p * vv.x; o[d + 1] = o[d + 1] * corr + p * vv.y; o[d + 2] = o[d + 2] * corr + p * vv.z; o[d + 3] = o[d + 3] * corr + p * vv.w; }
        }
    }
    const float il = 1.f / lsum;
#pragma unroll
    for (int d = 0; d < 64; d += 2) *(unsigned*)(mix + qrow * D + 768 + hq * 64 + d) = pk2(o[d] * il, o[d + 1] * il);
    __syncthreads();
}

__device__ __forceinline__ unsigned moe_cnt(unsigned char* ws, int e) { return __hip_atomic_load((unsigned*)ws + CW_MOE + 64 * e, RLX_AGENT); }
__device__ __forceinline__ volatile LAS int* moe_tiles_lds(unsigned char* ws, LAS unsigned char* lds) {
    volatile LAS int* TS = (volatile LAS int*)(lds + MISC_OFF) + 16;
    __syncthreads();
    if (tidx_() < 8) TS[9 + tidx_()] = (int)moe_cnt(ws, (int)tidx_());
    __syncthreads();
    if (tidx_() == 0) { int acc = 0; for (int e = 0; e < 8; ++e) { TS[e] = acc; acc += (TS[9 + e] + 255) >> 8; } TS[8] = acc; }
    __syncthreads();
    return TS;
}
__device__ __forceinline__ int exp_of_tile(volatile LAS int* TS, int rt) { int e = 0;
#pragma unroll
    for (int k = 1; k < 8; ++k) e += (rt >= TS[k]);
    return e; }
__device__ __forceinline__ void ph_moe_gather(unsigned char* ws, LAS unsigned char* lds, int gw, int NGW, int lane) {
    volatile LAS int* TS = moe_tiles_lds(ws, lds);
    const int nrows = TS[8] * 256;
    const int* tok = (const int*)(ws + WS_TOK); const unsigned char* h = (const unsigned char*)(ws + WS_H); unsigned char* xg = (unsigned char*)(ws + WS_XG);
    constexpr int GR = 16;
    for (int r0 = gw; r0 < nrows; r0 += GR * NGW) {
        int tk[GR]; bool ok[GR];
#pragma unroll
        for (int j = 0; j < GR; ++j) { const int r = r0 + j * NGW; const int rc = r < nrows ? r : r0; const int rt = rc >> 8; const int e = exp_of_tile(TS, rt);
            const int local = rc - TS[e] * 256; ok[j] = r < nrows && local < TS[9 + e]; tk[j] = tok[e * MOE_CAP + (ok[j] ? local : 0)]; }
        v4u v[GR];
#pragma unroll
        for (int j = 0; j < GR; ++j) v[j] = ((const v4u*)(h + (size_t)(ok[j] ? tk[j] : 0) * D))[lane];
#pragma unroll
        for (int j = 0; j < GR; ++j) { const int r = r0 + j * NGW; if (r < nrows) ((v4u*)(xg + (size_t)r * D))[lane] = ok[j] ? v[j] : (v4u){0u, 0u, 0u, 0u}; }
    }
}
__device__ __forceinline__ void ph_moe_combine(unsigned char* ws, LAS unsigned char* lds, float* out, const float* gate2  , int gw, int NGW, int lane) {
    volatile LAS int* TS = moe_tiles_lds(ws, lds);
    const int* asg = (const int*)(ws + WS_ASG); const float* gt = (const float*)(ws + WS_GATE); const bf16* yr = (const bf16*)(ws + WS_YR);
    constexpr int CT = 4;
    for (int m0 = gw; m0 < M; m0 += CT * NGW) {
        int mm[CT]; size_t ra[CT], rb[CT]; float ga[CT], gbv[CT];
#pragma unroll
        for (int u = 0; u < CT; ++u) { mm[u] = m0 + u * NGW < M ? m0 + u * NGW : m0; const int s0 = asg[mm[u] * 2], s1 = asg[mm[u] * 2 + 1];
            const int e0 = s0 / MOE_CAP, p0 = s0 % MOE_CAP, e1 = s1 / MOE_CAP, p1 = s1 % MOE_CAP;
            ra[u] = (size_t)TS[e0] * 256 + p0; rb[u] = (size_t)TS[e1] * 256 + p1; ga[u] = gt[s0]; gbv[u] = gt[s1]; }
        v4u a0[CT][2], a1[CT][2], xq[CT][2]; const bf16* xb = (const bf16*)(ws + WS_XB);
#pragma unroll
        for (int u = 0; u < CT; ++u)
#pragma unroll
            for (int j = 0; j < 2; ++j) { const int col = (j * 64 + lane) * 8;
                a0[u][j] = *(const v4u*)(yr + ra[u] * D + col); a1[u][j] = *(const v4u*)(yr + rb[u] * D + col);
                xq[u][j] = *(const v4u*)(xb + (size_t)mm[u] * D + col); }
#pragma unroll
        for (int u = 0; u < CT; ++u) { if (u > 0 && m0 + u * NGW >= M) break;
            const float* gb = gate2 + (size_t)(mm[u] / T) * 6144; const float g0 = ga[u], g1 = gbv[u];
#pragma unroll
            for (int j = 0; j < 2; ++j) { const int col = (j * 64 + lane) * 8; const f32x4* gp = (const f32x4*)(gb + col); const f32x4 gg0 = gp[0], gg1 = gp[1];
                const v4u A0 = a0[u][j], A1 = a1[u][j], XQ = xq[u][j]; f32x4 X0 = {bflo(XQ.x), bfhi(XQ.x), bflo(XQ.y), bfhi(XQ.y)}, X1 = {bflo(XQ.z), bfhi(XQ.z), bflo(XQ.w), bfhi(XQ.w)};
                X0.x += gg0.x * (g0 * bflo(A0.x) + g1 * bflo(A1.x)); X0.y += gg0.y * (g0 * bfhi(A0.x) + g1 * bfhi(A1.x)); X0.z += gg0.z * (g0 * bflo(A0.y) + g1 * bflo(A1.y)); X0.w += gg0.w * (g0 * bfhi(A0.y) + g1 * bfhi(A1.y));
                X1.x += gg1.x * (g0 * bflo(A0.z) + g1 * bflo(A1.z)); X1.y += gg1.y * (g0 * bfhi(A0.z) + g1 * bfhi(A1.z)); X1.z += gg1.z * (g0 * bflo(A0.w) + g1 * bflo(A1.w)); X1.w += gg1.w * (g0 * bfhi(A0.w) + g1 * bfhi(A1.w));
                f32x4* op = (f32x4*)(out + (size_t)mm[u] * D + col); op[0] = X0; op[1] = X1; } }
    }
}

#define LANE_ fresh_lane()
#define TID_ tidx_()
constexpr int NPHASE = 23;
#ifndef PH_MASK
#define PH_MASK 0xFFFFFFFFu
#endif
#define EN(b) ((PH_MASK >> (b)) & 1u)

#define IN(k) (lo <= (k) && (k) < hi)
#define SEAM(k) do { if (IN(k) && IN((k) + 1)) xcd_barrier(bar); } while (0)
template <int l>
__device__ __forceinline__ void layer_phases(const Args& args, unsigned char* ws, LAS unsigned char* lds, float* out, const float* mod, bf16* H, const XcdBarrier& bar,
                                             int lo, int hi, int li, int wave, int G, int gw, int NGW) {

        const int pb = 2 + 10 * l;
        const float* modl = mod + (size_t)l * 8 * 6144;
        if (EN(0) && IN(pb + 0)) {
            pg8::Gemm g{H, (const bf16*)(ws + WS_WIN) + (size_t)l * NZ * 1024, M, NZ, 1024}; pg8::StaticOrder S; S.init(M, NZ, G, (int)blockIdx.x);
            pg8::EpiBf16<0> E{(bf16*)(ws + WS_Z), NZ, nullptr, 0, 0, 1.f};
            pg8::gemm_phase<pg8::EpiBf16<0>, pg8::StaticOrder, true, true>(lds + RING_OFF, g, S, E);
        } SEAM(pb + 0);
        if (EN(1) && IN(pb + 1)) {
#if POSTZ_NAIVE
            ph_postz(args, ws, lds, l, gw, NGW, wave, LANE_);
#else
            ph_postz_mfma<l>(args, ws, lds, G, TID_, wave, LANE_, DRY_REP && li == 1);
#endif
        } SEAM(pb + 1);
        if (IN(pb + 3)) {
            if (EN(14) && blockIdx.x >= 64 && blockIdx.x < 128) ph_convert(args, ws, lds, ((int)blockIdx.x - 64) * 8 + wave, 64 * 8, wave, LANE_, 1 + l);
            if (EN(2) && blockIdx.x < 64 && wave < 2 && !(ATTN_ONLY_REP && li == 1)) scan_carry(ws, (int)blockIdx.x, wave, LANE_);
            __syncthreads();
            #if ATTN_NAIVE
            if (EN(3)) for (int u = blockIdx.x; u < 256; u += G) ph_attn_naive(ws, lds, u, TID_);
#else
            if (EN(3) && !(CARRY_ONLY_REP && li == 1)) { volatile LAS unsigned* qw = (volatile LAS unsigned*)(lds + MISC_OFF) + 26;
                for (;;) { __syncthreads(); if (TID_ == 0) qw[0] = __hip_atomic_fetch_add((unsigned*)ws + CW_ATQ + 64 * (l + 2 * (li & 1)), 1u, RLX_AGENT); __syncthreads();
                    const unsigned u = qw[0]; if (u >= 512u) break; ph_attn_pipe(ws, lds, (int)(u & 31u), 15 - (int)(u >> 5), wave, LANE_); } }
#endif
        } SEAM(pb + 3);
        if (EN(2) && IN(pb + 4)) { ph_scan_out(args, ws, lds, l, gw, NGW, wave, LANE_); } SEAM(pb + 4);
        if (EN(4) && IN(pb + 5)) {
            pg8::Gemm g{(const bf16*)(ws + WS_MIX), (const bf16*)(ws + WS_WOUT) + (size_t)l * 1024 * 1024, M, D, D}; pg8::StaticOrder S; S.init(M, D, G, (int)blockIdx.x);
            pg8::EpiResB<l == 0> E{l == 0 ? (const void*)args.in[I_X] : (const void*)(ws + WS_XB), (pg8::bf16_t*)(ws + WS_XB), modl + 2 * 1024};
            pg8::gemm_phase<pg8::EpiResB<l == 0>, pg8::StaticOrder, true, true>(lds + RING_OFF, g, S, E);
        } SEAM(pb + 5);
        if constexpr (l == 0) {
            if (EN(5) && IN(pb + 6)) { ph_norm<false, false, true>(ws + WS_XB, args.in[I_NGAIN] + 1024, modl + 3 * 1024, H, nullptr, ws, gw, NGW, LANE_); } SEAM(pb + 6);
            if (EN(6) && IN(pb + 7)) {
                pg8::Gemm g{H, (const bf16*)(ws + WS_WFFI), M, 2 * DFF, D}; pg8::StaticOrder S; S.init(M, 2 * DFF, G, (int)blockIdx.x);
                pg8::EpiSwiglu E{(bf16*)(ws + WS_ACT), DFF, 1 << 20};
                pg8::gemm_phase<pg8::EpiSwiglu, pg8::StaticOrder, true, true>(lds + RING_OFF, g, S, E);
            } SEAM(pb + 7);
            if (EN(7) && IN(pb + 8)) {
                pg8::Gemm g{(const bf16*)(ws + WS_ACT), (const bf16*)(ws + WS_WFFO), M, D, DFF}; pg8::StaticOrder S; S.init(M, D, G, (int)blockIdx.x);
                pg8::EpiResB<false> E{(const void*)(ws + WS_XB), (pg8::bf16_t*)(ws + WS_XB), modl + 5 * 1024};
                pg8::gemm_phase<pg8::EpiResB<false>, pg8::StaticOrder, true, true>(lds + RING_OFF, g, S, E);
            } SEAM(pb + 8);
            if (EN(5) && IN(pb + 9)) { ph_norm<false, false, true>(ws + WS_XB, args.in[I_NGAIN] + 2048, mod + (size_t)8 * 6144, H, nullptr, ws, gw, NGW, LANE_); } SEAM(pb + 9);
        } else {
            if (EN(8) && IN(pb + 6)) { ph_norm<true, true, true>(ws + WS_XB, args.in[I_NGAIN] + 3072, modl + 3 * 1024, H, args.in[I_ROUTER], ws, gw, NGW, LANE_, lds); } SEAM(pb + 6);
            if (EN(9) && IN(pb + 7)) { ph_moe_gather(ws, lds, gw, NGW, LANE_); } SEAM(pb + 7);
            if (EN(10) && IN(pb + 8)) {
                volatile LAS int* TS = moe_tiles_lds(ws, lds);
                pg8::Gemm g{(const bf16*)(ws + WS_XG), (const bf16*)(ws + WS_WMI), 0, 0, D / 2};
                pg8::MoeOrder S{28, TS[8] * 28, G, (int)blockIdx.x, TS[1], TS[2], TS[3], TS[4], TS[5], TS[6], TS[7]};
                pg8::EpiSwigluF8 E{ws + WS_MACT, DFFE, 28};
                pg8::gemm_phase_f8<pg8::EpiSwigluF8, pg8::MoeOrder, true, true>(lds + RING_OFF, g, S, E, F8_WEXP, F8_HEXP);
            } SEAM(pb + 8);
            if (EN(11) && IN(pb + 9)) {
                volatile LAS int* TS = moe_tiles_lds(ws, lds);
                pg8::Gemm g{(const bf16*)(ws + WS_MACT), (const bf16*)(ws + WS_WMO), 0, 0, DFFE / 2};
                pg8::MoeOrder S{4, TS[8] * 4, G, (int)blockIdx.x, TS[1], TS[2], TS[3], TS[4], TS[5], TS[6], TS[7]};
                pg8::EpiMoeOut E{(bf16*)(ws + WS_YR)};
                pg8::gemm_phase_f8<pg8::EpiMoeOut, pg8::MoeOrder, true, true>(lds + RING_OFF, g, S, E, F8_WEXP, F8_AEXP);
            } SEAM(pb + 9);
            if (EN(12) && IN(pb + 10)) { ph_moe_combine(ws, lds, out, modl + 5 * 1024, gw, NGW, LANE_); }
        }
    }
#undef IN
#undef SEAM
#ifndef ATTN_NAIVE
#define ATTN_NAIVE 0
#endif
#ifndef POSTZ_NAIVE
#define POSTZ_NAIVE 0
#endif
#ifndef SCAN_NAIVE
#define SCAN_NAIVE 0
#endif
#ifndef MK_SPLIT
#define MK_SPLIT 0
#endif
__global__ void __launch_bounds__(NWAVES * 64, 2) fwd_kernel(Args args) {
    LAS unsigned char* lds = (LAS unsigned char*)lds_raw;
    const int wave = __builtin_amdgcn_readfirstlane((int)threadIdx.x >> 6);
    const int G = gridDim.x, gw = blockIdx.x * NWAVES + wave, NGW = G * NWAVES, GT = G * NWAVES * 64;
#define GTID_ ((int)blockIdx.x * (NWAVES * 64) + TID_)
    unsigned char* ws = args.ws;
    for (int u = threadIdx.x; u < (LDS_BYTES - LDSCTL_OFF) / 4; u += NWAVES * 64) ((LAS unsigned*)(lds + LDSCTL_OFF))[u] = 0u;
    __syncthreads();
    if ((threadIdx.x & 63) == 0) ((volatile LAS int*)(lds + WMAP_OFF))[hw_slot_()] = wave;
    __syncthreads();
    XcdBarrier bar; bar.bar = (unsigned*)ws + CW_BAR + args.li * XCD_BAR_WORDS; bar.x = 0; bar.st = nullptr;
    if (!MK_SPLIT) bar = xcd_barrier_post((unsigned*)ws + CW_BAR + args.li * XCD_BAR_WORDS, (volatile LAS unsigned*)(lds + MISC_OFF) + 8);
    const int lo = args.ph_lo, hi = args.ph_hi;
#define IN(k) (lo <= (k) && (k) < hi)
#define SEAM(k) do { if (IN(k) && IN((k) + 1)) xcd_barrier(bar); } while (0)
    float* out = args.out;
    const float* mod = (const float*)(ws + WS_MOD);
    bf16* H = (bf16*)(ws + WS_H);

    if (EN(13) && IN(0)) { ph_mod_rope(args, ws, lds, gw, NGW, TID_, LANE_, GTID_, GT); } SEAM(0);
    if (IN(1)) { if (EN(14)) { ph_convert(args, ws, lds, gw, NGW, wave, LANE_, 0); ph_small_weights(args, ws, GTID_, GT); }
                 if (EN(5)) ph_norm<false>(args.in[I_X], args.in[I_NGAIN], mod, H, nullptr, ws, gw, NGW, LANE_); } SEAM(1);

    layer_phases<0>(args, ws, lds, out, mod, H, bar, lo, hi, args.li, wave, G, gw, NGW);
    layer_phases<1>(args, ws, lds, out, mod, H, bar, lo, hi, args.li, wave, G, gw, NGW);
#undef IN
#undef SEAM
}

extern "C" void kernel_launch(void* const* d_in, const int* in_sizes, int n_in, void* d_out, int out_size, void* d_ws, size_t ws_size, hipStream_t stream) {
    static int grid = 0;
    if (grid == 0) {
        if (n_in != 29 || out_size != M * D || ws_size < WS_END || ws_size < WS_MIX_END) { fprintf(stderr, "kernel_launch: unexpected shapes (n_in %d out %d ws %zu)\n", n_in, out_size, ws_size); grid = -1; return; }
        int dev = 0, cus = 0, per_cu = 0;
        if (hipGetDevice(&dev) != hipSuccess || hipDeviceGetAttribute(&cus, hipDeviceAttributeMultiprocessorCount, dev) != hipSuccess) { grid = -1; return; }
        if (hipFuncSetAttribute((const void*)fwd_kernel, hipFuncAttributeMaxDynamicSharedMemorySize, LDS_BYTES) != hipSuccess) { fprintf(stderr, "kernel_launch: hipFuncSetAttribute failed\n"); grid = -1; return; }
        if (hipOccupancyMaxActiveBlocksPerMultiprocessor(&per_cu, (const void*)fwd_kernel, NWAVES * 64, LDS_BYTES) != hipSuccess || per_cu < 1) fprintf(stderr, "kernel_launch: occupancy query says %d\n", per_cu);
        (void)hipGetLastError();
        grid = cus;
    }
    if (grid < 0) return;
    (void)hipMemsetAsync((char*)d_ws + WS_CTL, 0, CTL_ZERO_BYTES, stream);
    Args a{};
    for (int i = 0; i < 29; ++i) a.in[i] = (const float*)d_in[i];
    a.out = (float*)d_out; a.ws = (unsigned char*)d_ws;
#if defined(TIME_PHASE)
    { const int K = TIME_PHASE; const int cuts[4] = {0, K + 1, K, NPHASE};
      a.ph_lo = 0; a.ph_hi = K + 1; a.li = 0; hipLaunchKernelGGL(fwd_kernel, dim3(grid), dim3(NWAVES * 64), LDS_BYTES, stream, a);
      a.ph_lo = K; a.ph_hi = K + 1; a.li = 1; hipLaunchKernelGGL(fwd_kernel, dim3(grid), dim3(NWAVES * 64), LDS_BYTES, stream, a);
      a.ph_lo = K + 1; a.ph_hi = NPHASE; a.li = 2; hipLaunchKernelGGL(fwd_kernel, dim3(grid), dim3(NWAVES * 64), LDS_BYTES, stream, a); (void)cuts; }
#else
    a.ph_lo = 0; a.ph_hi = NPHASE; a.li = 0;
    hipLaunchKernelGGL(fwd_kernel, dim3(grid), dim3(NWAVES * 64), LDS_BYTES, stream, a);
#endif
}
```

```cpp
#include <hip/hip_runtime.h>
#include <cstdio>
#include <cstdint>

extern __shared__ __attribute__((aligned(16))) unsigned char lds_raw[];
#define WMAP_OFF (131072 + 512)
__device__ __forceinline__ int hw_slot_() { return (int)__builtin_amdgcn_s_getreg((5 << 11) | (0 << 6) | 4); }
__device__ __forceinline__ int lane_id_() { int l; asm volatile("v_mbcnt_lo_u32_b32 %0, -1, 0\n\tv_mbcnt_hi_u32_b32 %0, -1, %0" : "=v"(l)); return l; }
__device__ __forceinline__ int wave_id_() { return __builtin_amdgcn_readfirstlane(((volatile __attribute__((address_space(3))) int*)((__attribute__((address_space(3))) unsigned char*)lds_raw + WMAP_OFF))[hw_slot_()]); }
__device__ __forceinline__ int tidx_() { return wave_id_() * 64 + lane_id_(); }

namespace pg8 {
#define PG8_LAS __attribute__((address_space(3)))
typedef unsigned short bf16_t;
typedef short bf16x8 __attribute__((ext_vector_type(8)));
typedef float f32x4 __attribute__((ext_vector_type(4)));
typedef unsigned u32x4 __attribute__((ext_vector_type(4)));
constexpr int BM = 256, BK = 64, HALF = 128, HTB = HALF * BK * 2  , STAGE_BYTES = 8 * HTB, NXCD = 8, WGM = 8;

__host__ __device__ __forceinline__ int lds_byte(int r, int c) { const int st = (r >> 4) * 2 + (c >> 5), rr = r & 15, cc = c & 31, ob = rr * 64 + cc * 2; return st * 1024 + (ob ^ (((ob >> 9) & 1) << 5)); }
__host__ __device__ __forceinline__ void stage_rc(int b, int& R, int& C) { const int st = b / 1024, sb = b % 1024, swz = sb ^ (((sb >> 9) & 1) << 5); R = (st >> 1) * 16 + swz / 64; C = (st & 1) * 32 + (swz % 64) / 2; }
__host__ __device__ __forceinline__ int perm32(int rho) { const int n = rho >> 4, i = rho & 15; return 8 * (i >> 2) + 4 * n + (i & 3); }

struct Unit { int pm, pn; };
struct Gemm { const bf16_t* A; const bf16_t* Bt; int M, N, K; };

struct StaticOrder {
    int nM, nN, nwg, G, c;
    __host__ __device__ void init(int M, int N, int G_, int c_) { nM = M / BM; nN = N / BM; nwg = nM * nN; G = G_; c = c_; }
    __host__ __device__ bool next(int i, Unit& u) const {
        const long L = (long)i * G + c; if (L >= nwg) return false;
        int wgid = (int)L; { const int q = nwg / NXCD, r = nwg % NXCD, xcd = wgid % NXCD, off = wgid / NXCD; wgid = (xcd < r ? xcd * (q + 1) : r * (q + 1) + (xcd - r) * q) + off; }
        const int nig = WGM * nN, gid = wgid / nig, fm = gid * WGM, gsz = (nM - fm) < WGM ? (nM - fm) : WGM;
        u.pm = fm + ((wgid % nig) % gsz); u.pn = (wgid % nig) / gsz; return true;
    }
    __device__ __forceinline__ void a_ready(const Unit&) const {}
    __device__ __forceinline__ void done(const Unit&) const {}
};

__device__ __forceinline__ unsigned cvt_pk_bf16(float lo, float hi) { unsigned r; asm volatile("v_cvt_pk_bf16_f32 %0, %1, %2" : "=v"(r) : "v"(lo), "v"(hi)); return r; }
typedef float f32x2 __attribute__((ext_vector_type(2)));
__device__ __forceinline__ f32x2 gelu_pk(f32x2 v) {
    const f32x2 av = __builtin_elementwise_abs(v), d = av * 0.2316418882f + 1.0f;
    f32x2 t; t.x = __builtin_amdgcn_rcpf(d.x); t.y = __builtin_amdgcn_rcpf(d.y);
    f32x2 q = t * 0.5307027145f + (-0.7265760135f); q = q * t + 0.7107068705f; q = q * t + (-0.142248368f); q = q * t + 0.127414796f; q = q * t;
    const f32x2 s = (v * v) * (-0.72134752044f);
    f32x2 e; e.x = __builtin_amdgcn_exp2f(s.x); e.y = __builtin_amdgcn_exp2f(s.y);
    const f32x2 m = v * (q * e), r = v - m;
    f32x2 o; o.x = v.x < 0.f ? m.x : r.x; o.y = v.y < 0.f ? m.y : r.y; return o;
}

template <int ACT  > struct EpiBf16 {
    static constexpr bool PERM = true, AFTER_DRAIN = false; static_assert(ACT == 0 || ACT == 1, "EpiBf16: ACT is 0 (none) or 1 (gelu_pk)");
    bf16_t* O; int ldc; const float* bias; int split_cols; size_t split_stride; float scale0;
    __device__ __forceinline__ void operator()(const f32x4 (&acc)[2][2][4][2], const Unit& u, int wr, int wc, int fr, int fq) const {
        const int row0 = u.pm * BM + wr * 64 + fr; int colt = u.pn * BM; bf16_t* base = O;
        float sc = 1.f; if (split_cols) { const int t = colt / split_cols; base += (size_t)t * split_stride; colt -= t * split_cols; if (t == 0) sc = scale0; }
        const int col0 = colt + wc * 32 + 8 * fq, bcol0 = u.pn * BM + wc * 32 + 8 * fq;
        f32x4 bv[2][2];
#pragma unroll
        for (int bj = 0; bj < 2; ++bj)
#pragma unroll
            for (int n = 0; n < 2; ++n) bv[bj][n] = bias ? *(const f32x4*)(bias + bcol0 + bj * HALF + 4 * n) : (f32x4){0.f, 0.f, 0.f, 0.f};
#pragma unroll
        for (int ai = 0; ai < 2; ++ai)
#pragma unroll
            for (int m = 0; m < 4; ++m) { bf16_t* rowp = base + (size_t)(row0 + ai * HALF + m * 16) * ldc + col0;
#pragma unroll
                for (int bj = 0; bj < 2; ++bj) { f32x4 v0 = acc[ai][bj][m][0] + bv[bj][0], v1 = acc[ai][bj][m][1] + bv[bj][1];
                    if (ACT == 1) { f32x2 a = gelu_pk((f32x2){v0[0], v0[1]}), b = gelu_pk((f32x2){v0[2], v0[3]}), c = gelu_pk((f32x2){v1[0], v1[1]}), d = gelu_pk((f32x2){v1[2], v1[3]});
                        v0 = (f32x4){a.x, a.y, b.x, b.y}; v1 = (f32x4){c.x, c.y, d.x, d.y}; }
                    v0 = v0 * sc; v1 = v1 * sc; u32x4 w; w.x = cvt_pk_bf16(v0[0], v0[1]); w.y = cvt_pk_bf16(v0[2], v0[3]); w.z = cvt_pk_bf16(v1[0], v1[1]); w.w = cvt_pk_bf16(v1[2], v1[3]);
                    *(u32x4*)(rowp + bj * HALF) = w; } }
    }
};

template <class Epi, class Sched, bool ALIGN_EPI = false, bool SP2 = false>
__device__ __forceinline__ void gemm_phase(PG8_LAS unsigned char* lds, const Gemm g, const Sched& S, const Epi& E) {
    int tid_ = tidx_(); asm volatile("" : "+v"(tid_));
    const int tid = tid_, wid = __builtin_amdgcn_readfirstlane(tid >> 6), lane = tid & 63, wr = wid >> 2, wc = wid & 3, fr = lane & 15, fq = lane >> 4;
    const int K = g.K, nt = K / BK;
    unsigned voffA[2], voffB[2];
#pragma unroll
    for (int i = 0; i < 2; ++i) { int R, C; stage_rc(tid * 16 + i * 8192, R, C); const int Rb = Epi::PERM ? ((R & ~31) + perm32(R & 31)) : R;
        voffA[i] = (unsigned)(R * K + C) * 2u; voffB[i] = (unsigned)(Rb * K + C) * 2u; }
    const size_t kstep = (size_t)(BK * 2);
    const size_t hstep = (size_t)HALF * K * 2;
    const size_t tstep = 2 * hstep;
    const unsigned ldsw = (unsigned)wid * 1024u;
    const int aoff = lds_byte(wr * 64 + fr, fq * 8), boff = lds_byte(wc * 32 + fr, fq * 8);
#define PG8_SA(b, h) (((b) * 2 + (h)) * HTB)
#define PG8_SB(b, h) ((4 + (b) * 2 + (h)) * HTB)
#define PG8_STAGE(bufoff, gbase, voff) do { _Pragma("unroll") for (int _i = 0; _i < 2; ++_i) \
        __builtin_amdgcn_global_load_lds((const unsigned*)((const char*)(gbase) + (voff)[_i]), (PG8_LAS unsigned*)(lds + (bufoff) + ldsw + _i * 8192), 16, 0, 0); } while (0)
#define PG8_LDA(dst, b, h) do { _Pragma("unroll") for (int m = 0; m < 4; ++m) _Pragma("unroll") for (int k = 0; k < 2; ++k) dst[m][k] = *(const PG8_LAS bf16x8*)(lds + PG8_SA(b, h) + aoff + m * 2048 + k * 1024); } while (0)
#define PG8_LDB(dst, b, h) do { _Pragma("unroll") for (int n = 0; n < 2; ++n) _Pragma("unroll") for (int k = 0; k < 2; ++k) dst[n][k] = *(const PG8_LAS bf16x8*)(lds + PG8_SB(b, h) + boff + n * 2048 + k * 1024); } while (0)
#define PG8_MMA(ai, bj, At, Bt) do { __builtin_amdgcn_s_setprio(1); _Pragma("unroll") for (int m = 0; m < 4; ++m) _Pragma("unroll") for (int n = 0; n < 2; ++n) _Pragma("unroll") for (int k = 0; k < 2; ++k) \
        acc[ai][bj][m][n] = __builtin_amdgcn_mfma_f32_16x16x32_bf16(Bt[n][k], At[m][k], acc[ai][bj][m][n], 0, 0, 0); __builtin_amdgcn_s_setprio(0); } while (0)
#define PG8_WAIT_V(n) asm volatile("s_waitcnt vmcnt(" #n ")" ::: "memory")
#define PG8_WAIT_L(n) asm volatile("s_waitcnt lgkmcnt(" #n ")" ::: "memory")
#define PG8_BAR __builtin_amdgcn_s_barrier()
#define PG8_SCHED __builtin_amdgcn_sched_barrier(0)
    Unit cur, nxt; int ui = 0;
    if (!S.next(0, cur)) return;
    f32x4 acc[2][2][4][2];
#pragma unroll
    for (int a = 0; a < 2; ++a)
#pragma unroll
        for (int b = 0; b < 2; ++b)
#pragma unroll
            for (int m = 0; m < 4; ++m)
#pragma unroll
                for (int n = 0; n < 2; ++n) acc[a][b][m][n] = (f32x4){0.f, 0.f, 0.f, 0.f};
    bf16x8 At[4][2], B0[2][2], B1[2][2];
    const char* cA = (const char*)g.A + (size_t)cur.pm * tstep; const char* cB = (const char*)g.Bt + (size_t)cur.pn * tstep;
    S.a_ready(cur);
    if constexpr (SP2) {
        PG8_STAGE(PG8_SB(0, 0), cB, voffB); PG8_STAGE(PG8_SB(0, 1), cB + hstep, voffB); PG8_STAGE(PG8_SA(0, 0), cA, voffA); PG8_STAGE(PG8_SA(0, 1), cA + hstep, voffA);
        if (wr == 1) PG8_BAR;
        PG8_WAIT_V(2); PG8_BAR;
        PG8_STAGE(PG8_SB(1, 0), cB + kstep, voffB); PG8_STAGE(PG8_SA(1, 0), cA + kstep, voffA); PG8_STAGE(PG8_SB(1, 1), cB + hstep + kstep, voffB);
        PG8_WAIT_V(6); PG8_BAR;
    } else {
        PG8_STAGE(PG8_SB(0, 0), cB, voffB); PG8_STAGE(PG8_SA(0, 0), cA, voffA); PG8_STAGE(PG8_SB(0, 1), cB + hstep, voffB); PG8_STAGE(PG8_SA(0, 1), cA + hstep, voffA);
        if (wr == 1) PG8_BAR;
        PG8_WAIT_V(4); PG8_BAR;
        PG8_STAGE(PG8_SB(1, 0), cB + kstep, voffB); PG8_STAGE(PG8_SA(1, 0), cA + kstep, voffA); PG8_STAGE(PG8_SB(1, 1), cB + hstep + kstep, voffB);
        PG8_WAIT_V(6); PG8_BAR;
    }
    for (;;) {
        const bool has_next = S.next(ui + 1, nxt);
        const char* nA = has_next ? (const char*)g.A + (size_t)nxt.pm * tstep : cA; const char* nB = has_next ? (const char*)g.Bt + (size_t)nxt.pn * tstep : cB;
        for (int t = 0; t < nt; t += 2) {
            const bool last = (t == nt - 2);
            const char* a1 = cA + (size_t)(t + 1) * kstep;
            const char* a2 = last ? nA : cA + (size_t)(t + 2) * kstep; const char* b2 = last ? nB : cB + (size_t)(t + 2) * kstep;
            const char* a3 = a2 + kstep; const char* b3 = b2 + kstep;
            if (last && has_next) S.a_ready(nxt);
            if constexpr (SP2) {
            PG8_LDB(B0, 0, 0); PG8_LDB(B1, 0, 1); PG8_SCHED; PG8_LDA(At, 0, 0); PG8_STAGE(PG8_SA(1, 1), a1 + hstep, voffA);
            PG8_WAIT_V(8); PG8_WAIT_L(0); PG8_BAR; PG8_MMA(0, 0, At, B0); PG8_MMA(0, 1, At, B1); PG8_BAR; PG8_SCHED;
            PG8_LDA(At, 0, 1); PG8_STAGE(PG8_SB(0, 0), b2, voffB); PG8_STAGE(PG8_SB(0, 1), b2 + hstep, voffB); PG8_STAGE(PG8_SA(0, 0), a2, voffA);
            PG8_WAIT_V(8); PG8_WAIT_L(0); PG8_BAR; PG8_MMA(1, 0, At, B0); PG8_MMA(1, 1, At, B1); PG8_BAR; PG8_SCHED;
            PG8_LDB(B0, 1, 0); PG8_LDB(B1, 1, 1); PG8_SCHED; PG8_LDA(At, 1, 0); PG8_STAGE(PG8_SA(0, 1), a2 + hstep, voffA);
            PG8_WAIT_V(8); PG8_WAIT_L(0); PG8_BAR; PG8_MMA(0, 0, At, B0); PG8_MMA(0, 1, At, B1); PG8_BAR; PG8_SCHED;
            PG8_LDA(At, 1, 1); PG8_STAGE(PG8_SB(1, 0), b3, voffB); PG8_STAGE(PG8_SB(1, 1), b3 + hstep, voffB); PG8_STAGE(PG8_SA(1, 0), a3, voffA);
            PG8_WAIT_V(8); PG8_WAIT_L(0); PG8_BAR; PG8_MMA(1, 0, At, B0); PG8_MMA(1, 1, At, B1); PG8_BAR; PG8_SCHED;
            } else {
            PG8_LDB(B0, 0, 0); PG8_SCHED; PG8_LDA(At, 0, 0); PG8_STAGE(PG8_SA(1, 1), a1 + hstep, voffA);
            PG8_WAIT_L(8); PG8_BAR; PG8_WAIT_L(0); PG8_MMA(0, 0, At, B0); PG8_BAR; PG8_SCHED;
            PG8_LDB(B1, 0, 1); PG8_STAGE(PG8_SB(0, 0), b2, voffB);
            PG8_BAR; PG8_WAIT_L(0); PG8_MMA(0, 1, At, B1); PG8_BAR;
            PG8_LDA(At, 0, 1); PG8_STAGE(PG8_SA(0, 0), a2, voffA);
            PG8_BAR; PG8_WAIT_L(0); PG8_MMA(1, 0, At, B0); PG8_BAR; PG8_SCHED;
            PG8_STAGE(PG8_SB(0, 1), b2 + hstep, voffB);
            PG8_WAIT_V(6); PG8_BAR; PG8_MMA(1, 1, At, B1); PG8_BAR;
            PG8_LDB(B0, 1, 0); PG8_SCHED; PG8_LDA(At, 1, 0); PG8_STAGE(PG8_SA(0, 1), a2 + hstep, voffA);
            PG8_WAIT_L(8); PG8_BAR; PG8_WAIT_L(0); PG8_MMA(0, 0, At, B0); PG8_BAR; PG8_SCHED;
            PG8_LDB(B1, 1, 1); PG8_STAGE(PG8_SB(1, 0), b3, voffB);
            PG8_BAR; PG8_WAIT_L(0); PG8_MMA(0, 1, At, B1); PG8_BAR;
            PG8_LDA(At, 1, 1); PG8_STAGE(PG8_SA(1, 0), a3, voffA);
            PG8_BAR; PG8_WAIT_L(0); PG8_MMA(1, 0, At, B0); PG8_BAR; PG8_SCHED;
            PG8_STAGE(PG8_SB(1, 1), b3 + hstep, voffB);
            PG8_WAIT_V(6); PG8_BAR; PG8_MMA(1, 1, At, B1); PG8_BAR;
            }
        }
        if constexpr (ALIGN_EPI) { if (wr == 0) PG8_BAR; }
        if constexpr (!Epi::AFTER_DRAIN) { E(acc, cur, wr, wc, fr, fq); S.done(cur); }
        if (!has_next) break;
#pragma unroll
        for (int a = 0; a < 2; ++a)
#pragma unroll
            for (int b = 0; b < 2; ++b)
#pragma unroll
                for (int m = 0; m < 4; ++m)
#pragma unroll
                    for (int n = 0; n < 2; ++n) acc[a][b][m][n] = (f32x4){0.f, 0.f, 0.f, 0.f};
        cur = nxt; cA = nA; cB = nB; ++ui;
        if constexpr (ALIGN_EPI) { if (wr == 1) PG8_BAR; }
    }
    PG8_WAIT_V(0);
    if constexpr (!ALIGN_EPI) { if (wr == 0) PG8_BAR; }
    PG8_BAR;
    if constexpr (Epi::AFTER_DRAIN) { E.fused(acc, cur, wr, wc, fr, fq, lds, wid, lane); S.done(cur); }
#undef PG8_SA
#undef PG8_SB
#undef PG8_STAGE
#undef PG8_LDA
#undef PG8_LDB
#undef PG8_MMA
#undef PG8_WAIT_V
#undef PG8_WAIT_L
#undef PG8_BAR
#undef PG8_SCHED
}
typedef int v8i_t __attribute__((ext_vector_type(8)));
template <class Epi, class Sched, bool ALIGN_EPI = false, bool SP2 = false>
__device__ __forceinline__ void gemm_phase_f8(PG8_LAS unsigned char* lds, const Gemm g, const Sched& S, const Epi& E, int sexp_w, int sexp_a) {
    int tid_ = tidx_(); asm volatile("" : "+v"(tid_));
    const int tid = tid_, wid = __builtin_amdgcn_readfirstlane(tid >> 6), lane = tid & 63, wr = wid >> 2, wc = wid & 3, fr = lane & 15, fq = lane >> 4;
    const int K = g.K, nt = K / BK;
    unsigned voffA[2], voffB[2];
#pragma unroll
    for (int i = 0; i < 2; ++i) { int R, C; stage_rc(tid * 16 + i * 8192, R, C); const int Rb = Epi::PERM ? ((R & ~31) + perm32(R & 31)) : R;
        voffA[i] = (unsigned)(R * K + C) * 2u; voffB[i] = (unsigned)(Rb * K + C) * 2u; }
    const size_t kstep = (size_t)(BK * 2);
    const size_t hstep = (size_t)HALF * K * 2;
    const size_t tstep = 2 * hstep;
    const unsigned ldsw = (unsigned)wid * 1024u;
    const int sexp_both = sexp_w | (sexp_a << 8);
    const int fo8 = (fq >> 1) * 1024 + ((fr * 64 + 32 * (fq & 1)) ^ ((fr >> 3) << 5));
    const int sw8 = (fq & 1) << 4;
    const int aoff = wr * 8192 + fo8 + sw8, boff = wc * 4096 + fo8 + sw8, aoff2 = wr * 8192 + fo8 + (16 - sw8), boff2 = wc * 4096 + fo8 + (16 - sw8);
#define PG8_SA(b, h) (((b) * 2 + (h)) * HTB)
#define PG8_SB(b, h) ((4 + (b) * 2 + (h)) * HTB)
#define PG8_STAGE(bufoff, gbase, voff) do { _Pragma("unroll") for (int _i = 0; _i < 2; ++_i) \
        __builtin_amdgcn_global_load_lds((const unsigned*)((const char*)(gbase) + (voff)[_i]), (PG8_LAS unsigned*)(lds + (bufoff) + ldsw + _i * 8192), 16, 0, 0); } while (0)
#define PG8_LDA(dst, b, h) do { _Pragma("unroll") for (int m = 0; m < 4; ++m) { const u32x4 lo_ = *(const PG8_LAS u32x4*)(lds + PG8_SA(b, h) + aoff + m * 2048), hi_ = *(const PG8_LAS u32x4*)(lds + PG8_SA(b, h) + aoff2 + m * 2048); struct { u32x4 a_, b_; } pr_ = {lo_, hi_}; dst[m] = __builtin_bit_cast(v8i_t, pr_); } } while (0)
#define PG8_LDB(dst, b, h) do { _Pragma("unroll") for (int n = 0; n < 2; ++n) { const u32x4 lo_ = *(const PG8_LAS u32x4*)(lds + PG8_SB(b, h) + boff + n * 2048), hi_ = *(const PG8_LAS u32x4*)(lds + PG8_SB(b, h) + boff2 + n * 2048); struct { u32x4 a_, b_; } pr_ = {lo_, hi_}; dst[n] = __builtin_bit_cast(v8i_t, pr_); } } while (0)
#define PG8_MMA(ai, bj, At, Bt) do { __builtin_amdgcn_s_setprio(1); _Pragma("unroll") for (int m = 0; m < 4; ++m) _Pragma("unroll") for (int n = 0; n < 2; ++n) \
        asm volatile("v_mfma_scale_f32_16x16x128_f8f6f4 %0, %1, %2, %0, %3, %3 op_sel:[0,1,0] op_sel_hi:[0,0,0]" : "+v"(acc[ai][bj][m][n]) : "v"(Bt[n]), "v"(At[m]), "v"(sexp_both)); __builtin_amdgcn_s_setprio(0); } while (0)
#define PG8_WAIT_V(n) asm volatile("s_waitcnt vmcnt(" #n ")" ::: "memory")
#define PG8_WAIT_L(n) asm volatile("s_waitcnt lgkmcnt(" #n ")" ::: "memory")
#define PG8_BAR __builtin_amdgcn_s_barrier()
#define PG8_SCHED __builtin_amdgcn_sched_barrier(0)
    Unit cur, nxt; int ui = 0;
    if (!S.next(0, cur)) return;
    f32x4 acc[2][2][4][2];
#pragma unroll
    for (int a = 0; a < 2; ++a)
#pragma unroll
        for (int b = 0; b < 2; ++b)
#pragma unroll
            for (int m = 0; m < 4; ++m)
#pragma unroll
                for (int n = 0; n < 2; ++n) acc[a][b][m][n] = (f32x4){0.f, 0.f, 0.f, 0.f};
    v8i_t At[4], B0[2], B1[2];
    const char* cA = (const char*)g.A + (size_t)cur.pm * tstep; const char* cB = (const char*)g.Bt + (size_t)cur.pn * tstep;
    S.a_ready(cur);
    if constexpr (SP2) {
        PG8_STAGE(PG8_SB(0, 0), cB, voffB); PG8_STAGE(PG8_SB(0, 1), cB + hstep, voffB); PG8_STAGE(PG8_SA(0, 0), cA, voffA); PG8_STAGE(PG8_SA(0, 1), cA + hstep, voffA);
        if (wr == 1) PG8_BAR;
        PG8_WAIT_V(2); PG8_BAR;
        PG8_STAGE(PG8_SB(1, 0), cB + kstep, voffB); PG8_STAGE(PG8_SA(1, 0), cA + kstep, voffA); PG8_STAGE(PG8_SB(1, 1), cB + hstep + kstep, voffB);
        PG8_WAIT_V(6); PG8_BAR;
    } else {
        PG8_STAGE(PG8_SB(0, 0), cB, voffB); PG8_STAGE(PG8_SA(0, 0), cA, voffA); PG8_STAGE(PG8_SB(0, 1), cB + hstep, voffB); PG8_STAGE(PG8_SA(0, 1), cA + hstep, voffA);
        if (wr == 1) PG8_BAR;
        PG8_WAIT_V(4); PG8_BAR;
        PG8_STAGE(PG8_SB(1, 0), cB + kstep, voffB); PG8_STAGE(PG8_SA(1, 0), cA + kstep, voffA); PG8_STAGE(PG8_SB(1, 1), cB + hstep + kstep, voffB);
        PG8_WAIT_V(6); PG8_BAR;
    }
    for (;;) {
        const bool has_next = S.next(ui + 1, nxt);
        const char* nA = has_next ? (const char*)g.A + (size_t)nxt.pm * tstep : cA; const char* nB = has_next ? (const char*)g.Bt + (size_t)nxt.pn * tstep : cB;
#pragma nounroll
        for (int t = 0; t < nt; t += 2) {
            const bool last = (t == nt - 2);
            const char* a1 = cA + (size_t)(t + 1) * kstep;
            const char* a2 = last ? nA : cA + (size_t)(t + 2) * kstep; const char* b2 = last ? nB : cB + (size_t)(t + 2) * kstep;
            const char* a3 = a2 + kstep; const char* b3 = b2 + kstep;
            if (last && has_next) S.a_ready(nxt);
            if constexpr (SP2) {
            PG8_LDB(B0, 0, 0); PG8_LDB(B1, 0, 1); PG8_SCHED; PG8_LDA(At, 0, 0); PG8_STAGE(PG8_SA(1, 1), a1 + hstep, voffA);
            PG8_WAIT_V(8); PG8_WAIT_L(0); PG8_BAR; PG8_MMA(0, 0, At, B0); PG8_MMA(0, 1, At, B1); PG8_BAR; PG8_SCHED;
            PG8_LDA(At, 0, 1); PG8_STAGE(PG8_SB(0, 0), b2, voffB); PG8_STAGE(PG8_SB(0, 1), b2 + hstep, voffB); PG8_STAGE(PG8_SA(0, 0), a2, voffA);
            PG8_WAIT_V(8); PG8_WAIT_L(0); PG8_BAR; PG8_MMA(1, 0, At, B0); PG8_MMA(1, 1, At, B1); PG8_BAR; PG8_SCHED;
            PG8_LDB(B0, 1, 0); PG8_LDB(B1, 1, 1); PG8_SCHED; PG8_LDA(At, 1, 0); PG8_STAGE(PG8_SA(0, 1), a2 + hstep, voffA);
            PG8_WAIT_V(8); PG8_WAIT_L(0); PG8_BAR; PG8_MMA(0, 0, At, B0); PG8_MMA(0, 1, At, B1); PG8_BAR; PG8_SCHED;
            PG8_LDA(At, 1, 1); PG8_STAGE(PG8_SB(1, 0), b3, voffB); PG8_STAGE(PG8_SB(1, 1), b3 + hstep, voffB); PG8_STAGE(PG8_SA(1, 0), a3, voffA);
            PG8_WAIT_V(8); PG8_WAIT_L(0); PG8_BAR; PG8_MMA(1, 0, At, B0); PG8_MMA(1, 1, At, B1); PG8_BAR; PG8_SCHED;
            } else {
            PG8_LDB(B0, 0, 0); PG8_SCHED; PG8_LDA(At, 0, 0); PG8_STAGE(PG8_SA(1, 1), a1 + hstep, voffA);
            PG8_WAIT_L(8); PG8_BAR; PG8_WAIT_L(0); PG8_MMA(0, 0, At, B0); PG8_BAR; PG8_SCHED;
            PG8_LDB(B1, 0, 1); PG8_STAGE(PG8_SB(0, 0), b2, voffB);
            PG8_BAR; PG8_WAIT_L(0); PG8_MMA(0, 1, At, B1); PG8_BAR;
            PG8_LDA(At, 0, 1); PG8_STAGE(PG8_SA(0, 0), a2, voffA);
            PG8_BAR; PG8_WAIT_L(0); PG8_MMA(1, 0, At, B0); PG8_BAR; PG8_SCHED;
            PG8_STAGE(PG8_SB(0, 1), b2 + hstep, voffB);
            PG8_WAIT_V(6); PG8_BAR; PG8_MMA(1, 1, At, B1); PG8_BAR;
            PG8_LDB(B0, 1, 0); PG8_SCHED; PG8_LDA(At, 1, 0); PG8_STAGE(PG8_SA(0, 1), a2 + hstep, voffA);
            PG8_WAIT_L(8); PG8_BAR; PG8_WAIT_L(0); PG8_MMA(0, 0, At, B0); PG8_BAR; PG8_SCHED;
            PG8_LDB(B1, 1, 1); PG8_STAGE(PG8_SB(1, 0), b3, voffB);
            PG8_BAR; PG8_WAIT_L(0); PG8_MMA(0, 1, At, B1); PG8_BAR;
            PG8_LDA(At, 1, 1); PG8_STAGE(PG8_SA(1, 0), a3, voffA);
            PG8_BAR; PG8_WAIT_L(0); PG8_MMA(1, 0, At, B0); PG8_BAR; PG8_SCHED;
            PG8_STAGE(PG8_SB(1, 1), b3 + hstep, voffB);
            PG8_WAIT_V(6); PG8_BAR; PG8_MMA(1, 1, At, B1); PG8_BAR;
            }
        }
        if constexpr (ALIGN_EPI) { if (wr == 0) PG8_BAR; }
        asm volatile("s_nop 15\n\ts_nop 15" ::: "memory");
        if constexpr (!Epi::AFTER_DRAIN) { int t2_ = tidx_(); asm volatile("" : "+v"(t2_)); const int w2_ = __builtin_amdgcn_readfirstlane(t2_ >> 6), l2_ = t2_ & 63;
            E(acc, cur, w2_ >> 2, w2_ & 3, l2_ & 15, l2_ >> 4); S.done(cur); }
        if (!has_next) break;
#pragma unroll
        for (int a = 0; a < 2; ++a)
#pragma unroll
            for (int b = 0; b < 2; ++b)
#pragma unroll
                for (int m = 0; m < 4; ++m)
#pragma unroll
                    for (int n = 0; n < 2; ++n) acc[a][b][m][n] = (f32x4){0.f, 0.f, 0.f, 0.f};
        cur = nxt; cA = nA; cB = nB; ++ui;
        if constexpr (ALIGN_EPI) { if (wr == 1) PG8_BAR; }
    }
    PG8_WAIT_V(0);
    if constexpr (!ALIGN_EPI) { if (wr == 0) PG8_BAR; }
    PG8_BAR;
    if constexpr (Epi::AFTER_DRAIN) { E.fused(acc, cur, wr, wc, fr, fq, lds, wid, lane); S.done(cur); }
#undef PG8_SA
#undef PG8_SB
#undef PG8_STAGE
#undef PG8_LDA
#undef PG8_LDB
#undef PG8_MMA
#undef PG8_WAIT_V
#undef PG8_WAIT_L
#undef PG8_BAR
#undef PG8_SCHED
}
}

constexpr int NWAVES = 8;
constexpr int BATCH = 8, T = 4096, D = 1024, M = BATCH * T;
constexpr int RW = 512, NH = 8, HD = 64;
constexpr int NZ = 2560;
constexpr int OFF_WD = 1536, OFF_AD = 1600, OFF_GD = 1664, SHIFT_COLS = 1824;
constexpr int OFF_POOL = 1824, OFF_QLAT = 2080, OFF_KVLAT = 2336, OFF_KROPE = 2464, OFF_VD = 2496;
constexpr int N_IN0 = 2496, N_IN1 = 2528;
constexpr int DFF = 2816, NEXP = 8, DFFE = 3584;
constexpr int MLA_H = 4, QK = 96, VD = 64;
constexpr int MOE_CAP = M;
constexpr int MOE_MAXTILES = (2 * M) / 256 + NEXP;

constexpr size_t MiB = 1u << 20;
constexpr size_t WS_CTL = 0, CTL_ZERO_BYTES = 1 * MiB;
constexpr size_t WS_MOD = 1 * MiB;
constexpr size_t WS_COS = 2 * MiB, WS_SIN = 4 * MiB;
constexpr size_t WS_TOK = 8 * MiB;
constexpr size_t WS_GATE = 9 * MiB;
constexpr size_t WS_ASG = 10 * MiB;
constexpr size_t WS_WIN = 16 * MiB;
constexpr size_t WS_WOUT = 26 * MiB;
constexpr size_t WS_WFFI = 30 * MiB;
constexpr size_t WS_WFFO = 41 * MiB;
constexpr size_t WS_WMI = 48 * MiB;
constexpr size_t WS_XB = 112 * MiB;
constexpr size_t WS_WMO = 188 * MiB;
constexpr size_t WS_H = 216 * MiB;
constexpr size_t WS_VF = 280 * MiB;
constexpr size_t WS_BIG = 312 * MiB;
constexpr size_t WS_Z = WS_BIG;
constexpr size_t WS_R = WS_BIG + 160 * MiB;
constexpr size_t WS_K = WS_R + 32 * MiB, WS_V = WS_R + 64 * MiB, WS_KK = WS_R + 96 * MiB, WS_A = WS_R + 128 * MiB;
constexpr size_t WS_LW = WS_R + 160 * MiB;
constexpr size_t WS_G = WS_LW + 64 * MiB;
constexpr size_t WS_QM = WS_G + 32 * MiB;
constexpr size_t WS_KM = WS_QM + 24 * MiB;
constexpr size_t WS_VM = WS_KM + 24 * MiB;
constexpr size_t WS_MIX = WS_VM + 16 * MiB;
constexpr size_t WS_MIX_END = WS_MIX + 64 * MiB;
constexpr size_t WS_ACT = WS_BIG;
constexpr size_t WS_XG = WS_VF;
constexpr size_t WS_YR = WS_VF;
constexpr size_t WS_MACT = WS_VF + 132 * MiB;
constexpr size_t WS_END = WS_MACT + 462 * MiB;
static_assert(WS_MIX_END <= 896 * MiB && WS_END <= 896 * MiB, "d_ws map");
static_assert((size_t)MOE_MAXTILES * 256 * 1024 * 2 <= 132 * MiB && (size_t)MOE_MAXTILES * 256 * 3584 * 2 <= 462 * MiB, "moe buffers");
constexpr int CW_BAR = 4096;
constexpr int CW_MOE = 16384;
constexpr int CW_ATQ = 20480;
static_assert((CW_ATQ + 128) * 4 <= (int)CTL_ZERO_BYTES, "ctl map");

constexpr int RING_OFF = 0, RING_BYTES = 131072;
constexpr int LDSCTL_OFF = RING_BYTES, MISC_OFF = LDSCTL_OFF + 320;
constexpr int LDS_BYTES = 147456;

#define GAS __attribute__((address_space(1)))
#define LAS __attribute__((address_space(3)))
typedef unsigned short bf16;
typedef unsigned v4u __attribute__((ext_vector_type(4)));
typedef unsigned v2u __attribute__((ext_vector_type(2)));
typedef float f32x4 __attribute__((ext_vector_type(4)));
typedef short bf16x8 __attribute__((ext_vector_type(8)));
typedef GAS unsigned gu32;
#define RLX_AGENT __ATOMIC_RELAXED, __HIP_MEMORY_SCOPE_AGENT
#define LDS_WAIT() asm volatile("s_waitcnt lgkmcnt(0)" ::: "memory")
#define VM_WAIT() asm volatile("s_waitcnt vmcnt(0)" ::: "memory")
__device__ __forceinline__ unsigned cvtpk(float lo, float hi) { typedef float f2_t __attribute__((ext_vector_type(2))); typedef __bf16 b2_t __attribute__((ext_vector_type(2)));
    f2_t v = {lo, hi}; b2_t b = __builtin_convertvector(v, b2_t); return __builtin_bit_cast(unsigned, b); }
__device__ __forceinline__ unsigned f2bf(float f) { return cvtpk(f, f) & 0xffffu; }
__device__ __forceinline__ unsigned pk2(float lo, float hi) { return cvtpk(lo, hi); }
__device__ __forceinline__ float bf2f(bf16 v) { return __uint_as_float(((unsigned)v) << 16); }
__device__ __forceinline__ float bflo(unsigned w) { return __uint_as_float(w << 16); }
__device__ __forceinline__ float bfhi(unsigned w) { return __uint_as_float(w & 0xffff0000u); }
__device__ __forceinline__ unsigned f8pk2(float a, float b) { a = fminf(fmaxf(a, -448.f), 448.f); b = fminf(fmaxf(b, -448.f), 448.f); return (unsigned)__builtin_amdgcn_cvt_pk_fp8_f32(a, b, 0, false) & 0xffffu; }
__device__ __forceinline__ unsigned f8pk4(float a, float b, float c_, float d) { a = fminf(fmaxf(a, -448.f), 448.f); b = fminf(fmaxf(b, -448.f), 448.f); c_ = fminf(fmaxf(c_, -448.f), 448.f); d = fminf(fmaxf(d, -448.f), 448.f);
    int w = __builtin_amdgcn_cvt_pk_fp8_f32(a, b, 0, false); w = __builtin_amdgcn_cvt_pk_fp8_f32(c_, d, w, true); return (unsigned)w; }
constexpr float F8_WSCALE = 64.f, F8_HSCALE = 8.f, F8_ASCALE = 4.f;
constexpr int F8_WEXP = 127 - 6, F8_HEXP = 127 - 3, F8_AEXP = 127 - 2;
__device__ __forceinline__ float sigmoidf_(float x) { return __builtin_amdgcn_rcpf(1.f + __expf(-x)); }
__device__ __forceinline__ float tanhf_(float x) { const float e = __expf(2.f * x); return 1.f - 2.f * __builtin_amdgcn_rcpf(1.f + e); }
__device__ __forceinline__ float half_sum32(float v) {
    v += __int_as_float(__builtin_amdgcn_mov_dpp(__float_as_int(v), 0xB1, 0xF, 0xF, true));
    v += __int_as_float(__builtin_amdgcn_mov_dpp(__float_as_int(v), 0x4E, 0xF, 0xF, true));
    v += __int_as_float(__builtin_amdgcn_mov_dpp(__float_as_int(v), 0x141, 0xF, 0xF, true));
    v += __int_as_float(__builtin_amdgcn_mov_dpp(__float_as_int(v), 0x140, 0xF, 0xF, true));
    v += __int_as_float(__builtin_amdgcn_ds_swizzle(__float_as_int(v), 0x401F));
    return v;
}
__device__ __forceinline__ float other_half(float v) { const unsigned u = __float_as_uint(v); auto rr = __builtin_amdgcn_permlane32_swap(u, u, false, false); return __uint_as_float(rr[0] == u ? rr[1] : rr[0]); }
__device__ __forceinline__ float wave_sum(float v) { v = half_sum32(v); const unsigned u = __float_as_uint(v); auto rr = __builtin_amdgcn_permlane32_swap(u, u, false, false); return __uint_as_float(rr[0]) + __uint_as_float(rr[1]); }

__device__ __forceinline__ void st_put(LAS unsigned char* ST, int i, int col, float v) { *(LAS bf16*)(ST + i * 256 + col * 2) = (bf16)f2bf(v); }
template <int NCOLS> __device__ __forceinline__ void st_flush(LAS unsigned char* ST, bf16* gbase, int rowstride, int lane, bool dry) {
    constexpr int CPR = NCOLS / 8, TOTAL = 32 * CPR;
    LDS_WAIT();
#pragma unroll
    for (int k = 0; k < (TOTAL + 63) / 64; ++k) { const int c = lane + 64 * k;
        if (c < TOTAL) { const int row = c / CPR, ch = c % CPR; const v4u v = *(const LAS v4u*)(ST + row * 256 + ch * 16); if (!dry) *(v4u*)(gbase + (unsigned)(row * rowstride + ch * 8)) = v; } }
    LDS_WAIT();
}
__device__ __forceinline__ void st_flush_kimg(LAS unsigned char* ST, bf16* gtile, int lane, bool dry) {
    LDS_WAIT();
#pragma unroll
    for (int k = 0; k < 6; ++k) { const int c = (lane & 63) + 64 * k; const int ch = c >> 5, row = c & 31;
        const v4u v = *(const LAS v4u*)(ST + row * 256 + ch * 16); if (!dry) *(v4u*)(gtile + (unsigned)(ch * 512 + row * 8)) = v; }
    LDS_WAIT();
}
__device__ __forceinline__ int fresh_lane() { return lane_id_(); }
__device__ __forceinline__ float rsq_(float x) { return __builtin_amdgcn_rsqf(x); }
__device__ __forceinline__ float rcp_(float x) { return __builtin_amdgcn_rcpf(x); }
#define XB_TMO      128
#define XB_XCNT(j)  (256  + 64 * (j))
#define XB_XSUB(j)  (1280 + 64 * (j))
#define XB_XGEN(j)  (2304 + 64 * (j))
#define XB_TOP      3328
#define XB_TOPGEN   3392
#define XCD_BAR_WORDS 3456
#define XB_SPIN_CAP (1u << 18)
__device__ __forceinline__ unsigned xb_ld(unsigned* p)              { return __hip_atomic_load(p, __ATOMIC_RELAXED, __HIP_MEMORY_SCOPE_AGENT); }
__device__ __forceinline__ unsigned xb_add(unsigned* p, unsigned v) { return __hip_atomic_fetch_add(p, v, __ATOMIC_RELAXED, __HIP_MEMORY_SCOPE_AGENT); }
__device__ __forceinline__ unsigned xb_xcc_id() { return (unsigned)__builtin_amdgcn_s_getreg((3 << 11) | 20) & 0xFu; }
#define XB_SPIN(cond, bar) do { unsigned _sp = 0; while (cond) { __builtin_amdgcn_s_sleep(1); \
    if ((++_sp & 255u) == 0u) { if (xb_ld(&(bar)[XB_TMO])) break; if (_sp > XB_SPIN_CAP) { atomicAdd(&(bar)[XB_TMO], 1u); break; } } } } while (0)
struct XcdBarrier { unsigned* bar; unsigned x; volatile LAS unsigned* st; };
__device__ __forceinline__ XcdBarrier xcd_barrier_post(unsigned* bar, volatile LAS unsigned* st) {
    XcdBarrier b; b.bar = bar; b.x = xb_xcc_id(); b.st = st;
    if (tidx_() == 0) (void)xb_add(&bar[XB_XCNT(b.x)], 1u);
    return b;
}
__device__ __forceinline__ void xcd_barrier_complete(unsigned* bar, unsigned x, unsigned& nloc, unsigned& nx) {
    const unsigned G = gridDim.x * gridDim.y * gridDim.z;
    unsigned sum, cnt, mine, sp = 0u;
    for (;;) {
        sum = 0u; cnt = 0u; mine = 0u;
#pragma unroll
        for (unsigned j = 0; j < 16; ++j) { const unsigned c = xb_ld(&bar[XB_XCNT(j)]); sum += c; cnt += (c > 0u) ? 1u : 0u; mine = (j == x) ? c : mine; }
        if (sum == G) break;
        __builtin_amdgcn_s_sleep(1);
        if ((++sp & 255u) == 0u) { if (xb_ld(&bar[XB_TMO])) break; if (sp > XB_SPIN_CAP) { atomicAdd(&bar[XB_TMO], 1u); break; } }
    }
    nloc = mine > 0u ? mine : 1u; nx = cnt > 0u ? cnt : 1u;
}
__device__ __forceinline__ void xcd_barrier(const XcdBarrier& b) {
    asm volatile("s_waitcnt vmcnt(0)" ::: "memory");
    __syncthreads();
    if (tidx_() == 0) {
        unsigned* bar = b.bar;
        __builtin_amdgcn_s_waitcnt(0);
        unsigned nloc = b.st[0], nx = b.st[1];
        if (nloc == 0u) { xcd_barrier_complete(bar, b.x, nloc, nx); b.st[0] = nloc; b.st[1] = nx; }
        const unsigned old = xb_add(&bar[XB_XSUB(b.x)], 1u);
        const unsigned gen = old / nloc;
        if (old + 1u == (gen + 1u) * nloc) {
            __builtin_amdgcn_fence(__ATOMIC_RELEASE, "agent");
            asm volatile("s_waitcnt vmcnt(0)" ::: "memory");
            const unsigned og = xb_add(&bar[XB_TOP], 1u);
            const unsigned tg = og / nx;
            if (og + 1u == (tg + 1u) * nx) xb_add(&bar[XB_TOPGEN], 1u);
            else XB_SPIN(xb_ld(&bar[XB_TOPGEN]) == tg, bar);
            __builtin_amdgcn_fence(__ATOMIC_ACQUIRE, "agent");
            xb_add(&bar[XB_XGEN(b.x)], 1u);
            asm volatile("s_waitcnt vmcnt(0)" ::: "memory");
        } else {
            XB_SPIN(xb_ld(&bar[XB_XGEN(b.x)]) == gen, bar);
            __builtin_amdgcn_fence(__ATOMIC_ACQUIRE, "agent");
            asm volatile("s_waitcnt vmcnt(0)" ::: "memory");
        }
    }
    __syncthreads();
}

struct Args { const float* in[29]; float* out; unsigned char* ws; int ph_lo, ph_hi, li, pad; };
static_assert(sizeof(Args) == 29 * 8 + 8 + 8 + 16, "Args has no padding");
enum { I_X = 0, I_C, I_POS, I_WADA, I_BADA, I_NGAIN, I_WIN0, I_WIN1, I_MU, I_MUV, I_RVEC, I_RV0, I_RW2, I_RA2, I_RG2, I_RV2, I_POOLW, I_POOLS,
       I_QLG, I_KVLG, I_WQUP, I_WKVUP, I_QKG, I_WOUT, I_FFI, I_FFO, I_ROUTER, I_MOEI, I_MOEO };

namespace pg8 {
struct EpiRes {
    static constexpr bool PERM = false, AFTER_DRAIN = false;
    const float* xsrc; float* out; const float* gate;
    __device__ __forceinline__ void operator()(const f32x4 (&acc)[2][2][4][2], const Unit& u, int wr, int wc, int fr, int fq) const {
        const int row0 = u.pm * BM + wr * 64 + fr, col0 = u.pn * BM + wc * 32 + 4 * fq;
        const float* gb = gate + (size_t)((u.pm * BM) / T) * 6144;
        f32x4 gv[2][2];
#pragma unroll
        for (int bj = 0; bj < 2; ++bj)
#pragma unroll
            for (int n = 0; n < 2; ++n) gv[bj][n] = *(const f32x4*)(gb + col0 + bj * HALF + n * 16);
        f32x4 xs[2][2], xn[2][2];
        { const size_t off = (size_t)row0 * 1024 + col0;
#pragma unroll
          for (int bj = 0; bj < 2; ++bj)
#pragma unroll
              for (int n = 0; n < 2; ++n) xs[bj][n] = *(const f32x4*)(xsrc + off + bj * HALF + n * 16); }
#pragma unroll
        for (int g = 0; g < 8; ++g) { const int ai = g >> 2, m = g & 3;
            const size_t off = (size_t)(row0 + ai * HALF + m * 16) * 1024 + col0;
            if (g + 1 < 8) { const size_t offn = (size_t)(row0 + ((g + 1) >> 2) * HALF + ((g + 1) & 3) * 16) * 1024 + col0;
#pragma unroll
                for (int bj = 0; bj < 2; ++bj)
#pragma unroll
                    for (int n = 0; n < 2; ++n) xn[bj][n] = *(const f32x4*)(xsrc + offn + bj * HALF + n * 16); }
#pragma unroll
            for (int bj = 0; bj < 2; ++bj)
#pragma unroll
                for (int n = 0; n < 2; ++n) *(f32x4*)(out + off + bj * HALF + n * 16) = xs[bj][n] + gv[bj][n] * acc[ai][bj][m][n];
#pragma unroll
            for (int bj = 0; bj < 2; ++bj)
#pragma unroll
                for (int n = 0; n < 2; ++n) xs[bj][n] = xn[bj][n];
        }
    }
};
template <bool XF32> struct EpiResB {
    static constexpr bool PERM = true, AFTER_DRAIN = false;
    const void* xsrc; bf16_t* out; const float* gate;
    __device__ __forceinline__ void ldx(f32x4 (&d)[2][2], size_t off) const {
#pragma unroll
        for (int bj = 0; bj < 2; ++bj) {
            if constexpr (XF32) { d[bj][0] = *(const f32x4*)((const float*)xsrc + off + bj * HALF); d[bj][1] = *(const f32x4*)((const float*)xsrc + off + bj * HALF + 4); }
            else { const u32x4 r = *(const u32x4*)((const bf16_t*)xsrc + off + bj * HALF);
                   d[bj][0] = (f32x4){bflo(r.x), bfhi(r.x), bflo(r.y), bfhi(r.y)}; d[bj][1] = (f32x4){bflo(r.z), bfhi(r.z), bflo(r.w), bfhi(r.w)}; } }
    }
    __device__ __forceinline__ void operator()(const f32x4 (&acc)[2][2][4][2], const Unit& u, int wr, int wc, int fr, int fq) const {
        const int row0 = u.pm * BM + wr * 64 + fr, col0 = u.pn * BM + wc * 32 + 8 * fq;
        const float* gb = gate + (size_t)((u.pm * BM) / T) * 6144;
        f32x4 gv[2][2];
#pragma unroll
        for (int bj = 0; bj < 2; ++bj)
#pragma unroll
            for (int n = 0; n < 2; ++n) gv[bj][n] = *(const f32x4*)(gb + col0 + bj * HALF + 4 * n);
        f32x4 xs[2][2], xn[2][2];
        ldx(xs, (size_t)row0 * 1024 + col0);
#pragma unroll
        for (int g = 0; g < 8; ++g) { const int ai = g >> 2, m = g & 3;
            const size_t off = (size_t)(row0 + ai * HALF + m * 16) * 1024 + col0;
            if (g + 1 < 8) ldx(xn, (size_t)(row0 + ((g + 1) >> 2) * HALF + ((g + 1) & 3) * 16) * 1024 + col0);
#pragma unroll
            for (int bj = 0; bj < 2; ++bj) { const f32x4 y0 = xs[bj][0] + gv[bj][0] * acc[ai][bj][m][0], y1 = xs[bj][1] + gv[bj][1] * acc[ai][bj][m][1];
                u32x4 w; w.x = cvt_pk_bf16(y0[0], y0[1]); w.y = cvt_pk_bf16(y0[2], y0[3]); w.z = cvt_pk_bf16(y1[0], y1[1]); w.w = cvt_pk_bf16(y1[2], y1[3]);
                *(u32x4*)(out + off + bj * HALF) = w; }
#pragma unroll
            for (int bj = 0; bj < 2; ++bj)
#pragma unroll
                for (int n = 0; n < 2; ++n) xs[bj][n] = xn[bj][n];
        }
    }
};
struct EpiSwiglu {
    static constexpr bool PERM = true, AFTER_DRAIN = false;
    bf16_t* O; int ldo; int npn;
    __device__ __forceinline__ void operator()(const f32x4 (&acc)[2][2][4][2], const Unit& u, int wr, int wc, int fr, int fq) const {
        const int row0 = u.pm * BM + wr * 64 + fr, col0 = (u.pn % npn) * HALF + wc * 32 + 8 * fq;
#pragma unroll
        for (int ai = 0; ai < 2; ++ai)
#pragma unroll
            for (int m = 0; m < 4; ++m) { bf16_t* rowp = O + (size_t)(row0 + ai * HALF + m * 16) * ldo + col0;
                float o[8];
#pragma unroll
                for (int n = 0; n < 2; ++n)
#pragma unroll
                    for (int j = 0; j < 4; ++j) { const float g = acc[ai][0][m][n][j], uu = acc[ai][1][m][n][j]; o[n * 4 + j] = g * __builtin_amdgcn_rcpf(1.f + __expf(-g)) * uu; }
                u32x4 w; w.x = cvt_pk_bf16(o[0], o[1]); w.y = cvt_pk_bf16(o[2], o[3]); w.z = cvt_pk_bf16(o[4], o[5]); w.w = cvt_pk_bf16(o[6], o[7]);
                *(u32x4*)rowp = w; }
    }
};
struct EpiSwigluF8 {
    static constexpr bool PERM = true, AFTER_DRAIN = false;
    unsigned char* O; int ldo; int npn;
    __device__ __forceinline__ void operator()(const f32x4 (&acc)[2][2][4][2], const Unit& u, int wr, int wc, int fr, int fq) const {
        const int row0 = u.pm * BM + wr * 64 + fr, col0 = (u.pn % npn) * HALF + wc * 32 + 8 * fq;
#pragma unroll
        for (int ai = 0; ai < 2; ++ai)
#pragma unroll
            for (int m = 0; m < 4; ++m) { unsigned char* rowp = O + (size_t)(row0 + ai * HALF + m * 16) * ldo + col0;
                float o[8];
#pragma unroll
                for (int n = 0; n < 2; ++n)
#pragma unroll
                    for (int j = 0; j < 4; ++j) { const float g = acc[ai][0][m][n][j], uu = acc[ai][1][m][n][j]; o[n * 4 + j] = g * __builtin_amdgcn_rcpf(1.f + __expf(-g)) * uu * F8_ASCALE; }
                v2u w; w.x = f8pk4(o[0], o[1], o[2], o[3]); w.y = f8pk4(o[4], o[5], o[6], o[7]);
                asm volatile("" : "+v"(w.x), "+v"(w.y));
                *(v2u*)rowp = w; }
    }
};
struct EpiMoeOut {
    static constexpr bool PERM = true, AFTER_DRAIN = false;
    bf16_t* O;
    __device__ __forceinline__ void operator()(const f32x4 (&acc)[2][2][4][2], const Unit& u, int wr, int wc, int fr, int fq) const {
        const int row0 = u.pm * BM + wr * 64 + fr, col0 = (u.pn & 3) * BM + wc * 32 + 8 * fq;
#pragma unroll
        for (int ai = 0; ai < 2; ++ai)
#pragma unroll
            for (int m = 0; m < 4; ++m) { bf16_t* rowp = O + (size_t)(row0 + ai * HALF + m * 16) * 1024 + col0;
#pragma unroll
                for (int bj = 0; bj < 2; ++bj) { const f32x4 v0 = acc[ai][bj][m][0], v1 = acc[ai][bj][m][1];
                    u32x4 w; w.x = cvt_pk_bf16(v0[0], v0[1]); w.y = cvt_pk_bf16(v0[2], v0[3]); w.z = cvt_pk_bf16(v1[0], v1[1]); w.w = cvt_pk_bf16(v1[2], v1[3]);
                    *(u32x4*)(rowp + bj * HALF) = w; } }
    }
};
struct MoeOrder {
    int npn, nunits, G, c; int ts1, ts2, ts3, ts4, ts5, ts6, ts7;
    __device__ __forceinline__ bool next(int i, Unit& u) const {
        const int s = (c & 7) * (G >> 3) + (c >> 3);
        const int L = i * G + s; if (L >= nunits) return false;
        const int nrt = nunits / npn, nig = 8 * npn, gid = L / nig, fm = gid * 8, gsz = (nrt - fm) < 8 ? (nrt - fm) : 8, r = L % nig;
        const int rt = fm + r % gsz, pl = r / gsz;
        const int e = (rt >= ts1) + (rt >= ts2) + (rt >= ts3) + (rt >= ts4) + (rt >= ts5) + (rt >= ts6) + (rt >= ts7);
        u.pm = rt; u.pn = e * npn + pl; return true;
    }
    __device__ __forceinline__ void a_ready(const Unit&) const {}
    __device__ __forceinline__ void done(const Unit&) const {}
};
}

typedef float f32x16 __attribute__((ext_vector_type(16)));
constexpr int CHK = 32, NCHK = T / CHK;
constexpr size_t WS_SM = WS_R;
constexpr size_t WS_SNT = WS_R + 64 * MiB;
constexpr size_t WS_SRP = WS_R + 128 * MiB;
constexpr size_t WS_SYL = WS_H;
constexpr size_t WS_XV = WS_H + 32 * MiB;
constexpr size_t WS_BON = WS_MIX_END;
static_assert(WS_BON + 1 * MiB <= 896 * MiB, "ws");

__device__ __forceinline__ bf16x8 mkfrag(unsigned a, unsigned b, unsigned c, unsigned d) { v4u w = {a, b, c, d}; return __builtin_bit_cast(bf16x8, w); }
__device__ __forceinline__ bf16x8 accfrag(const f32x16& a, int s2) {
    return s2 == 0 ? mkfrag(cvtpk(a[0], a[1]), cvtpk(a[2], a[3]), cvtpk(a[4], a[5]), cvtpk(a[6], a[7]))
                   : mkfrag(cvtpk(a[8], a[9]), cvtpk(a[10], a[11]), cvtpk(a[12], a[13]), cvtpk(a[14], a[15]));
}
#define MFMA32(A, B, C) __builtin_amdgcn_mfma_f32_32x32x16_bf16((A), (B), (C), 0, 0, 0)
__device__ __forceinline__ int tm_addr(int row, int chunk) { return row * 128 + ((chunk ^ ((row >> 1) & 7)) << 4); }
__device__ __forceinline__ int cm_addr(int row, int chunk) { return row * 64 + ((chunk ^ ((row >> 2) & 3)) << 4); }
__device__ __forceinline__ int qrow(int r, int h) { return (r & 3) + 8 * (r >> 2) + 4 * h; }

template <int MODE>
__device__ __forceinline__ void scan_pass(const bf16* Rg, const bf16* Kg, const bf16* Vg, const bf16* KKg, const bf16* Ag, const float* LWg, size_t base,
                                          LAS unsigned char* L, LAS float* gC, int lane) {
    float cum = 0.f;
    if constexpr (MODE == 0) {
#pragma unroll 8
        for (int t = 0; t < CHK; ++t) {
            const size_t o = base + (size_t)t * RW + lane;
            const float kk = bf2f(KKg[o]), a = bf2f(Ag[o]), k = bf2f(Kg[o]), r = bf2f(Rg[o]), lw = LWg[o];
            const float cumx = cum; cum += lw;
            const float ea = __expf(cumx), eb = __expf(-cum), er = __expf(cum);
            const int ad = tm_addr(t, lane >> 3) + (lane & 7) * 2;
            *(LAS bf16*)(L + ad) = (bf16)f2bf(-kk * ea);
            *(LAS bf16*)(L + 4096 + ad) = (bf16)f2bf(kk * a * eb);
            *(LAS bf16*)(L + 8192 + ad) = (bf16)f2bf(k * eb);
            *(LAS bf16*)(L + 12288 + ad) = (bf16)f2bf(r * er);
        }
        gC[lane] = __expf(cum);
    } else {
#pragma unroll
        for (int s2 = 0; s2 < 2; ++s2) {
            float xa[16], xv[16], xb[16], xk[16];
#pragma unroll
            for (int u = 0; u < 16; ++u) {
                const size_t o = base + (size_t)(s2 * 16 + u) * RW + lane;
                const float kk = bf2f(KKg[o]), a = bf2f(Ag[o]), k = bf2f(Kg[o]), v = bf2f(Vg[o]), lw = LWg[o];
                const float cumx = cum; cum += lw;
                const float ea = __expf(cumx), eb = __expf(-cum);
                xa[u] = -kk * ea; xv[u] = v; xb[u] = kk * a * eb; xk[u] = k * eb;
            }
#pragma unroll
            for (int h = 0; h < 2; ++h) {
                const int ad = cm_addr(lane, 2 * s2 + h); const int u0 = 4 * h, u1 = 8 + 4 * h;
                *(LAS v4u*)(L + ad) = (v4u){cvtpk(xa[u0], xa[u0 + 1]), cvtpk(xa[u0 + 2], xa[u0 + 3]), cvtpk(xa[u1], xa[u1 + 1]), cvtpk(xa[u1 + 2], xa[u1 + 3])};
                *(LAS v4u*)(L + 4096 + ad) = (v4u){cvtpk(xv[u0], xv[u0 + 1]), cvtpk(xv[u0 + 2], xv[u0 + 3]), cvtpk(xv[u1], xv[u1 + 1]), cvtpk(xv[u1 + 2], xv[u1 + 3])};
                *(LAS v4u*)(L + 8192 + ad) = (v4u){cvtpk(xb[u0], xb[u0 + 1]), cvtpk(xb[u0 + 2], xb[u0 + 3]), cvtpk(xb[u1], xb[u1 + 1]), cvtpk(xb[u1 + 2], xb[u1 + 3])};
                *(LAS v4u*)(L + 12288 + ad) = (v4u){cvtpk(xk[u0], xk[u0 + 1]), cvtpk(xk[u0 + 2], xk[u0 + 3]), cvtpk(xk[u1], xk[u1 + 1]), cvtpk(xk[u1 + 2], xk[u1 + 3])};
            }
        }
    }
}

__device__ __forceinline__ void scan_local_item(unsigned char* ws, int item, LAS unsigned char* L, LAS float* gC, int lane) {
    const int hh = item % NH, bn = item / NH;
    const size_t base = (size_t)bn * CHK * RW + hh * 64;
    const bf16* Rg = (const bf16*)(ws + WS_R); const bf16* Kg = (const bf16*)(ws + WS_K); const bf16* Vg = (const bf16*)(ws + WS_V); const bf16* KKg = (const bf16*)(ws + WS_KK); const bf16* Ag = (const bf16*)(ws + WS_A);
    const float* LWg = (const float*)(ws + WS_LW);
    const int p = lane & 31, h = lane >> 5;
    const f32x16 zero16 = {0.f, 0.f, 0.f, 0.f, 0.f, 0.f, 0.f, 0.f, 0.f, 0.f, 0.f, 0.f, 0.f, 0.f, 0.f, 0.f};
    LDS_WAIT();
    scan_pass<0>(Rg, Kg, Vg, KKg, Ag, LWg, base, L, gC, lane);
    LDS_WAIT();
    f32x16 Aab = zero16, AabT = zero16, Aak = zero16, Arb = zero16, Ark = zero16;
#pragma unroll
    for (int s = 0; s < 4; ++s) {
        const int ad = tm_addr(p, 2 * s + h);
        const bf16x8 fa = *(const LAS bf16x8*)(L + ad), fb = *(const LAS bf16x8*)(L + 4096 + ad), fk = *(const LAS bf16x8*)(L + 8192 + ad), fr = *(const LAS bf16x8*)(L + 12288 + ad);
        Aab = MFMA32(fb, fa, Aab); AabT = MFMA32(fa, fb, AabT); Aak = MFMA32(fk, fa, Aak); Arb = MFMA32(fb, fr, Arb); Ark = MFMA32(fk, fr, Ark);
    }
    unsigned rin[2][8];
#pragma unroll
    for (int ct = 0; ct < 2; ++ct)
#pragma unroll
        for (int g = 0; g < 4; ++g) { const v2u w = *(const LAS v2u*)(L + 12288 + tm_addr(p, 4 * ct + g) + 8 * h); rin[ct][2 * g] = w.x; rin[ct][2 * g + 1] = w.y; }
#pragma unroll
    for (int r = 0; r < 16; ++r) { const int q = qrow(r, h);
        Aab[r] = (q < p) ? Aab[r] : 0.f;  Aak[r] = (q < p) ? Aak[r] : 0.f;
        AabT[r] = (p < q) ? AabT[r] : 0.f;
        Arb[r] = (q <= p) ? Arb[r] : 0.f; Ark[r] = (q <= p) ? Ark[r] : 0.f; }
    f32x16 Tm = Aab;
#pragma unroll
    for (int r = 0; r < 16; ++r) Tm[r] += (qrow(r, h) == p) ? 1.f : 0.f;
    bf16x8 X0 = accfrag(Aab, 0), X1 = accfrag(Aab, 1), XT0 = accfrag(AabT, 0), XT1 = accfrag(AabT, 1);
#pragma unroll
    for (int it = 0; it < 4; ++it) {
        f32x16 X2T = MFMA32(X0, XT0, zero16); X2T = MFMA32(X1, XT1, X2T);
        const bf16x8 T0 = accfrag(Tm, 0), T1 = accfrag(Tm, 1);
        const bf16x8 Y0 = accfrag(X2T, 0), Y1 = accfrag(X2T, 1);
        Tm = MFMA32(Y0, T0, Tm); Tm = MFMA32(Y1, T1, Tm);
        if (it < 3) { f32x16 X2 = MFMA32(XT0, X0, zero16); X2 = MFMA32(XT1, X1, X2);
            X0 = accfrag(X2, 0); X1 = accfrag(X2, 1); XT0 = Y0; XT1 = Y1; }
    }
    const bf16x8 Tf0 = accfrag(Tm, 0), Tf1 = accfrag(Tm, 1);
    const bf16x8 Akf0 = accfrag(Aak, 0), Akf1 = accfrag(Aak, 1), Abf0 = accfrag(Arb, 0), Abf1 = accfrag(Arb, 1), Arf0 = accfrag(Ark, 0), Arf1 = accfrag(Ark, 1);
    LDS_WAIT();
    scan_pass<1>(Rg, Kg, Vg, KKg, Ag, LWg, base, L, gC, lane);
    LDS_WAIT();
    bf16x8 fAT[2][2], fVT[2][2], fBT[2][2], fKT[2][2];
#pragma unroll
    for (int ct = 0; ct < 2; ++ct)
#pragma unroll
        for (int s2 = 0; s2 < 2; ++s2) { const int ad = cm_addr(32 * ct + p, 2 * s2 + h);
            fAT[ct][s2] = *(const LAS bf16x8*)(L + ad); fVT[ct][s2] = *(const LAS bf16x8*)(L + 4096 + ad); fBT[ct][s2] = *(const LAS bf16x8*)(L + 8192 + ad); fKT[ct][s2] = *(const LAS bf16x8*)(L + 12288 + ad); }
    bf16x8 fPT[2][2], fQT[2][2];
#pragma unroll
    for (int ct = 0; ct < 2; ++ct) {
        f32x16 a = MFMA32(Tf0, fAT[ct][0], zero16); a = MFMA32(Tf1, fAT[ct][1], a); fPT[ct][0] = accfrag(a, 0); fPT[ct][1] = accfrag(a, 1);
        f32x16 b = MFMA32(Akf0, fVT[ct][0], zero16); b = MFMA32(Akf1, fVT[ct][1], b);
        const bf16x8 av0 = accfrag(b, 0), av1 = accfrag(b, 1);
        f32x16 c = MFMA32(Tf0, av0, zero16); c = MFMA32(Tf1, av1, c); fQT[ct][0] = accfrag(c, 0); fQT[ct][1] = accfrag(c, 1);
    }
    bf16* RPo = (bf16*)(ws + WS_SRP) + (size_t)item * 2048; bf16* YLo = (bf16*)(ws + WS_SYL) + (size_t)item * 2048;
    bf16* Mo = (bf16*)(ws + WS_SM) + (size_t)item * 4096; bf16* NTo = (bf16*)(ws + WS_SNT) + (size_t)item * 4096;
#pragma unroll
    for (int ct = 0; ct < 2; ++ct) {
        f32x16 a;
#pragma unroll
        for (int g = 0; g < 8; ++g) { a[2 * g] = bflo(rin[ct][g]); a[2 * g + 1] = bfhi(rin[ct][g]); }
        a = MFMA32(fPT[ct][0], Abf0, a); a = MFMA32(fPT[ct][1], Abf1, a);
#pragma unroll
        for (int s2 = 0; s2 < 2; ++s2) *(bf16x8*)(RPo + p * 64 + (4 * ct + 2 * s2 + h) * 8) = accfrag(a, s2);
        f32x16 y = MFMA32(Abf0, fQT[ct][0], zero16); y = MFMA32(Abf1, fQT[ct][1], y); y = MFMA32(Arf0, fVT[ct][0], y); y = MFMA32(Arf1, fVT[ct][1], y);
#pragma unroll
        for (int s2 = 0; s2 < 2; ++s2) *(bf16x8*)(YLo + (32 * ct + p) * 32 + (2 * s2 + h) * 8) = accfrag(y, s2);
    }
#pragma unroll
    for (int ctp = 0; ctp < 2; ++ctp) {
        const float gl = gC[32 * ctp + p];
#pragma unroll
        for (int ct = 0; ct < 2; ++ct) {
            f32x16 m = MFMA32(fPT[ct][0], fBT[ctp][0], zero16); m = MFMA32(fPT[ct][1], fBT[ctp][1], m);
#pragma unroll
            for (int r = 0; r < 16; ++r) m[r] = (m[r] + ((ct == ctp && qrow(r, h) == p) ? 1.f : 0.f)) * gl;
#pragma unroll
            for (int s2 = 0; s2 < 2; ++s2) *(bf16x8*)(Mo + (32 * ctp + p) * 64 + (4 * ct + 2 * s2 + h) * 8) = accfrag(m, s2);
        }
    }
#pragma unroll
    for (int ctd = 0; ctd < 2; ++ctd)
#pragma unroll
        for (int ctp = 0; ctp < 2; ++ctp) {
            f32x16 n = MFMA32(fBT[ctp][0], fQT[ctd][0], zero16); n = MFMA32(fBT[ctp][1], fQT[ctd][1], n); n = MFMA32(fKT[ctp][0], fVT[ctd][0], n); n = MFMA32(fKT[ctp][1], fVT[ctd][1], n);
#pragma unroll
            for (int r = 0; r < 16; ++r) n[r] *= gC[32 * ctp + qrow(r, h)];
#pragma unroll
            for (int s2 = 0; s2 < 2; ++s2) *(bf16x8*)(NTo + (32 * ctd + p) * 64 + (4 * ctp + 2 * s2 + h) * 8) = accfrag(n, s2);
        }
}

__device__ __forceinline__ void ph_scan_local(unsigned char* ws, LAS unsigned char* lds, int gw, int NGW, int wave, int lane) {
    LAS unsigned char* L = lds + RING_OFF + wave * 16384;
    LAS float* gC = (LAS float*)(lds + LDSCTL_OFF + 4096) + wave * 64;
    for (int item = gw; item < BATCH * NCHK * NH; item += NGW) scan_local_item(ws, item, L, gC, lane);
}

__device__ __forceinline__ f32x16 ld_acc_bf16(const bf16* p0, const bf16* p1) {
    const v4u a = *(const v4u*)p0, b = *(const v4u*)p1; f32x16 r;
    r[0] = bflo(a.x); r[1] = bfhi(a.x); r[2] = bflo(a.y); r[3] = bfhi(a.y); r[4] = bflo(a.z); r[5] = bfhi(a.z); r[6] = bflo(a.w); r[7] = bfhi(a.w);
    r[8] = bflo(b.x); r[9] = bfhi(b.x); r[10] = bflo(b.y); r[11] = bfhi(b.y); r[12] = bflo(b.z); r[13] = bfhi(b.z); r[14] = bflo(b.w); r[15] = bfhi(b.w); return r;
}
constexpr size_t WS_SS = WS_LW;
__device__ __forceinline__ void scan_carry(unsigned char* ws, int bh, int ctd, int lane) {
    const int b = bh / NH, hh = bh % NH; const int p = lane & 31, h = lane >> 5;
    const bf16* Mb = (const bf16*)(ws + WS_SM); const bf16* NTb = (const bf16*)(ws + WS_SNT); bf16* Sg = (bf16*)(ws + WS_SS);
    const f32x16 zero16 = {0.f, 0.f, 0.f, 0.f, 0.f, 0.f, 0.f, 0.f, 0.f, 0.f, 0.f, 0.f, 0.f, 0.f, 0.f, 0.f};
    f32x16 S[2] = {zero16, zero16};
    v4u m0[2][4], n0[2][2], m1[2][4], n1[2][2], m2[2][4], n2[2][2];
#define CARRY_LOAD(MQ, NQ, nn) do { const int nc_ = (nn) < NCHK ? (nn) : NCHK - 1; const size_t it_ = (size_t)(b * NCHK + nc_) * NH + hh; const bf16* Mi_ = Mb + it_ * 4096; const bf16* NTi_ = NTb + it_ * 4096 + ctd * 2048; \
      _Pragma("unroll") for (int ctp = 0; ctp < 2; ++ctp) _Pragma("unroll") for (int s4 = 0; s4 < 4; ++s4) MQ[ctp][s4] = *(const v4u*)(Mi_ + ((4 * ctp + s4) * 64 + (lane & 63)) * 8); \
      _Pragma("unroll") for (int ctp = 0; ctp < 2; ++ctp) _Pragma("unroll") for (int s2 = 0; s2 < 2; ++s2) NQ[ctp][s2] = *(const v4u*)(NTi_ + ((2 * ctp + s2) * 64 + (lane & 63)) * 8); } while (0)
#define CARRY_STEP(nn, MC, NC, MQ2, NQ2) do { \
      CARRY_LOAD(MQ2, NQ2, (nn) + 2); \
      bf16* Si_ = Sg + ((size_t)(b * NCHK + (nn)) * NH + hh) * 4096 + ctd * 2048; bf16x8 Sf[4]; \
      _Pragma("unroll") for (int s4 = 0; s4 < 4; ++s4) { Sf[s4] = accfrag(S[s4 >> 1], s4 & 1); *(bf16x8*)(Si_ + (s4 * 64 + (lane & 63)) * 8) = Sf[s4]; } \
      _Pragma("unroll") for (int ctp = 0; ctp < 2; ++ctp) { const v4u x = NC[ctp][0], y = NC[ctp][1]; f32x16 sn; \
          sn[0] = bflo(x.x); sn[1] = bfhi(x.x); sn[2] = bflo(x.y); sn[3] = bfhi(x.y); sn[4] = bflo(x.z); sn[5] = bfhi(x.z); sn[6] = bflo(x.w); sn[7] = bfhi(x.w); \
          sn[8] = bflo(y.x); sn[9] = bfhi(y.x); sn[10] = bflo(y.y); sn[11] = bfhi(y.y); sn[12] = bflo(y.z); sn[13] = bfhi(y.z); sn[14] = bflo(y.w); sn[15] = bfhi(y.w); \
          _Pragma("unroll") for (int s4 = 0; s4 < 4; ++s4) sn = MFMA32(__builtin_bit_cast(bf16x8, MC[ctp][s4]), Sf[s4], sn); \
          S[ctp] = sn; } } while (0)
    CARRY_LOAD(m0, n0, 0); CARRY_LOAD(m1, n1, 1);
    static_assert(NCHK % 3 == 2, "carry loop tail");
#pragma unroll 1
    for (int n = 0; n + 2 < NCHK; n += 3) { CARRY_STEP(n, m0, n0, m2, n2); CARRY_STEP(n + 1, m1, n1, m0, n0); CARRY_STEP(n + 2, m2, n2, m1, n1); }
    CARRY_STEP(NCHK - 2, m0, n0, m2, n2); CARRY_STEP(NCHK - 1, m1, n1, m0, n0);
#undef CARRY_LOAD
#undef CARRY_STEP
}
__device__ __forceinline__ void scan_out_item(const Args& a, unsigned char* ws, LAS unsigned char* ST, int l, int item, int lane) {
    const int hh = item % NH, bn = item / NH; const int p = lane & 31, h = lane >> 5;
    const bf16* Si = (const bf16*)(ws + WS_SS) + (size_t)item * 4096; const bf16* RPi = (const bf16*)(ws + WS_SRP) + (size_t)item * 2048; const bf16* YLi = (const bf16*)(ws + WS_SYL) + (size_t)item * 2048;
    const float* BONu = (const float*)(ws + WS_BON) + (size_t)bn * CHK * 8 + hh; bf16* mixu = (bf16*)(ws + WS_MIX) + (size_t)bn * CHK * D + hh * 64;
    const float* rvec = a.in[I_RVEC] + l * 7 * RW;
    bf16x8 rp[4], sf[2][4]; v4u yl[2][2], xv[2][2], xg[2][2]; float bon[16];
#pragma unroll
    for (int s4 = 0; s4 < 4; ++s4) rp[s4] = *(const bf16x8*)(RPi + (s4 * 64 + (lane & 63)) * 8);
#pragma unroll
    for (int ctd = 0; ctd < 2; ++ctd)
#pragma unroll
        for (int s4 = 0; s4 < 4; ++s4) sf[ctd][s4] = *(const bf16x8*)(Si + ((4 * ctd + s4) * 64 + (lane & 63)) * 8);
    { const v4u* XV = (const v4u*)(ws + WS_XV) + ((size_t)item * 4) * 64 + lane; const v4u* XG = (const v4u*)(ws + WS_G) + ((size_t)item * 4) * 64 + lane;
#pragma unroll
      for (int ctd = 0; ctd < 2; ++ctd)
#pragma unroll
          for (int hq = 0; hq < 2; ++hq) { yl[ctd][hq] = *(const v4u*)(YLi + ((2 * ctd + hq) * 64 + (lane & 63)) * 8); xv[ctd][hq] = XV[(ctd * 2 + hq) * 64]; xg[ctd][hq] = XG[(ctd * 2 + hq) * 64]; } }
#pragma unroll
    for (int r = 0; r < 16; ++r) bon[r] = BONu[qrow(r, h) * 8];
    float lng[2], lnb[2];
#pragma unroll
    for (int ctd = 0; ctd < 2; ++ctd) { lng[ctd] = rvec[5 * RW + hh * 64 + 32 * ctd + p]; lnb[ctd] = rvec[6 * RW + hh * 64 + 32 * ctd + p]; }
    f32x16 Y[2];
#define UNPK(DST, W0, W1) do { DST[0] = bflo(W0.x); DST[1] = bfhi(W0.x); DST[2] = bflo(W0.y); DST[3] = bfhi(W0.y); DST[4] = bflo(W0.z); DST[5] = bfhi(W0.z); DST[6] = bflo(W0.w); DST[7] = bfhi(W0.w); \
        DST[8] = bflo(W1.x); DST[9] = bfhi(W1.x); DST[10] = bflo(W1.y); DST[11] = bfhi(W1.y); DST[12] = bflo(W1.z); DST[13] = bfhi(W1.z); DST[14] = bflo(W1.w); DST[15] = bfhi(W1.w); } while (0)
#pragma unroll
    for (int ctd = 0; ctd < 2; ++ctd) { UNPK(Y[ctd], yl[ctd][0], yl[ctd][1]);
#pragma unroll
        for (int s4 = 0; s4 < 4; ++s4) Y[ctd] = MFMA32(rp[s4], sf[ctd][s4], Y[ctd]); }
    float vv[2][16], gg[2][16];
#pragma unroll
    for (int ctd = 0; ctd < 2; ++ctd) { UNPK(vv[ctd], xv[ctd][0], xv[ctd][1]); UNPK(gg[ctd], xg[ctd][0], xg[ctd][1]); }
#undef UNPK
#pragma unroll
    for (int r = 0; r < 16; ++r) {
        const float y0 = Y[0][r], y1 = Y[1][r];
        const float s1 = half_sum32(y0 + y1), s2 = half_sum32(y0 * y0 + y1 * y1);
        const float mean = s1 * (1.f / 64.f), var = fmaxf(s2 * (1.f / 64.f) - mean * mean, 0.f), rstd = 1.f / sqrtf(var + 64e-5f);
        const int i = qrow(r, h);
        st_put(ST, i, p, ((y0 - mean) * rstd * lng[0] + lnb[0] + bon[r] * vv[0][r]) * gg[0][r]);
        st_put(ST, i, 32 + p, ((y1 - mean) * rstd * lng[1] + lnb[1] + bon[r] * vv[1][r]) * gg[1][r]);
    }
    st_flush<64>(ST, mixu, D, lane, false);
}
__device__ __forceinline__ void ph_scan_out(const Args& a, unsigned char* ws, LAS unsigned char* lds, int l, int gw, int NGW, int wave, int lane_in) {
    LAS unsigned char* ST = lds + RING_OFF + wave * 8192;
    for (int item = gw; item < BATCH * NCHK * NH; item += NGW) { const int lane = fresh_lane(); scan_out_item(a, ws, ST, l, item, lane); }
}

constexpr size_t WS_VT = WS_BON + 1 * MiB;
static_assert(WS_VT + 16 * MiB <= 896 * MiB, "ws");
constexpr int AT_KB = 0, AT_VB = 16384, AT_STAGE = 24576;
__device__ __forceinline__ int atk_addr(int row, int chunk) { return row * 256 + ((chunk ^ (row & 15)) << 4); }

__device__ __forceinline__ const bf16* at_ksrc(const bf16* KM, int b, int hq, int kt, int c) { const int row = c / 12, ch = c % 12; return KM + (size_t)(b * T + kt * 64 + row) * 384 + hq * 96 + ch * 8; }
__device__ __forceinline__ const bf16* at_vsrc(const bf16* VTg, int b, int hq, int kt, int v) { return VTg + ((size_t)((b * 4 + hq) * 128 + 2 * kt + (v >> 8)) * 64 + ((v >> 2) & 63)) * 32 + (v & 3) * 8; }
__device__ __forceinline__ int at_kdst(int c) { const int row = c / 12, ch = c % 12; return AT_KB + atk_addr(row, ch); }
__device__ __forceinline__ int at_vdst(int v) { return AT_VB + (v >> 8) * 4096 + cm_addr((v >> 2) & 63, v & 3); }
__device__ __forceinline__ void attn_stage_load(const bf16* KM, const bf16* VTg, int b, int hq, int kt, int tid, v4u& rg0, v4u& rg1, v4u& rg2) {
    rg0 = *(const v4u*)at_ksrc(KM, b, hq, kt, tid);
    const bf16* sb = tid < 256 ? at_ksrc(KM, b, hq, kt, 512 + tid) : at_vsrc(VTg, b, hq, kt, tid - 256);
    rg1 = *(const v4u*)sb;
    if (tid < 256) rg2 = *(const v4u*)at_vsrc(VTg, b, hq, kt, 256 + tid);
}
__device__ __forceinline__ void attn_stage_store(LAS unsigned char* S, int tid, const v4u& rg0, const v4u& rg1, const v4u& rg2) {
    *(LAS v4u*)(S + at_kdst(tid)) = rg0;
    const int db = tid < 256 ? at_kdst(512 + tid) : at_vdst(tid - 256);
    *(LAS v4u*)(S + db) = rg1;
    if (tid < 256) *(LAS v4u*)(S + at_vdst(256 + tid)) = rg2;
}

__device__ __forceinline__ void ph_attn_mfma(unsigned char* ws, LAS unsigned char* lds, int bh, int qb, int tid, int wave, int lane) {
    const int b = bh >> 2, hq = bh & 3;
    const bf16* QM = (const bf16*)(ws + WS_QM); const bf16* KM = (const bf16*)(ws + WS_KM); const bf16* VTg = (const bf16*)(ws + WS_VT); bf16* mix = (bf16*)(ws + WS_MIX);
    LAS unsigned char* L = lds + RING_OFF;
    const int p = lane & 31, h = lane >> 5;
    const f32x16 zero16 = {0.f, 0.f, 0.f, 0.f, 0.f, 0.f, 0.f, 0.f, 0.f, 0.f, 0.f, 0.f, 0.f, 0.f, 0.f, 0.f};
    {
        const int q0 = qb * 256; const int ntile = 4 * (qb + 1);
        const int qrow_ = q0 + wave * 32 + p;
        const int qmax_w = q0 + wave * 32 + 31, qmin_w = q0 + wave * 32;
        bf16x8 qf[6];
#pragma unroll
        for (int s = 0; s < 6; ++s) qf[s] = *(const bf16x8*)(QM + (size_t)(b * T + qrow_) * 384 + hq * 96 + 16 * s + 8 * h);
        f32x16 O[2] = {zero16, zero16}; float mrun = -1.0e30f, lrun = 0.f;
        v4u rg0, rg1, rg2 = (v4u){0u, 0u, 0u, 0u};
        __syncthreads();
        attn_stage_load(KM, VTg, b, hq, 0, tid, rg0, rg1, rg2); attn_stage_store(L, tid, rg0, rg1, rg2);
        __syncthreads();
#pragma unroll 1
        for (int kt = 0; kt < ntile; ++kt) {
            LAS unsigned char* S = L + (kt & 1) * AT_STAGE;
            if (kt + 1 < ntile) attn_stage_load(KM, VTg, b, hq, kt + 1, tid, rg0, rg1, rg2);
            if (kt * 64 <= qmax_w) {
                f32x16 s0 = zero16, s1 = zero16;
#pragma unroll
                for (int s = 0; s < 6; ++s) {
                    const bf16x8 k0 = *(const LAS bf16x8*)(S + AT_KB + atk_addr(p, 2 * s + h)), k1 = *(const LAS bf16x8*)(S + AT_KB + atk_addr(32 + p, 2 * s + h));
                    s0 = MFMA32(k0, qf[s], s0); s1 = MFMA32(k1, qf[s], s1);
                }
                if (kt * 64 + 63 > qmin_w) {
#pragma unroll
                    for (int r = 0; r < 16; ++r) { const int kv = kt * 64 + qrow(r, h); if (kv > qrow_) s0[r] = -1.0e30f; if (kv + 32 > qrow_) s1[r] = -1.0e30f; }
                }
                float rm = fmaxf(s0[0], s1[0]);
#pragma unroll
                for (int r = 1; r < 16; ++r) rm = fmaxf(rm, fmaxf(s0[r], s1[r]));
                { const unsigned u_ = __float_as_uint(rm); auto rr_ = __builtin_amdgcn_permlane32_swap(u_, u_, false, false); rm = fmaxf(__uint_as_float(rr_[0]), __uint_as_float(rr_[1])); }
                const float mnew = fmaxf(mrun, rm); const float alpha = __builtin_amdgcn_exp2f(mrun - mnew); mrun = mnew;
                float ls = 0.f;
#pragma unroll
                for (int r = 0; r < 16; ++r) { s0[r] = __builtin_amdgcn_exp2f(s0[r] - mnew); s1[r] = __builtin_amdgcn_exp2f(s1[r] - mnew); ls += s0[r] + s1[r]; }
                lrun = lrun * alpha + ls;
#pragma unroll
                for (int r = 0; r < 16; ++r) { O[0][r] *= alpha; O[1][r] *= alpha; }
                const bf16x8 p00 = accfrag(s0, 0), p01 = accfrag(s0, 1), p10 = accfrag(s1, 0), p11 = accfrag(s1, 1);
#pragma unroll
                for (int dvt = 0; dvt < 2; ++dvt) {
                    const bf16x8 v00 = *(const LAS bf16x8*)(S + AT_VB + cm_addr(32 * dvt + p, h)), v01 = *(const LAS bf16x8*)(S + AT_VB + cm_addr(32 * dvt + p, 2 + h));
                    const bf16x8 v10 = *(const LAS bf16x8*)(S + AT_VB + 4096 + cm_addr(32 * dvt + p, h)), v11 = *(const LAS bf16x8*)(S + AT_VB + 4096 + cm_addr(32 * dvt + p, 2 + h));
                    O[dvt] = MFMA32(v00, p00, O[dvt]); O[dvt] = MFMA32(v01, p01, O[dvt]); O[dvt] = MFMA32(v10, p10, O[dvt]); O[dvt] = MFMA32(v11, p11, O[dvt]);
                }
            }
            if (kt + 1 < ntile) attn_stage_store(L + ((kt + 1) & 1) * AT_STAGE, tid, rg0, rg1, rg2);
            __syncthreads();
        }
        float ltot; { const unsigned u_ = __float_as_uint(lrun); auto rr_ = __builtin_amdgcn_permlane32_swap(u_, u_, false, false); ltot = __uint_as_float(rr_[0]) + __uint_as_float(rr_[1]); } const float il = 1.f / ltot;
        bf16* orow = mix + (size_t)(b * T + qrow_) * D + 768 + hq * 64;
#pragma unroll
        for (int dvt = 0; dvt < 2; ++dvt)
#pragma unroll
            for (int g = 0; g < 4; ++g) { v2u w; w.x = cvtpk(O[dvt][4 * g] * il, O[dvt][4 * g + 1] * il); w.y = cvtpk(O[dvt][4 * g + 2] * il, O[dvt][4 * g + 3] * il);
                *(v2u*)(orow + 32 * dvt + 8 * g + 4 * h) = w; }
    }
}

constexpr int AT2_KSLOT = 12288, AT2_VSLOT = 8192, AT2_K = 0, AT2_V = 4 * AT2_KSLOT;
__device__ __forceinline__ void glds16(const void* g, unsigned lds_base) {
    unsigned sv; asm volatile("s_mov_b32 %0, m0\n\ts_mov_b32 m0, %2\n\ts_nop 0\n\tglobal_load_lds_dwordx4 %1, off\n\ts_mov_b32 m0, %0" : "=&s"(sv) : "v"(g), "s"(lds_base) : "memory"); }
#define AT_SBAR() __builtin_amdgcn_sched_barrier(0)
#define AT_PIN(x) asm volatile("" : "+v"(x))
#define AT_WB(N) asm volatile("s_waitcnt vmcnt(" #N ") lgkmcnt(0)\n\ts_barrier" ::: "memory")
#define AT_MX3(a, b, c) __builtin_fmaxf(__builtin_fmaxf((a), (b)), (c))
__device__ __forceinline__ float at_rowmax(const f32x16& p0, const f32x16& p1) {
    float a = AT_MX3(p0[0], p0[1], p1[0]), b = AT_MX3(p0[2], p0[3], p1[1]); a = AT_MX3(a, p1[2], p1[3]);
#pragma unroll
    for (int r = 4; r < 16; r += 4) { a = AT_MX3(a, p0[r], p0[r + 1]); b = AT_MX3(b, p0[r + 2], p0[r + 3]); a = AT_MX3(a, p1[r], p1[r + 1]); b = AT_MX3(b, p1[r + 2], p1[r + 3]); }
    const float m = __builtin_fmaxf(a, b); auto rr = __builtin_amdgcn_permlane32_swap(__float_as_uint(m), __float_as_uint(m), false, false);
    return __builtin_fmaxf(__uint_as_float(rr[0]), __uint_as_float(rr[1])); }
__device__ __forceinline__ void at_cmask(f32x16& p0, f32x16& p1, int jb, int qrel, int h) {
    int d = qrel - (64 * jb + 4 * h); asm volatile("" : "+v"(d));
#pragma unroll
    for (int r = 0; r < 16; ++r) { const int c = (r & 3) + 8 * (r >> 2); if (c > d) p0[r] = -INFINITY; if (c + 32 > d) p1[r] = -INFINITY; } }
__device__ __forceinline__ void at_kload2(bf16x8* kf, const LAS unsigned char* kp, int s) { kf[2 * s] = *(const LAS bf16x8*)(kp + s * 2048); kf[2 * s + 1] = *(const LAS bf16x8*)(kp + s * 2048 + 512); }
#ifndef ATTN_THR
#define ATTN_THR 8
#endif

__device__ __forceinline__ void ph_attn_pipe(unsigned char* ws, LAS unsigned char* lds, int bh, int qb, int wave, int lane) {
    const int b = bh >> 2, hq = bh & 3;
    const bf16* QM = (const bf16*)(ws + WS_QM); const bf16* KM = (const bf16*)(ws + WS_KM); const bf16* VTg = (const bf16*)(ws + WS_VT); bf16* mix = (bf16*)(ws + WS_MIX);
    LAS unsigned char* L = lds + RING_OFF;
    const int p = lane & 31, h = lane >> 5;
    const int q0 = qb * 256, NT = 4 * (qb + 1);
    const int qrel = wave * 32 + p; const bool wlo = wave < 4;
    const bf16* ksrc = KM + (size_t)((b * 4 + hq) * 64) * 6144 + wave * 512 + (lane & 63) * 8;
    const int vrow = (wave & 3) * 16 + (lane >> 2);
    const bf16* vsrc = VTg + (size_t)((b * 4 + hq) * 128 + (wave >> 2)) * 2048 + ((((vrow >> 5) * 4 + ((lane & 3) ^ ((vrow >> 2) & 3))) * 32 + (vrow & 31)) * 8);
    const unsigned lds0 = (unsigned)(size_t)L;
    const unsigned kdst = lds0 + AT2_K + wave * 1024, vdst = lds0 + AT2_V + wave * 1024;
#define RFL(x) ((unsigned)__builtin_amdgcn_readfirstlane((int)(x)))
#define DMA_K(t, slot) do { glds16(ksrc + (size_t)(t) * 6144, RFL(kdst + (slot) * AT2_KSLOT)); if (wlo) glds16(ksrc + (size_t)(t) * 6144 + 4096, RFL(kdst + (slot) * AT2_KSLOT + 8192)); } while (0)
#define DMA_V(t, slot) glds16(vsrc + (size_t)(t) * 4096, RFL(vdst + (slot) * AT2_VSLOT))
    const int vx = (h ^ ((p >> 2) & 3));
    const LAS unsigned char* vpA = L + AT2_V + p * 64 + (vx << 4);
    const LAS unsigned char* vpB = L + AT2_V + p * 64 + ((vx ^ 2) << 4);
    const LAS unsigned char* kp0 = L + AT2_K + h * 1024 + p * 16;
    DMA_K(0, 0); DMA_V(0, 0); DMA_K(1, 1); DMA_K(2, 2); DMA_K(3, 3); DMA_V(1, 1);
    bf16x8 qf[6];
    { const bf16* Qw = QM + (size_t)(b * T + q0 + qrel) * 384 + hq * 96 + 8 * h;
#pragma unroll
      for (int s = 0; s < 6; ++s) qf[s] = *(const bf16x8*)(Qw + 16 * s); }
    float mhat = 0.f, l_reg = 0.f, fres = 1.f; f32x16 o0, o1;
    const f32x16 zero16 = {0.f, 0.f, 0.f, 0.f, 0.f, 0.f, 0.f, 0.f, 0.f, 0.f, 0.f, 0.f, 0.f, 0.f, 0.f, 0.f};
    o0 = zero16; o1 = zero16; bool resc = false;
    f32x16 pA0, pA1, pB0, pB1; bf16x8 kf[12], vf[8]; v4u pw0, pw1, pw2, pw3;
    int sl_prev = 0, sl_cur = 0, sl_next = 1;
#define ROT() do { sl_prev = sl_cur; sl_cur = sl_next; sl_next = (sl_next + 1) & 3; } while (0)
#define EX(v) __builtin_amdgcn_exp2f((v) + nmh)
#define RESC() do { if (resc) { _Pragma("unroll") for (int r = 0; r < 16; ++r) { o0[r] *= fres; o1[r] *= fres; } } } while (0)
    AT_WB(0);
#pragma unroll
    for (int s = 0; s < 6; ++s) at_kload2(kf, kp0, s);
    pA0 = MFMA32(kf[0], qf[0], zero16); pA1 = MFMA32(kf[1], qf[0], zero16);
#pragma unroll
    for (int s = 1; s < 6; ++s) { pA0 = MFMA32(kf[2 * s], qf[s], pA0); pA1 = MFMA32(kf[2 * s + 1], qf[s], pA1); }
    if (NT == 4) at_cmask(pA0, pA1, 0, qrel, h);
    { mhat = at_rowmax(pA0, pA1); const float nmh = -mhat;
#pragma unroll
      for (int r = 0; r < 16; ++r) { pA0[r] = EX(pA0[r]); pA1[r] = EX(pA1[r]); } }
    AT_WB(0);
    if (4 < NT) DMA_K(4, 0); DMA_V(2, 2); ROT();
#pragma unroll
    for (int s = 0; s < 6; ++s) at_kload2(kf, kp0 + sl_cur * AT2_KSLOT, s);
    if (4 < NT) { if (wlo) { AT_WB(3); } else { AT_WB(2); } } else { AT_WB(1); }
#define PKW(P, i) cvtpk(P[i], P[i + 1])
#define PAF(k) __builtin_bit_cast(bf16x8, pw##k)
#define VOFF(j) ((((j) >> 1) >> 1) * 4096 + ((j) & 1) * 2048)
#define VRD(j) do { vf[j] = *(const LAS bf16x8*)(((((j) >> 1) & 1) ? vpB_ : vpA_) + VOFF(j)); } while (0)
#define KRD(G, s) do { if (G) { at_kload2(kf, kp0 + sl_next * AT2_KSLOT, s); AT_SBAR(); } } while (0)
#define GAPA3(MF, a0, a1, a2, W0, W1, PW) do { MF; sacc += a0; sacc += a1; sacc += a2; W0; W1; AT_PIN(PW); AT_PIN(sacc); AT_SBAR(); } while (0)
#define GAPB(MF, X, i) do { MF; X[i] = EX(X[i]); X[i + 1] = EX(X[i + 1]); X[i + 2] = EX(X[i + 2]); X[i + 3] = EX(X[i + 3]); AT_PIN(X); AT_SBAR(); } while (0)
#define WAIT2() do { if (wlo) { AT_WB(6); } else { AT_WB(4); } } while (0)
#define WAITN(GK, GV) do { if (GK) { if (GV) { if (wlo) { AT_WB(3); } else { AT_WB(2); } } else { if (wlo) { AT_WB(2); } else { AT_WB(1); } } } else { if (GV) { AT_WB(1); } else { AT_WB(0); } } } while (0)
#define STEP(C0, C1, P0, P1, t, MASK, GK, GV, GL) do { AT_SBAR(); \
    const LAS unsigned char* vpA_ = vpA + sl_prev * AT2_VSLOT; const LAS unsigned char* vpB_ = vpB + sl_prev * AT2_VSLOT; \
    float sacc = P0[0] + P0[1]; \
    VRD(0); AT_SBAR(); GAPA3(C0 = MFMA32(kf[0], qf[0], zero16), P0[2], P0[3], P0[4],    pw0[0] = PKW(P0, 0),  pw0[1] = PKW(P0, 2),  pw0); \
    VRD(1); AT_SBAR(); GAPA3(C1 = MFMA32(kf[1], qf[0], zero16), P0[5], P0[6], P0[7],    pw0[2] = PKW(P0, 4),  pw0[3] = PKW(P0, 6),  pw0); \
    VRD(2); AT_SBAR(); GAPA3(C0 = MFMA32(kf[2], qf[1], C0),     P0[8], P0[9], P0[10],   pw1[0] = PKW(P0, 8),  (void)0,              pw1); \
    VRD(3); AT_SBAR(); GAPA3(C1 = MFMA32(kf[3], qf[1], C1),     P0[11], P0[12], P0[13], pw1[1] = PKW(P0, 10), pw1[2] = PKW(P0, 12), pw1); \
    VRD(4); AT_SBAR(); GAPA3(C0 = MFMA32(kf[4], qf[2], C0),     P0[14], P0[15], P1[0],  pw1[3] = PKW(P0, 14), (void)0,              pw1); \
    VRD(5); AT_SBAR(); GAPA3(C1 = MFMA32(kf[5], qf[2], C1),     P1[1], P1[2], P1[3],    pw2[0] = PKW(P1, 0),  pw2[1] = PKW(P1, 2),  pw2); \
    VRD(6); AT_SBAR(); GAPA3(C0 = MFMA32(kf[6], qf[3], C0),     P1[4], P1[5], P1[6],    pw2[2] = PKW(P1, 4),  (void)0,              pw2); \
    VRD(7); AT_SBAR(); GAPA3(C1 = MFMA32(kf[7], qf[3], C1),     P1[7], P1[8], P1[9],    pw2[3] = PKW(P1, 6),  pw3[0] = PKW(P1, 8),  pw3); \
                       GAPA3(C0 = MFMA32(kf[8], qf[4], C0),     P1[10], P1[11], P1[12], pw3[1] = PKW(P1, 10), (void)0,              pw3); \
                       GAPA3(C1 = MFMA32(kf[9], qf[4], C1),     P1[13], P1[14], P1[15], pw3[2] = PKW(P1, 12), pw3[3] = PKW(P1, 14), pw3); \
    C0 = MFMA32(kf[10], qf[5], C0); C1 = MFMA32(kf[11], qf[5], C1); AT_SBAR(); \
    l_reg += sacc; \
    if (GK) DMA_K((t) + 4, sl_cur); if (GV) DMA_V((t) + 2, (sl_next + 1) & 3); \
    if (MASK) at_cmask(C0, C1, (t) - (NT - 4), qrel, h); \
    { const float rm = at_rowmax(C0, C1) - mhat; resc = false; \
      if (__builtin_expect(__any(rm > (float)ATTN_THR), 0)) { const float dl = __builtin_fmaxf(rm, 0.f); mhat += dl; fres = __builtin_amdgcn_exp2f(-dl); l_reg *= fres; resc = true; } } \
    const float nmh = -mhat; AT_SBAR(); \
    GAPB(o0 = MFMA32(vf[0], PAF(0), o0), C0, 0);               GAPB(o1 = MFMA32(vf[1], PAF(0), o1), C0, 4); \
    KRD(GL, 0); GAPB(o0 = MFMA32(vf[2], PAF(1), o0), C0, 8);   KRD(GL, 1); GAPB(o1 = MFMA32(vf[3], PAF(1), o1), C0, 12); \
    KRD(GL, 2); GAPB(o0 = MFMA32(vf[4], PAF(2), o0), C1, 0);   KRD(GL, 3); GAPB(o1 = MFMA32(vf[5], PAF(2), o1), C1, 4); \
    KRD(GL, 4); GAPB(o0 = MFMA32(vf[6], PAF(3), o0), C1, 8);   KRD(GL, 5); GAPB(o1 = MFMA32(vf[7], PAF(3), o1), C1, 12); \
    } while (0)
    int t = 1;
    for (; t + 5 < NT; t += 2) {
        STEP(pB0, pB1, pA0, pA1, t, false, true, true, true);     WAIT2(); RESC(); ROT();
        STEP(pA0, pA1, pB0, pB1, t + 1, false, true, true, true); WAIT2(); RESC(); ROT();
    }
#define ENDW(tt) do { if ((tt) + 4 < NT) { WAITN(true, true); } else if ((tt) + 2 < NT) { WAITN(false, true); } else { WAITN(false, false); } } while (0)
    for (; t + 1 < NT; t += 2) {
        STEP(pB0, pB1, pA0, pA1, t, true, (t + 4 < NT), (t + 2 < NT), (t + 1 < NT));         ENDW(t);     RESC(); ROT();
        STEP(pA0, pA1, pB0, pB1, t + 1, true, (t + 5 < NT), (t + 3 < NT), (t + 2 < NT));     ENDW(t + 1); RESC(); ROT();
    }
    STEP(pB0, pB1, pA0, pA1, NT - 1, true, false, false, false); RESC();
    { float sacc = pB0[0] + pB0[1];
#pragma unroll
      for (int r = 2; r < 16; ++r) sacc += pB0[r];
#pragma unroll
      for (int r = 0; r < 16; ++r) sacc += pB1[r];
      l_reg += sacc;
      pw0 = (v4u){PKW(pB0, 0), PKW(pB0, 2), PKW(pB0, 4), PKW(pB0, 6)}; pw1 = (v4u){PKW(pB0, 8), PKW(pB0, 10), PKW(pB0, 12), PKW(pB0, 14)};
      pw2 = (v4u){PKW(pB1, 0), PKW(pB1, 2), PKW(pB1, 4), PKW(pB1, 6)}; pw3 = (v4u){PKW(pB1, 8), PKW(pB1, 10), PKW(pB1, 12), PKW(pB1, 14)};
      const LAS unsigned char* vpA_ = vpA + sl_cur * AT2_VSLOT; const LAS unsigned char* vpB_ = vpB + sl_cur * AT2_VSLOT;
      VRD(0); VRD(1); VRD(2); VRD(3); VRD(4); VRD(5); VRD(6); VRD(7);
      o0 = MFMA32(vf[0], PAF(0), o0); o1 = MFMA32(vf[1], PAF(0), o1); o0 = MFMA32(vf[2], PAF(1), o0); o1 = MFMA32(vf[3], PAF(1), o1);
      o0 = MFMA32(vf[4], PAF(2), o0); o1 = MFMA32(vf[5], PAF(2), o1); o0 = MFMA32(vf[6], PAF(3), o0); o1 = MFMA32(vf[7], PAF(3), o1); }
    float ltot; { const unsigned u_ = __float_as_uint(l_reg); auto rr_ = __builtin_amdgcn_permlane32_swap(u_, u_, false, false); ltot = __uint_as_float(rr_[0]) + __uint_as_float(rr_[1]); }
    const float il = __builtin_amdgcn_rcpf(ltot);
    bf16* orow = mix + (size_t)(b * T + q0 + qrel) * D + 768 + hq * 64;
#pragma unroll
    for (int g = 0; g < 4; ++g) { v2u w; w.x = cvtpk(o0[4 * g] * il, o0[4 * g + 1] * il); w.y = cvtpk(o0[4 * g + 2] * il, o0[4 * g + 3] * il); *(v2u*)(orow + 8 * g + 4 * h) = w; }
#pragma unroll
    for (int g = 0; g < 4; ++g) { v2u w; w.x = cvtpk(o1[4 * g] * il, o1[4 * g + 1] * il); w.y = cvtpk(o1[4 * g + 2] * il, o1[4 * g + 3] * il); *(v2u*)(orow + 32 + 8 * g + 4 * h) = w; }
#undef RFL
#undef DMA_K
#undef DMA_V
#undef ROT
#undef EX
#undef RESC
#undef PKW
#undef PAF
#undef VOFF
#undef VRD
#undef KRD
#undef GAPA3
#undef GAPB
#undef WAITN
#undef WAIT2
#undef STEP
#undef ENDW
}

constexpr size_t WS_XA = WS_R;
constexpr size_t WS_XL = WS_LW;
constexpr size_t WS_SMALLW = 6 * MiB;
constexpr int O_W2T = 0, O_A2T = 32768, O_G2T = 65536, O_V2T = 147456, O_POOLT = 163840, O_WQT = 180224, O_WKVT = 278528, LAYER_SMALLW = 344064;
constexpr int PZ_XW = 0, PZ_XA = 4096, PZ_XG = 8192  , PZ_XV = 18432  , PZ_PP = 20480  , PZ_QN = 36864  , PZ_KVN = 53248  , PZ_END = 61440;
template <int PITCH> __device__ __forceinline__ int pz_addr(int row, int chunk) {
    if constexpr (PITCH == 128) return row * 128 + ((chunk ^ ((row >> 1) & 7)) << 4);
    else if constexpr (PITCH == 64 || PITCH == 320) return row * PITCH + ((chunk ^ ((row >> 2) & 3)) << 4);
    else return row * PITCH + ((chunk ^ (row & 15)) << 4);
}
template <int PITCH> __device__ __forceinline__ void pz_put(LAS unsigned char* tile, int row, int k, float v) { *(LAS bf16*)(tile + pz_addr<PITCH>(row, k >> 3) + (k & 7) * 2) = (bf16)f2bf(v); }

__device__ __forceinline__ unsigned wfrag_off(int n, int k8, int K) { return (unsigned)(((((n >> 5) * (K >> 4) + (k8 >> 1)) * 2 + (k8 & 1)) * 32 + (n & 31)) * 8); }
__device__ __forceinline__ void small_transpose(const float* src, int K, int N, bf16* dst, int gtid, int GT) {
    const int k8n = K / 8;
    for (int it = gtid; it < N * k8n; it += GT) { const int n = it / k8n, k0 = (it % k8n) * 8;
        v4u o; o.x = pk2(src[(size_t)(k0 + 0) * N + n], src[(size_t)(k0 + 1) * N + n]); o.y = pk2(src[(size_t)(k0 + 2) * N + n], src[(size_t)(k0 + 3) * N + n]);
        o.z = pk2(src[(size_t)(k0 + 4) * N + n], src[(size_t)(k0 + 5) * N + n]); o.w = pk2(src[(size_t)(k0 + 6) * N + n], src[(size_t)(k0 + 7) * N + n]);
        *(v4u*)(dst + wfrag_off(n, k0 >> 3, K)) = o; }
}
__device__ __forceinline__ void ph_small_weights(const Args& a, unsigned char* ws, int gtid, int GT) {
    for (int l = 0; l < 2; ++l) {
        bf16* base = (bf16*)(ws + WS_SMALLW) + (size_t)l * LAYER_SMALLW;
        small_transpose(a.in[I_RW2] + (size_t)l * 64 * RW, 64, RW, base + O_W2T, gtid, GT);
        small_transpose(a.in[I_RA2] + (size_t)l * 64 * RW, 64, RW, base + O_A2T, gtid, GT);
        small_transpose(a.in[I_RG2] + (size_t)l * 160 * RW, 160, RW, base + O_G2T, gtid, GT);
        if (l == 1) small_transpose(a.in[I_RV2], 32, RW, base + O_V2T, gtid, GT);
        for (int g = 0; g < 4; ++g) small_transpose(a.in[I_POOLW] + (size_t)(l * 4 + g) * 4096, 64, 64, base + O_POOLT + g * 4096, gtid, GT);
        small_transpose(a.in[I_WQUP] + (size_t)l * 256 * 384, 256, 384, base + O_WQT, gtid, GT);
        small_transpose(a.in[I_WKVUP] + (size_t)l * 128 * 512, 128, 512, base + O_WKVT, gtid, GT);
    }
}

template <int PITCH, int KSTEPS, int NTILES, int KG = 2>
__device__ __forceinline__ void pz_gemm(f32x16 (&acc)[NTILES], const LAS unsigned char* X, const bf16* WT, int K, int n0, int p, int h, int kc0 = 0) {
    constexpr int NG = KSTEPS / KG;
    static_assert(KSTEPS % KG == 0, "k-steps");
    bf16x8 wb[2][KG][NTILES];
#pragma unroll
    for (int q = 0; q < KG; ++q)
#pragma unroll
        for (int jt = 0; jt < NTILES; ++jt) wb[0][q][jt] = *(const bf16x8*)(WT + wfrag_off(n0 + 32 * jt + (p & 31), 2 * q + (h & 1), K));
#pragma unroll
    for (int g = 0; g < NG; ++g) {
        if (g + 1 < NG) {
#pragma unroll
            for (int q = 0; q < KG; ++q)
#pragma unroll
                for (int jt = 0; jt < NTILES; ++jt) wb[(g + 1) & 1][q][jt] = *(const bf16x8*)(WT + wfrag_off(n0 + 32 * jt + (p & 31), 2 * ((g + 1) * KG + q) + (h & 1), K));
        }
#pragma unroll
        for (int q = 0; q < KG; ++q) {
            const bf16x8 xa = *(const LAS bf16x8*)(X + pz_addr<PITCH>(p, kc0 + 2 * (g * KG + q) + h));
#pragma unroll
            for (int jt = 0; jt < NTILES; ++jt) acc[jt] = MFMA32(xa, wb[g & 1][q][jt], acc[jt]);
        }
        asm volatile("" ::: "memory");
    }
}


template <int WIN>
__device__ __forceinline__ void pool_wave(const bf16* zc, int tt0, int i0, LAS unsigned char* PP, int gi, int lane) {
    float u[16 + WIN - 1];
    bf16 raw[16 + WIN - 1];
#pragma unroll
    for (int k = 0; k < 16 + WIN - 1; ++k) { const int off = i0 + k - (WIN - 1); const int offc = (tt0 + off >= 0) ? off : -tt0; raw[k] = zc[(ptrdiff_t)offc * NZ]; }
    __builtin_amdgcn_sched_barrier(0);
#pragma unroll
    for (int k = 0; k < 16 + WIN - 1; ++k) { const int off = i0 + k - (WIN - 1); u[k] = (tt0 + off >= 0) ? bf2f(raw[k]) : 0.f; }
    float s = 0.f;
#pragma unroll
    for (int k = 0; k < WIN - 1; ++k) s += u[k];
#pragma unroll
    for (int j = 0; j < 16; ++j) { s += u[WIN - 1 + j]; const int tt = tt0 + i0 + j; const int cnt = (tt + 1) < WIN ? (tt + 1) : WIN;
        pz_put<512>(PP, i0 + j, gi * 64 + lane, s * rcp_((float)cnt) - u[WIN - 1 + j]); s -= u[j]; }
}

#ifndef PZ_ABL
#define PZ_ABL 0
#endif
#ifndef PZ_PART
#define PZ_PART 7
#endif
template <int l>
__device__ __forceinline__ void ph_postz_mfma(const Args& a, unsigned char* ws, LAS unsigned char* lds, int G, int tid, int wave, int lane_in, bool dry) {
    LAS unsigned char* L = lds + RING_OFF;
    const bf16* z = (const bf16*)(ws + WS_Z);
    const float* mu = a.in[I_MU] + l * SHIFT_COLS; const float* muv = a.in[I_MUV];
    const float* rvec = a.in[I_RVEC] + l * 7 * RW; const float* v0p = a.in[I_RV0];
    const bf16* SW = (const bf16*)(ws + WS_SMALLW) + (size_t)l * LAYER_SMALLW;
    bf16* Rr = (bf16*)(ws + WS_R); bf16* Kr = (bf16*)(ws + WS_K); bf16* Vr = (bf16*)(ws + WS_V); bf16* KKr = (bf16*)(ws + WS_KK); bf16* Ar = (bf16*)(ws + WS_A);
    float* LWr = (float*)(ws + WS_LW); bf16* Gr = (bf16*)(ws + WS_G); bf16* VF = (bf16*)(ws + WS_VF); bf16* mix = (bf16*)(ws + WS_MIX); float* BON = (float*)(ws + WS_BON);
    bf16* QM = (bf16*)(ws + WS_QM); bf16* KM = (bf16*)(ws + WS_KM); bf16* VM = (bf16*)(ws + WS_VM);
    const float* pools = a.in[I_POOLS] + l * 256; const float* qlg = a.in[I_QLG] + l * 256; const float* kvlg = a.in[I_KVLG] + l * 128;
    const float* qkg = a.in[I_QKG] + l * 2 * 96; const float* ct = (const float*)(ws + WS_COS); const float* st = (const float*)(ws + WS_SIN);
    const f32x16 zero16 = {0.f, 0.f, 0.f, 0.f, 0.f, 0.f, 0.f, 0.f, 0.f, 0.f, 0.f, 0.f, 0.f, 0.f, 0.f, 0.f};
    for (int unit = blockIdx.x; unit < M / 32; unit += G) {
        const int lane = fresh_lane();
        const int p = lane & 31, h = lane >> 5;
        LAS unsigned char* ST = L + PZ_END + wave * 8192;
        const int t0 = unit * 32; const int tt0 = t0 % T;
        const bf16* zu = z + (size_t)t0 * NZ;
        bf16* Ru = Rr + (size_t)t0 * RW; bf16* Ku = Kr + (size_t)t0 * RW; bf16* Vu = Vr + (size_t)t0 * RW; bf16* KKu = KKr + (size_t)t0 * RW; bf16* Au = Ar + (size_t)t0 * RW;
        float* LWu = LWr + (size_t)t0 * RW; bf16* Gu = Gr + (size_t)t0 * RW; bf16* VFu = VF + (size_t)t0 * RW; bf16* mixu = mix + (size_t)t0 * D; float* BONu = BON + (size_t)t0 * 8;
        bf16* QMu = QM + (size_t)t0 * 384; bf16* KMu = KM + (size_t)t0 * 384; bf16* VMu = VM + (size_t)t0 * 256; const float* ctu = ct + (size_t)t0 * 16; const float* stu = st + (size_t)t0 * 16;
        __syncthreads();
        if (dry && (PZ_ABL & 4)) {} else {
            { const int gi = wave & 3, i0 = (wave >> 2) * 16; const bf16* zc = z + (size_t)t0 * NZ + OFF_POOL + gi * 64 + lane;
              if (gi == 0) pool_wave<2>(zc, tt0, i0, L + PZ_PP, gi, lane); else if (gi == 1) pool_wave<4>(zc, tt0, i0, L + PZ_PP, gi, lane);
              else if (gi == 2) pool_wave<8>(zc, tt0, i0, L + PZ_PP, gi, lane); else pool_wave<16>(zc, tt0, i0, L + PZ_PP, gi, lane); }
            float cW[4], pW[4], cA[4], pA[4], cG0[4], pG0[4], cG1[4], pG1[4], cG2[4], pG2[4], cV[4], pV[4], q4[4][4], k2[4][2];
            int wv; asm volatile("v_mov_b32 %0, %1" : "=v"(wv) : "s"(wave));
#pragma unroll
            for (int t4 = 0; t4 < 4; ++t4) { const int i = wv * 4 + t4; const bool hp = (tt0 + i) > 0;
                const bf16* zb = zu - NZ;
                const unsigned oc = (unsigned)((i + 1) * NZ) + (unsigned)lane, op = hp ? oc - NZ : oc; const unsigned l31 = (unsigned)(lane & 31), oc31 = (unsigned)((i + 1) * NZ) + l31, op31 = hp ? oc31 - NZ : oc31;
                cW[t4] = bf2f(zb[oc + OFF_WD]); pW[t4] = bf2f(zb[op + OFF_WD]); cA[t4] = bf2f(zb[oc + OFF_AD]); pA[t4] = bf2f(zb[op + OFF_AD]);
                cG0[t4] = bf2f(zb[oc + OFF_GD]); pG0[t4] = bf2f(zb[op + OFF_GD]); cG1[t4] = bf2f(zb[oc + OFF_GD + 64]); pG1[t4] = bf2f(zb[op + OFF_GD + 64]);
                cG2[t4] = bf2f(zb[oc31 + OFF_GD + 128]); pG2[t4] = bf2f(zb[op31 + OFF_GD + 128]);
                if (l > 0) { cV[t4] = bf2f(zb[oc31 + OFF_VD]); pV[t4] = bf2f(zb[op31 + OFF_VD]); } else { cV[t4] = 0.f; pV[t4] = 0.f; }
#pragma unroll
                for (int j = 0; j < 4; ++j) q4[t4][j] = bf2f(zb[oc + OFF_QLAT + 64 * j]);
#pragma unroll
                for (int j = 0; j < 2; ++j) k2[t4][j] = bf2f(zb[oc + OFF_KVLAT + 64 * j]); }
            const float muW = mu[OFF_WD + lane], muA = mu[OFF_AD + lane], muG0 = mu[OFF_GD + lane], muG1 = mu[OFF_GD + 64 + lane], muG2 = mu[OFF_GD + 128 + (lane & 31)], muV = l > 0 ? muv[lane & 31] : 0.f;
#pragma unroll
            for (int t4 = 0; t4 < 4; ++t4) { const int i = wv * 4 + t4; const float pm = (tt0 + i) > 0 ? 1.f : 0.f;
#define SH(c_, p_, m_) ((c_) + (m_) * (pm * (p_) - (c_)))
                pz_put<128>(L + PZ_XW, i, lane, tanhf_(SH(cW[t4], pW[t4], muW))); pz_put<128>(L + PZ_XA, i, lane, SH(cA[t4], pA[t4], muA));
                pz_put<320>(L + PZ_XG, i, lane, sigmoidf_(SH(cG0[t4], pG0[t4], muG0))); pz_put<320>(L + PZ_XG, i, lane + 64, sigmoidf_(SH(cG1[t4], pG1[t4], muG1)));
                if (lane < 32) pz_put<320>(L + PZ_XG, i, lane + 128, sigmoidf_(SH(cG2[t4], pG2[t4], muG2)));
                if (l > 0 && lane < 32) pz_put<64>(L + PZ_XV, i, lane, SH(cV[t4], pV[t4], muV));
#undef SH
                float s = 0.f;
#pragma unroll
                for (int j = 0; j < 4; ++j) s += q4[t4][j] * q4[t4][j];
                const float rs = rsq_(wave_sum(s) * (1.f / 256.f) + 1e-6f);
#pragma unroll
                for (int j = 0; j < 4; ++j) pz_put<512>(L + PZ_QN, i, lane + 64 * j, q4[t4][j] * rs * qlg[lane + 64 * j]);
                s = 0.f;
#pragma unroll
                for (int j = 0; j < 2; ++j) s += k2[t4][j] * k2[t4][j];
                const float rk = rsq_(wave_sum(s) * (1.f / 128.f) + 1e-6f);
#pragma unroll
                for (int j = 0; j < 2; ++j) pz_put<256>(L + PZ_KVN, i, lane + 64 * j, k2[t4][j] * rk * kvlg[lane + 64 * j]);
            }
        }
        __syncthreads();
        if (dry && (PZ_ABL & 2)) {} else if ((PZ_PART & 2) && wave < 4) {
            const int hq = wave; const int fi = p & 15;
            { f32x16 aq[3] = {zero16, zero16, zero16};
              { f32x16 a01[2] = {zero16, zero16}; pz_gemm<512, 16, 2, 4>(a01, L + PZ_QN, SW + O_WQT, 256, hq * 96, p, h); aq[0] = a01[0]; aq[1] = a01[1]; }
              { f32x16 a2[1] = {zero16}; pz_gemm<512, 16, 1, 4>(a2, L + PZ_QN, SW + O_WQT, 256, hq * 96 + 64, p, h); aq[2] = a2[0]; }
              const float C2 = 0.10206207261596577f * 1.4426950408889634f; const float gq0 = qkg[p] * C2, gq1 = qkg[32 + p] * C2, gq2 = qkg[64 + p] * C2;
              float csv[16], snv[16];
#pragma unroll
              for (int r = 0; r < 16; ++r) { csv[r] = ctu[qrow(r, h) * 16 + fi]; snv[r] = stu[qrow(r, h) * 16 + fi]; }
#pragma unroll
              for (int r = 0; r < 16; ++r) {
                const int i = qrow(r, h);
                const float cs = csv[r], sn = snv[r];
                const float xq = aq[2][r], xqo = __int_as_float(__builtin_amdgcn_ds_swizzle(__float_as_int(xq), 0x401F));
                const float qpe = p < 16 ? xq * cs - xqo * sn : xqo * sn + xq * cs;
                const float q0 = aq[0][r], q1 = aq[1][r];
                const float rq = rsq_(half_sum32(q0 * q0 + q1 * q1 + qpe * qpe) * (1.f / 96.f) + 1e-6f);
                st_put(ST, i, p, q0 * rq * gq0); st_put(ST, i, 32 + p, q1 * rq * gq1); st_put(ST, i, 64 + p, qpe * rq * gq2);
                if ((r & 3) == 3) asm volatile("" ::: "memory");
              }
              st_flush<96>(ST, QMu + hq * 96, 384, lane, dry); }
        } else if (PZ_PART & 6) {
            const int hq = wave - 4, gi = wave - 4; const int fi = p & 15;
            { f32x16 ak[2] = {zero16, zero16};
              pz_gemm<256, 8, 2, 4>(ak, L + PZ_KVN, SW + O_WKVT, 128, hq * 128, p, h);
              const float gk0 = qkg[96 + p], gk1 = qkg[96 + 32 + p], gk2 = qkg[96 + 64 + p];
              float csv[16], snv[16]; bf16 xkv[16];
#pragma unroll
              for (int r = 0; r < 16; ++r) { csv[r] = ctu[qrow(r, h) * 16 + fi]; snv[r] = stu[qrow(r, h) * 16 + fi]; xkv[r] = zu[(unsigned)(qrow(r, h) * NZ + OFF_KROPE + p)]; }
#pragma unroll
              for (int r = 0; r < 16; ++r) {
                const int i = qrow(r, h);
                const float cs = csv[r], sn = snv[r];
                const float xk = bf2f(xkv[r]), xko = __int_as_float(__builtin_amdgcn_ds_swizzle(__float_as_int(xk), 0x401F));
                const float kpe = p < 16 ? xk * cs - xko * sn : xko * sn + xk * cs;
                const float k0 = ak[0][r], k1 = ak[1][r];
                const float rk = rsq_(half_sum32(k0 * k0 + k1 * k1 + kpe * kpe) * (1.f / 96.f) + 1e-6f);
                st_put(ST, i, p, k0 * rk * gk0); st_put(ST, i, 32 + p, k1 * rk * gk1); st_put(ST, i, 64 + p, kpe * rk * gk2);
                if ((r & 3) == 3) asm volatile("" ::: "memory");
              }
              st_flush_kimg(ST, KM + ((size_t)(((t0 / T) * 4 + hq) * 64 + (tt0 >> 6)) * 6144 + (unsigned)((tt0 & 63) * 8)), lane, dry); }
            { f32x16 av[2] = {zero16, zero16};
              pz_gemm<256, 8, 2, 4>(av, L + PZ_KVN, SW + O_WKVT, 128, hq * 128 + 64, p, h);
              { bf16* vt = (bf16*)(ws + WS_VT) + (size_t)(((t0 / T) * 4 + hq) * 128 + tt0 / 32) * 2048;
#pragma unroll
                for (int jt = 0; jt < 2; ++jt)
#pragma unroll
                    for (int s2 = 0; s2 < 2; ++s2) if (!dry) { *(bf16x8*)(vt + (unsigned)(((jt * 2 + s2) * 64 + (((h & 1) << 5) | p)) * 8)) = accfrag(av[jt], s2); } }
              asm volatile("" ::: "memory"); }

            f32x16 ap[2] = {zero16, zero16};
            pz_gemm<512, 4, 2>(ap, L + PZ_PP, SW + O_POOLT + gi * 4096, 64, 0, p, h, 8 * gi);
            const float ps0 = pools[gi * 64 + p], ps1 = pools[gi * 64 + 32 + p];
#pragma unroll
            for (int r = 0; r < 16; ++r) { st_put(ST, qrow(r, h), p, ap[0][r] * ps0); st_put(ST, qrow(r, h), 32 + p, ap[1][r] * ps1); }
            st_flush<64>(ST, mixu + 512 + gi * 64, D, lane, dry);
        }
        if (!(dry && (PZ_ABL & 1))) {
            const int hh = wave;
            { f32x16 aG[2] = {zero16, zero16};
              pz_gemm<320, 10, 2, 5>(aG, L + PZ_XG, SW + O_G2T, 160, hh * 64, p, h);
              { unsigned char* XGb = ws + WS_G + ((size_t)unit * NH + hh) * (4 * 64 * 16); const unsigned lo16 = (unsigned)lane * 16u;
#pragma unroll
                for (int jt = 0; jt < 2; ++jt)
#pragma unroll
                    for (int hq = 0; hq < 2; ++hq) if (!dry) *(v4u*)(XGb + (lo16 + (unsigned)((jt * 2 + hq) * 1024))) = (v4u){cvtpk(aG[jt][8 * hq], aG[jt][8 * hq + 1]), cvtpk(aG[jt][8 * hq + 2], aG[jt][8 * hq + 3]), cvtpk(aG[jt][8 * hq + 4], aG[jt][8 * hq + 5]), cvtpk(aG[jt][8 * hq + 6], aG[jt][8 * hq + 7])}; }
              asm volatile("" ::: "memory"); }
            float lwv[2][16]; unsigned pkk[2][8], paa[2][8], pkf[2][8], prr[2][8], pvv[2][8], pgv[2][8];
            { f32x16 aA[2] = {zero16, zero16};
              pz_gemm<128, 4, 2>(aA, L + PZ_XA, SW + O_A2T, 64, hh * 64, p, h);
#pragma unroll
              for (int jt = 0; jt < 2; ++jt) { const float a0 = rvec[RW + hh * 64 + 32 * jt + p];
#pragma unroll
                  for (int q = 0; q < 8; ++q) paa[jt][q] = cvtpk(sigmoidf_(a0 + aA[jt][2 * q]), sigmoidf_(a0 + aA[jt][2 * q + 1])); } }
            if (l > 0) { f32x16 aV[2] = {zero16, zero16};
              pz_gemm<64, 2, 2>(aV, L + PZ_XV, SW + O_V2T, 32, hh * 64, p, h);
#pragma unroll
              for (int jt = 0; jt < 2; ++jt) { const float v0c = v0p[hh * 64 + 32 * jt + p];
#pragma unroll
                  for (int q = 0; q < 8; ++q) pgv[jt][q] = cvtpk(sigmoidf_(v0c + aV[jt][2 * q]), sigmoidf_(v0c + aV[jt][2 * q + 1])); } }
            unsigned char* XAb = ws + WS_XV + ((size_t)unit * NH + hh) * (4 * 64 * 16);
            {
            LAS unsigned* stash = (LAS unsigned*)ST + lane;
            float mr[2], mk[2], mv[2], kkc[2], kac[2], rkc[2];
#pragma unroll
            for (int jt = 0; jt < 2; ++jt) { const int c = hh * 64 + 32 * jt + p; mr[jt] = mu[c]; mk[jt] = mu[512 + c]; mv[jt] = mu[1024 + c];
                kkc[jt] = rvec[2 * RW + c]; kac[jt] = rvec[3 * RW + c]; rkc[jt] = rvec[4 * RW + c]; }
            bf16 rw[2][2][7];
#define ZL_LOAD(BUF, R) do { int hv_ = h; asm volatile("" : "+v"(hv_)); const int i_ = qrow((R), hv_); const bool hp_ = (tt0 + i_) > 0; \
                const bf16* zc_ = zu + (i_ * NZ + hh * 64 + p); const bf16* zp_ = hp_ ? zc_ - NZ : zc_; const unsigned ov_ = (unsigned)(i_ * RW + hh * 64 + p); \
                _Pragma("unroll") for (int jt_ = 0; jt_ < 2; ++jt_) { rw[BUF][jt_][0] = zc_[32 * jt_]; rw[BUF][jt_][1] = zc_[512 + 32 * jt_]; rw[BUF][jt_][2] = zc_[1024 + 32 * jt_]; \
                    rw[BUF][jt_][3] = zp_[32 * jt_]; rw[BUF][jt_][4] = zp_[512 + 32 * jt_]; rw[BUF][jt_][5] = zp_[1024 + 32 * jt_]; rw[BUF][jt_][6] = l > 0 ? VFu[ov_ + 32u * jt_] : (bf16)0; } } while (0)
            ZL_LOAD(0, 0);
#pragma unroll
            for (int rp = 0; rp < 8; ++rp) {
                float kk2[2][2], k2[2][2], r2[2][2], v2[2][2];
#pragma unroll
                for (int rr = 0; rr < 2; ++rr) {
                    const int r = 2 * rp + rr;
                    if (r + 1 < 16) ZL_LOAD((r + 1) & 1, r + 1);
                    int hv = h; asm volatile("" : "+v"(hv));
                    const int i = qrow(r, hv); const bool hp = (tt0 + i) > 0;
                    const float pm = hp ? 1.f : 0.f;
                    const unsigned ov = (unsigned)(i * RW + hh * 64 + p);
                    float kkr[2]; float n2 = 0.f, bs = 0.f;
#pragma unroll
                    for (int jt = 0; jt < 2; ++jt) {
                        const bf16* w_ = rw[r & 1][jt];
                        const float zr_ = bf2f(w_[0]), zk_ = bf2f(w_[1]), zv_ = bf2f(w_[2]);
                        const float pr_ = pm * bf2f(w_[3]), pk_ = pm * bf2f(w_[4]), pv_ = pm * bf2f(w_[5]);
                        const float rv = zr_ + mr[jt] * (pr_ - zr_), k0 = zk_ + mk[jt] * (pk_ - zk_), v0 = zv_ + mv[jt] * (pv_ - zv_);
                        float v = v0;
                        if (l == 0) { if (!dry) { VFu[ov + 32u * jt] = (bf16)f2bf(v0); } }
                        else { const float vf = bf2f(w_[6]); v = v0 + (vf - v0) * (rr ? bfhi(pgv[jt][rp]) : bflo(pgv[jt][rp])); }
                        const float aa = rr ? bfhi(paa[jt][rp]) : bflo(paa[jt][rp]);
                        kkr[jt] = k0 * kkc[jt]; n2 += kkr[jt] * kkr[jt];
                        const float k = k0 * (1.f + (aa - 1.f) * kac[jt]);
                        r2[jt][rr] = bf2f((bf16)f2bf(rv)); k2[jt][rr] = bf2f((bf16)f2bf(k)); v2[jt][rr] = bf2f((bf16)f2bf(v));
                        bs += r2[jt][rr] * k2[jt][rr] * rkc[jt];
                    }
                    n2 = half_sum32(n2); bs = half_sum32(bs);
                    const float inv = rsq_(fmaxf(n2, 1e-24f));
                    kk2[0][rr] = kkr[0] * inv; kk2[1][rr] = kkr[1] * inv;
                    if (p == 0) if (!dry) { BONu[(unsigned)(i * 8 + hh)] = bs; }
                }
#pragma unroll
                for (int jt = 0; jt < 2; ++jt) { pkk[jt][rp] = cvtpk(kk2[jt][0], kk2[jt][1]); pkf[jt][rp] = cvtpk(k2[jt][0], k2[jt][1]);
                    prr[jt][rp] = cvtpk(r2[jt][0], r2[jt][1]); pvv[jt][rp] = cvtpk(v2[jt][0], v2[jt][1]); }
                asm volatile("" ::: "memory");
                if (rp == 3) {
#pragma unroll
                    for (int jt = 0; jt < 2; ++jt)
#pragma unroll
                        for (int q = 0; q < 4; ++q) { stash[((jt * 4 + q) * 4 + 0) * 64] = pkk[jt][q]; stash[((jt * 4 + q) * 4 + 1) * 64] = pkf[jt][q]; stash[((jt * 4 + q) * 4 + 2) * 64] = prr[jt][q]; stash[((jt * 4 + q) * 4 + 3) * 64] = pvv[jt][q]; }
                    asm volatile("" ::: "memory");
                }
            }
#undef ZL_LOAD
            LDS_WAIT();
#pragma unroll
            for (int jt = 0; jt < 2; ++jt)
#pragma unroll
                for (int q = 0; q < 4; ++q) { pkk[jt][q] = stash[((jt * 4 + q) * 4 + 0) * 64]; pkf[jt][q] = stash[((jt * 4 + q) * 4 + 1) * 64]; prr[jt][q] = stash[((jt * 4 + q) * 4 + 2) * 64]; pvv[jt][q] = stash[((jt * 4 + q) * 4 + 3) * 64]; }
#pragma unroll
            for (int jt = 0; jt < 2; ++jt) { if (!dry) { const unsigned lo16 = (unsigned)lane * 16u; *(v4u*)(XAb + (lo16 + (unsigned)((jt * 2) * 1024))) = (v4u){pvv[jt][0], pvv[jt][1], pvv[jt][2], pvv[jt][3]}; *(v4u*)(XAb + (lo16 + (unsigned)((jt * 2 + 1) * 1024))) = (v4u){pvv[jt][4], pvv[jt][5], pvv[jt][6], pvv[jt][7]}; } }
            }
            { f32x16 aW[2] = {zero16, zero16};
              int p_ = p, h_ = h; asm volatile("" : "+v"(p_), "+v"(h_));
              pz_gemm<128, 4, 2>(aW, L + PZ_XW, SW + O_W2T, 64, hh * 64, p_, h_);
#pragma unroll
              for (int jt = 0; jt < 2; ++jt) { const float w0 = rvec[hh * 64 + 32 * jt + p];
#pragma unroll
                  for (int r = 0; r < 16; ++r) lwv[jt][r] = -0.6065306597126334f * sigmoidf_(w0 + aW[jt][r]); } }
            __syncthreads();
            if (!dry) {
            const size_t item_ = (size_t)unit * NH + hh;
            LAS unsigned char* TT = L + wave * 16384; LAS float* gC = (LAS float*)(lds + LDSCTL_OFF + 4096) + wave * 64;
            bf16x8 fAT[2][2], fBT[2][2], fKT[2][2], fRT[2][2], fVT[2][2];
#pragma unroll
            for (int jt = 0; jt < 2; ++jt) {
                float cum[16], tot[4], oth[4];
#pragma unroll
                for (int g = 0; g < 4; ++g) { cum[4 * g] = lwv[jt][4 * g]; cum[4 * g + 1] = cum[4 * g] + lwv[jt][4 * g + 1]; cum[4 * g + 2] = cum[4 * g + 1] + lwv[jt][4 * g + 2]; cum[4 * g + 3] = cum[4 * g + 2] + lwv[jt][4 * g + 3];
                    tot[g] = cum[4 * g + 3]; oth[g] = other_half(tot[g]); }
                float run = 0.f;
#pragma unroll
                for (int g = 0; g < 4; ++g) { const float base = run + (h ? oth[g] : 0.f);
#pragma unroll
                    for (int b4 = 0; b4 < 4; ++b4) cum[4 * g + b4] += base;
                    run += tot[g] + oth[g]; }
                gC[32 * jt + p] = __expf(run);
#pragma unroll
                for (int s2 = 0; s2 < 2; ++s2) {
                    unsigned da[4], db[4], dk[4], dr[4];
#pragma unroll
                    for (int qq = 0; qq < 4; ++qq) { const int q = 4 * s2 + qq;
                        float at2[2], bt2[2], kt2[2], rt2[2];
#pragma unroll
                        for (int rr = 0; rr < 2; ++rr) { const int r = 2 * q + rr; const float cv = cum[r], cx = cv - lwv[jt][r];
                            const float ea = __expf(cx), eb = __expf(-cv), er = __expf(cv);
                            const float kk = rr ? bfhi(pkk[jt][q]) : bflo(pkk[jt][q]), aa = rr ? bfhi(paa[jt][q]) : bflo(paa[jt][q]);
                            const float kf = rr ? bfhi(pkf[jt][q]) : bflo(pkf[jt][q]), rv = rr ? bfhi(prr[jt][q]) : bflo(prr[jt][q]);
                            at2[rr] = -kk * ea; bt2[rr] = kk * aa * eb; kt2[rr] = kf * eb; rt2[rr] = rv * er; }
                        da[qq] = cvtpk(at2[0], at2[1]); db[qq] = cvtpk(bt2[0], bt2[1]); dk[qq] = cvtpk(kt2[0], kt2[1]); dr[qq] = cvtpk(rt2[0], rt2[1]); }
                    fAT[jt][s2] = mkfrag(da[0], da[1], da[2], da[3]); fBT[jt][s2] = mkfrag(db[0], db[1], db[2], db[3]); fKT[jt][s2] = mkfrag(dk[0], dk[1], dk[2], dk[3]); fRT[jt][s2] = mkfrag(dr[0], dr[1], dr[2], dr[3]);
                    fVT[jt][s2] = mkfrag(pvv[jt][4 * s2], pvv[jt][4 * s2 + 1], pvv[jt][4 * s2 + 2], pvv[jt][4 * s2 + 3]);
                }
            }
            const int wbase = h * 512 + p * 2, rbase = p * 128 + h * 16;
#define TM_PUT(TILE, ARR) do { _Pragma("unroll") for (int jt = 0; jt < 2; ++jt) _Pragma("unroll") for (int r = 0; r < 16; ++r) \
                *(LAS bf16*)(TT + wbase + ((TILE) * 4096 + ((r & 3) + 8 * (r >> 2)) * 128 + jt * 64)) = (bf16)ARR[jt][r >> 3][r & 7]; } while (0)
            LDS_WAIT();
            TM_PUT(0, fAT); TM_PUT(1, fBT); TM_PUT(2, fKT); TM_PUT(3, fRT);
            LDS_WAIT();
#undef TM_PUT
            f32x16 Aab = zero16, AabT = zero16, Aak = zero16, Arb = zero16, Ark = zero16;
#pragma unroll
            for (int s4 = 0; s4 < 4; ++s4) {
                const bf16x8 fa = *(const LAS bf16x8*)(TT + rbase + s4 * 32), fb = *(const LAS bf16x8*)(TT + rbase + 4096 + s4 * 32), fk = *(const LAS bf16x8*)(TT + rbase + 8192 + s4 * 32), fr = *(const LAS bf16x8*)(TT + rbase + 12288 + s4 * 32);
                Aab = MFMA32(fb, fa, Aab); AabT = MFMA32(fa, fb, AabT); Aak = MFMA32(fk, fa, Aak); Arb = MFMA32(fb, fr, Arb); Ark = MFMA32(fk, fr, Ark);
            }
#pragma unroll
            for (int r = 0; r < 16; ++r) { const int q = qrow(r, h);
                Aab[r] = (q < p) ? Aab[r] : 0.f;  Aak[r] = (q < p) ? Aak[r] : 0.f; AabT[r] = (p < q) ? AabT[r] : 0.f;
                Arb[r] = (q <= p) ? Arb[r] : 0.f; Ark[r] = (q <= p) ? Ark[r] : 0.f; }
            f32x16 Tm = Aab;
#pragma unroll
            for (int r = 0; r < 16; ++r) Tm[r] += (qrow(r, h) == p) ? 1.f : 0.f;
            bf16x8 X0 = accfrag(Aab, 0), X1 = accfrag(Aab, 1), XT0 = accfrag(AabT, 0), XT1 = accfrag(AabT, 1);
#pragma unroll
            for (int it = 0; it < 4; ++it) {
                f32x16 X2T = MFMA32(X0, XT0, zero16); X2T = MFMA32(X1, XT1, X2T);
                const bf16x8 T0 = accfrag(Tm, 0), T1 = accfrag(Tm, 1);
                const bf16x8 Y0 = accfrag(X2T, 0), Y1 = accfrag(X2T, 1);
                Tm = MFMA32(Y0, T0, Tm); Tm = MFMA32(Y1, T1, Tm);
                if (it < 3) { f32x16 X2 = MFMA32(XT0, X0, zero16); X2 = MFMA32(XT1, X1, X2); X0 = accfrag(X2, 0); X1 = accfrag(X2, 1); XT0 = Y0; XT1 = Y1; }
            }
            const bf16x8 Tf0 = accfrag(Tm, 0), Tf1 = accfrag(Tm, 1);
            const bf16x8 Akf0 = accfrag(Aak, 0), Akf1 = accfrag(Aak, 1), Abf0 = accfrag(Arb, 0), Abf1 = accfrag(Arb, 1), Arf0 = accfrag(Ark, 0), Arf1 = accfrag(Ark, 1);
            bf16x8 fPT[2][2], fQT[2][2];
#pragma unroll
            for (int ct = 0; ct < 2; ++ct) {
                f32x16 a_ = MFMA32(Tf0, fAT[ct][0], zero16); a_ = MFMA32(Tf1, fAT[ct][1], a_); fPT[ct][0] = accfrag(a_, 0); fPT[ct][1] = accfrag(a_, 1);
                f32x16 b_ = MFMA32(Akf0, fVT[ct][0], zero16); b_ = MFMA32(Akf1, fVT[ct][1], b_);
                const bf16x8 av0 = accfrag(b_, 0), av1 = accfrag(b_, 1);
                f32x16 c_ = MFMA32(Tf0, av0, zero16); c_ = MFMA32(Tf1, av1, c_); fQT[ct][0] = accfrag(c_, 0); fQT[ct][1] = accfrag(c_, 1);
            }
            const int ln_ = ((h & 1) << 5) | p;
            bf16* RPo = (bf16*)(ws + WS_SRP) + item_ * 2048; bf16* YLo = (bf16*)(ws + WS_SYL) + item_ * 2048;
            bf16* Mo = (bf16*)(ws + WS_SM) + item_ * 4096; bf16* NTo = (bf16*)(ws + WS_SNT) + item_ * 4096;
#pragma unroll
            for (int ct = 0; ct < 2; ++ct) {
                f32x16 a_;
#pragma unroll
                for (int g = 0; g < 4; ++g) { const v2u w = *(const LAS v2u*)(TT + (p * 128 + 8 * h) + (12288 + (4 * ct + g) * 16));
                    a_[4 * g] = bflo(w.x); a_[4 * g + 1] = bfhi(w.x); a_[4 * g + 2] = bflo(w.y); a_[4 * g + 3] = bfhi(w.y); }
                a_ = MFMA32(fPT[ct][0], Abf0, a_); a_ = MFMA32(fPT[ct][1], Abf1, a_);
#pragma unroll
                for (int s2 = 0; s2 < 2; ++s2) *(bf16x8*)(RPo + (unsigned)(((2 * ct + s2) * 64 + ln_) * 8)) = accfrag(a_, s2);
                f32x16 y_ = MFMA32(Abf0, fQT[ct][0], zero16); y_ = MFMA32(Abf1, fQT[ct][1], y_); y_ = MFMA32(Arf0, fVT[ct][0], y_); y_ = MFMA32(Arf1, fVT[ct][1], y_);
#pragma unroll
                for (int s2 = 0; s2 < 2; ++s2) *(bf16x8*)(YLo + (unsigned)(((2 * ct + s2) * 64 + ln_) * 8)) = accfrag(y_, s2);
            }
            LDS_WAIT();
#pragma unroll
            for (int ctp = 0; ctp < 2; ++ctp) {
                const float gl = gC[32 * ctp + p];
#pragma unroll
                for (int ct = 0; ct < 2; ++ct) {
                    f32x16 m_ = MFMA32(fPT[ct][0], fBT[ctp][0], zero16); m_ = MFMA32(fPT[ct][1], fBT[ctp][1], m_);
#pragma unroll
                    for (int r = 0; r < 16; ++r) m_[r] = (m_[r] + ((ct == ctp && qrow(r, h) == p) ? 1.f : 0.f)) * gl;
#pragma unroll
                    for (int s2 = 0; s2 < 2; ++s2) *(bf16x8*)(Mo + (unsigned)(((4 * ctp + 2 * ct + s2) * 64 + ln_) * 8)) = accfrag(m_, s2);
                    __builtin_amdgcn_sched_barrier(0);
                }
            }
#pragma unroll
            for (int ctd = 0; ctd < 2; ++ctd)
#pragma unroll
                for (int ctp = 0; ctp < 2; ++ctp) {
                    f32x16 n_ = MFMA32(fBT[ctp][0], fQT[ctd][0], zero16); n_ = MFMA32(fBT[ctp][1], fQT[ctd][1], n_); n_ = MFMA32(fKT[ctp][0], fVT[ctd][0], n_); n_ = MFMA32(fKT[ctp][1], fVT[ctd][1], n_);
#pragma unroll
                    for (int g = 0; g < 4; ++g) { const f32x4 gv = *(const LAS f32x4*)(gC + 4 * h + (32 * ctp + 8 * g)); n_[4 * g] *= gv.x; n_[4 * g + 1] *= gv.y; n_[4 * g + 2] *= gv.z; n_[4 * g + 3] *= gv.w; }
#pragma unroll
                    for (int s2 = 0; s2 < 2; ++s2) *(bf16x8*)(NTo + (unsigned)(((4 * ctd + 2 * ctp + s2) * 64 + ln_) * 8)) = accfrag(n_, s2);
                    __builtin_amdgcn_sched_barrier(0);
                }

            }
        }
    }
}

__device__ __forceinline__ void scan_local2_item(unsigned char* ws, int item_i, LAS unsigned char* TT, LAS float* gC, int lane) {
    const size_t item = (size_t)item_i; const int p = lane & 31, h = lane >> 5;
    const f32x16 zero16 = {0.f, 0.f, 0.f, 0.f, 0.f, 0.f, 0.f, 0.f, 0.f, 0.f, 0.f, 0.f, 0.f, 0.f, 0.f, 0.f};
    float lwv[2][16]; unsigned pkk[2][8], paa[2][8], pkf[2][8], prr[2][8], pvv[2][8];
    { const v4u* XA = (const v4u*)(ws + WS_XA) + (item * 20) * 64 + lane; const v4u* XL = (const v4u*)(ws + WS_XL) + (item * 8) * 64 + lane;
#pragma unroll
      for (int jt = 0; jt < 2; ++jt)
#pragma unroll
          for (int hq = 0; hq < 2; ++hq) {
              { const v4u w = XA[(0 * 4 + jt * 2 + hq) * 64]; pkk[jt][4 * hq] = w.x; pkk[jt][4 * hq + 1] = w.y; pkk[jt][4 * hq + 2] = w.z; pkk[jt][4 * hq + 3] = w.w; }
              { const v4u w = XA[(1 * 4 + jt * 2 + hq) * 64]; paa[jt][4 * hq] = w.x; paa[jt][4 * hq + 1] = w.y; paa[jt][4 * hq + 2] = w.z; paa[jt][4 * hq + 3] = w.w; }
              { const v4u w = XA[(2 * 4 + jt * 2 + hq) * 64]; pkf[jt][4 * hq] = w.x; pkf[jt][4 * hq + 1] = w.y; pkf[jt][4 * hq + 2] = w.z; pkf[jt][4 * hq + 3] = w.w; }
              { const v4u w = XA[(3 * 4 + jt * 2 + hq) * 64]; prr[jt][4 * hq] = w.x; prr[jt][4 * hq + 1] = w.y; prr[jt][4 * hq + 2] = w.z; prr[jt][4 * hq + 3] = w.w; }
              { const v4u w = XA[(4 * 4 + jt * 2 + hq) * 64]; pvv[jt][4 * hq] = w.x; pvv[jt][4 * hq + 1] = w.y; pvv[jt][4 * hq + 2] = w.z; pvv[jt][4 * hq + 3] = w.w; } }
#pragma unroll
      for (int jt = 0; jt < 2; ++jt)
#pragma unroll
          for (int g = 0; g < 4; ++g) { const v4u w = XL[(jt * 4 + g) * 64]; lwv[jt][4 * g] = __uint_as_float(w.x); lwv[jt][4 * g + 1] = __uint_as_float(w.y); lwv[jt][4 * g + 2] = __uint_as_float(w.z); lwv[jt][4 * g + 3] = __uint_as_float(w.w); } }
    {
            bf16x8 fAT[2][2], fBT[2][2], fKT[2][2], fRT[2][2], fVT[2][2];
#pragma unroll
            for (int jt = 0; jt < 2; ++jt) {
                float cum[16], tot[4], oth[4];
#pragma unroll
                for (int g = 0; g < 4; ++g) { cum[4 * g] = lwv[jt][4 * g]; cum[4 * g + 1] = cum[4 * g] + lwv[jt][4 * g + 1]; cum[4 * g + 2] = cum[4 * g + 1] + lwv[jt][4 * g + 2]; cum[4 * g + 3] = cum[4 * g + 2] + lwv[jt][4 * g + 3];
                    tot[g] = cum[4 * g + 3]; oth[g] = other_half(tot[g]); }
                float run = 0.f;
#pragma unroll
                for (int g = 0; g < 4; ++g) { const float base = run + (h ? oth[g] : 0.f);
#pragma unroll
                    for (int b4 = 0; b4 < 4; ++b4) cum[4 * g + b4] += base;
                    run += tot[g] + oth[g]; }
                gC[32 * jt + p] = __expf(run);
#pragma unroll
                for (int s2 = 0; s2 < 2; ++s2) {
                    unsigned da[4], db[4], dk[4], dr[4];
#pragma unroll
                    for (int qq = 0; qq < 4; ++qq) { const int q = 4 * s2 + qq;
                        float at2[2], bt2[2], kt2[2], rt2[2];
#pragma unroll
                        for (int rr = 0; rr < 2; ++rr) { const int r = 2 * q + rr; const float cv = cum[r], cx = cv - lwv[jt][r];
                            const float ea = __expf(cx), eb = __expf(-cv), er = __expf(cv);
                            const float kk = rr ? bfhi(pkk[jt][q]) : bflo(pkk[jt][q]), aa = rr ? bfhi(paa[jt][q]) : bflo(paa[jt][q]);
                            const float kf = rr ? bfhi(pkf[jt][q]) : bflo(pkf[jt][q]), rv = rr ? bfhi(prr[jt][q]) : bflo(prr[jt][q]);
                            at2[rr] = -kk * ea; bt2[rr] = kk * aa * eb; kt2[rr] = kf * eb; rt2[rr] = rv * er; }
                        da[qq] = cvtpk(at2[0], at2[1]); db[qq] = cvtpk(bt2[0], bt2[1]); dk[qq] = cvtpk(kt2[0], kt2[1]); dr[qq] = cvtpk(rt2[0], rt2[1]); }
                    fAT[jt][s2] = mkfrag(da[0], da[1], da[2], da[3]); fBT[jt][s2] = mkfrag(db[0], db[1], db[2], db[3]); fKT[jt][s2] = mkfrag(dk[0], dk[1], dk[2], dk[3]); fRT[jt][s2] = mkfrag(dr[0], dr[1], dr[2], dr[3]);
                    fVT[jt][s2] = mkfrag(pvv[jt][4 * s2], pvv[jt][4 * s2 + 1], pvv[jt][4 * s2 + 2], pvv[jt][4 * s2 + 3]);
                }
            }
            const int wbase = h * 512 + p * 2, rbase = p * 128 + h * 16;
#define TM_PUT(TILE, ARR) do { _Pragma("unroll") for (int jt = 0; jt < 2; ++jt) _Pragma("unroll") for (int r = 0; r < 16; ++r) \
                *(LAS bf16*)(TT + wbase + ((TILE) * 4096 + ((r & 3) + 8 * (r >> 2)) * 128 + jt * 64)) = (bf16)ARR[jt][r >> 3][r & 7]; } while (0)
            LDS_WAIT();
            TM_PUT(0, fAT); TM_PUT(1, fBT); TM_PUT(2, fKT); TM_PUT(3, fRT);
            LDS_WAIT();
#undef TM_PUT
            f32x16 Aab = zero16, AabT = zero16, Aak = zero16, Arb = zero16, Ark = zero16;
#pragma unroll
            for (int s4 = 0; s4 < 4; ++s4) {
                const bf16x8 fa = *(const LAS bf16x8*)(TT + rbase + s4 * 32), fb = *(const LAS bf16x8*)(TT + rbase + 4096 + s4 * 32), fk = *(const LAS bf16x8*)(TT + rbase + 8192 + s4 * 32), fr = *(const LAS bf16x8*)(TT + rbase + 12288 + s4 * 32);
                Aab = MFMA32(fb, fa, Aab); AabT = MFMA32(fa, fb, AabT); Aak = MFMA32(fk, fa, Aak); Arb = MFMA32(fb, fr, Arb); Ark = MFMA32(fk, fr, Ark);
            }
#pragma unroll
            for (int r = 0; r < 16; ++r) { const int q = qrow(r, h);
                Aab[r] = (q < p) ? Aab[r] : 0.f;  Aak[r] = (q < p) ? Aak[r] : 0.f; AabT[r] = (p < q) ? AabT[r] : 0.f;
                Arb[r] = (q <= p) ? Arb[r] : 0.f; Ark[r] = (q <= p) ? Ark[r] : 0.f; }
            f32x16 Tm = Aab;
#pragma unroll
            for (int r = 0; r < 16; ++r) Tm[r] += (qrow(r, h) == p) ? 1.f : 0.f;
            bf16x8 X0 = accfrag(Aab, 0), X1 = accfrag(Aab, 1), XT0 = accfrag(AabT, 0), XT1 = accfrag(AabT, 1);
#pragma unroll
            for (int it = 0; it < 4; ++it) {
                f32x16 X2T = MFMA32(X0, XT0, zero16); X2T = MFMA32(X1, XT1, X2T);
                const bf16x8 T0 = accfrag(Tm, 0), T1 = accfrag(Tm, 1);
                const bf16x8 Y0 = accfrag(X2T, 0), Y1 = accfrag(X2T, 1);
                Tm = MFMA32(Y0, T0, Tm); Tm = MFMA32(Y1, T1, Tm);
                if (it < 3) { f32x16 X2 = MFMA32(XT0, X0, zero16); X2 = MFMA32(XT1, X1, X2); X0 = accfrag(X2, 0); X1 = accfrag(X2, 1); XT0 = Y0; XT1 = Y1; }
            }
            const bf16x8 Tf0 = accfrag(Tm, 0), Tf1 = accfrag(Tm, 1);
            const bf16x8 Akf0 = accfrag(Aak, 0), Akf1 = accfrag(Aak, 1), Abf0 = accfrag(Arb, 0), Abf1 = accfrag(Arb, 1), Arf0 = accfrag(Ark, 0), Arf1 = accfrag(Ark, 1);
            bf16x8 fPT[2][2], fQT[2][2];
#pragma unroll
            for (int ct = 0; ct < 2; ++ct) {
                f32x16 a_ = MFMA32(Tf0, fAT[ct][0], zero16); a_ = MFMA32(Tf1, fAT[ct][1], a_); fPT[ct][0] = accfrag(a_, 0); fPT[ct][1] = accfrag(a_, 1);
                f32x16 b_ = MFMA32(Akf0, fVT[ct][0], zero16); b_ = MFMA32(Akf1, fVT[ct][1], b_);
                const bf16x8 av0 = accfrag(b_, 0), av1 = accfrag(b_, 1);
                f32x16 c_ = MFMA32(Tf0, av0, zero16); c_ = MFMA32(Tf1, av1, c_); fQT[ct][0] = accfrag(c_, 0); fQT[ct][1] = accfrag(c_, 1);
            }
            bf16* RPo = (bf16*)(ws + WS_SRP) + item * 2048; bf16* YLo = (bf16*)(ws + WS_SYL) + item * 2048;
            bf16* Mo = (bf16*)(ws + WS_SM) + item * 4096; bf16* NTo = (bf16*)(ws + WS_SNT) + item * 4096;
#pragma unroll
            for (int ct = 0; ct < 2; ++ct) {
                f32x16 a_;
#pragma unroll
                for (int g = 0; g < 4; ++g) { const v2u w = *(const LAS v2u*)(TT + (p * 128 + 8 * h) + (12288 + (4 * ct + g) * 16));
                    a_[4 * g] = bflo(w.x); a_[4 * g + 1] = bfhi(w.x); a_[4 * g + 2] = bflo(w.y); a_[4 * g + 3] = bfhi(w.y); }
                a_ = MFMA32(fPT[ct][0], Abf0, a_); a_ = MFMA32(fPT[ct][1], Abf1, a_);
#pragma unroll
                for (int s2 = 0; s2 < 2; ++s2) *(bf16x8*)(RPo + (unsigned)(p * 64 + (4 * ct + 2 * s2 + h) * 8)) = accfrag(a_, s2);
                f32x16 y_ = MFMA32(Abf0, fQT[ct][0], zero16); y_ = MFMA32(Abf1, fQT[ct][1], y_); y_ = MFMA32(Arf0, fVT[ct][0], y_); y_ = MFMA32(Arf1, fVT[ct][1], y_);
#pragma unroll
                for (int s2 = 0; s2 < 2; ++s2) *(bf16x8*)(YLo + (unsigned)((32 * ct + p) * 32 + (2 * s2 + h) * 8)) = accfrag(y_, s2);
            }
            LDS_WAIT();
#pragma unroll
            for (int ctp = 0; ctp < 2; ++ctp) {
                const float gl = gC[32 * ctp + p];
#pragma unroll
                for (int ct = 0; ct < 2; ++ct) {
                    f32x16 m_ = MFMA32(fPT[ct][0], fBT[ctp][0], zero16); m_ = MFMA32(fPT[ct][1], fBT[ctp][1], m_);
#pragma unroll
                    for (int r = 0; r < 16; ++r) m_[r] = (m_[r] + ((ct == ctp && qrow(r, h) == p) ? 1.f : 0.f)) * gl;
#pragma unroll
                    for (int s2 = 0; s2 < 2; ++s2) *(bf16x8*)(Mo + (unsigned)((32 * ctp + p) * 64 + (4 * ct + 2 * s2 + h) * 8)) = accfrag(m_, s2);
                    __builtin_amdgcn_sched_barrier(0);
                }
            }
#pragma unroll
            for (int ctd = 0; ctd < 2; ++ctd)
#pragma unroll
                for (int ctp = 0; ctp < 2; ++ctp) {
                    f32x16 n_ = MFMA32(fBT[ctp][0], fQT[ctd][0], zero16); n_ = MFMA32(fBT[ctp][1], fQT[ctd][1], n_); n_ = MFMA32(fKT[ctp][0], fVT[ctd][0], n_); n_ = MFMA32(fKT[ctp][1], fVT[ctd][1], n_);
#pragma unroll
                    for (int g = 0; g < 4; ++g) { const f32x4 gv = *(const LAS f32x4*)(gC + 4 * h + (32 * ctp + 8 * g)); n_[4 * g] *= gv.x; n_[4 * g + 1] *= gv.y; n_[4 * g + 2] *= gv.z; n_[4 * g + 3] *= gv.w; }
#pragma unroll
                    for (int s2 = 0; s2 < 2; ++s2) *(bf16x8*)(NTo + (unsigned)((32 * ctd + p) * 64 + (4 * ctp + 2 * s2 + h) * 8)) = accfrag(n_, s2);
                    __builtin_amdgcn_sched_barrier(0);
                }
    }
}
__device__ __forceinline__ void ph_scan_local2(unsigned char* ws, LAS unsigned char* lds, int gw, int NGW, int wave, int lane_in) {
    LAS unsigned char* TT = lds + RING_OFF + wave * 16384;
    LAS float* gC = (LAS float*)(lds + LDSCTL_OFF + 4096) + wave * 64;
    for (int item = gw; item < BATCH * NCHK * NH; item += NGW) { int lane = lane_in; asm volatile("" : "+v"(lane)); scan_local2_item(ws, item, TT, gC, lane); }
}
#ifndef DRY_REP
#define DRY_REP 0
#endif
#ifndef CARRY_ONLY_REP
#define CARRY_ONLY_REP 0
#endif
#ifndef ATTN_ONLY_REP
#define ATTN_ONLY_REP 0
#endif


__device__ __forceinline__ double rope_inv_freq(int i) {
    const double q = (i & 3) == 0 ? 1.0 : (i & 3) == 1 ? 0.5623413251903491 : (i & 3) == 2 ? 0.31622776601683794 : 0.1778279410038923;
    const double p = (i >> 2) == 0 ? 1.0 : (i >> 2) == 1 ? 0.1 : (i >> 2) == 2 ? 0.01 : 0.001;
    return q * p;
}
__device__ __forceinline__ void ph_mod_rope(const Args& a, unsigned char* ws, LAS unsigned char* lds, int gw, int NGW, int tid, int lane, int gtid, int GT) {
    const float* c = a.in[I_C]; const float* wada = a.in[I_WADA]; const float* bada = a.in[I_BADA];
    float* mod = (float*)(ws + WS_MOD);
    LAS float* cs = (LAS float*)(lds + RING_OFF);
    for (int i = tid; i < 8 * 1024; i += NWAVES * 64) { const float cv = c[i]; cs[i] = cv * sigmoidf_(cv); }
    __syncthreads();
    LAS float* red = cs + 8 * 1024;
    const int wave = tid >> 6;
    for (int it = blockIdx.x; it < 2 * 96; it += gridDim.x) {
        const int l = it / 96, jb = it % 96, kc = wave; const int j0 = jb * 64 + lane;
        float acc[8];
#pragma unroll
        for (int b = 0; b < 8; ++b) acc[b] = 0.f;
        const float* wp = wada + ((size_t)l * 1024 + kc * 128) * 6144 + j0;
#pragma unroll 16
        for (int k = 0; k < 128; ++k) { const float w = wp[(size_t)k * 6144];
#pragma unroll
            for (int b = 0; b < 8; ++b) acc[b] += w * cs[b * 1024 + kc * 128 + k]; }
        __syncthreads();
#pragma unroll
        for (int b = 0; b < 8; ++b) red[(wave * 8 + b) * 64 + lane] = acc[b];
        __syncthreads();
        { const int b = tid >> 6, j = tid & 63; float s = bada[l * 6144 + jb * 64 + j];
#pragma unroll
          for (int w = 0; w < 8; ++w) s += red[(w * 8 + b) * 64 + j];
          mod[(size_t)(l * 8 + b) * 6144 + jb * 64 + j] = s; }
    }
    const int* pos = (const int*)a.in[I_POS];
    float* ct = (float*)(ws + WS_COS); float* st = (float*)(ws + WS_SIN);
    for (int it = gtid; it < M * 16; it += GT) {
        const int t = it >> 4, i = it & 15;
        const double inv = rope_inv_freq(i);
        double rev = (double)pos[t] * inv * 0.15915494309189535;
        rev -= floor(rev);
        const float rf = (float)rev;
        ct[it] = __builtin_amdgcn_cosf(rf); st[it] = __builtin_amdgcn_sinf(rf);
    }
}

__device__ __forceinline__ void cvt_item(const float* W, int Nsrc, int K, bf16* WT, int dst_row0, int src_col0, int k0, LAS float* scr, int lane) {
    if (src_col0 >= 0) {
        const int lr = lane >> 3, lc = (lane & 7) * 4; f32x4 v[8];
        const float* src = W + (size_t)(k0 + lr) * Nsrc + src_col0 + lc;
#pragma unroll
        for (int i = 0; i < 8; ++i) v[i] = *(const f32x4*)(src + (size_t)(8 * i) * Nsrc);
#pragma unroll
        for (int i = 0; i < 8; ++i) { LAS float* dd = scr + (8 * i + lr) * 33 + lc; dd[0] = v[i].x; dd[1] = v[i].y; dd[2] = v[i].z; dd[3] = v[i].w; }
    } else {
#pragma unroll 8
        for (int i = 0; i < 32; ++i) { const int kk = 2 * i + (lane >> 5); scr[kk * 33 + (lane & 31)] = 0.f; }
    }
    LDS_WAIT();
    const int c = lane & 7;
#pragma unroll
    for (int j = 0; j < 4; ++j) { const int n = (lane >> 3) + 8 * j; const LAS float* s = scr + (8 * c) * 33 + n;
        v4u o; o.x = pk2(s[0 * 33], s[1 * 33]); o.y = pk2(s[2 * 33], s[3 * 33]); o.z = pk2(s[4 * 33], s[5 * 33]); o.w = pk2(s[6 * 33], s[7 * 33]);
        *(v4u*)(WT + (size_t)(dst_row0 + n) * K + k0 + 8 * c) = o; }
    LDS_WAIT();
}
__device__ __forceinline__ int swiglu_src_col(int nrow, int F) { const int pn = nrow >> 8, within = nrow & 255; return (within >> 7) * F + pn * 128 + (within & 127); }

__device__ __forceinline__ void cvt_item_f8(const float* W, int Nsrc, int K, unsigned char* WT, int dst_row0, int src_col0, int k0, LAS float* scr, int lane) {
    { const int lr = lane >> 3, lc = (lane & 7) * 4; f32x4 v[8];
      const float* src = W + (size_t)(k0 + lr) * Nsrc + src_col0 + lc;
#pragma unroll
      for (int i = 0; i < 8; ++i) v[i] = *(const f32x4*)(src + (size_t)(8 * i) * Nsrc);
#pragma unroll
      for (int i = 0; i < 8; ++i) { LAS float* dd = scr + (8 * i + lr) * 33 + lc; dd[0] = v[i].x * F8_WSCALE; dd[1] = v[i].y * F8_WSCALE; dd[2] = v[i].z * F8_WSCALE; dd[3] = v[i].w * F8_WSCALE; } }
    LDS_WAIT();
    const int c = lane & 3;
#pragma unroll
    for (int j = 0; j < 2; ++j) { const int n = (lane >> 2) + 16 * j; const LAS float* s = scr + (16 * c) * 33 + n;
        v4u o; o.x = f8pk4(s[0 * 33], s[1 * 33], s[2 * 33], s[3 * 33]); o.y = f8pk4(s[4 * 33], s[5 * 33], s[6 * 33], s[7 * 33]);
        o.z = f8pk4(s[8 * 33], s[9 * 33], s[10 * 33], s[11 * 33]); o.w = f8pk4(s[12 * 33], s[13 * 33], s[14 * 33], s[15 * 33]);
        *(v4u*)(WT + (size_t)(dst_row0 + n) * K + k0 + 16 * c) = o; }
    LDS_WAIT();
}
__device__ __forceinline__ void cvt_f8_load(f32x4 (&v)[8], const float* W, int Nsrc, int src_col0, int k0, int lane) {
    const int lr = lane >> 3, lc = (lane & 7) * 4; const float* src = W + (size_t)(k0 + lr) * Nsrc + src_col0 + lc;
#pragma unroll
    for (int i = 0; i < 8; ++i) v[i] = *(const f32x4*)(src + (size_t)(8 * i) * Nsrc);
}
__device__ __forceinline__ void cvt_f8_finish(const f32x4 (&v)[8], int K, unsigned char* WT, int dst_row0, int k0, LAS float* scr, int lane) {
    { const int lr = lane >> 3, lc = (lane & 7) * 4;
#pragma unroll
      for (int i = 0; i < 8; ++i) { LAS float* dd = scr + (8 * i + lr) * 33 + lc; dd[0] = v[i].x * F8_WSCALE; dd[1] = v[i].y * F8_WSCALE; dd[2] = v[i].z * F8_WSCALE; dd[3] = v[i].w * F8_WSCALE; } }
    LDS_WAIT();
    const int c = lane & 3;
#pragma unroll
    for (int j = 0; j < 2; ++j) { const int n = (lane >> 2) + 16 * j; const LAS float* s = scr + (16 * c) * 33 + n;
        v4u o; o.x = f8pk4(s[0 * 33], s[1 * 33], s[2 * 33], s[3 * 33]); o.y = f8pk4(s[4 * 33], s[5 * 33], s[6 * 33], s[7 * 33]);
        o.z = f8pk4(s[8 * 33], s[9 * 33], s[10 * 33], s[11 * 33]); o.w = f8pk4(s[12 * 33], s[13 * 33], s[14 * 33], s[15 * 33]);
        *(v4u*)(WT + (size_t)(dst_row0 + n) * K + k0 + 16 * c) = o; }
    LDS_WAIT();
}
__device__ __forceinline__ void ph_convert(const Args& a, unsigned char* ws, LAS unsigned char* lds, int gw, int NGW, int wave, int lane, int part) {
    LAS float* scr = (LAS float*)(lds + RING_OFF + wave * 16384);
    constexpr int I_WIN = 80 * 16;
    constexpr int I_WO = 32 * 16;
    constexpr int I_FI = 176 * 16;
    constexpr int I_FO = 32 * 44;
    constexpr int I_MI = 224 * 16;
    constexpr int I_MO = 32 * 56;
    constexpr int NITEMS = 2 * I_WIN + 2 * I_WO + I_FI + I_FO + 8 * I_MI + 8 * I_MO;
    constexpr int NDENSE = 2 * I_WIN + 2 * I_WO + I_FI + I_FO, HALFMOE = (NITEMS - NDENSE) / 2;
    static_assert((NITEMS - NDENSE) % 2 == 0, "MoE items");
    constexpr int NMIX = 2 * I_WIN + 2 * I_WO;
    const int lo = part == 0 ? 0 : NDENSE + (part - 1) * HALFMOE, hi = part == 0 ? NMIX : lo + HALFMOE;
    if (part == 1) {
        for (int it = NMIX + gw; it < NDENSE; it += NGW) { int r = it - NMIX;
            if (r < I_FI) { const int nb = r / 16, kb = r % 16;
                cvt_item(a.in[I_FFI], 2 * DFF, 1024, (bf16*)(ws + WS_WFFI), nb * 32, swiglu_src_col(nb * 32, DFF), kb * 64, scr, lane); continue; }
            r -= I_FI;
            { const int nb = r / 44, kb = r % 44;
              cvt_item(a.in[I_FFO], 1024, DFF, (bf16*)(ws + WS_WFFO), nb * 32, nb * 32, kb * 64, scr, lane); } }
    }
    if (part != 0) {
        const float* Wc; int Nc, Kc, drc, scc, k0c; unsigned char* WTc;
#define MOE_DECODE(it_, W_, N_, K_, WT_, dr_, sc_, k0_) do { int r_ = (it_) - NDENSE; \
            if (r_ < 8 * I_MI) { const int e_ = r_ / I_MI; r_ %= I_MI; const int nb_ = r_ / 16, kb_ = r_ % 16; W_ = a.in[I_MOEI] + (size_t)e_ * 1024 * 2 * DFFE; N_ = 2 * DFFE; K_ = 1024; \
                WT_ = ws + WS_WMI + (size_t)e_ * 2 * DFFE * 1024; dr_ = nb_ * 32; sc_ = swiglu_src_col(nb_ * 32, DFFE); k0_ = kb_ * 64; } \
            else { r_ -= 8 * I_MI; const int e_ = r_ / I_MO; r_ %= I_MO; const int nb_ = r_ / 56, kb_ = r_ % 56; W_ = a.in[I_MOEO] + (size_t)e_ * DFFE * 1024; N_ = 1024; K_ = DFFE; \
                WT_ = ws + WS_WMO + (size_t)e_ * 1024 * DFFE; dr_ = nb_ * 32; sc_ = nb_ * 32; k0_ = kb_ * 64; } } while (0)
        int it = lo + gw; if (it >= hi) return;
        f32x4 va[8], vb[8];
        MOE_DECODE(it, Wc, Nc, Kc, WTc, drc, scc, k0c); cvt_f8_load(va, Wc, Nc, scc, k0c, lane);
        for (;;) {
            const int itn = it + NGW; const bool more = itn < hi;
            const float* Wn = Wc; int Nn = Nc, Kn = Kc, drn = drc, scn = scc, k0n = k0c; unsigned char* WTn = WTc;
            if (more) { MOE_DECODE(itn, Wn, Nn, Kn, WTn, drn, scn, k0n); cvt_f8_load(vb, Wn, Nn, scn, k0n, lane); }
            cvt_f8_finish(va, Kc, WTc, drc, k0c, scr, lane);
            if (!more) break;
#pragma unroll
            for (int i = 0; i < 8; ++i) va[i] = vb[i];
            Wc = Wn; Nc = Nn; Kc = Kn; WTc = WTn; drc = drn; scc = scn; k0c = k0n; it = itn;
        }
#undef MOE_DECODE
        return;
    }
    for (int it = lo + gw; it < hi; it += NGW) {
        int r = it;
        if (r < 2 * I_WIN) { const int l = r / I_WIN; r %= I_WIN; const int nb = r / 16, kb = r % 16;
            const int nvalid = l == 0 ? N_IN0 / 32 : N_IN1 / 32;
            cvt_item(a.in[l == 0 ? I_WIN0 : I_WIN1], l == 0 ? N_IN0 : N_IN1, 1024, (bf16*)(ws + WS_WIN) + (size_t)l * NZ * 1024, nb * 32, nb < nvalid ? nb * 32 : -1, kb * 64, scr, lane); continue; }
        r -= 2 * I_WIN;
        if (r < 2 * I_WO) { const int l = r / I_WO; r %= I_WO; const int nb = r / 16, kb = r % 16;
            cvt_item(a.in[I_WOUT] + (size_t)l * 1024 * 1024, 1024, 1024, (bf16*)(ws + WS_WOUT) + (size_t)l * 1024 * 1024, nb * 32, nb * 32, kb * 64, scr, lane); continue; }
        r -= 2 * I_WO;
        if (r < I_FI) { const int nb = r / 16, kb = r % 16;
            cvt_item(a.in[I_FFI], 2 * DFF, 1024, (bf16*)(ws + WS_WFFI), nb * 32, swiglu_src_col(nb * 32, DFF), kb * 64, scr, lane); continue; }
        r -= I_FI;
        if (r < I_FO) { const int nb = r / 44, kb = r % 44;
            cvt_item(a.in[I_FFO], 1024, DFF, (bf16*)(ws + WS_WFFO), nb * 32, nb * 32, kb * 64, scr, lane); continue; }
        r -= I_FO;
        if (r < 8 * I_MI) { const int e = r / I_MI; r %= I_MI; const int nb = r / 16, kb = r % 16;
            cvt_item_f8(a.in[I_MOEI] + (size_t)e * 1024 * 2 * DFFE, 2 * DFFE, 1024, ws + WS_WMI + (size_t)e * 2 * DFFE * 1024, nb * 32, swiglu_src_col(nb * 32, DFFE), kb * 64, scr, lane); continue; }
        r -= 8 * I_MI;
        { const int e = r / I_MO; r %= I_MO; const int nb = r / 56, kb = r % 56;
            cvt_item_f8(a.in[I_MOEO] + (size_t)e * DFFE * 1024, 1024, DFFE, ws + WS_WMO + (size_t)e * 1024 * DFFE, nb * 32, nb * 32, kb * 64, scr, lane); }
    }
}

template <bool XB16> __device__ __forceinline__ f32x4 ld_x4(const void* x, size_t row, int idx) {
    if constexpr (XB16) { const v2u r = ((const v2u*)((const bf16*)x + row * D))[idx]; return (f32x4){bflo(r.x), bfhi(r.x), bflo(r.y), bfhi(r.y)}; }
    else return ((const f32x4*)((const float*)x + row * D))[idx];
}
template <bool ROUTE, bool F8OUT = false, bool XB16 = false>
__device__ __forceinline__ void ph_norm(const void* x, const float* gain, const float* mod_shift  , bf16* h,
                                        const float* router, unsigned char* ws, int gw, int NGW, int lane, LAS unsigned char* lds = nullptr) {
    if constexpr (!ROUTE) {
        for (int m0 = gw; m0 < M; m0 += 2 * NGW) {
            const int m1 = m0 + NGW < M ? m0 + NGW : m0;
            f32x4 v0[4], v1[4]; float s0 = 0.f, s1 = 0.f;
#pragma unroll
            for (int j = 0; j < 4; ++j) { v0[j] = ld_x4<XB16>(x, (size_t)m0, lane + 64 * j); v1[j] = ld_x4<XB16>(x, (size_t)m1, lane + 64 * j); }
#pragma unroll
            for (int j = 0; j < 4; ++j) { s0 += (v0[j].x * v0[j].x + v0[j].y * v0[j].y) + (v0[j].z * v0[j].z + v0[j].w * v0[j].w); s1 += (v1[j].x * v1[j].x + v1[j].y * v1[j].y) + (v1[j].z * v1[j].z + v1[j].w * v1[j].w); }
            const int b0 = m0 / T, b1 = m1 / T;
            const f32x4* gp = (const f32x4*)gain + lane;
            const f32x4* sh0 = (const f32x4*)(mod_shift + (size_t)b0 * 6144) + lane; const f32x4* sc0 = (const f32x4*)(mod_shift + (size_t)b0 * 6144 + 1024) + lane;
            const f32x4* sh1 = (const f32x4*)(mod_shift + (size_t)b1 * 6144) + lane; const f32x4* sc1 = (const f32x4*)(mod_shift + (size_t)b1 * 6144 + 1024) + lane;
            f32x4 gq[4], h0[4], c0[4], h1[4], c1[4];
#pragma unroll
            for (int j = 0; j < 4; ++j) { gq[j] = gp[64 * j]; h0[j] = sh0[64 * j]; c0[j] = sc0[64 * j]; h1[j] = sh1[64 * j]; c1[j] = sc1[64 * j]; }
            const float rs0 = 1.f / sqrtf(wave_sum(s0) * (1.f / D) + 1e-6f), rs1 = 1.f / sqrtf(wave_sum(s1) * (1.f / D) + 1e-6f);
            unsigned long long* o0 = (unsigned long long*)(h + (size_t)m0 * D) + lane; unsigned long long* o1 = (unsigned long long*)(h + (size_t)m1 * D) + lane;
#pragma unroll
            for (int j = 0; j < 4; ++j) { const f32x4 g = gq[j];
                const f32x4 a0 = (v0[j] * rs0) * g * (c0[j] + 1.f) + h0[j], a1 = (v1[j] * rs1) * g * (c1[j] + 1.f) + h1[j];
                if constexpr (F8OUT) { ((unsigned*)((unsigned char*)h + (size_t)m0 * D))[lane + 64 * j] = f8pk4(a0.x * F8_HSCALE, a0.y * F8_HSCALE, a0.z * F8_HSCALE, a0.w * F8_HSCALE);
                                       ((unsigned*)((unsigned char*)h + (size_t)m1 * D))[lane + 64 * j] = f8pk4(a1.x * F8_HSCALE, a1.y * F8_HSCALE, a1.z * F8_HSCALE, a1.w * F8_HSCALE); }
                else {
                o0[64 * j] = (unsigned long long)pk2(a0.x, a0.y) | ((unsigned long long)pk2(a0.z, a0.w) << 32);
                o1[64 * j] = (unsigned long long)pk2(a1.x, a1.y) | ((unsigned long long)pk2(a1.z, a1.w) << 32); } }
        }
        return;
    }
    int se0 = 0, se1 = 0, sm = 0, nb = 0; float sg0 = 0.f, sg1 = 0.f;
    LAS float* rt = (LAS float*)(lds + RING_OFF);
    for (int i = tidx_(); i < 1024 * 8 / 4; i += NWAVES * 64) ((LAS f32x4*)rt)[i] = ((const f32x4*)router)[i];
    __syncthreads();
    for (int m = gw; m < M; m += NGW) {
        const int b = m / T;
        const f32x4* gp = (const f32x4*)gain + lane; const f32x4* shp = (const f32x4*)(mod_shift + (size_t)b * 6144) + lane; const f32x4* scp = (const f32x4*)(mod_shift + (size_t)b * 6144 + 1024) + lane;
        f32x4 v[4], gq[4], hq_[4], cq[4]; float s = 0.f;
#pragma unroll
        for (int j = 0; j < 4; ++j) { v[j] = ld_x4<XB16>(x, (size_t)m, lane + 64 * j); gq[j] = gp[64 * j]; hq_[j] = shp[64 * j]; cq[j] = scp[64 * j]; }
#pragma unroll
        for (int j = 0; j < 4; ++j) s += (v[j].x * v[j].x + v[j].y * v[j].y) + (v[j].z * v[j].z + v[j].w * v[j].w);
        const float rs = 1.f / sqrtf(wave_sum(s) * (1.f / D) + 1e-6f);
        unsigned long long* o8 = (unsigned long long*)(h + (size_t)m * D) + lane;
#pragma unroll
        for (int j = 0; j < 4; ++j) { const f32x4 g = gq[j], sh = hq_[j], sc = cq[j];
            v[j] = (v[j] * rs) * g * (sc + 1.f) + sh;
            if constexpr (F8OUT) ((unsigned*)((unsigned char*)h + (size_t)m * D))[lane + 64 * j] = f8pk4(v[j].x * F8_HSCALE, v[j].y * F8_HSCALE, v[j].z * F8_HSCALE, v[j].w * F8_HSCALE);
            else o8[64 * j] = (unsigned long long)pk2(v[j].x, v[j].y) | ((unsigned long long)pk2(v[j].z, v[j].w) << 32); }
        if constexpr (ROUTE) {
            float lg[8];
#pragma unroll
            for (int e = 0; e < 8; ++e) lg[e] = 0.f;
#pragma unroll
            for (int j = 0; j < 4; ++j)
#pragma unroll
                for (int q = 0; q < 4; ++q) { const int d = 256 * j + 4 * lane + q; const f32x4 r0 = *(const LAS f32x4*)(rt + d * 8), r1 = *(const LAS f32x4*)(rt + d * 8 + 4); const float hv = v[j][q];
                    lg[0] += hv * r0.x; lg[1] += hv * r0.y; lg[2] += hv * r0.z; lg[3] += hv * r0.w; lg[4] += hv * r1.x; lg[5] += hv * r1.y; lg[6] += hv * r1.z; lg[7] += hv * r1.w; }
#pragma unroll
            for (int e = 0; e < 8; ++e) lg[e] = wave_sum(lg[e]);
            int i0 = 0; float v0 = lg[0];
#pragma unroll
            for (int e = 1; e < 8; ++e) if (lg[e] > v0) { v0 = lg[e]; i0 = e; }
            int i1 = -1; float v1 = -3.0e38f;
#pragma unroll
            for (int e = 0; e < 8; ++e) if (e != i0 && lg[e] > v1) { v1 = lg[e]; i1 = e; }
            const float e1 = __expf(v1 - v0), g0 = 1.f / (1.f + e1), g1 = e1 / (1.f + e1);
            if (lane == nb) { se0 = i0; se1 = i1; sg0 = g0; sg1 = g1; sm = m; }
            ++nb;
        }
        if constexpr (ROUTE) {
            if (nb == 16 || m + NGW >= M) {
                const bool act = lane < nb; const unsigned long long lt = (1ull << lane) - 1ull;
                unsigned long long m0[8], m1[8]; unsigned myc = 0;
#pragma unroll
                for (int e = 0; e < 8; ++e) { m0[e] = __ballot(act && se0 == e); m1[e] = __ballot(act && se1 == e); const unsigned ce = (unsigned)(__popcll(m0[e]) + __popcll(m1[e])); myc = (lane == e) ? ce : myc; }
                unsigned base = 0;
                if (lane < 8) base = __hip_atomic_fetch_add((unsigned*)ws + CW_MOE + 64 * lane, myc, RLX_AGENT);
                int p0 = 0, p1 = 0;
#pragma unroll
                for (int e = 0; e < 8; ++e) { const unsigned be = (unsigned)__shfl((int)base, e);
                    if (se0 == e) p0 = (int)(be + (unsigned)__popcll(m0[e] & lt));
                    if (se1 == e) p1 = (int)(be + (unsigned)__popcll(m0[e]) + (unsigned)__popcll(m1[e] & lt)); }
                if (act) { ((int*)(ws + WS_TOK))[se0 * MOE_CAP + p0] = sm; ((float*)(ws + WS_GATE))[se0 * MOE_CAP + p0] = sg0; ((int*)(ws + WS_ASG))[sm * 2] = se0 * MOE_CAP + p0;
                           ((int*)(ws + WS_TOK))[se1 * MOE_CAP + p1] = sm; ((float*)(ws + WS_GATE))[se1 * MOE_CAP + p1] = sg1; ((int*)(ws + WS_ASG))[sm * 2 + 1] = se1 * MOE_CAP + p1; }
                nb = 0;
            }
        }
    }
}

__device__ __forceinline__ void ph_postz(const Args& a, unsigned char* ws, LAS unsigned char* lds, int l, int gw, int NGW, int wave, int lane) {
    LAS float* S = (LAS float*)(lds + RING_OFF + wave * 16384);
    LAS float* xw = S, *xa = S + 64, *xg = S + 128, *xv = S + 288, *pp = S + 320, *qn = S + 576, *kvn = S + 832, *qb = S + 960, *kvb = S + 1344, *kpe = S + 1856, *qpe = S + 1888;
    const bf16* z = (const bf16*)(ws + WS_Z);
    const float* mu = a.in[I_MU] + l * SHIFT_COLS; const float* muv = a.in[I_MUV];
    const float* rvec = a.in[I_RVEC] + l * 7 * RW; const float* w2 = a.in[I_RW2] + (size_t)l * 64 * RW; const float* a2 = a.in[I_RA2] + (size_t)l * 64 * RW;
    const float* g2 = a.in[I_RG2] + (size_t)l * 160 * RW; const float* v2 = a.in[I_RV2]; const float* v0p = a.in[I_RV0];
    bf16* Rr = (bf16*)(ws + WS_R); bf16* Kr = (bf16*)(ws + WS_K); bf16* Vr = (bf16*)(ws + WS_V); bf16* KKr = (bf16*)(ws + WS_KK); bf16* Ar = (bf16*)(ws + WS_A);
    float* LWr = (float*)(ws + WS_LW); bf16* Gr = (bf16*)(ws + WS_G); bf16* VF = (bf16*)(ws + WS_VF); bf16* mix = (bf16*)(ws + WS_MIX);
    bf16* QM = (bf16*)(ws + WS_QM); bf16* KM = (bf16*)(ws + WS_KM); bf16* VM = (bf16*)(ws + WS_VM);
    const float* poolw = a.in[I_POOLW] + (size_t)l * 4 * 64 * 64; const float* pools = a.in[I_POOLS] + l * 256;
    const float* qlg = a.in[I_QLG] + l * 256; const float* kvlg = a.in[I_KVLG] + l * 128; const float* wqup = a.in[I_WQUP] + (size_t)l * 256 * 384; const float* wkvup = a.in[I_WKVUP] + (size_t)l * 128 * 512;
    const float* qkg = a.in[I_QKG] + l * 2 * 96; const float* ct = (const float*)(ws + WS_COS); const float* st = (const float*)(ws + WS_SIN);
    for (int m = gw; m < M; m += NGW) {
        const int tt = m % T; const bool hp = tt > 0;
        const bf16* zr = z + (size_t)m * NZ; const bf16* zp = zr - NZ;
#define ZS(col) ({ const int c_ = (col); const float zc_ = bf2f(zr[c_]); const float zq_ = hp ? bf2f(zp[c_]) : 0.f; zc_ + mu[c_] * (zq_ - zc_); })
        LDS_WAIT();
        xw[lane] = tanhf_(ZS(OFF_WD + lane)); xa[lane] = ZS(OFF_AD + lane);
        xg[lane] = sigmoidf_(ZS(OFF_GD + lane)); xg[lane + 64] = sigmoidf_(ZS(OFF_GD + 64 + lane)); if (lane < 32) xg[lane + 128] = sigmoidf_(ZS(OFF_GD + 128 + lane));
        if (l > 0 && lane < 32) { const float zc = bf2f(zr[OFF_VD + lane]); const float zq = hp ? bf2f(zp[OFF_VD + lane]) : 0.f; xv[lane] = zc + muv[lane] * (zq - zc); }
#pragma unroll
        for (int gi = 0; gi < 4; ++gi) { const int win = 2 << gi; const int cnt = (tt + 1) < win ? (tt + 1) : win; const int col = OFF_POOL + gi * 64 + lane;
            float s = 0.f; for (int q = 0; q < cnt; ++q) s += bf2f(zr[col - q * NZ]);
            pp[gi * 64 + lane] = s / (float)cnt - bf2f(zr[col]); }
        { float q4[4]; float s = 0.f;
#pragma unroll
          for (int j = 0; j < 4; ++j) { q4[j] = bf2f(zr[OFF_QLAT + lane + 64 * j]); s += q4[j] * q4[j]; }
          const float rs = 1.f / sqrtf(wave_sum(s) * (1.f / 256.f) + 1e-6f);
#pragma unroll
          for (int j = 0; j < 4; ++j) qn[lane + 64 * j] = q4[j] * rs * qlg[lane + 64 * j];
          float k2[2]; s = 0.f;
#pragma unroll
          for (int j = 0; j < 2; ++j) { k2[j] = bf2f(zr[OFF_KVLAT + lane + 64 * j]); s += k2[j] * k2[j]; }
          const float rk = 1.f / sqrtf(wave_sum(s) * (1.f / 128.f) + 1e-6f);
#pragma unroll
          for (int j = 0; j < 2; ++j) kvn[lane + 64 * j] = k2[j] * rk * kvlg[lane + 64 * j];
          if (lane < 16) { const float x1 = bf2f(zr[OFF_KROPE + lane]), x2 = bf2f(zr[OFF_KROPE + 16 + lane]); const float cs = ct[m * 16 + lane], sn = st[m * 16 + lane];
              kpe[lane] = x1 * cs - x2 * sn; kpe[lane + 16] = x1 * sn + x2 * cs; } }
        LDS_WAIT();
#pragma nounroll
        for (int hh = 0; hh < NH; ++hh) {
            const int c = hh * 64 + lane;
            const float r = ZS(c), k0 = ZS(512 + c), v0 = ZS(1024 + c);
            float wlo = 0.f, alo = 0.f, gg = 0.f;
#pragma unroll 4
            for (int i = 0; i < 64; ++i) { wlo += xw[i] * w2[i * RW + c]; alo += xa[i] * a2[i * RW + c]; }
#pragma unroll 4
            for (int i = 0; i < 160; ++i) gg += xg[i] * g2[i * RW + c];
            float v = v0;
            if (l == 0) { VF[(size_t)m * RW + c] = (bf16)f2bf(v0); }
            else { float vlo = 0.f;
#pragma unroll 4
                for (int i = 0; i < 32; ++i) vlo += xv[i] * v2[i * RW + c]; const float vf = bf2f(VF[(size_t)m * RW + c]); v = v0 + (vf - v0) * sigmoidf_(v0p[c] + vlo); }
            const float lw = -0.6065306597126334f * sigmoidf_(rvec[0 * RW + c] + wlo);
            const float aa = sigmoidf_(rvec[1 * RW + c] + alo);
            const float kkr = k0 * rvec[2 * RW + c];
            const float nrm = sqrtf(wave_sum(kkr * kkr));
            const float kk = kkr / fmaxf(nrm, 1e-12f);
            const float k = k0 * (1.f + (aa - 1.f) * rvec[3 * RW + c]);
            { const float bsum = wave_sum(bf2f((bf16)f2bf(r)) * bf2f((bf16)f2bf(k)) * rvec[4 * RW + c]); if (lane == 0) ((float*)(ws + WS_BON))[(size_t)m * 8 + hh] = bsum; }
            const size_t o = (size_t)m * RW + c;
            Rr[o] = (bf16)f2bf(r); Kr[o] = (bf16)f2bf(k); Vr[o] = (bf16)f2bf(v); KKr[o] = (bf16)f2bf(kk); Ar[o] = (bf16)f2bf(aa); LWr[o] = lw; Gr[o] = (bf16)f2bf(gg);
        }
#pragma nounroll
        for (int gi = 0; gi < 4; ++gi) { float y = 0.f; const float* wp = poolw + gi * 4096 + lane;
#pragma unroll 4
            for (int c = 0; c < 64; ++c) y += pp[gi * 64 + c] * wp[c * 64];
            mix[(size_t)m * D + 512 + gi * 64 + lane] = (bf16)f2bf(y * pools[gi * 64 + lane]); }
        { float ac[6];
#pragma unroll
          for (int j = 0; j < 6; ++j) ac[j] = 0.f;
#pragma unroll 2
          for (int i = 0; i < 256; ++i) { const float xv_ = qn[i];
#pragma unroll
              for (int j = 0; j < 6; ++j) ac[j] += xv_ * wqup[i * 384 + lane + 64 * j]; }
#pragma unroll
          for (int j = 0; j < 6; ++j) qb[lane + 64 * j] = ac[j]; }
        { float ac[8];
#pragma unroll
          for (int j = 0; j < 8; ++j) ac[j] = 0.f;
#pragma unroll 2
          for (int i = 0; i < 128; ++i) { const float xv_ = kvn[i];
#pragma unroll
              for (int j = 0; j < 8; ++j) ac[j] += xv_ * wkvup[i * 512 + lane + 64 * j]; }
#pragma unroll
          for (int j = 0; j < 8; ++j) kvb[lane + 64 * j] = ac[j]; }
        LDS_WAIT();
        { const int hq = lane >> 4, i = lane & 15; const float x1 = qb[hq * 96 + 64 + i], x2 = qb[hq * 96 + 80 + i]; const float cs = ct[m * 16 + i], sn = st[m * 16 + i];
          qpe[hq * 32 + i] = x1 * cs - x2 * sn; qpe[hq * 32 + 16 + i] = x1 * sn + x2 * cs; }
        LDS_WAIT();
#pragma unroll
        for (int hq = 0; hq < MLA_H; ++hq) {
            const float qa = qb[hq * 96 + lane], qr_ = lane < 32 ? qpe[hq * 32 + lane] : 0.f;
            const float ka = kvb[hq * 128 + lane], kr_ = lane < 32 ? kpe[lane] : 0.f;
            const float rq = 1.f / sqrtf(wave_sum(qa * qa + qr_ * qr_) * (1.f / 96.f) + 1e-6f);
            const float rk = 1.f / sqrtf(wave_sum(ka * ka + kr_ * kr_) * (1.f / 96.f) + 1e-6f);
            QM[(size_t)m * 384 + hq * 96 + lane] = (bf16)f2bf(qa * rq * qkg[lane]); KM[(size_t)m * 384 + hq * 96 + lane] = (bf16)f2bf(ka * rk * qkg[96 + lane]);
            if (lane < 32) { QM[(size_t)m * 384 + hq * 96 + 64 + lane] = (bf16)f2bf(qr_ * rq * qkg[64 + lane]); KM[(size_t)m * 384 + hq * 96 + 64 + lane] = (bf16)f2bf(kr_ * rk * qkg[96 + 64 + lane]); }
            VM[(size_t)m * 256 + hq * 64 + lane] = (bf16)f2bf(kvb[hq * 128 + 64 + lane]);
        }
#undef ZS
    }
}

__device__ __forceinline__ void ph_scan_naive(const Args& a, unsigned char* ws, int l, int bh, int lane) {
    const int b = bh / NH, hh = bh % NH; const int c = hh * 64 + lane;
    const bf16* Rr = (const bf16*)(ws + WS_R); const bf16* Kr = (const bf16*)(ws + WS_K); const bf16* Vr = (const bf16*)(ws + WS_V); const bf16* KKr = (const bf16*)(ws + WS_KK); const bf16* Ar = (const bf16*)(ws + WS_A);
    const float* LWr = (const float*)(ws + WS_LW); const bf16* Gr = (const bf16*)(ws + WS_G); bf16* mix = (bf16*)(ws + WS_MIX);
    const float* rvec = a.in[I_RVEC] + l * 7 * RW; const float rk_ = rvec[4 * RW + c], lng = rvec[5 * RW + c], lnb = rvec[6 * RW + c];
    float S[64];
#pragma unroll
    for (int j = 0; j < 64; ++j) S[j] = 0.f;
    size_t o = (size_t)(b * T) * RW + c;
    float r = bf2f(Rr[o]), k = bf2f(Kr[o]), v = bf2f(Vr[o]), kk = bf2f(KKr[o]), aa = bf2f(Ar[o]), lw = LWr[o], g = bf2f(Gr[o]);
    for (int t = 0; t < T; ++t) {
        const size_t on = o + (t + 1 < T ? RW : 0);
        const float rn = bf2f(Rr[on]), kn = bf2f(Kr[on]), vn = bf2f(Vr[on]), kkn = bf2f(KKr[on]), aan = bf2f(Ar[on]), lwn = LWr[on], gn = bf2f(Gr[on]);
        const float w = __expf(lw), na = -kk, bb = kk * aa;
        float sa = 0.f;
#pragma unroll
        for (int j = 0; j < 64; ++j) sa += S[j] * __int_as_float(__builtin_amdgcn_readlane(__float_as_int(na), j));
        float y = 0.f;
#pragma unroll
        for (int j = 0; j < 64; ++j) {
            const float wj = __int_as_float(__builtin_amdgcn_readlane(__float_as_int(w), j)), bj = __int_as_float(__builtin_amdgcn_readlane(__float_as_int(bb), j));
            const float kj = __int_as_float(__builtin_amdgcn_readlane(__float_as_int(k), j)), rj = __int_as_float(__builtin_amdgcn_readlane(__float_as_int(r), j));
            S[j] = S[j] * wj + sa * bj + v * kj; y += S[j] * rj; }
        const float mu = wave_sum(y) * (1.f / 64.f); const float dy = y - mu; const float var = wave_sum(dy * dy) * (1.f / 64.f);
        const float yn = dy * (1.f / sqrtf(var + 64e-5f)) * lng + lnb;
        const float bon = wave_sum(r * k * rk_) * v;
        mix[(size_t)(b * T + t) * D + c] = (bf16)f2bf((yn + bon) * g);
        o = on; r = rn; k = kn; v = vn; kk = kkn; aa = aan; lw = lwn; g = gn;
    }
}

__device__ __forceinline__ void ph_attn_naive(unsigned char* ws, LAS unsigned char* lds, int unit, int tid) {
    const int bh = unit >> 3, qb = unit & 7; const int b = bh >> 2, hq = bh & 3;
    const bf16* QM = (const bf16*)(ws + WS_QM); const bf16* KM = (const bf16*)(ws + WS_KM); const bf16* VM = (const bf16*)(ws + WS_VM); bf16* mix = (bf16*)(ws + WS_MIX);
    LAS float* Ks = (LAS float*)(lds + RING_OFF);
    LAS float* Vs = Ks + 64 * 96;
    const int qpos = qb * 512 + tid; const size_t qrow = (size_t)(b * T + qpos);
    float q[96];
    const float sc = 1.f;
#pragma unroll
    for (int d = 0; d < 96; ++d) q[d] = bf2f(QM[qrow * 384 + hq * 96 + d]) * sc;
    float o[64];
#pragma unroll
    for (int d = 0; d < 64; ++d) o[d] = 0.f;
    float mx = -3.0e38f, lsum = 0.f;
    const int ntile = (qb * 512 + 511) / 64 + 1;
    const int wave_qmax = qb * 512 + (tid | 63);
    for (int kt = 0; kt < ntile; ++kt) {
        __syncthreads();
        for (int i = tid; i < 64 * 96; i += 512) { const int kr = i / 96, d = i % 96; Ks[i] = bf2f(KM[(size_t)(b * T + kt * 64 + kr) * 384 + hq * 96 + d]); }
        for (int i = tid; i < 64 * 64; i += 512) { const int kr = i >> 6, d = i & 63; Vs[i] = bf2f(VM[(size_t)(b * T + kt * 64 + kr) * 256 + hq * 64 + d]); }
        __syncthreads();
        if (kt * 64 > wave_qmax) continue;
        for (int j = 0; j < 64; ++j) {
            const int kpos = kt * 64 + j;
            float s = 0.f;
#pragma unroll
            for (int d = 0; d < 96; d += 4) { const f32x4 kv = *(const LAS f32x4*)(Ks + j * 96 + d); s += q[d] * kv.x + q[d + 1] * kv.y + q[d + 2] * kv.z + q[d + 3] * kv.w; }
            if (kpos > qpos) s = -3.0e38f;
            const float mn = fmaxf(mx, s); const float corr = exp2f(mx - mn), p = exp2f(s - mn);
            lsum = lsum * corr + p; mx = mn;
#pragma unroll
            for (int d = 0; d < 64; d += 4) { const f32x4 vv = *(const LAS f32x4*)(Vs + j * 64 + d); o[d] = o[d] * corr + p * vv.x; o[d + 1] = o[d + 1] * corr + p * vv.y; o[d + 2] = o[d + 2] * corr + p * vv.z; o[d + 3] = o[d + 3] * corr + p * vv.w; }
        }
    }
    const float il = 1.f / lsum;
#pragma unroll
    for (int d = 0; d < 64; d += 2) *(unsigned*)(mix + qrow * D + 768 + hq * 64 + d) = pk2(o[d] * il, o[d + 1] * il);
    __syncthreads();
}

__device__ __forceinline__ unsigned moe_cnt(unsigned char* ws, int e) { return __hip_atomic_load((unsigned*)ws + CW_MOE + 64 * e, RLX_AGENT); }
__device__ __forceinline__ volatile LAS int* moe_tiles_lds(unsigned char* ws, LAS unsigned char* lds) {
    volatile LAS int* TS = (volatile LAS int*)(lds + MISC_OFF) + 16;
    __syncthreads();
    if (tidx_() < 8) TS[9 + tidx_()] = (int)moe_cnt(ws, (int)tidx_());
    __syncthreads();
    if (tidx_() == 0) { int acc = 0; for (int e = 0; e < 8; ++e) { TS[e] = acc; acc += (TS[9 + e] + 255) >> 8; } TS[8] = acc; }
    __syncthreads();
    return TS;
}
__device__ __forceinline__ int exp_of_tile(volatile LAS int* TS, int rt) { int e = 0;
#pragma unroll
    for (int k = 1; k < 8; ++k) e += (rt >= TS[k]);
    return e; }
__device__ __forceinline__ void ph_moe_gather(unsigned char* ws, LAS unsigned char* lds, int gw, int NGW, int lane) {
    volatile LAS int* TS = moe_tiles_lds(ws, lds);
    const int nrows = TS[8] * 256;
    const int* tok = (const int*)(ws + WS_TOK); const unsigned char* h = (const unsigned char*)(ws + WS_H); unsigned char* xg = (unsigned char*)(ws + WS_XG);
    constexpr int GR = 16;
    for (int r0 = gw; r0 < nrows; r0 += GR * NGW) {
        int tk[GR]; bool ok[GR];
#pragma unroll
        for (int j = 0; j < GR; ++j) { const int r = r0 + j * NGW; const int rc = r < nrows ? r : r0; const int rt = rc >> 8; const int e = exp_of_tile(TS, rt);
            const int local = rc - TS[e] * 256; ok[j] = r < nrows && local < TS[9 + e]; tk[j] = tok[e * MOE_CAP + (ok[j] ? local : 0)]; }
        v4u v[GR];
#pragma unroll
        for (int j = 0; j < GR; ++j) v[j] = ((const v4u*)(h + (size_t)(ok[j] ? tk[j] : 0) * D))[lane];
#pragma unroll
        for (int j = 0; j < GR; ++j) { const int r = r0 + j * NGW; if (r < nrows) ((v4u*)(xg + (size_t)r * D))[lane] = ok[j] ? v[j] : (v4u){0u, 0u, 0u, 0u}; }
    }
}
__device__ __forceinline__ void ph_moe_combine(unsigned char* ws, LAS unsigned char* lds, float* out, const float* gate2  , int gw, int NGW, int lane) {
    volatile LAS int* TS = moe_tiles_lds(ws, lds);
    const int* asg = (const int*)(ws + WS_ASG); const float* gt = (const float*)(ws + WS_GATE); const bf16* yr = (const bf16*)(ws + WS_YR);
    constexpr int CT = 4;
    for (int m0 = gw; m0 < M; m0 += CT * NGW) {
        int mm[CT]; size_t ra[CT], rb[CT]; float ga[CT], gbv[CT];
#pragma unroll
        for (int u = 0; u < CT; ++u) { mm[u] = m0 + u * NGW < M ? m0 + u * NGW : m0; const int s0 = asg[mm[u] * 2], s1 = asg[mm[u] * 2 + 1];
            const int e0 = s0 / MOE_CAP, p0 = s0 % MOE_CAP, e1 = s1 / MOE_CAP, p1 = s1 % MOE_CAP;
            ra[u] = (size_t)TS[e0] * 256 + p0; rb[u] = (size_t)TS[e1] * 256 + p1; ga[u] = gt[s0]; gbv[u] = gt[s1]; }
        v4u a0[CT][2], a1[CT][2], xq[CT][2]; const bf16* xb = (const bf16*)(ws + WS_XB);
#pragma unroll
        for (int u = 0; u < CT; ++u)
#pragma unroll
            for (int j = 0; j < 2; ++j) { const int col = (j * 64 + lane) * 8;
                a0[u][j] = *(const v4u*)(yr + ra[u] * D + col); a1[u][j] = *(const v4u*)(yr + rb[u] * D + col);
                xq[u][j] = *(const v4u*)(xb + (size_t)mm[u] * D + col); }
#pragma unroll
        for (int u = 0; u < CT; ++u) { if (u > 0 && m0 + u * NGW >= M) break;
            const float* gb = gate2 + (size_t)(mm[u] / T) * 6144; const float g0 = ga[u], g1 = gbv[u];
#pragma unroll
            for (int j = 0; j < 2; ++j) { const int col = (j * 64 + lane) * 8; const f32x4* gp = (const f32x4*)(gb + col); const f32x4 gg0 = gp[0], gg1 = gp[1];
                const v4u A0 = a0[u][j], A1 = a1[u][j], XQ = xq[u][j]; f32x4 X0 = {bflo(XQ.x), bfhi(XQ.x), bflo(XQ.y), bfhi(XQ.y)}, X1 = {bflo(XQ.z), bfhi(XQ.z), bflo(XQ.w), bfhi(XQ.w)};
                X0.x += gg0.x * (g0 * bflo(A0.x) + g1 * bflo(A1.x)); X0.y += gg0.y * (g0 * bfhi(A0.x) + g1 * bfhi(A1.x)); X0.z += gg0.z * (g0 * bflo(A0.y) + g1 * bflo(A1.y)); X0.w += gg0.w * (g0 * bfhi(A0.y) + g1 * bfhi(A1.y));
                X1.x += gg1.x * (g0 * bflo(A0.z) + g1 * bflo(A1.z)); X1.y += gg1.y * (g0 * bfhi(A0.z) + g1 * bfhi(A1.z)); X1.z += gg1.z * (g0 * bflo(A0.w) + g1 * bflo(A1.w)); X1.w += gg1.w * (g0 * bfhi(A0.w) + g1 * bfhi(A1.w));
                f32x4* op = (f32x4*)(out + (size_t)mm[u] * D + col); op[0] = X0; op[1] = X1; } }
    }
}

#define LANE_ fresh_lane()
#define TID_ tidx_()
constexpr int NPHASE = 23;
#ifndef PH_MASK
#define PH_MASK 0xFFFFFFFFu
#endif
#define EN(b) ((PH_MASK >> (b)) & 1u)

#define IN(k) (lo <= (k) && (k) < hi)
#define SEAM(k) do { if (IN(k) && IN((k) + 1)) xcd_barrier(bar); } while (0)
template <int l>
__device__ __forceinline__ void layer_phases(const Args& args, unsigned char* ws, LAS unsigned char* lds, float* out, const float* mod, bf16* H, const XcdBarrier& bar,
                                             int lo, int hi, int li, int wave, int G, int gw, int NGW) {

        const int pb = 2 + 10 * l;
        const float* modl = mod + (size_t)l * 8 * 6144;
        if (EN(0) && IN(pb + 0)) {
            pg8::Gemm g{H, (const bf16*)(ws + WS_WIN) + (size_t)l * NZ * 1024, M, NZ, 1024}; pg8::StaticOrder S; S.init(M, NZ, G, (int)blockIdx.x);
            pg8::EpiBf16<0> E{(bf16*)(ws + WS_Z), NZ, nullptr, 0, 0, 1.f};
            pg8::gemm_phase<pg8::EpiBf16<0>, pg8::StaticOrder, true, true>(lds + RING_OFF, g, S, E);
        } SEAM(pb + 0);
        if (EN(1) && IN(pb + 1)) {
#if POSTZ_NAIVE
            ph_postz(args, ws, lds, l, gw, NGW, wave, LANE_);
#else
            ph_postz_mfma<l>(args, ws, lds, G, TID_, wave, LANE_, DRY_REP && li == 1);
#endif
        } SEAM(pb + 1);
        if (IN(pb + 3)) {
            if (EN(14) && blockIdx.x >= 64 && blockIdx.x < 128) ph_convert(args, ws, lds, ((int)blockIdx.x - 64) * 8 + wave, 64 * 8, wave, LANE_, 1 + l);
            if (EN(2) && blockIdx.x < 64 && wave < 2 && !(ATTN_ONLY_REP && li == 1)) scan_carry(ws, (int)blockIdx.x, wave, LANE_);
            __syncthreads();
            #if ATTN_NAIVE
            if (EN(3)) for (int u = blockIdx.x; u < 256; u += G) ph_attn_naive(ws, lds, u, TID_);
#else
            if (EN(3) && !(CARRY_ONLY_REP && li == 1)) { volatile LAS unsigned* qw = (volatile LAS unsigned*)(lds + MISC_OFF) + 26;
                for (;;) { __syncthreads(); if (TID_ == 0) qw[0] = __hip_atomic_fetch_add((unsigned*)ws + CW_ATQ + 64 * (l + 2 * (li & 1)), 1u, RLX_AGENT); __syncthreads();
                    const unsigned u = qw[0]; if (u >= 512u) break; ph_attn_pipe(ws, lds, (int)(u & 31u), 15 - (int)(u >> 5), wave, LANE_); } }
#endif
        } SEAM(pb + 3);
        if (EN(2) && IN(pb + 4)) { ph_scan_out(args, ws, lds, l, gw, NGW, wave, LANE_); } SEAM(pb + 4);
        if (EN(4) && IN(pb + 5)) {
            pg8::Gemm g{(const bf16*)(ws + WS_MIX), (const bf16*)(ws + WS_WOUT) + (size_t)l * 1024 * 1024, M, D, D}; pg8::StaticOrder S; S.init(M, D, G, (int)blockIdx.x);
            pg8::EpiResB<l == 0> E{l == 0 ? (const void*)args.in[I_X] : (const void*)(ws + WS_XB), (pg8::bf16_t*)(ws + WS_XB), modl + 2 * 1024};
            pg8::gemm_phase<pg8::EpiResB<l == 0>, pg8::StaticOrder, true, true>(lds + RING_OFF, g, S, E);
        } SEAM(pb + 5);
        if constexpr (l == 0) {
            if (EN(5) && IN(pb + 6)) { ph_norm<false, false, true>(ws + WS_XB, args.in[I_NGAIN] + 1024, modl + 3 * 1024, H, nullptr, ws, gw, NGW, LANE_); } SEAM(pb + 6);
            if (EN(6) && IN(pb + 7)) {
                pg8::Gemm g{H, (const bf16*)(ws + WS_WFFI), M, 2 * DFF, D}; pg8::StaticOrder S; S.init(M, 2 * DFF, G, (int)blockIdx.x);
                pg8::EpiSwiglu E{(bf16*)(ws + WS_ACT), DFF, 1 << 20};
                pg8::gemm_phase<pg8::EpiSwiglu, pg8::StaticOrder, true, true>(lds + RING_OFF, g, S, E);
            } SEAM(pb + 7);
            if (EN(7) && IN(pb + 8)) {
                pg8::Gemm g{(const bf16*)(ws + WS_ACT), (const bf16*)(ws + WS_WFFO), M, D, DFF}; pg8::StaticOrder S; S.init(M, D, G, (int)blockIdx.x);
                pg8::EpiResB<false> E{(const void*)(ws + WS_XB), (pg8::bf16_t*)(ws + WS_XB), modl + 5 * 1024};
                pg8::gemm_phase<pg8::EpiResB<false>, pg8::StaticOrder, true, true>(lds + RING_OFF, g, S, E);
            } SEAM(pb + 8);
            if (EN(5) && IN(pb + 9)) { ph_norm<false, false, true>(ws + WS_XB, args.in[I_NGAIN] + 2048, mod + (size_t)8 * 6144, H, nullptr, ws, gw, NGW, LANE_); } SEAM(pb + 9);
        } else {
            if (EN(8) && IN(pb + 6)) { ph_norm<true, true, true>(ws + WS_XB, args.in[I_NGAIN] + 3072, modl + 3 * 1024, H, args.in[I_ROUTER], ws, gw, NGW, LANE_, lds); } SEAM(pb + 6);
            if (EN(9) && IN(pb + 7)) { ph_moe_gather(ws, lds, gw, NGW, LANE_); } SEAM(pb + 7);
            if (EN(10) && IN(pb + 8)) {
                volatile LAS int* TS = moe_tiles_lds(ws, lds);
                pg8::Gemm g{(const bf16*)(ws + WS_XG), (const bf16*)(ws + WS_WMI), 0, 0, D / 2};
                pg8::MoeOrder S{28, TS[8] * 28, G, (int)blockIdx.x, TS[1], TS[2], TS[3], TS[4], TS[5], TS[6], TS[7]};
                pg8::EpiSwigluF8 E{ws + WS_MACT, DFFE, 28};
                pg8::gemm_phase_f8<pg8::EpiSwigluF8, pg8::MoeOrder, true, true>(lds + RING_OFF, g, S, E, F8_WEXP, F8_HEXP);
            } SEAM(pb + 8);
            if (EN(11) && IN(pb + 9)) {
                volatile LAS int* TS = moe_tiles_lds(ws, lds);
                pg8::Gemm g{(const bf16*)(ws + WS_MACT), (const bf16*)(ws + WS_WMO), 0, 0, DFFE / 2};
                pg8::MoeOrder S{4, TS[8] * 4, G, (int)blockIdx.x, TS[1], TS[2], TS[3], TS[4], TS[5], TS[6], TS[7]};
                pg8::EpiMoeOut E{(bf16*)(ws + WS_YR)};
                pg8::gemm_phase_f8<pg8::EpiMoeOut, pg8::MoeOrder, true, true>(lds + RING_OFF, g, S, E, F8_WEXP, F8_AEXP);
            } SEAM(pb + 9);
            if (EN(12) && IN(pb + 10)) { ph_moe_combine(ws, lds, out, modl + 5 * 1024, gw, NGW, LANE_); }
        }
    }
#undef IN
#undef SEAM
#ifndef ATTN_NAIVE
#define ATTN_NAIVE 0
#endif
#ifndef POSTZ_NAIVE
#define POSTZ_NAIVE 0
#endif
#ifndef SCAN_NAIVE
#define SCAN_NAIVE 0
#endif
#ifndef MK_SPLIT
#define MK_SPLIT 0
#endif
__global__ void __launch_bounds__(NWAVES * 64, 2) fwd_kernel(Args args) {
    LAS unsigned char* lds = (LAS unsigned char*)lds_raw;
    const int wave = __builtin_amdgcn_readfirstlane((int)threadIdx.x >> 6);
    const int G = gridDim.x, gw = blockIdx.x * NWAVES + wave, NGW = G * NWAVES, GT = G * NWAVES * 64;
#define GTID_ ((int)blockIdx.x * (NWAVES * 64) + TID_)
    unsigned char* ws = args.ws;
    for (int u = threadIdx.x; u < (LDS_BYTES - LDSCTL_OFF) / 4; u += NWAVES * 64) ((LAS unsigned*)(lds + LDSCTL_OFF))[u] = 0u;
    __syncthreads();
    if ((threadIdx.x & 63) == 0) ((volatile LAS int*)(lds + WMAP_OFF))[hw_slot_()] = wave;
    __syncthreads();
    XcdBarrier bar; bar.bar = (unsigned*)ws + CW_BAR + args.li * XCD_BAR_WORDS; bar.x = 0; bar.st = nullptr;
    if (!MK_SPLIT) bar = xcd_barrier_post((unsigned*)ws + CW_BAR + args.li * XCD_BAR_WORDS, (volatile LAS unsigned*)(lds + MISC_OFF) + 8);
    const int lo = args.ph_lo, hi = args.ph_hi;
#define IN(k) (lo <= (k) && (k) < hi)
#define SEAM(k) do { if (IN(k) && IN((k) + 1)) xcd_barrier(bar); } while (0)
    float* out = args.out;
    const float* mod = (const float*)(ws + WS_MOD);
    bf16* H = (bf16*)(ws + WS_H);

    if (EN(13) && IN(0)) { ph_mod_rope(args, ws, lds, gw, NGW, TID_, LANE_, GTID_, GT); } SEAM(0);
    if (IN(1)) { if (EN(14)) { ph_convert(args, ws, lds, gw, NGW, wave, LANE_, 0); ph_small_weights(args, ws, GTID_, GT); }
                 if (EN(5)) ph_norm<false>(args.in[I_X], args.in[I_NGAIN], mod, H, nullptr, ws, gw, NGW, LANE_); } SEAM(1);

    layer_phases<0>(args, ws, lds, out, mod, H, bar, lo, hi, args.li, wave, G, gw, NGW);
    layer_phases<1>(args, ws, lds, out, mod, H, bar, lo, hi, args.li, wave, G, gw, NGW);
#undef IN
#undef SEAM
}

extern "C" void kernel_launch(void* const* d_in, const int* in_sizes, int n_in, void* d_out, int out_size, void* d_ws, size_t ws_size, hipStream_t stream) {
    static int grid = 0;
    if (grid == 0) {
        if (n_in != 29 || out_size != M * D || ws_size < WS_END || ws_size < WS_MIX_END) { fprintf(stderr, "kernel_launch: unexpected shapes (n_in %d out %d ws %zu)\n", n_in, out_size, ws_size); grid = -1; return; }
        int dev = 0, cus = 0, per_cu = 0;
        if (hipGetDevice(&dev) != hipSuccess || hipDeviceGetAttribute(&cus, hipDeviceAttributeMultiprocessorCount, dev) != hipSuccess) { grid = -1; return; }
        if (hipFuncSetAttribute((const void*)fwd_kernel, hipFuncAttributeMaxDynamicSharedMemorySize, LDS_BYTES) != hipSuccess) { fprintf(stderr, "kernel_launch: hipFuncSetAttribute failed\n"); grid = -1; return; }
        if (hipOccupancyMaxActiveBlocksPerMultiprocessor(&per_cu, (const void*)fwd_kernel, NWAVES * 64, LDS_BYTES) != hipSuccess || per_cu < 1) fprintf(stderr, "kernel_launch: occupancy query says %d\n", per_cu);
        (void)hipGetLastError();
        grid = cus;
    }
    if (grid < 0) return;
    (void)hipMemsetAsync((char*)d_ws + WS_CTL, 0, CTL_ZERO_BYTES, stream);
    Args a{};
    for (int i = 0; i < 29; ++i) a.in[i] = (const float*)d_in[i];
    a.out = (float*)d_out; a.ws = (unsigned char*)d_ws;
#if defined(TIME_PHASE)
    { const int K = TIME_PHASE; const int cuts[4] = {0, K + 1, K, NPHASE};
      a.ph_lo = 0; a.ph_hi = K + 1; a.li = 0; hipLaunchKernelGGL(fwd_kernel, dim3(grid), dim3(NWAVES * 64), LDS_BYTES, stream, a);
      a.ph_lo = K; a.ph_hi = K + 1; a.li = 1; hipLaunchKernelGGL(fwd_kernel, dim3(grid), dim3(NWAVES * 64), LDS_BYTES, stream, a);
      a.ph_lo = K + 1; a.ph_hi = NPHASE; a.li = 2; hipLaunchKernelGGL(fwd_kernel, dim3(grid), dim3(NWAVES * 64), LDS_BYTES, stream, a); (void)cuts; }
#else
    a.ph_lo = 0; a.ph_hi = NPHASE; a.li = 0;
    hipLaunchKernelGGL(fwd_kernel, dim3(grid), dim3(NWAVES * 64), LDS_BYTES, stream, a);
#endif
}
```

```cpp
#include <hip/hip_runtime.h>
#include <cstdio>
#include <cstdint>

extern __shared__ __attribute__((aligned(16))) unsigned char lds_raw[];
#define WMAP_OFF (131072 + 512)
__device__ __forceinline__ int hw_slot_() { return (int)__builtin_amdgcn_s_getreg((5 << 11) | (0 << 6) | 4); }
__device__ __forceinline__ int lane_id_() { int l; asm volatile("v_mbcnt_lo_u32_b32 %0, -1, 0\n\tv_mbcnt_hi_u32_b32 %0, -1, %0" : "=v"(l)); return l; }
__device__ __forceinline__ int wave_id_() { return __builtin_amdgcn_readfirstlane(((volatile __attribute__((address_space(3))) int*)((__attribute__((address_space(3))) unsigned char*)lds_raw + WMAP_OFF))[hw_slot_()]); }
__device__ __forceinline__ int tidx_() { return wave_id_() * 64 + lane_id_(); }

namespace pg8 {
#define PG8_LAS __attribute__((address_space(3)))
typedef unsigned short bf16_t;
typedef short bf16x8 __attribute__((ext_vector_type(8)));
typedef float f32x4 __attribute__((ext_vector_type(4)));
typedef unsigned u32x4 __attribute__((ext_vector_type(4)));
constexpr int BM = 256, BK = 64, HALF = 128, HTB = HALF * BK * 2  , STAGE_BYTES = 8 * HTB, NXCD = 8, WGM = 8;

__host__ __device__ __forceinline__ int lds_byte(int r, int c) { const int st = (r >> 4) * 2 + (c >> 5), rr = r & 15, cc = c & 31, ob = rr * 64 + cc * 2; return st * 1024 + (ob ^ (((ob >> 9) & 1) << 5)); }
__host__ __device__ __forceinline__ void stage_rc(int b, int& R, int& C) { const int st = b / 1024, sb = b % 1024, swz = sb ^ (((sb >> 9) & 1) << 5); R = (st >> 1) * 16 + swz / 64; C = (st & 1) * 32 + (swz % 64) / 2; }
__host__ __device__ __forceinline__ int perm32(int rho) { const int n = rho >> 4, i = rho & 15; return 8 * (i >> 2) + 4 * n + (i & 3); }

struct Unit { int pm, pn; };
struct Gemm { const bf16_t* A; const bf16_t* Bt; int M, N, K; };

struct StaticOrder {
    int nM, nN, nwg, G, c;
    __host__ __device__ void init(int M, int N, int G_, int c_) { nM = M / BM; nN = N / BM; nwg = nM * nN; G = G_; c = c_; }
    __host__ __device__ bool next(int i, Unit& u) const {
        const long L = (long)i * G + c; if (L >= nwg) return false;
        int wgid = (int)L; { const int q = nwg / NXCD, r = nwg % NXCD, xcd = wgid % NXCD, off = wgid / NXCD; wgid = (xcd < r ? xcd * (q + 1) : r * (q + 1) + (xcd - r) * q) + off; }
        const int nig = WGM * nN, gid = wgid / nig, fm = gid * WGM, gsz = (nM - fm) < WGM ? (nM - fm) : WGM;
        u.pm = fm + ((wgid % nig) % gsz); u.pn = (wgid % nig) / gsz; return true;
    }
    __device__ __forceinline__ void a_ready(const Unit&) const {}
    __device__ __forceinline__ void done(const Unit&) const {}
};

__device__ __forceinline__ unsigned cvt_pk_bf16(float lo, float hi) { unsigned r; asm volatile("v_cvt_pk_bf16_f32 %0, %1, %2" : "=v"(r) : "v"(lo), "v"(hi)); return r; }
typedef float f32x2 __attribute__((ext_vector_type(2)));
__device__ __forceinline__ f32x2 gelu_pk(f32x2 v) {
    const f32x2 av = __builtin_elementwise_abs(v), d = av * 0.2316418882f + 1.0f;
    f32x2 t; t.x = __builtin_amdgcn_rcpf(d.x); t.y = __builtin_amdgcn_rcpf(d.y);
    f32x2 q = t * 0.5307027145f + (-0.7265760135f); q = q * t + 0.7107068705f; q = q * t + (-0.142248368f); q = q * t + 0.127414796f; q = q * t;
    const f32x2 s = (v * v) * (-0.72134752044f);
    f32x2 e; e.x = __builtin_amdgcn_exp2f(s.x); e.y = __builtin_amdgcn_exp2f(s.y);
    const f32x2 m = v * (q * e), r = v - m;
    f32x2 o; o.x = v.x < 0.f ? m.x : r.x; o.y = v.y < 0.f ? m.y : r.y; return o;
}

template <int ACT  > struct EpiBf16 {
    static constexpr bool PERM = true, AFTER_DRAIN = false; static_assert(ACT == 0 || ACT == 1, "EpiBf16: ACT is 0 (none) or 1 (gelu_pk)");
    bf16_t* O; int ldc; const float* bias; int split_cols; size_t split_stride; float scale0;
    __device__ __forceinline__ void operator()(const f32x4 (&acc)[2][2][4][2], const Unit& u, int wr, int wc, int fr, int fq) const {
        const int row0 = u.pm * BM + wr * 64 + fr; int colt = u.pn * BM; bf16_t* base = O;
        float sc = 1.f; if (split_cols) { const int t = colt / split_cols; base += (size_t)t * split_stride; colt -= t * split_cols; if (t == 0) sc = scale0; }
        const int col0 = colt + wc * 32 + 8 * fq, bcol0 = u.pn * BM + wc * 32 + 8 * fq;
        f32x4 bv[2][2];
#pragma unroll
        for (int bj = 0; bj < 2; ++bj)
#pragma unroll
            for (int n = 0; n < 2; ++n) bv[bj][n] = bias ? *(const f32x4*)(bias + bcol0 + bj * HALF + 4 * n) : (f32x4){0.f, 0.f, 0.f, 0.f};
#pragma unroll
        for (int ai = 0; ai < 2; ++ai)
#pragma unroll
            for (int m = 0; m < 4; ++m) { bf16_t* rowp = base + (size_t)(row0 + ai * HALF + m * 16) * ldc + col0;
#pragma unroll
                for (int bj = 0; bj < 2; ++bj) { f32x4 v0 = acc[ai][bj][m][0] + bv[bj][0], v1 = acc[ai][bj][m][1] + bv[bj][1];
                    if (ACT == 1) { f32x2 a = gelu_pk((f32x2){v0[0], v0[1]}), b = gelu_pk((f32x2){v0[2], v0[3]}), c = gelu_pk((f32x2){v1[0], v1[1]}), d = gelu_pk((f32x2){v1[2], v1[3]});
                        v0 = (f32x4){a.x, a.y, b.x, b.y}; v1 = (f32x4){c.x, c.y, d.x, d.y}; }
                    v0 = v0 * sc; v1 = v1 * sc; u32x4 w; w.x = cvt_pk_bf16(v0[0], v0[1]); w.y = cvt_pk_bf16(v0[2], v0[3]); w.z = cvt_pk_bf16(v1[0], v1[1]); w.w = cvt_pk_bf16(v1[2], v1[3]);
                    *(u32x4*)(rowp + bj * HALF) = w; } }
    }
};

template <class Epi, class Sched, bool ALIGN_EPI = false, bool SP2 = false>
__device__ __forceinline__ void gemm_phase(PG8_LAS unsigned char* lds, const Gemm g, const Sched& S, const Epi& E) {
    int tid_ = tidx_(); asm volatile("" : "+v"(tid_));
    const int tid = tid_, wid = __builtin_amdgcn_readfirstlane(tid >> 6), lane = tid & 63, wr = wid >> 2, wc = wid & 3, fr = lane & 15, fq = lane >> 4;
    const int K = g.K, nt = K / BK;
    unsigned voffA[2], voffB[2];
#pragma unroll
    for (int i = 0; i < 2; ++i) { int R, C; stage_rc(tid * 16 + i * 8192, R, C); const int Rb = Epi::PERM ? ((R & ~31) + perm32(R & 31)) : R;
        voffA[i] = (unsigned)(R * K + C) * 2u; voffB[i] = (unsigned)(Rb * K + C) * 2u; }
    const size_t kstep = (size_t)(BK * 2);
    const size_t hstep = (size_t)HALF * K * 2;
    const size_t tstep = 2 * hstep;
    const unsigned ldsw = (unsigned)wid * 1024u;
    const int aoff = lds_byte(wr * 64 + fr, fq * 8), boff = lds_byte(wc * 32 + fr, fq * 8);
#define PG8_SA(b, h) (((b) * 2 + (h)) * HTB)
#define PG8_SB(b, h) ((4 + (b) * 2 + (h)) * HTB)
#define PG8_STAGE(bufoff, gbase, voff) do { _Pragma("unroll") for (int _i = 0; _i < 2; ++_i) \
        __builtin_amdgcn_global_load_lds((const unsigned*)((const char*)(gbase) + (voff)[_i]), (PG8_LAS unsigned*)(lds + (bufoff) + ldsw + _i * 8192), 16, 0, 0); } while (0)
#define PG8_LDA(dst, b, h) do { _Pragma("unroll") for (int m = 0; m < 4; ++m) _Pragma("unroll") for (int k = 0; k < 2; ++k) dst[m][k] = *(const PG8_LAS bf16x8*)(lds + PG8_SA(b, h) + aoff + m * 2048 + k * 1024); } while (0)
#define PG8_LDB(dst, b, h) do { _Pragma("unroll") for (int n = 0; n < 2; ++n) _Pragma("unroll") for (int k = 0; k < 2; ++k) dst[n][k] = *(const PG8_LAS bf16x8*)(lds + PG8_SB(b, h) + boff + n * 2048 + k * 1024); } while (0)
#define PG8_MMA(ai, bj, At, Bt) do { __builtin_amdgcn_s_setprio(1); _Pragma("unroll") for (int m = 0; m < 4; ++m) _Pragma("unroll") for (int n = 0; n < 2; ++n) _Pragma("unroll") for (int k = 0; k < 2; ++k) \
        acc[ai][bj][m][n] = __builtin_amdgcn_mfma_f32_16x16x32_bf16(Bt[n][k], At[m][k], acc[ai][bj][m][n], 0, 0, 0); __builtin_amdgcn_s_setprio(0); } while (0)
#define PG8_WAIT_V(n) asm volatile("s_waitcnt vmcnt(" #n ")" ::: "memory")
#define PG8_WAIT_L(n) asm volatile("s_waitcnt lgkmcnt(" #n ")" ::: "memory")
#define PG8_BAR __builtin_amdgcn_s_barrier()
#define PG8_SCHED __builtin_amdgcn_sched_barrier(0)
    Unit cur, nxt; int ui = 0;
    if (!S.next(0, cur)) return;
    f32x4 acc[2][2][4][2];
#pragma unroll
    for (int a = 0; a < 2; ++a)
#pragma unroll
        for (int b = 0; b < 2; ++b)
#pragma unroll
            for (int m = 0; m < 4; ++m)
#pragma unroll
                for (int n = 0; n < 2; ++n) acc[a][b][m][n] = (f32x4){0.f, 0.f, 0.f, 0.f};
    bf16x8 At[4][2], B0[2][2], B1[2][2];
    const char* cA = (const char*)g.A + (size_t)cur.pm * tstep; const char* cB = (const char*)g.Bt + (size_t)cur.pn * tstep;
    S.a_ready(cur);
    if constexpr (SP2) {
        PG8_STAGE(PG8_SB(0, 0), cB, voffB); PG8_STAGE(PG8_SB(0, 1), cB + hstep, voffB); PG8_STAGE(PG8_SA(0, 0), cA, voffA); PG8_STAGE(PG8_SA(0, 1), cA + hstep, voffA);
        if (wr == 1) PG8_BAR;
        PG8_WAIT_V(2); PG8_BAR;
        PG8_STAGE(PG8_SB(1, 0), cB + kstep, voffB); PG8_STAGE(PG8_SA(1, 0), cA + kstep, voffA); PG8_STAGE(PG8_SB(1, 1), cB + hstep + kstep, voffB);
        PG8_WAIT_V(6); PG8_BAR;
    } else {
        PG8_STAGE(PG8_SB(0, 0), cB, voffB); PG8_STAGE(PG8_SA(0, 0), cA, voffA); PG8_STAGE(PG8_SB(0, 1), cB + hstep, voffB); PG8_STAGE(PG8_SA(0, 1), cA + hstep, voffA);
        if (wr == 1) PG8_BAR;
        PG8_WAIT_V(4); PG8_BAR;
        PG8_STAGE(PG8_SB(1, 0), cB + kstep, voffB); PG8_STAGE(PG8_SA(1, 0), cA + kstep, voffA); PG8_STAGE(PG8_SB(1, 1), cB + hstep + kstep, voffB);
        PG8_WAIT_V(6); PG8_BAR;
    }
    for (;;) {
        const bool has_next = S.next(ui + 1, nxt);
        const char* nA = has_next ? (const char*)g.A + (size_t)nxt.pm * tstep : cA; const char* nB = has_next ? (const char*)g.Bt + (size_t)nxt.pn * tstep : cB;
        for (int t = 0; t < nt; t += 2) {
            const bool last = (t == nt - 2);
            const char* a1 = cA + (size_t)(t + 1) * kstep;
            const char* a2 = last ? nA : cA + (size_t)(t + 2) * kstep; const char* b2 = last ? nB : cB + (size_t)(t + 2) * kstep;
            const char* a3 = a2 + kstep; const char* b3 = b2 + kstep;
            if (last && has_next) S.a_ready(nxt);
            if constexpr (SP2) {
            PG8_LDB(B0, 0, 0); PG8_LDB(B1, 0, 1); PG8_SCHED; PG8_LDA(At, 0, 0); PG8_STAGE(PG8_SA(1, 1), a1 + hstep, voffA);
            PG8_WAIT_V(8); PG8_WAIT_L(0); PG8_BAR; PG8_MMA(0, 0, At, B0); PG8_MMA(0, 1, At, B1); PG8_BAR; PG8_SCHED;
            PG8_LDA(At, 0, 1); PG8_STAGE(PG8_SB(0, 0), b2, voffB); PG8_STAGE(PG8_SB(0, 1), b2 + hstep, voffB); PG8_STAGE(PG8_SA(0, 0), a2, voffA);
            PG8_WAIT_V(8); PG8_WAIT_L(0); PG8_BAR; PG8_MMA(1, 0, At, B0); PG8_MMA(1, 1, At, B1); PG8_BAR; PG8_SCHED;
            PG8_LDB(B0, 1, 0); PG8_LDB(B1, 1, 1); PG8_SCHED; PG8_LDA(At, 1, 0); PG8_STAGE(PG8_SA(0, 1), a2 + hstep, voffA);
            PG8_WAIT_V(8); PG8_WAIT_L(0); PG8_BAR; PG8_MMA(0, 0, At, B0); PG8_MMA(0, 1, At, B1); PG8_BAR; PG8_SCHED;
            PG8_LDA(At, 1, 1); PG8_STAGE(PG8_SB(1, 0), b3, voffB); PG8_STAGE(PG8_SB(1, 1), b3 + hstep, voffB); PG8_STAGE(PG8_SA(1, 0), a3, voffA);
            PG8_WAIT_V(8); PG8_WAIT_L(0); PG8_BAR; PG8_MMA(1, 0, At, B0); PG8_MMA(1, 1, At, B1); PG8_BAR; PG8_SCHED;
            } else {
            PG8_LDB(B0, 0, 0); PG8_SCHED; PG8_LDA(At, 0, 0); PG8_STAGE(PG8_SA(1, 1), a1 + hstep, voffA);
            PG8_WAIT_L(8); PG8_BAR; PG8_WAIT_L(0); PG8_MMA(0, 0, At, B0); PG8_BAR; PG8_SCHED;
            PG8_LDB(B1, 0, 1); PG8_STAGE(PG8_SB(0, 0), b2, voffB);
            PG8_BAR; PG8_WAIT_L(0); PG8_MMA(0, 1, At, B1); PG8_BAR;
            PG8_LDA(At, 0, 1); PG8_STAGE(PG8_SA(0, 0), a2, voffA);
            PG8_BAR; PG8_WAIT_L(0); PG8_MMA(1, 0, At, B0); PG8_BAR; PG8_SCHED;
            PG8_STAGE(PG8_SB(0, 1), b2 + hstep, voffB);
            PG8_WAIT_V(6); PG8_BAR; PG8_MMA(1, 1, At, B1); PG8_BAR;
            PG8_LDB(B0, 1, 0); PG8_SCHED; PG8_LDA(At, 1, 0); PG8_STAGE(PG8_SA(0, 1), a2 + hstep, voffA);
            PG8_WAIT_L(8); PG8_BAR; PG8_WAIT_L(0); PG8_MMA(0, 0, At, B0); PG8_BAR; PG8_SCHED;
            PG8_LDB(B1, 1, 1); PG8_STAGE(PG8_SB(1, 0), b3, voffB);
            PG8_BAR; PG8_WAIT_L(0); PG8_MMA(0, 1, At, B1); PG8_BAR;
            PG8_LDA(At, 1, 1); PG8_STAGE(PG8_SA(1, 0), a3, voffA);
            PG8_BAR; PG8_WAIT_L(0); PG8_MMA(1, 0, At, B0); PG8_BAR; PG8_SCHED;
            PG8_STAGE(PG8_SB(1, 1), b3 + hstep, voffB);
            PG8_WAIT_V(6); PG8_BAR; PG8_MMA(1, 1, At, B1); PG8_BAR;
            }
        }
        if constexpr (ALIGN_EPI) { if (wr == 0) PG8_BAR; }
        if constexpr (!Epi::AFTER_DRAIN) { E(acc, cur, wr, wc, fr, fq); S.done(cur); }
        if (!has_next) break;
#pragma unroll
        for (int a = 0; a < 2; ++a)
#pragma unroll
            for (int b = 0; b < 2; ++b)
#pragma unroll
                for (int m = 0; m < 4; ++m)
#pragma unroll
                    for (int n = 0; n < 2; ++n) acc[a][b][m][n] = (f32x4){0.f, 0.f, 0.f, 0.f};
        cur = nxt; cA = nA; cB = nB; ++ui;
        if constexpr (ALIGN_EPI) { if (wr == 1) PG8_BAR; }
    }
    PG8_WAIT_V(0);
    if constexpr (!ALIGN_EPI) { if (wr == 0) PG8_BAR; }
    PG8_BAR;
    if constexpr (Epi::AFTER_DRAIN) { E.fused(acc, cur, wr, wc, fr, fq, lds, wid, lane); S.done(cur); }
#undef PG8_SA
#undef PG8_SB
#undef PG8_STAGE
#undef PG8_LDA
#undef PG8_LDB
#undef PG8_MMA
#undef PG8_WAIT_V
#undef PG8_WAIT_L
#undef PG8_BAR
#undef PG8_SCHED
}
typedef int v8i_t __attribute__((ext_vector_type(8)));
template <class Epi, class Sched, bool ALIGN_EPI = false, bool SP2 = false>
__device__ __forceinline__ void gemm_phase_f8(PG8_LAS unsigned char* lds, const Gemm g, const Sched& S, const Epi& E, int sexp_w, int sexp_a) {
    int tid_ = tidx_(); asm volatile("" : "+v"(tid_));
    const int tid = tid_, wid = __builtin_amdgcn_readfirstlane(tid >> 6), lane = tid & 63, wr = wid >> 2, wc = wid & 3, fr = lane & 15, fq = lane >> 4;
    const int K = g.K, nt = K / BK;
    unsigned voffA[2], voffB[2];
#pragma unroll
    for (int i = 0; i < 2; ++i) { int R, C; stage_rc(tid * 16 + i * 8192, R, C); const int Rb = Epi::PERM ? ((R & ~31) + perm32(R & 31)) : R;
        voffA[i] = (unsigned)(R * K + C) * 2u; voffB[i] = (unsigned)(Rb * K + C) * 2u; }
    const size_t kstep = (size_t)(BK * 2);
    const size_t hstep = (size_t)HALF * K * 2;
    const size_t tstep = 2 * hstep;
    const unsigned ldsw = (unsigned)wid * 1024u;
    const int sexp_both = sexp_w | (sexp_a << 8);
    const int fo8 = (fq >> 1) * 1024 + ((fr * 64 + 32 * (fq & 1)) ^ ((fr >> 3) << 5));
    const int sw8 = (fq & 1) << 4;
    const int aoff = wr * 8192 + fo8 + sw8, boff = wc * 4096 + fo8 + sw8, aoff2 = wr * 8192 + fo8 + (16 - sw8), boff2 = wc * 4096 + fo8 + (16 - sw8);
#define PG8_SA(b, h) (((b) * 2 + (h)) * HTB)
#define PG8_SB(b, h) ((4 + (b) * 2 + (h)) * HTB)
#define PG8_STAGE(bufoff, gbase, voff) do { _Pragma("unroll") for (int _i = 0; _i < 2; ++_i) \
        __builtin_amdgcn_global_load_lds((const unsigned*)((const char*)(gbase) + (voff)[_i]), (PG8_LAS unsigned*)(lds + (bufoff) + ldsw + _i * 8192), 16, 0, 0); } while (0)
#define PG8_LDA(dst, b, h) do { _Pragma("unroll") for (int m = 0; m < 4; ++m) { const u32x4 lo_ = *(const PG8_LAS u32x4*)(lds + PG8_SA(b, h) + aoff + m * 2048), hi_ = *(const PG8_LAS u32x4*)(lds + PG8_SA(b, h) + aoff2 + m * 2048); struct { u32x4 a_, b_; } pr_ = {lo_, hi_}; dst[m] = __builtin_bit_cast(v8i_t, pr_); } } while (0)
#define PG8_LDB(dst, b, h) do { _Pragma("unroll") for (int n = 0; n < 2; ++n) { const u32x4 lo_ = *(const PG8_LAS u32x4*)(lds + PG8_SB(b, h) + boff + n * 2048), hi_ = *(const PG8_LAS u32x4*)(lds + PG8_SB(b, h) + boff2 + n * 2048); struct { u32x4 a_, b_; } pr_ = {lo_, hi_}; dst[n] = __builtin_bit_cast(v8i_t, pr_); } } while (0)
#define PG8_MMA(ai, bj, At, Bt) do { __builtin_amdgcn_s_setprio(1); _Pragma("unroll") for (int m = 0; m < 4; ++m) _Pragma("unroll") for (int n = 0; n < 2; ++n) \
        asm volatile("v_mfma_scale_f32_16x16x128_f8f6f4 %0, %1, %2, %0, %3, %3 op_sel:[0,1,0] op_sel_hi:[0,0,0]" : "+v"(acc[ai][bj][m][n]) : "v"(Bt[n]), "v"(At[m]), "v"(sexp_both)); __builtin_amdgcn_s_setprio(0); } while (0)
#define PG8_WAIT_V(n) asm volatile("s_waitcnt vmcnt(" #n ")" ::: "memory")
#define PG8_WAIT_L(n) asm volatile("s_waitcnt lgkmcnt(" #n ")" ::: "memory")
#define PG8_BAR __builtin_amdgcn_s_barrier()
#define PG8_SCHED __builtin_amdgcn_sched_barrier(0)
    Unit cur, nxt; int ui = 0;
    if (!S.next(0, cur)) return;
    f32x4 acc[2][2][4][2];
#pragma unroll
    for (int a = 0; a < 2; ++a)
#pragma unroll
        for (int b = 0; b < 2; ++b)
#pragma unroll
            for (int m = 0; m < 4; ++m)
#pragma unroll
                for (int n = 0; n < 2; ++n) acc[a][b][m][n] = (f32x4){0.f, 0.f, 0.f, 0.f};
    v8i_t At[4], B0[2], B1[2];
    const char* cA = (const char*)g.A + (size_t)cur.pm * tstep; const char* cB = (const char*)g.Bt + (size_t)cur.pn * tstep;
    S.a_ready(cur);
    if constexpr (SP2) {
        PG8_STAGE(PG8_SB(0, 0), cB, voffB); PG8_STAGE(PG8_SB(0, 1), cB + hstep, voffB); PG8_STAGE(PG8_SA(0, 0), cA, voffA); PG8_STAGE(PG8_SA(0, 1), cA + hstep, voffA);
        if (wr == 1) PG8_BAR;
        PG8_WAIT_V(2); PG8_BAR;
        PG8_STAGE(PG8_SB(1, 0), cB + kstep, voffB); PG8_STAGE(PG8_SA(1, 0), cA + kstep, voffA); PG8_STAGE(PG8_SB(1, 1), cB + hstep + kstep, voffB);
        PG8_WAIT_V(6); PG8_BAR;
    } else {
        PG8_STAGE(PG8_SB(0, 0), cB, voffB); PG8_STAGE(PG8_SA(0, 0), cA, voffA); PG8_STAGE(PG8_SB(0, 1), cB + hstep, voffB); PG8_STAGE(PG8_SA(0, 1), cA + hstep, voffA);
        if (wr == 1) PG8_BAR;
        PG8_WAIT_V(4); PG8_BAR;
        PG8_STAGE(PG8_SB(1, 0), cB + kstep, voffB); PG8_STAGE(PG8_SA(1, 0), cA + kstep, voffA); PG8_STAGE(PG8_SB(1, 1), cB + hstep + kstep, voffB);
        PG8_WAIT_V(6); PG8_BAR;
    }
    for (;;) {
        const bool has_next = S.next(ui + 1, nxt);
        const char* nA = has_next ? (const char*)g.A + (size_t)nxt.pm * tstep : cA; const char* nB = has_next ? (const char*)g.Bt + (size_t)nxt.pn * tstep : cB;
#pragma nounroll
        for (int t = 0; t < nt; t += 2) {
            const bool last = (t == nt - 2);
            const char* a1 = cA + (size_t)(t + 1) * kstep;
            const char* a2 = last ? nA : cA + (size_t)(t + 2) * kstep; const char* b2 = last ? nB : cB + (size_t)(t + 2) * kstep;
            const char* a3 = a2 + kstep; const char* b3 = b2 + kstep;
            if (last && has_next) S.a_ready(nxt);
            if constexpr (SP2) {
            PG8_LDB(B0, 0, 0); PG8_LDB(B1, 0, 1); PG8_SCHED; PG8_LDA(At, 0, 0); PG8_STAGE(PG8_SA(1, 1), a1 + hstep, voffA);
            PG8_WAIT_V(8); PG8_WAIT_L(0); PG8_BAR; PG8_MMA(0, 0, At, B0); PG8_MMA(0, 1, At, B1); PG8_BAR; PG8_SCHED;
            PG8_LDA(At, 0, 1); PG8_STAGE(PG8_SB(0, 0), b2, voffB); PG8_STAGE(PG8_SB(0, 1), b2 + hstep, voffB); PG8_STAGE(PG8_SA(0, 0), a2, voffA);
            PG8_WAIT_V(8); PG8_WAIT_L(0); PG8_BAR; PG8_MMA(1, 0, At, B0); PG8_MMA(1, 1, At, B1); PG8_BAR; PG8_SCHED;
            PG8_LDB(B0, 1, 0); PG8_LDB(B1, 1, 1); PG8_SCHED; PG8_LDA(At, 1, 0); PG8_STAGE(PG8_SA(0, 1), a2 + hstep, voffA);
            PG8_WAIT_V(8); PG8_WAIT_L(0); PG8_BAR; PG8_MMA(0, 0, At, B0); PG8_MMA(0, 1, At, B1); PG8_BAR; PG8_SCHED;
            PG8_LDA(At, 1, 1); PG8_STAGE(PG8_SB(1, 0), b3, voffB); PG8_STAGE(PG8_SB(1, 1), b3 + hstep, voffB); PG8_STAGE(PG8_SA(1, 0), a3, voffA);
            PG8_WAIT_V(8); PG8_WAIT_L(0); PG8_BAR; PG8_MMA(1, 0, At, B0); PG8_MMA(1, 1, At, B1); PG8_BAR; PG8_SCHED;
            } else {
            PG8_LDB(B0, 0, 0); PG8_SCHED; PG8_LDA(At, 0, 0); PG8_STAGE(PG8_SA(1, 1), a1 + hstep, voffA);
            PG8_WAIT_L(8); PG8_BAR; PG8_WAIT_L(0); PG8_MMA(0, 0, At, B0); PG8_BAR; PG8_SCHED;
            PG8_LDB(B1, 0, 1); PG8_STAGE(PG8_SB(0, 0), b2, voffB);
            PG8_BAR; PG8_WAIT_L(0); PG8_MMA(0, 1, At, B1); PG8_BAR;
            PG8_LDA(At, 0, 1); PG8_STAGE(PG8_SA(0, 0), a2, voffA);
            PG8_BAR; PG8_WAIT_L(0); PG8_MMA(1, 0, At, B0); PG8_BAR; PG8_SCHED;
            PG8_STAGE(PG8_SB(0, 1), b2 + hstep, voffB);
            PG8_WAIT_V(6); PG8_BAR; PG8_MMA(1, 1, At, B1); PG8_BAR;
            PG8_LDB(B0, 1, 0); PG8_SCHED; PG8_LDA(At, 1, 0); PG8_STAGE(PG8_SA(0, 1), a2 + hstep, voffA);
            PG8_WAIT_L(8); PG8_BAR; PG8_WAIT_L(0); PG8_MMA(0, 0, At, B0); PG8_BAR; PG8_SCHED;
            PG8_LDB(B1, 1, 1); PG8_STAGE(PG8_SB(1, 0), b3, voffB);
            PG8_BAR; PG8_WAIT_L(0); PG8_MMA(0, 1, At, B1); PG8_BAR;
            PG8_LDA(At, 1, 1); PG8_STAGE(PG8_SA(1, 0), a3, voffA);
            PG8_BAR; PG8_WAIT_L(0); PG8_MMA(1, 0, At, B0); PG8_BAR; PG8_SCHED;
            PG8_STAGE(PG8_SB(1, 1), b3 + hstep, voffB);
            PG8_WAIT_V(6); PG8_BAR; PG8_MMA(1, 1, At, B1); PG8_BAR;
            }
        }
        if constexpr (ALIGN_EPI) { if (wr == 0) PG8_BAR; }
        asm volatile("s_nop 15\n\ts_nop 15" ::: "memory");
        if constexpr (!Epi::AFTER_DRAIN) { int t2_ = tidx_(); asm volatile("" : "+v"(t2_)); const int w2_ = __builtin_amdgcn_readfirstlane(t2_ >> 6), l2_ = t2_ & 63;
            E(acc, cur, w2_ >> 2, w2_ & 3, l2_ & 15, l2_ >> 4); S.done(cur); }
        if (!has_next) break;
#pragma unroll
        for (int a = 0; a < 2; ++a)
#pragma unroll
            for (int b = 0; b < 2; ++b)
#pragma unroll
                for (int m = 0; m < 4; ++m)
#pragma unroll
                    for (int n = 0; n < 2; ++n) acc[a][b][m][n] = (f32x4){0.f, 0.f, 0.f, 0.f};
        cur = nxt; cA = nA; cB = nB; ++ui;
        if constexpr (ALIGN_EPI) { if (wr == 1) PG8_BAR; }
    }
    PG8_WAIT_V(0);
    if constexpr (!ALIGN_EPI) { if (wr == 0) PG8_BAR; }
    PG8_BAR;
    if constexpr (Epi::AFTER_DRAIN) { E.fused(acc, cur, wr, wc, fr, fq, lds, wid, lane); S.done(cur); }
#undef PG8_SA
#undef PG8_SB
#undef PG8_STAGE
#undef PG8_LDA
#undef PG8_LDB
#undef PG8_MMA
#undef PG8_WAIT_V
#undef PG8_WAIT_L
#undef PG8_BAR
#undef PG8_SCHED
}
}

constexpr int NWAVES = 8;
constexpr int BATCH = 8, T = 4096, D = 1024, M = BATCH * T;
constexpr int RW = 512, NH = 8, HD = 64;
constexpr int NZ = 2560;
constexpr int OFF_WD = 1536, OFF_AD = 1600, OFF_GD = 1664, SHIFT_COLS = 1824;
constexpr int OFF_POOL = 1824, OFF_QLAT = 2080, OFF_KVLAT = 2336, OFF_KROPE = 2464, OFF_VD = 2496;
constexpr int N_IN0 = 2496, N_IN1 = 2528;
constexpr int DFF = 2816, NEXP = 8, DFFE = 3584;
constexpr int MLA_H = 4, QK = 96, VD = 64;
constexpr int MOE_CAP = M;
constexpr int MOE_MAXTILES = (2 * M) / 256 + NEXP;

constexpr size_t MiB = 1u << 20;
constexpr size_t WS_CTL = 0, CTL_ZERO_BYTES = 1 * MiB;
constexpr size_t WS_MOD = 1 * MiB;
constexpr size_t WS_COS = 2 * MiB, WS_SIN = 4 * MiB;
constexpr size_t WS_TOK = 8 * MiB;
constexpr size_t WS_GATE = 9 * MiB;
constexpr size_t WS_ASG = 10 * MiB;
constexpr size_t WS_WIN = 16 * MiB;
constexpr size_t WS_WOUT = 26 * MiB;
constexpr size_t WS_WFFI = 30 * MiB;
constexpr size_t WS_WFFO = 41 * MiB;
constexpr size_t WS_WMI = 48 * MiB;
constexpr size_t WS_XB = 112 * MiB;
constexpr size_t WS_WMO = 188 * MiB;
constexpr size_t WS_H = 216 * MiB;
constexpr size_t WS_VF = 280 * MiB;
constexpr size_t WS_BIG = 312 * MiB;
constexpr size_t WS_Z = WS_BIG;
constexpr size_t WS_R = WS_BIG + 160 * MiB;
constexpr size_t WS_K = WS_R + 32 * MiB, WS_V = WS_R + 64 * MiB, WS_KK = WS_R + 96 * MiB, WS_A = WS_R + 128 * MiB;
constexpr size_t WS_LW = WS_R + 160 * MiB;
constexpr size_t WS_G = WS_LW + 64 * MiB;
constexpr size_t WS_QM = WS_G + 32 * MiB;
constexpr size_t WS_KM = WS_QM + 24 * MiB;
constexpr size_t WS_VM = WS_KM + 24 * MiB;
constexpr size_t WS_MIX = WS_VM + 16 * MiB;
constexpr size_t WS_MIX_END = WS_MIX + 64 * MiB;
constexpr size_t WS_ACT = WS_BIG;
constexpr size_t WS_XG = WS_VF;
constexpr size_t WS_YR = WS_VF;
constexpr size_t WS_MACT = WS_VF + 132 * MiB;
constexpr size_t WS_END = WS_MACT + 462 * MiB;
static_assert(WS_MIX_END <= 896 * MiB && WS_END <= 896 * MiB, "d_ws map");
static_assert((size_t)MOE_MAXTILES * 256 * 1024 * 2 <= 132 * MiB && (size_t)MOE_MAXTILES * 256 * 3584 * 2 <= 462 * MiB, "moe buffers");
constexpr int CW_BAR = 4096;
constexpr int CW_MOE = 16384;
constexpr int CW_ATQ = 20480;
static_assert((CW_ATQ + 128) * 4 <= (int)CTL_ZERO_BYTES, "ctl map");

constexpr int RING_OFF = 0, RING_BYTES = 131072;
constexpr int LDSCTL_OFF = RING_BYTES, MISC_OFF = LDSCTL_OFF + 320;
constexpr int LDS_BYTES = 147456;

#define GAS __attribute__((address_space(1)))
#define LAS __attribute__((address_space(3)))
typedef unsigned short bf16;
typedef unsigned v4u __attribute__((ext_vector_type(4)));
typedef unsigned v2u __attribute__((ext_vector_type(2)));
typedef float f32x4 __attribute__((ext_vector_type(4)));
typedef short bf16x8 __attribute__((ext_vector_type(8)));
typedef GAS unsigned gu32;
#define RLX_AGENT __ATOMIC_RELAXED, __HIP_MEMORY_SCOPE_AGENT
#define LDS_WAIT() asm volatile("s_waitcnt lgkmcnt(0)" ::: "memory")
#define VM_WAIT() asm volatile("s_waitcnt vmcnt(0)" ::: "memory")
__device__ __forceinline__ unsigned cvtpk(float lo, float hi) { typedef float f2_t __attribute__((ext_vector_type(2))); typedef __bf16 b2_t __attribute__((ext_vector_type(2)));
    f2_t v = {lo, hi}; b2_t b = __builtin_convertvector(v, b2_t); return __builtin_bit_cast(unsigned, b); }
__device__ __forceinline__ unsigned f2bf(float f) { return cvtpk(f, f) & 0xffffu; }
__device__ __forceinline__ unsigned pk2(float lo, float hi) { return cvtpk(lo, hi); }
__device__ __forceinline__ float bf2f(bf16 v) { return __uint_as_float(((unsigned)v) << 16); }
__device__ __forceinline__ float bflo(unsigned w) { return __uint_as_float(w << 16); }
__device__ __forceinline__ float bfhi(unsigned w) { return __uint_as_float(w & 0xffff0000u); }
__device__ __forceinline__ unsigned f8pk2(float a, float b) { a = fminf(fmaxf(a, -448.f), 448.f); b = fminf(fmaxf(b, -448.f), 448.f); return (unsigned)__builtin_amdgcn_cvt_pk_fp8_f32(a, b, 0, false) & 0xffffu; }
__device__ __forceinline__ unsigned f8pk4(float a, float b, float c_, float d) { a = fminf(fmaxf(a, -448.f), 448.f); b = fminf(fmaxf(b, -448.f), 448.f); c_ = fminf(fmaxf(c_, -448.f), 448.f); d = fminf(fmaxf(d, -448.f), 448.f);
    int w = __builtin_amdgcn_cvt_pk_fp8_f32(a, b, 0, false); w = __builtin_amdgcn_cvt_pk_fp8_f32(c_, d, w, true); return (unsigned)w; }
constexpr float F8_WSCALE = 64.f, F8_HSCALE = 8.f, F8_ASCALE = 4.f;
constexpr int F8_WEXP = 127 - 6, F8_HEXP = 127 - 3, F8_AEXP = 127 - 2;
__device__ __forceinline__ float sigmoidf_(float x) { return __builtin_amdgcn_rcpf(1.f + __expf(-x)); }
__device__ __forceinline__ float tanhf_(float x) { const float e = __expf(2.f * x); return 1.f - 2.f * __builtin_amdgcn_rcpf(1.f + e); }
__device__ __forceinline__ float half_sum32(float v) {
    v += __int_as_float(__builtin_amdgcn_mov_dpp(__float_as_int(v), 0xB1, 0xF, 0xF, true));
    v += __int_as_float(__builtin_amdgcn_mov_dpp(__float_as_int(v), 0x4E, 0xF, 0xF, true));
    v += __int_as_float(__builtin_amdgcn_mov_dpp(__float_as_int(v), 0x141, 0xF, 0xF, true));
    v += __int_as_float(__builtin_amdgcn_mov_dpp(__float_as_int(v), 0x140, 0xF, 0xF, true));
    v += __int_as_float(__builtin_amdgcn_ds_swizzle(__float_as_int(v), 0x401F));
    return v;
}
__device__ __forceinline__ float other_half(float v) { const unsigned u = __float_as_uint(v); auto rr = __builtin_amdgcn_permlane32_swap(u, u, false, false); return __uint_as_float(rr[0] == u ? rr[1] : rr[0]); }
__device__ __forceinline__ float wave_sum(float v) { v = half_sum32(v); const unsigned u = __float_as_uint(v); auto rr = __builtin_amdgcn_permlane32_swap(u, u, false, false); return __uint_as_float(rr[0]) + __uint_as_float(rr[1]); }

__device__ __forceinline__ void st_put(LAS unsigned char* ST, int i, int col, float v) { *(LAS bf16*)(ST + i * 256 + col * 2) = (bf16)f2bf(v); }
template <int NCOLS> __device__ __forceinline__ void st_flush(LAS unsigned char* ST, bf16* gbase, int rowstride, int lane, bool dry) {
    constexpr int CPR = NCOLS / 8, TOTAL = 32 * CPR;
    LDS_WAIT();
#pragma unroll
    for (int k = 0; k < (TOTAL + 63) / 64; ++k) { const int c = lane + 64 * k;
        if (c < TOTAL) { const int row = c / CPR, ch = c % CPR; const v4u v = *(const LAS v4u*)(ST + row * 256 + ch * 16); if (!dry) *(v4u*)(gbase + (unsigned)(row * rowstride + ch * 8)) = v; } }
    LDS_WAIT();
}
__device__ __forceinline__ void st_flush_kimg(LAS unsigned char* ST, bf16* gtile, int lane, bool dry) {
    LDS_WAIT();
#pragma unroll
    for (int k = 0; k < 6; ++k) { const int c = (lane & 63) + 64 * k; const int ch = c >> 5, row = c & 31;
        const v4u v = *(const LAS v4u*)(ST + row * 256 + ch * 16); if (!dry) *(v4u*)(gtile + (unsigned)(ch * 512 + row * 8)) = v; }
    LDS_WAIT();
}
__device__ __forceinline__ int fresh_lane() { return lane_id_(); }
__device__ __forceinline__ float rsq_(float x) { return __builtin_amdgcn_rsqf(x); }
__device__ __forceinline__ float rcp_(float x) { return __builtin_amdgcn_rcpf(x); }
#define XB_TMO      128
#define XB_XCNT(j)  (256  + 64 * (j))
#define XB_XSUB(j)  (1280 + 64 * (j))
#define XB_XGEN(j)  (2304 + 64 * (j))
#define XB_TOP      3328
#define XB_TOPGEN   3392
#define XCD_BAR_WORDS 3456
#define XB_SPIN_CAP (1u << 18)
__device__ __forceinline__ unsigned xb_ld(unsigned* p)              { return __hip_atomic_load(p, __ATOMIC_RELAXED, __HIP_MEMORY_SCOPE_AGENT); }
__device__ __forceinline__ unsigned xb_add(unsigned* p, unsigned v) { return __hip_atomic_fetch_add(p, v, __ATOMIC_RELAXED, __HIP_MEMORY_SCOPE_AGENT); }
__device__ __forceinline__ unsigned xb_xcc_id() { return (unsigned)__builtin_amdgcn_s_getreg((3 << 11) | 20) & 0xFu; }
#define XB_SPIN(cond, bar) do { unsigned _sp = 0; while (cond) { __builtin_amdgcn_s_sleep(1); \
    if ((++_sp & 255u) == 0u) { if (xb_ld(&(bar)[XB_TMO])) break; if (_sp > XB_SPIN_CAP) { atomicAdd(&(bar)[XB_TMO], 1u); break; } } } } while (0)
struct XcdBarrier { unsigned* bar; unsigned x; volatile LAS unsigned* st; };
__device__ __forceinline__ XcdBarrier xcd_barrier_post(unsigned* bar, volatile LAS unsigned* st) {
    XcdBarrier b; b.bar = bar; b.x = xb_xcc_id(); b.st = st;
    if (tidx_() == 0) (void)xb_add(&bar[XB_XCNT(b.x)], 1u);
    return b;
}
__device__ __forceinline__ void xcd_barrier_complete(unsigned* bar, unsigned x, unsigned& nloc, unsigned& nx) {
    const unsigned G = gridDim.x * gridDim.y * gridDim.z;
    unsigned sum, cnt, mine, sp = 0u;
    for (;;) {
        sum = 0u; cnt = 0u; mine = 0u;
#pragma unroll
        for (unsigned j = 0; j < 16; ++j) { const unsigned c = xb_ld(&bar[XB_XCNT(j)]); sum += c; cnt += (c > 0u) ? 1u : 0u; mine = (j == x) ? c : mine; }
        if (sum == G) break;
        __builtin_amdgcn_s_sleep(1);
        if ((++sp & 255u) == 0u) { if (xb_ld(&bar[XB_TMO])) break; if (sp > XB_SPIN_CAP) { atomicAdd(&bar[XB_TMO], 1u); break; } }
    }
    nloc = mine > 0u ? mine : 1u; nx = cnt > 0u ? cnt : 1u;
}
__device__ __forceinline__ void xcd_barrier(const XcdBarrier& b) {
    asm volatile("s_waitcnt vmcnt(0)" ::: "memory");
    __syncthreads();
    if (tidx_() == 0) {
        unsigned* bar = b.bar;
        __builtin_amdgcn_s_waitcnt(0);
        unsigned nloc = b.st[0], nx = b.st[1];
        if (nloc == 0u) { xcd_barrier_complete(bar, b.x, nloc, nx); b.st[0] = nloc; b.st[1] = nx; }
        const unsigned old = xb_add(&bar[XB_XSUB(b.x)], 1u);
        const unsigned gen = old / nloc;
        if (old + 1u == (gen + 1u) * nloc) {
            __builtin_amdgcn_fence(__ATOMIC_RELEASE, "agent");
            asm volatile("s_waitcnt vmcnt(0)" ::: "memory");
            const unsigned og = xb_add(&bar[XB_TOP], 1u);
            const unsigned tg = og / nx;
            if (og + 1u == (tg + 1u) * nx) xb_add(&bar[XB_TOPGEN], 1u);
            else XB_SPIN(xb_ld(&bar[XB_TOPGEN]) == tg, bar);
            __builtin_amdgcn_fence(__ATOMIC_ACQUIRE, "agent");
            xb_add(&bar[XB_XGEN(b.x)], 1u);
            asm volatile("s_waitcnt vmcnt(0)" ::: "memory");
        } else {
            XB_SPIN(xb_ld(&bar[XB_XGEN(b.x)]) == gen, bar);
            __builtin_amdgcn_fence(__ATOMIC_ACQUIRE, "agent");
            asm volatile("s_waitcnt vmcnt(0)" ::: "memory");
        }
    }
    __syncthreads();
}

struct Args { const float* in[29]; float* out; unsigned char* ws; int ph_lo, ph_hi, li, pad; };
static_assert(sizeof(Args) == 29 * 8 + 8 + 8 + 16, "Args has no padding");
enum { I_X = 0, I_C, I_POS, I_WADA, I_BADA, I_NGAIN, I_WIN0, I_WIN1, I_MU, I_MUV, I_RVEC, I_RV0, I_RW2, I_RA2, I_RG2, I_RV2, I_POOLW, I_POOLS,
       I_QLG, I_KVLG, I_WQUP, I_WKVUP, I_QKG, I_WOUT, I_FFI, I_FFO, I_ROUTER, I_MOEI, I_MOEO };

namespace pg8 {
struct EpiRes {
    static constexpr bool PERM = false, AFTER_DRAIN = false;
    const float* xsrc; float* out; const float* gate;
    __device__ __forceinline__ void operator()(const f32x4 (&acc)[2][2][4][2], const Unit& u, int wr, int wc, int fr, int fq) const {
        const int row0 = u.pm * BM + wr * 64 + fr, col0 = u.pn * BM + wc * 32 + 4 * fq;
        const float* gb = gate + (size_t)((u.pm * BM) / T) * 6144;
        f32x4 gv[2][2];
#pragma unroll
        for (int bj = 0; bj < 2; ++bj)
#pragma unroll
            for (int n = 0; n < 2; ++n) gv[bj][n] = *(const f32x4*)(gb + col0 + bj * HALF + n * 16);
        f32x4 xs[2][2], xn[2][2];
        { const size_t off = (size_t)row0 * 1024 + col0;
#pragma unroll
          for (int bj = 0; bj < 2; ++bj)
#pragma unroll
              for (int n = 0; n < 2; ++n) xs[bj][n] = *(const f32x4*)(xsrc + off + bj * HALF + n * 16); }
#pragma unroll
        for (int g = 0; g < 8; ++g) { const int ai = g >> 2, m = g & 3;
            const size_t off = (size_t)(row0 + ai * HALF + m * 16) * 1024 + col0;
            if (g + 1 < 8) { const size_t offn = (size_t)(row0 + ((g + 1) >> 2) * HALF + ((g + 1) & 3) * 16) * 1024 + col0;
#pragma unroll
                for (int bj = 0; bj < 2; ++bj)
#pragma unroll
                    for (int n = 0; n < 2; ++n) xn[bj][n] = *(const f32x4*)(xsrc + offn + bj * HALF + n * 16); }
#pragma unroll
            for (int bj = 0; bj < 2; ++bj)
#pragma unroll
                for (int n = 0; n < 2; ++n) *(f32x4*)(out + off + bj * HALF + n * 16) = xs[bj][n] + gv[bj][n] * acc[ai][bj][m][n];
#pragma unroll
            for (int bj = 0; bj < 2; ++bj)
#pragma unroll
                for (int n = 0; n < 2; ++n) xs[bj][n] = xn[bj][n];
        }
    }
};
template <bool XF32> struct EpiResB {
    static constexpr bool PERM = true, AFTER_DRAIN = false;
    const void* xsrc; bf16_t* out; const float* gate;
    __device__ __forceinline__ void ldx(f32x4 (&d)[2][2], size_t off) const {
#pragma unroll
        for (int bj = 0; bj < 2; ++bj) {
            if constexpr (XF32) { d[bj][0] = *(const f32x4*)((const float*)xsrc + off + bj * HALF); d[bj][1] = *(const f32x4*)((const float*)xsrc + off + bj * HALF + 4); }
            else { const u32x4 r = *(const u32x4*)((const bf16_t*)xsrc + off + bj * HALF);
                   d[bj][0] = (f32x4){bflo(r.x), bfhi(r.x), bflo(r.y), bfhi(r.y)}; d[bj][1] = (f32x4){bflo(r.z), bfhi(r.z), bflo(r.w), bfhi(r.w)}; } }
    }
    __device__ __forceinline__ void operator()(const f32x4 (&acc)[2][2][4][2], const Unit& u, int wr, int wc, int fr, int fq) const {
        const int row0 = u.pm * BM + wr * 64 + fr, col0 = u.pn * BM + wc * 32 + 8 * fq;
        const float* gb = gate + (size_t)((u.pm * BM) / T) * 6144;
        f32x4 gv[2][2];
#pragma unroll
        for (int bj = 0; bj < 2; ++bj)
#pragma unroll
            for (int n = 0; n < 2; ++n) gv[bj][n] = *(const f32x4*)(gb + col0 + bj * HALF + 4 * n);
        f32x4 xs[2][2], xn[2][2];
        ldx(xs, (size_t)row0 * 1024 + col0);
#pragma unroll
        for (int g = 0; g < 8; ++g) { const int ai = g >> 2, m = g & 3;
            const size_t off = (size_t)(row0 + ai * HALF + m * 16) * 1024 + col0;
            if (g + 1 < 8) ldx(xn, (size_t)(row0 + ((g + 1) >> 2) * HALF + ((g + 1) & 3) * 16) * 1024 + col0);
#pragma unroll
            for (int bj = 0; bj < 2; ++bj) { const f32x4 y0 = xs[bj][0] + gv[bj][0] * acc[ai][bj][m][0], y1 = xs[bj][1] + gv[bj][1] * acc[ai][bj][m][1];
                u32x4 w; w.x = cvt_pk_bf16(y0[0], y0[1]); w.y = cvt_pk_bf16(y0[2], y0[3]); w.z = cvt_pk_bf16(y1[0], y1[1]); w.w = cvt_pk_bf16(y1[2], y1[3]);
                *(u32x4*)(out + off + bj * HALF) = w; }
#pragma unroll
            for (int bj = 0; bj < 2; ++bj)
#pragma unroll
                for (int n = 0; n < 2; ++n) xs[bj][n] = xn[bj][n];
        }
    }
};
__device__ __forceinline__ f32x2 swiglu_pk(f32x2 g, f32x2 u, float inv_s) {
    const f32x2 t = g * (-1.4426950408889634f);
    f32x2 e; e.x = __builtin_amdgcn_exp2f(t.x); e.y = __builtin_amdgcn_exp2f(t.y);
    const f32x2 d = e * inv_s + inv_s;
    f32x2 r; r.x = __builtin_amdgcn_rcpf(d.x); r.y = __builtin_amdgcn_rcpf(d.y);
    return (g * u) * r;
}
struct EpiSwiglu {
    static constexpr bool PERM = true, AFTER_DRAIN = false;
    bf16_t* O; int ldo; int npn;
    __device__ __forceinline__ void operator()(const f32x4 (&acc)[2][2][4][2], const Unit& u, int wr, int wc, int fr, int fq) const {
        const int row0 = u.pm * BM + wr * 64 + fr, col0 = (u.pn % npn) * HALF + wc * 32 + 8 * fq;
#pragma unroll
        for (int ai = 0; ai < 2; ++ai)
#pragma unroll
            for (int m = 0; m < 4; ++m) { bf16_t* rowp = O + (size_t)(row0 + ai * HALF + m * 16) * ldo + col0;
                float o[8];
#pragma unroll
                for (int n = 0; n < 2; ++n)
#pragma unroll
                    for (int j = 0; j < 4; j += 2) { const f32x2 r = swiglu_pk((f32x2){acc[ai][0][m][n][j], acc[ai][0][m][n][j + 1]}, (f32x2){acc[ai][1][m][n][j], acc[ai][1][m][n][j + 1]}, 1.f); o[n * 4 + j] = r.x; o[n * 4 + j + 1] = r.y; }
                u32x4 w; w.x = cvt_pk_bf16(o[0], o[1]); w.y = cvt_pk_bf16(o[2], o[3]); w.z = cvt_pk_bf16(o[4], o[5]); w.w = cvt_pk_bf16(o[6], o[7]);
                *(u32x4*)rowp = w; }
    }
};
struct EpiSwigluF8 {
    static constexpr bool PERM = true, AFTER_DRAIN = false;
    unsigned char* O; int ldo; int npn;
    __device__ __forceinline__ void operator()(const f32x4 (&acc)[2][2][4][2], const Unit& u, int wr, int wc, int fr, int fq) const {
        const int row0 = u.pm * BM + wr * 64 + fr, col0 = (u.pn % npn) * HALF + wc * 32 + 8 * fq;
#pragma unroll
        for (int ai = 0; ai < 2; ++ai)
#pragma unroll
            for (int m = 0; m < 4; ++m) { unsigned char* rowp = O + (size_t)(row0 + ai * HALF + m * 16) * ldo + col0;
                float o[8];
#pragma unroll
                for (int n = 0; n < 2; ++n)
#pragma unroll
                    for (int j = 0; j < 4; j += 2) { const f32x2 r = swiglu_pk((f32x2){acc[ai][0][m][n][j], acc[ai][0][m][n][j + 1]}, (f32x2){acc[ai][1][m][n][j], acc[ai][1][m][n][j + 1]}, 1.f / F8_ASCALE); o[n * 4 + j] = r.x; o[n * 4 + j + 1] = r.y; }
                v2u w; w.x = f8pk4(o[0], o[1], o[2], o[3]); w.y = f8pk4(o[4], o[5], o[6], o[7]);
                asm volatile("" : "+v"(w.x), "+v"(w.y));
                *(v2u*)rowp = w; }
    }
};
struct EpiMoeOut {
    static constexpr bool PERM = true, AFTER_DRAIN = false;
    bf16_t* O;
    __device__ __forceinline__ void operator()(const f32x4 (&acc)[2][2][4][2], const Unit& u, int wr, int wc, int fr, int fq) const {
        const int row0 = u.pm * BM + wr * 64 + fr, col0 = (u.pn & 3) * BM + wc * 32 + 8 * fq;
#pragma unroll
        for (int ai = 0; ai < 2; ++ai)
#pragma unroll
            for (int m = 0; m < 4; ++m) { bf16_t* rowp = O + (size_t)(row0 + ai * HALF + m * 16) * 1024 + col0;
#pragma unroll
                for (int bj = 0; bj < 2; ++bj) { const f32x4 v0 = acc[ai][bj][m][0], v1 = acc[ai][bj][m][1];
                    u32x4 w; w.x = cvt_pk_bf16(v0[0], v0[1]); w.y = cvt_pk_bf16(v0[2], v0[3]); w.z = cvt_pk_bf16(v1[0], v1[1]); w.w = cvt_pk_bf16(v1[2], v1[3]);
                    *(u32x4*)(rowp + bj * HALF) = w; } }
    }
};
struct MoeOrder {
    int npn, nunits, G, c; int ts1, ts2, ts3, ts4, ts5, ts6, ts7;
    __device__ __forceinline__ bool next(int i, Unit& u) const {
        const int s = (c & 7) * (G >> 3) + (c >> 3);
        const int L = i * G + s; if (L >= nunits) return false;
        const int nrt = nunits / npn, nig = 8 * npn, gid = L / nig, fm = gid * 8, gsz = (nrt - fm) < 8 ? (nrt - fm) : 8, r = L % nig;
        const int rt = fm + r % gsz, pl = r / gsz;
        const int e = (rt >= ts1) + (rt >= ts2) + (rt >= ts3) + (rt >= ts4) + (rt >= ts5) + (rt >= ts6) + (rt >= ts7);
        u.pm = rt; u.pn = e * npn + pl; return true;
    }
    __device__ __forceinline__ void a_ready(const Unit&) const {}
    __device__ __forceinline__ void done(const Unit&) const {}
};
}

typedef float f32x16 __attribute__((ext_vector_type(16)));
constexpr int CHK = 32, NCHK = T / CHK;
constexpr size_t WS_SM = WS_R;
constexpr size_t WS_SNT = WS_R + 64 * MiB;
constexpr size_t WS_SRP = WS_R + 128 * MiB;
constexpr size_t WS_SYL = WS_H;
constexpr size_t WS_XV = WS_H + 32 * MiB;
constexpr size_t WS_BON = WS_MIX_END;
static_assert(WS_BON + 1 * MiB <= 896 * MiB, "ws");

__device__ __forceinline__ bf16x8 mkfrag(unsigned a, unsigned b, unsigned c, unsigned d) { v4u w = {a, b, c, d}; return __builtin_bit_cast(bf16x8, w); }
__device__ __forceinline__ bf16x8 accfrag(const f32x16& a, int s2) {
    return s2 == 0 ? mkfrag(cvtpk(a[0], a[1]), cvtpk(a[2], a[3]), cvtpk(a[4], a[5]), cvtpk(a[6], a[7]))
                   : mkfrag(cvtpk(a[8], a[9]), cvtpk(a[10], a[11]), cvtpk(a[12], a[13]), cvtpk(a[14], a[15]));
}
#define MFMA32(A, B, C) __builtin_amdgcn_mfma_f32_32x32x16_bf16((A), (B), (C), 0, 0, 0)
__device__ __forceinline__ int tm_addr(int row, int chunk) { return row * 128 + ((chunk ^ ((row >> 1) & 7)) << 4); }
__device__ __forceinline__ int cm_addr(int row, int chunk) { return row * 64 + ((chunk ^ ((row >> 2) & 3)) << 4); }
__device__ __forceinline__ int qrow(int r, int h) { return (r & 3) + 8 * (r >> 2) + 4 * h; }

template <int MODE>
__device__ __forceinline__ void scan_pass(const bf16* Rg, const bf16* Kg, const bf16* Vg, const bf16* KKg, const bf16* Ag, const float* LWg, size_t base,
                                          LAS unsigned char* L, LAS float* gC, int lane) {
    float cum = 0.f;
    if constexpr (MODE == 0) {
#pragma unroll 8
        for (int t = 0; t < CHK; ++t) {
            const size_t o = base + (size_t)t * RW + lane;
            const float kk = bf2f(KKg[o]), a = bf2f(Ag[o]), k = bf2f(Kg[o]), r = bf2f(Rg[o]), lw = LWg[o];
            const float cumx = cum; cum += lw;
            const float ea = __expf(cumx), eb = __expf(-cum), er = __expf(cum);
            const int ad = tm_addr(t, lane >> 3) + (lane & 7) * 2;
            *(LAS bf16*)(L + ad) = (bf16)f2bf(-kk * ea);
            *(LAS bf16*)(L + 4096 + ad) = (bf16)f2bf(kk * a * eb);
            *(LAS bf16*)(L + 8192 + ad) = (bf16)f2bf(k * eb);
            *(LAS bf16*)(L + 12288 + ad) = (bf16)f2bf(r * er);
        }
        gC[lane] = __expf(cum);
    } else {
#pragma unroll
        for (int s2 = 0; s2 < 2; ++s2) {
            float xa[16], xv[16], xb[16], xk[16];
#pragma unroll
            for (int u = 0; u < 16; ++u) {
                const size_t o = base + (size_t)(s2 * 16 + u) * RW + lane;
                const float kk = bf2f(KKg[o]), a = bf2f(Ag[o]), k = bf2f(Kg[o]), v = bf2f(Vg[o]), lw = LWg[o];
                const float cumx = cum; cum += lw;
                const float ea = __expf(cumx), eb = __expf(-cum);
                xa[u] = -kk * ea; xv[u] = v; xb[u] = kk * a * eb; xk[u] = k * eb;
            }
#pragma unroll
            for (int h = 0; h < 2; ++h) {
                const int ad = cm_addr(lane, 2 * s2 + h); const int u0 = 4 * h, u1 = 8 + 4 * h;
                *(LAS v4u*)(L + ad) = (v4u){cvtpk(xa[u0], xa[u0 + 1]), cvtpk(xa[u0 + 2], xa[u0 + 3]), cvtpk(xa[u1], xa[u1 + 1]), cvtpk(xa[u1 + 2], xa[u1 + 3])};
                *(LAS v4u*)(L + 4096 + ad) = (v4u){cvtpk(xv[u0], xv[u0 + 1]), cvtpk(xv[u0 + 2], xv[u0 + 3]), cvtpk(xv[u1], xv[u1 + 1]), cvtpk(xv[u1 + 2], xv[u1 + 3])};
                *(LAS v4u*)(L + 8192 + ad) = (v4u){cvtpk(xb[u0], xb[u0 + 1]), cvtpk(xb[u0 + 2], xb[u0 + 3]), cvtpk(xb[u1], xb[u1 + 1]), cvtpk(xb[u1 + 2], xb[u1 + 3])};
                *(LAS v4u*)(L + 12288 + ad) = (v4u){cvtpk(xk[u0], xk[u0 + 1]), cvtpk(xk[u0 + 2], xk[u0 + 3]), cvtpk(xk[u1], xk[u1 + 1]), cvtpk(xk[u1 + 2], xk[u1 + 3])};
            }
        }
    }
}

__device__ __forceinline__ void scan_local_item(unsigned char* ws, int item, LAS unsigned char* L, LAS float* gC, int lane) {
    const int hh = item % NH, bn = item / NH;
    const size_t base = (size_t)bn * CHK * RW + hh * 64;
    const bf16* Rg = (const bf16*)(ws + WS_R); const bf16* Kg = (const bf16*)(ws + WS_K); const bf16* Vg = (const bf16*)(ws + WS_V); const bf16* KKg = (const bf16*)(ws + WS_KK); const bf16* Ag = (const bf16*)(ws + WS_A);
    const float* LWg = (const float*)(ws + WS_LW);
    const int p = lane & 31, h = lane >> 5;
    const f32x16 zero16 = {0.f, 0.f, 0.f, 0.f, 0.f, 0.f, 0.f, 0.f, 0.f, 0.f, 0.f, 0.f, 0.f, 0.f, 0.f, 0.f};
    LDS_WAIT();
    scan_pass<0>(Rg, Kg, Vg, KKg, Ag, LWg, base, L, gC, lane);
    LDS_WAIT();
    f32x16 Aab = zero16, AabT = zero16, Aak = zero16, Arb = zero16, Ark = zero16;
#pragma unroll
    for (int s = 0; s < 4; ++s) {
        const int ad = tm_addr(p, 2 * s + h);
        const bf16x8 fa = *(const LAS bf16x8*)(L + ad), fb = *(const LAS bf16x8*)(L + 4096 + ad), fk = *(const LAS bf16x8*)(L + 8192 + ad), fr = *(const LAS bf16x8*)(L + 12288 + ad);
        Aab = MFMA32(fb, fa, Aab); AabT = MFMA32(fa, fb, AabT); Aak = MFMA32(fk, fa, Aak); Arb = MFMA32(fb, fr, Arb); Ark = MFMA32(fk, fr, Ark);
    }
    unsigned rin[2][8];
#pragma unroll
    for (int ct = 0; ct < 2; ++ct)
#pragma unroll
        for (int g = 0; g < 4; ++g) { const v2u w = *(const LAS v2u*)(L + 12288 + tm_addr(p, 4 * ct + g) + 8 * h); rin[ct][2 * g] = w.x; rin[ct][2 * g + 1] = w.y; }
#pragma unroll
    for (int r = 0; r < 16; ++r) { const int q = qrow(r, h);
        Aab[r] = (q < p) ? Aab[r] : 0.f;  Aak[r] = (q < p) ? Aak[r] : 0.f;
        AabT[r] = (p < q) ? AabT[r] : 0.f;
        Arb[r] = (q <= p) ? Arb[r] : 0.f; Ark[r] = (q <= p) ? Ark[r] : 0.f; }
    f32x16 Tm = Aab;
#pragma unroll
    for (int r = 0; r < 16; ++r) Tm[r] += (qrow(r, h) == p) ? 1.f : 0.f;
    bf16x8 X0 = accfrag(Aab, 0), X1 = accfrag(Aab, 1), XT0 = accfrag(AabT, 0), XT1 = accfrag(AabT, 1);
#pragma unroll
    for (int it = 0; it < 4; ++it) {
        f32x16 X2T = MFMA32(X0, XT0, zero16); X2T = MFMA32(X1, XT1, X2T);
        const bf16x8 T0 = accfrag(Tm, 0), T1 = accfrag(Tm, 1);
        const bf16x8 Y0 = accfrag(X2T, 0), Y1 = accfrag(X2T, 1);
        Tm = MFMA32(Y0, T0, Tm); Tm = MFMA32(Y1, T1, Tm);
        if (it < 3) { f32x16 X2 = MFMA32(XT0, X0, zero16); X2 = MFMA32(XT1, X1, X2);
            X0 = accfrag(X2, 0); X1 = accfrag(X2, 1); XT0 = Y0; XT1 = Y1; }
    }
    const bf16x8 Tf0 = accfrag(Tm, 0), Tf1 = accfrag(Tm, 1);
    const bf16x8 Akf0 = accfrag(Aak, 0), Akf1 = accfrag(Aak, 1), Abf0 = accfrag(Arb, 0), Abf1 = accfrag(Arb, 1), Arf0 = accfrag(Ark, 0), Arf1 = accfrag(Ark, 1);
    LDS_WAIT();
    scan_pass<1>(Rg, Kg, Vg, KKg, Ag, LWg, base, L, gC, lane);
    LDS_WAIT();
    bf16x8 fAT[2][2], fVT[2][2], fBT[2][2], fKT[2][2];
#pragma unroll
    for (int ct = 0; ct < 2; ++ct)
#pragma unroll
        for (int s2 = 0; s2 < 2; ++s2) { const int ad = cm_addr(32 * ct + p, 2 * s2 + h);
            fAT[ct][s2] = *(const LAS bf16x8*)(L + ad); fVT[ct][s2] = *(const LAS bf16x8*)(L + 4096 + ad); fBT[ct][s2] = *(const LAS bf16x8*)(L + 8192 + ad); fKT[ct][s2] = *(const LAS bf16x8*)(L + 12288 + ad); }
    bf16x8 fPT[2][2], fQT[2][2];
#pragma unroll
    for (int ct = 0; ct < 2; ++ct) {
        f32x16 a = MFMA32(Tf0, fAT[ct][0], zero16); a = MFMA32(Tf1, fAT[ct][1], a); fPT[ct][0] = accfrag(a, 0); fPT[ct][1] = accfrag(a, 1);
        f32x16 b = MFMA32(Akf0, fVT[ct][0], zero16); b = MFMA32(Akf1, fVT[ct][1], b);
        const bf16x8 av0 = accfrag(b, 0), av1 = accfrag(b, 1);
        f32x16 c = MFMA32(Tf0, av0, zero16); c = MFMA32(Tf1, av1, c); fQT[ct][0] = accfrag(c, 0); fQT[ct][1] = accfrag(c, 1);
    }
    bf16* RPo = (bf16*)(ws + WS_SRP) + (size_t)item * 2048; bf16* YLo = (bf16*)(ws + WS_SYL) + (size_t)item * 2048;
    bf16* Mo = (bf16*)(ws + WS_SM) + (size_t)item * 4096; bf16* NTo = (bf16*)(ws + WS_SNT) + (size_t)item * 4096;
#pragma unroll
    for (int ct = 0; ct < 2; ++ct) {
        f32x16 a;
#pragma unroll
        for (int g = 0; g < 8; ++g) { a[2 * g] = bflo(rin[ct][g]); a[2 * g + 1] = bfhi(rin[ct][g]); }
        a = MFMA32(fPT[ct][0], Abf0, a); a = MFMA32(fPT[ct][1], Abf1, a);
#pragma unroll
        for (int s2 = 0; s2 < 2; ++s2) *(bf16x8*)(RPo + p * 64 + (4 * ct + 2 * s2 + h) * 8) = accfrag(a, s2);
        f32x16 y = MFMA32(Abf0, fQT[ct][0], zero16); y = MFMA32(Abf1, fQT[ct][1], y); y = MFMA32(Arf0, fVT[ct][0], y); y = MFMA32(Arf1, fVT[ct][1], y);
#pragma unroll
        for (int s2 = 0; s2 < 2; ++s2) *(bf16x8*)(YLo + (32 * ct + p) * 32 + (2 * s2 + h) * 8) = accfrag(y, s2);
    }
#pragma unroll
    for (int ctp = 0; ctp < 2; ++ctp) {
        const float gl = gC[32 * ctp + p];
#pragma unroll
        for (int ct = 0; ct < 2; ++ct) {
            f32x16 m = MFMA32(fPT[ct][0], fBT[ctp][0], zero16); m = MFMA32(fPT[ct][1], fBT[ctp][1], m);
#pragma unroll
            for (int r = 0; r < 16; ++r) m[r] = (m[r] + ((ct == ctp && qrow(r, h) == p) ? 1.f : 0.f)) * gl;
#pragma unroll
            for (int s2 = 0; s2 < 2; ++s2) *(bf16x8*)(Mo + (32 * ctp + p) * 64 + (4 * ct + 2 * s2 + h) * 8) = accfrag(m, s2);
        }
    }
#pragma unroll
    for (int ctd = 0; ctd < 2; ++ctd)
#pragma unroll
        for (int ctp = 0; ctp < 2; ++ctp) {
            f32x16 n = MFMA32(fBT[ctp][0], fQT[ctd][0], zero16); n = MFMA32(fBT[ctp][1], fQT[ctd][1], n); n = MFMA32(fKT[ctp][0], fVT[ctd][0], n); n = MFMA32(fKT[ctp][1], fVT[ctd][1], n);
#pragma unroll
            for (int r = 0; r < 16; ++r) n[r] *= gC[32 * ctp + qrow(r, h)];
#pragma unroll
            for (int s2 = 0; s2 < 2; ++s2) *(bf16x8*)(NTo + (32 * ctd + p) * 64 + (4 * ctp + 2 * s2 + h) * 8) = accfrag(n, s2);
        }
}

__device__ __forceinline__ void ph_scan_local(unsigned char* ws, LAS unsigned char* lds, int gw, int NGW, int wave, int lane) {
    LAS unsigned char* L = lds + RING_OFF + wave * 16384;
    LAS float* gC = (LAS float*)(lds + LDSCTL_OFF + 4096) + wave * 64;
    for (int item = gw; item < BATCH * NCHK * NH; item += NGW) scan_local_item(ws, item, L, gC, lane);
}

__device__ __forceinline__ f32x16 ld_acc_bf16(const bf16* p0, const bf16* p1) {
    const v4u a = *(const v4u*)p0, b = *(const v4u*)p1; f32x16 r;
    r[0] = bflo(a.x); r[1] = bfhi(a.x); r[2] = bflo(a.y); r[3] = bfhi(a.y); r[4] = bflo(a.z); r[5] = bfhi(a.z); r[6] = bflo(a.w); r[7] = bfhi(a.w);
    r[8] = bflo(b.x); r[9] = bfhi(b.x); r[10] = bflo(b.y); r[11] = bfhi(b.y); r[12] = bflo(b.z); r[13] = bfhi(b.z); r[14] = bflo(b.w); r[15] = bfhi(b.w); return r;
}
constexpr size_t WS_SS = WS_LW;
__device__ __forceinline__ void scan_carry(unsigned char* ws, int bh, int ctd, int lane) {
    const int b = bh / NH, hh = bh % NH; const int p = lane & 31, h = lane >> 5;
    const bf16* Mb = (const bf16*)(ws + WS_SM); const bf16* NTb = (const bf16*)(ws + WS_SNT); bf16* Sg = (bf16*)(ws + WS_SS);
    const f32x16 zero16 = {0.f, 0.f, 0.f, 0.f, 0.f, 0.f, 0.f, 0.f, 0.f, 0.f, 0.f, 0.f, 0.f, 0.f, 0.f, 0.f};
    f32x16 S[2] = {zero16, zero16};
    v4u m0[2][4], n0[2][2], m1[2][4], n1[2][2], m2[2][4], n2[2][2];
#define CARRY_LOAD(MQ, NQ, nn) do { const int nc_ = (nn) < NCHK ? (nn) : NCHK - 1; const size_t it_ = (size_t)(b * NCHK + nc_) * NH + hh; const bf16* Mi_ = Mb + it_ * 4096; const bf16* NTi_ = NTb + it_ * 4096 + ctd * 2048; \
      _Pragma("unroll") for (int ctp = 0; ctp < 2; ++ctp) _Pragma("unroll") for (int s4 = 0; s4 < 4; ++s4) MQ[ctp][s4] = *(const v4u*)(Mi_ + ((4 * ctp + s4) * 64 + (lane & 63)) * 8); \
      _Pragma("unroll") for (int ctp = 0; ctp < 2; ++ctp) _Pragma("unroll") for (int s2 = 0; s2 < 2; ++s2) NQ[ctp][s2] = *(const v4u*)(NTi_ + ((2 * ctp + s2) * 64 + (lane & 63)) * 8); } while (0)
#define CARRY_STEP(nn, MC, NC, MQ2, NQ2) do { \
      CARRY_LOAD(MQ2, NQ2, (nn) + 2); \
      bf16* Si_ = Sg + ((size_t)(b * NCHK + (nn)) * NH + hh) * 4096 + ctd * 2048; bf16x8 Sf[4]; \
      _Pragma("unroll") for (int s4 = 0; s4 < 4; ++s4) { Sf[s4] = accfrag(S[s4 >> 1], s4 & 1); *(bf16x8*)(Si_ + (s4 * 64 + (lane & 63)) * 8) = Sf[s4]; } \
      _Pragma("unroll") for (int ctp = 0; ctp < 2; ++ctp) { const v4u x = NC[ctp][0], y = NC[ctp][1]; f32x16 sn; \
          sn[0] = bflo(x.x); sn[1] = bfhi(x.x); sn[2] = bflo(x.y); sn[3] = bfhi(x.y); sn[4] = bflo(x.z); sn[5] = bfhi(x.z); sn[6] = bflo(x.w); sn[7] = bfhi(x.w); \
          sn[8] = bflo(y.x); sn[9] = bfhi(y.x); sn[10] = bflo(y.y); sn[11] = bfhi(y.y); sn[12] = bflo(y.z); sn[13] = bfhi(y.z); sn[14] = bflo(y.w); sn[15] = bfhi(y.w); \
          _Pragma("unroll") for (int s4 = 0; s4 < 4; ++s4) sn = MFMA32(__builtin_bit_cast(bf16x8, MC[ctp][s4]), Sf[s4], sn); \
          S[ctp] = sn; } } while (0)
    CARRY_LOAD(m0, n0, 0); CARRY_LOAD(m1, n1, 1);
    static_assert(NCHK % 3 == 2, "carry loop tail");
#pragma unroll 1
    for (int n = 0; n + 2 < NCHK; n += 3) { CARRY_STEP(n, m0, n0, m2, n2); CARRY_STEP(n + 1, m1, n1, m0, n0); CARRY_STEP(n + 2, m2, n2, m1, n1); }
    CARRY_STEP(NCHK - 2, m0, n0, m2, n2); CARRY_STEP(NCHK - 1, m1, n1, m0, n0);
#undef CARRY_LOAD
#undef CARRY_STEP
}
__device__ __forceinline__ void scan_out_item(const Args& a, unsigned char* ws, LAS unsigned char* ST, int l, int item, int lane) {
    const int hh = item % NH, bn = item / NH; const int p = lane & 31, h = lane >> 5;
    const bf16* Si = (const bf16*)(ws + WS_SS) + (size_t)item * 4096; const bf16* RPi = (const bf16*)(ws + WS_SRP) + (size_t)item * 2048; const bf16* YLi = (const bf16*)(ws + WS_SYL) + (size_t)item * 2048;
    const float* BONu = (const float*)(ws + WS_BON) + (size_t)bn * CHK * 8 + hh; bf16* mixu = (bf16*)(ws + WS_MIX) + (size_t)bn * CHK * D + hh * 64;
    const float* rvec = a.in[I_RVEC] + l * 7 * RW;
    bf16x8 rp[4], sf[2][4]; v4u yl[2][2], xv[2][2], xg[2][2]; float bon[16];
#pragma unroll
    for (int s4 = 0; s4 < 4; ++s4) rp[s4] = *(const bf16x8*)(RPi + (s4 * 64 + (lane & 63)) * 8);
#pragma unroll
    for (int ctd = 0; ctd < 2; ++ctd)
#pragma unroll
        for (int s4 = 0; s4 < 4; ++s4) sf[ctd][s4] = *(const bf16x8*)(Si + ((4 * ctd + s4) * 64 + (lane & 63)) * 8);
    { const v4u* XV = (const v4u*)(ws + WS_XV) + ((size_t)item * 4) * 64 + lane; const v4u* XG = (const v4u*)(ws + WS_G) + ((size_t)item * 4) * 64 + lane;
#pragma unroll
      for (int ctd = 0; ctd < 2; ++ctd)
#pragma unroll
          for (int hq = 0; hq < 2; ++hq) { yl[ctd][hq] = *(const v4u*)(YLi + ((2 * ctd + hq) * 64 + (lane & 63)) * 8); xv[ctd][hq] = XV[(ctd * 2 + hq) * 64]; xg[ctd][hq] = XG[(ctd * 2 + hq) * 64]; } }
#pragma unroll
    for (int r = 0; r < 16; ++r) bon[r] = BONu[qrow(r, h) * 8];
    float lng[2], lnb[2];
#pragma unroll
    for (int ctd = 0; ctd < 2; ++ctd) { lng[ctd] = rvec[5 * RW + hh * 64 + 32 * ctd + p]; lnb[ctd] = rvec[6 * RW + hh * 64 + 32 * ctd + p]; }
    f32x16 Y[2];
#define UNPK(DST, W0, W1) do { DST[0] = bflo(W0.x); DST[1] = bfhi(W0.x); DST[2] = bflo(W0.y); DST[3] = bfhi(W0.y); DST[4] = bflo(W0.z); DST[5] = bfhi(W0.z); DST[6] = bflo(W0.w); DST[7] = bfhi(W0.w); \
        DST[8] = bflo(W1.x); DST[9] = bfhi(W1.x); DST[10] = bflo(W1.y); DST[11] = bfhi(W1.y); DST[12] = bflo(W1.z); DST[13] = bfhi(W1.z); DST[14] = bflo(W1.w); DST[15] = bfhi(W1.w); } while (0)
#pragma unroll
    for (int ctd = 0; ctd < 2; ++ctd) { UNPK(Y[ctd], yl[ctd][0], yl[ctd][1]);
#pragma unroll
        for (int s4 = 0; s4 < 4; ++s4) Y[ctd] = MFMA32(rp[s4], sf[ctd][s4], Y[ctd]); }
    float vv[2][16], gg[2][16];
#pragma unroll
    for (int ctd = 0; ctd < 2; ++ctd) { UNPK(vv[ctd], xv[ctd][0], xv[ctd][1]); UNPK(gg[ctd], xg[ctd][0], xg[ctd][1]); }
#undef UNPK
#pragma unroll
    for (int r = 0; r < 16; ++r) {
        const float y0 = Y[0][r], y1 = Y[1][r];
        const float s1 = half_sum32(y0 + y1), s2 = half_sum32(y0 * y0 + y1 * y1);
        const float mean = s1 * (1.f / 64.f), var = fmaxf(s2 * (1.f / 64.f) - mean * mean, 0.f), rstd = 1.f / sqrtf(var + 64e-5f);
        const int i = qrow(r, h);
        st_put(ST, i, p, ((y0 - mean) * rstd * lng[0] + lnb[0] + bon[r] * vv[0][r]) * gg[0][r]);
        st_put(ST, i, 32 + p, ((y1 - mean) * rstd * lng[1] + lnb[1] + bon[r] * vv[1][r]) * gg[1][r]);
    }
    st_flush<64>(ST, mixu, D, lane, false);
}
__device__ __forceinline__ void ph_scan_out(const Args& a, unsigned char* ws, LAS unsigned char* lds, int l, int gw, int NGW, int wave, int lane_in) {
    LAS unsigned char* ST = lds + RING_OFF + wave * 8192;
    for (int item = gw; item < BATCH * NCHK * NH; item += NGW) { const int lane = fresh_lane(); scan_out_item(a, ws, ST, l, item, lane); }
}

constexpr size_t WS_VT = WS_BON + 1 * MiB;
static_assert(WS_VT + 16 * MiB <= 896 * MiB, "ws");
constexpr int AT_KB = 0, AT_VB = 16384, AT_STAGE = 24576;
__device__ __forceinline__ int atk_addr(int row, int chunk) { return row * 256 + ((chunk ^ (row & 15)) << 4); }

__device__ __forceinline__ const bf16* at_ksrc(const bf16* KM, int b, int hq, int kt, int c) { const int row = c / 12, ch = c % 12; return KM + (size_t)(b * T + kt * 64 + row) * 384 + hq * 96 + ch * 8; }
__device__ __forceinline__ const bf16* at_vsrc(const bf16* VTg, int b, int hq, int kt, int v) { return VTg + ((size_t)((b * 4 + hq) * 128 + 2 * kt + (v >> 8)) * 64 + ((v >> 2) & 63)) * 32 + (v & 3) * 8; }
__device__ __forceinline__ int at_kdst(int c) { const int row = c / 12, ch = c % 12; return AT_KB + atk_addr(row, ch); }
__device__ __forceinline__ int at_vdst(int v) { return AT_VB + (v >> 8) * 4096 + cm_addr((v >> 2) & 63, v & 3); }
__device__ __forceinline__ void attn_stage_load(const bf16* KM, const bf16* VTg, int b, int hq, int kt, int tid, v4u& rg0, v4u& rg1, v4u& rg2) {
    rg0 = *(const v4u*)at_ksrc(KM, b, hq, kt, tid);
    const bf16* sb = tid < 256 ? at_ksrc(KM, b, hq, kt, 512 + tid) : at_vsrc(VTg, b, hq, kt, tid - 256);
    rg1 = *(const v4u*)sb;
    if (tid < 256) rg2 = *(const v4u*)at_vsrc(VTg, b, hq, kt, 256 + tid);
}
__device__ __forceinline__ void attn_stage_store(LAS unsigned char* S, int tid, const v4u& rg0, const v4u& rg1, const v4u& rg2) {
    *(LAS v4u*)(S + at_kdst(tid)) = rg0;
    const int db = tid < 256 ? at_kdst(512 + tid) : at_vdst(tid - 256);
    *(LAS v4u*)(S + db) = rg1;
    if (tid < 256) *(LAS v4u*)(S + at_vdst(256 + tid)) = rg2;
}

__device__ __forceinline__ void ph_attn_mfma(unsigned char* ws, LAS unsigned char* lds, int bh, int qb, int tid, int wave, int lane) {
    const int b = bh >> 2, hq = bh & 3;
    const bf16* QM = (const bf16*)(ws + WS_QM); const bf16* KM = (const bf16*)(ws + WS_KM); const bf16* VTg = (const bf16*)(ws + WS_VT); bf16* mix = (bf16*)(ws + WS_MIX);
    LAS unsigned char* L = lds + RING_OFF;
    const int p = lane & 31, h = lane >> 5;
    const f32x16 zero16 = {0.f, 0.f, 0.f, 0.f, 0.f, 0.f, 0.f, 0.f, 0.f, 0.f, 0.f, 0.f, 0.f, 0.f, 0.f, 0.f};
    {
        const int q0 = qb * 256; const int ntile = 4 * (qb + 1);
        const int qrow_ = q0 + wave * 32 + p;
        const int qmax_w = q0 + wave * 32 + 31, qmin_w = q0 + wave * 32;
        bf16x8 qf[6];
#pragma unroll
        for (int s = 0; s < 6; ++s) qf[s] = *(const bf16x8*)(QM + (size_t)(b * T + qrow_) * 384 + hq * 96 + 16 * s + 8 * h);
        f32x16 O[2] = {zero16, zero16}; float mrun = -1.0e30f, lrun = 0.f;
        v4u rg0, rg1, rg2 = (v4u){0u, 0u, 0u, 0u};
        __syncthreads();
        attn_stage_load(KM, VTg, b, hq, 0, tid, rg0, rg1, rg2); attn_stage_store(L, tid, rg0, rg1, rg2);
        __syncthreads();
#pragma unroll 1
        for (int kt = 0; kt < ntile; ++kt) {
            LAS unsigned char* S = L + (kt & 1) * AT_STAGE;
            if (kt + 1 < ntile) attn_stage_load(KM, VTg, b, hq, kt + 1, tid, rg0, rg1, rg2);
            if (kt * 64 <= qmax_w) {
                f32x16 s0 = zero16, s1 = zero16;
#pragma unroll
                for (int s = 0; s < 6; ++s) {
                    const bf16x8 k0 = *(const LAS bf16x8*)(S + AT_KB + atk_addr(p, 2 * s + h)), k1 = *(const LAS bf16x8*)(S + AT_KB + atk_addr(32 + p, 2 * s + h));
                    s0 = MFMA32(k0, qf[s], s0); s1 = MFMA32(k1, qf[s], s1);
                }
                if (kt * 64 + 63 > qmin_w) {
#pragma unroll
                    for (int r = 0; r < 16; ++r) { const int kv = kt * 64 + qrow(r, h); if (kv > qrow_) s0[r] = -1.0e30f; if (kv + 32 > qrow_) s1[r] = -1.0e30f; }
                }
                float rm = fmaxf(s0[0], s1[0]);
#pragma unroll
                for (int r = 1; r < 16; ++r) rm = fmaxf(rm, fmaxf(s0[r], s1[r]));
                { const unsigned u_ = __float_as_uint(rm); auto rr_ = __builtin_amdgcn_permlane32_swap(u_, u_, false, false); rm = fmaxf(__uint_as_float(rr_[0]), __uint_as_float(rr_[1])); }
                const float mnew = fmaxf(mrun, rm); const float alpha = __builtin_amdgcn_exp2f(mrun - mnew); mrun = mnew;
                float ls = 0.f;
#pragma unroll
                for (int r = 0; r < 16; ++r) { s0[r] = __builtin_amdgcn_exp2f(s0[r] - mnew); s1[r] = __builtin_amdgcn_exp2f(s1[r] - mnew); ls += s0[r] + s1[r]; }
                lrun = lrun * alpha + ls;
#pragma unroll
                for (int r = 0; r < 16; ++r) { O[0][r] *= alpha; O[1][r] *= alpha; }
                const bf16x8 p00 = accfrag(s0, 0), p01 = accfrag(s0, 1), p10 = accfrag(s1, 0), p11 = accfrag(s1, 1);
#pragma unroll
                for (int dvt = 0; dvt < 2; ++dvt) {
                    const bf16x8 v00 = *(const LAS bf16x8*)(S + AT_VB + cm_addr(32 * dvt + p, h)), v01 = *(const LAS bf16x8*)(S + AT_VB + cm_addr(32 * dvt + p, 2 + h));
                    const bf16x8 v10 = *(const LAS bf16x8*)(S + AT_VB + 4096 + cm_addr(32 * dvt + p, h)), v11 = *(const LAS bf16x8*)(S + AT_VB + 4096 + cm_addr(32 * dvt + p, 2 + h));
                    O[dvt] = MFMA32(v00, p00, O[dvt]); O[dvt] = MFMA32(v01, p01, O[dvt]); O[dvt] = MFMA32(v10, p10, O[dvt]); O[dvt] = MFMA32(v11, p11, O[dvt]);
                }
            }
            if (kt + 1 < ntile) attn_stage_store(L + ((kt + 1) & 1) * AT_STAGE, tid, rg0, rg1, rg2);
            __syncthreads();
        }
        float ltot; { const unsigned u_ = __float_as_uint(lrun); auto rr_ = __builtin_amdgcn_permlane32_swap(u_, u_, false, false); ltot = __uint_as_float(rr_[0]) + __uint_as_float(rr_[1]); } const float il = 1.f / ltot;
        bf16* orow = mix + (size_t)(b * T + qrow_) * D + 768 + hq * 64;
#pragma unroll
        for (int dvt = 0; dvt < 2; ++dvt)
#pragma unroll
            for (int g = 0; g < 4; ++g) { v2u w; w.x = cvtpk(O[dvt][4 * g] * il, O[dvt][4 * g + 1] * il); w.y = cvtpk(O[dvt][4 * g + 2] * il, O[dvt][4 * g + 3] * il);
                *(v2u*)(orow + 32 * dvt + 8 * g + 4 * h) = w; }
    }
}

constexpr int AT2_KSLOT = 12288, AT2_VSLOT = 8192, AT2_K = 0, AT2_V = 4 * AT2_KSLOT;
__device__ __forceinline__ void glds16(const void* g, unsigned lds_base) {
    unsigned sv; asm volatile("s_mov_b32 %0, m0\n\ts_mov_b32 m0, %2\n\ts_nop 0\n\tglobal_load_lds_dwordx4 %1, off\n\ts_mov_b32 m0, %0" : "=&s"(sv) : "v"(g), "s"(lds_base) : "memory"); }
#define AT_SBAR() __builtin_amdgcn_sched_barrier(0)
#define AT_PIN(x) asm volatile("" : "+v"(x))
#define AT_WB(N) asm volatile("s_waitcnt vmcnt(" #N ") lgkmcnt(0)\n\ts_barrier" ::: "memory")
#define AT_MX3(a, b, c) __builtin_fmaxf(__builtin_fmaxf((a), (b)), (c))
__device__ __forceinline__ float at_rowmax(const f32x16& p0, const f32x16& p1) {
    float a = AT_MX3(p0[0], p0[1], p1[0]), b = AT_MX3(p0[2], p0[3], p1[1]); a = AT_MX3(a, p1[2], p1[3]);
#pragma unroll
    for (int r = 4; r < 16; r += 4) { a = AT_MX3(a, p0[r], p0[r + 1]); b = AT_MX3(b, p0[r + 2], p0[r + 3]); a = AT_MX3(a, p1[r], p1[r + 1]); b = AT_MX3(b, p1[r + 2], p1[r + 3]); }
    const float m = __builtin_fmaxf(a, b); auto rr = __builtin_amdgcn_permlane32_swap(__float_as_uint(m), __float_as_uint(m), false, false);
    return __builtin_fmaxf(__uint_as_float(rr[0]), __uint_as_float(rr[1])); }
__device__ __forceinline__ void at_cmask(f32x16& p0, f32x16& p1, int jb, int qrel, int h) {
    int d = qrel - (64 * jb + 4 * h); asm volatile("" : "+v"(d));
#pragma unroll
    for (int r = 0; r < 16; ++r) { const int c = (r & 3) + 8 * (r >> 2); if (c > d) p0[r] = -INFINITY; if (c + 32 > d) p1[r] = -INFINITY; } }
__device__ __forceinline__ void at_kload2(bf16x8* kf, const LAS unsigned char* kp, int s) { kf[2 * s] = *(const LAS bf16x8*)(kp + s * 2048); kf[2 * s + 1] = *(const LAS bf16x8*)(kp + s * 2048 + 512); }
#ifndef ATTN_THR
#define ATTN_THR 8
#endif

__device__ __forceinline__ void ph_attn_pipe(unsigned char* ws, LAS unsigned char* lds, int bh, int qb, int wave, int lane) {
    const int b = bh >> 2, hq = bh & 3;
    const bf16* QM = (const bf16*)(ws + WS_QM); const bf16* KM = (const bf16*)(ws + WS_KM); const bf16* VTg = (const bf16*)(ws + WS_VT); bf16* mix = (bf16*)(ws + WS_MIX);
    LAS unsigned char* L = lds + RING_OFF;
    const int p = lane & 31, h = lane >> 5;
    const int q0 = qb * 256, NT = 4 * (qb + 1);
    const int qrel = wave * 32 + p; const bool wlo = wave < 4;
    const bf16* ksrc = KM + (size_t)((b * 4 + hq) * 64) * 6144 + wave * 512 + (lane & 63) * 8;
    const int vrow = (wave & 3) * 16 + (lane >> 2);
    const bf16* vsrc = VTg + (size_t)((b * 4 + hq) * 128 + (wave >> 2)) * 2048 + ((((vrow >> 5) * 4 + ((lane & 3) ^ ((vrow >> 2) & 3))) * 32 + (vrow & 31)) * 8);
    const unsigned lds0 = (unsigned)(size_t)L;
    const unsigned kdst = lds0 + AT2_K + wave * 1024, vdst = lds0 + AT2_V + wave * 1024;
#define RFL(x) ((unsigned)__builtin_amdgcn_readfirstlane((int)(x)))
#define DMA_K(t, slot) do { glds16(ksrc + (size_t)(t) * 6144, RFL(kdst + (slot) * AT2_KSLOT)); if (wlo) glds16(ksrc + (size_t)(t) * 6144 + 4096, RFL(kdst + (slot) * AT2_KSLOT + 8192)); } while (0)
#define DMA_V(t, slot) glds16(vsrc + (size_t)(t) * 4096, RFL(vdst + (slot) * AT2_VSLOT))
    const int vx = (h ^ ((p >> 2) & 3));
    const LAS unsigned char* vpA = L + AT2_V + p * 64 + (vx << 4);
    const LAS unsigned char* vpB = L + AT2_V + p * 64 + ((vx ^ 2) << 4);
    const LAS unsigned char* kp0 = L + AT2_K + h * 1024 + p * 16;
    DMA_K(0, 0); DMA_V(0, 0); DMA_K(1, 1); DMA_K(2, 2); DMA_K(3, 3); DMA_V(1, 1);
    bf16x8 qf[6];
    { const bf16* Qw = QM + (size_t)(b * T + q0 + qrel) * 384 + hq * 96 + 8 * h;
#pragma unroll
      for (int s = 0; s < 6; ++s) qf[s] = *(const bf16x8*)(Qw + 16 * s); }
    float mhat = 0.f, l_reg = 0.f, fres = 1.f; f32x16 o0, o1;
    const f32x16 zero16 = {0.f, 0.f, 0.f, 0.f, 0.f, 0.f, 0.f, 0.f, 0.f, 0.f, 0.f, 0.f, 0.f, 0.f, 0.f, 0.f};
    o0 = zero16; o1 = zero16; bool resc = false;
    f32x16 pA0, pA1, pB0, pB1; bf16x8 kf[12], vf[8]; v4u pw0, pw1, pw2, pw3;
    int sl_prev = 0, sl_cur = 0, sl_next = 1;
#define ROT() do { sl_prev = sl_cur; sl_cur = sl_next; sl_next = (sl_next + 1) & 3; } while (0)
#define EX(v) __builtin_amdgcn_exp2f((v) + nmh)
#define RESC() do { if (resc) { _Pragma("unroll") for (int r = 0; r < 16; ++r) { o0[r] *= fres; o1[r] *= fres; } } } while (0)
    AT_WB(0);
#pragma unroll
    for (int s = 0; s < 6; ++s) at_kload2(kf, kp0, s);
    pA0 = MFMA32(kf[0], qf[0], zero16); pA1 = MFMA32(kf[1], qf[0], zero16);
#pragma unroll
    for (int s = 1; s < 6; ++s) { pA0 = MFMA32(kf[2 * s], qf[s], pA0); pA1 = MFMA32(kf[2 * s + 1], qf[s], pA1); }
    if (NT == 4) at_cmask(pA0, pA1, 0, qrel, h);
    { mhat = at_rowmax(pA0, pA1); const float nmh = -mhat;
#pragma unroll
      for (int r = 0; r < 16; ++r) { pA0[r] = EX(pA0[r]); pA1[r] = EX(pA1[r]); } }
    AT_WB(0);
    if (4 < NT) DMA_K(4, 0); DMA_V(2, 2); ROT();
#pragma unroll
    for (int s = 0; s < 6; ++s) at_kload2(kf, kp0 + sl_cur * AT2_KSLOT, s);
    if (4 < NT) { if (wlo) { AT_WB(3); } else { AT_WB(2); } } else { AT_WB(1); }
#define PKW(P, i) cvtpk(P[i], P[i + 1])
#define PAF(k) __builtin_bit_cast(bf16x8, pw##k)
#define VOFF(j) ((((j) >> 1) >> 1) * 4096 + ((j) & 1) * 2048)
#define VRD(j) do { vf[j] = *(const LAS bf16x8*)(((((j) >> 1) & 1) ? vpB_ : vpA_) + VOFF(j)); } while (0)
#define KRD(G, s) do { if (G) { at_kload2(kf, kp0 + sl_next * AT2_KSLOT, s); AT_SBAR(); } } while (0)
#define GAPA3(MF, a0, a1, a2, W0, W1, PW) do { MF; sacc += a0; sacc += a1; sacc += a2; W0; W1; AT_PIN(PW); AT_PIN(sacc); AT_SBAR(); } while (0)
#define GAPB(MF, X, i) do { MF; X[i] = EX(X[i]); X[i + 1] = EX(X[i + 1]); X[i + 2] = EX(X[i + 2]); X[i + 3] = EX(X[i + 3]); AT_PIN(X); AT_SBAR(); } while (0)
#define WAIT2() do { if (wlo) { AT_WB(6); } else { AT_WB(4); } } while (0)
#define WAITN(GK, GV) do { if (GK) { if (GV) { if (wlo) { AT_WB(3); } else { AT_WB(2); } } else { if (wlo) { AT_WB(2); } else { AT_WB(1); } } } else { if (GV) { AT_WB(1); } else { AT_WB(0); } } } while (0)
#define STEP(C0, C1, P0, P1, t, MASK, GK, GV, GL) do { AT_SBAR(); \
    const LAS unsigned char* vpA_ = vpA + sl_prev * AT2_VSLOT; const LAS unsigned char* vpB_ = vpB + sl_prev * AT2_VSLOT; \
    float sacc = P0[0] + P0[1]; \
    VRD(0); AT_SBAR(); GAPA3(C0 = MFMA32(kf[0], qf[0], zero16), P0[2], P0[3], P0[4],    pw0[0] = PKW(P0, 0),  pw0[1] = PKW(P0, 2),  pw0); \
    VRD(1); AT_SBAR(); GAPA3(C1 = MFMA32(kf[1], qf[0], zero16), P0[5], P0[6], P0[7],    pw0[2] = PKW(P0, 4),  pw0[3] = PKW(P0, 6),  pw0); \
    VRD(2); AT_SBAR(); GAPA3(C0 = MFMA32(kf[2], qf[1], C0),     P0[8], P0[9], P0[10],   pw1[0] = PKW(P0, 8),  (void)0,              pw1); \
    VRD(3); AT_SBAR(); GAPA3(C1 = MFMA32(kf[3], qf[1], C1),     P0[11], P0[12], P0[13], pw1[1] = PKW(P0, 10), pw1[2] = PKW(P0, 12), pw1); \
    VRD(4); AT_SBAR(); GAPA3(C0 = MFMA32(kf[4], qf[2], C0),     P0[14], P0[15], P1[0],  pw1[3] = PKW(P0, 14), (void)0,              pw1); \
    VRD(5); AT_SBAR(); GAPA3(C1 = MFMA32(kf[5], qf[2], C1),     P1[1], P1[2], P1[3],    pw2[0] = PKW(P1, 0),  pw2[1] = PKW(P1, 2),  pw2); \
    VRD(6); AT_SBAR(); GAPA3(C0 = MFMA32(kf[6], qf[3], C0),     P1[4], P1[5], P1[6],    pw2[2] = PKW(P1, 4),  (void)0,              pw2); \
    VRD(7); AT_SBAR(); GAPA3(C1 = MFMA32(kf[7], qf[3], C1),     P1[7], P1[8], P1[9],    pw2[3] = PKW(P1, 6),  pw3[0] = PKW(P1, 8),  pw3); \
                       GAPA3(C0 = MFMA32(kf[8], qf[4], C0),     P1[10], P1[11], P1[12], pw3[1] = PKW(P1, 10), (void)0,              pw3); \
                       GAPA3(C1 = MFMA32(kf[9], qf[4], C1),     P1[13], P1[14], P1[15], pw3[2] = PKW(P1, 12), pw3[3] = PKW(P1, 14), pw3); \
    C0 = MFMA32(kf[10], qf[5], C0); C1 = MFMA32(kf[11], qf[5], C1); AT_SBAR(); \
    l_reg += sacc; \
    if (GK) DMA_K((t) + 4, sl_cur); if (GV) DMA_V((t) + 2, (sl_next + 1) & 3); \
    if (MASK) at_cmask(C0, C1, (t) - (NT - 4), qrel, h); \
    { const float rm = at_rowmax(C0, C1) - mhat; resc = false; \
      if (__builtin_expect(__any(rm > (float)ATTN_THR), 0)) { const float dl = __builtin_fmaxf(rm, 0.f); mhat += dl; fres = __builtin_amdgcn_exp2f(-dl); l_reg *= fres; resc = true; } } \
    const float nmh = -mhat; AT_SBAR(); \
    GAPB(o0 = MFMA32(vf[0], PAF(0), o0), C0, 0);               GAPB(o1 = MFMA32(vf[1], PAF(0), o1), C0, 4); \
    KRD(GL, 0); GAPB(o0 = MFMA32(vf[2], PAF(1), o0), C0, 8);   KRD(GL, 1); GAPB(o1 = MFMA32(vf[3], PAF(1), o1), C0, 12); \
    KRD(GL, 2); GAPB(o0 = MFMA32(vf[4], PAF(2), o0), C1, 0);   KRD(GL, 3); GAPB(o1 = MFMA32(vf[5], PAF(2), o1), C1, 4); \
    KRD(GL, 4); GAPB(o0 = MFMA32(vf[6], PAF(3), o0), C1, 8);   KRD(GL, 5); GAPB(o1 = MFMA32(vf[7], PAF(3), o1), C1, 12); \
    } while (0)
    int t = 1;
    for (; t + 5 < NT; t += 2) {
        STEP(pB0, pB1, pA0, pA1, t, false, true, true, true);     WAIT2(); RESC(); ROT();
        STEP(pA0, pA1, pB0, pB1, t + 1, false, true, true, true); WAIT2(); RESC(); ROT();
    }
#define ENDW(tt) do { if ((tt) + 4 < NT) { WAITN(true, true); } else if ((tt) + 2 < NT) { WAITN(false, true); } else { WAITN(false, false); } } while (0)
    for (; t + 1 < NT; t += 2) {
        STEP(pB0, pB1, pA0, pA1, t, true, (t + 4 < NT), (t + 2 < NT), (t + 1 < NT));         ENDW(t);     RESC(); ROT();
        STEP(pA0, pA1, pB0, pB1, t + 1, true, (t + 5 < NT), (t + 3 < NT), (t + 2 < NT));     ENDW(t + 1); RESC(); ROT();
    }
    STEP(pB0, pB1, pA0, pA1, NT - 1, true, false, false, false); RESC();
    { float sacc = pB0[0] + pB0[1];
#pragma unroll
      for (int r = 2; r < 16; ++r) sacc += pB0[r];
#pragma unroll
      for (int r = 0; r < 16; ++r) sacc += pB1[r];
      l_reg += sacc;
      pw0 = (v4u){PKW(pB0, 0), PKW(pB0, 2), PKW(pB0, 4), PKW(pB0, 6)}; pw1 = (v4u){PKW(pB0, 8), PKW(pB0, 10), PKW(pB0, 12), PKW(pB0, 14)};
      pw2 = (v4u){PKW(pB1, 0), PKW(pB1, 2), PKW(pB1, 4), PKW(pB1, 6)}; pw3 = (v4u){PKW(pB1, 8), PKW(pB1, 10), PKW(pB1, 12), PKW(pB1, 14)};
      const LAS unsigned char* vpA_ = vpA + sl_cur * AT2_VSLOT; const LAS unsigned char* vpB_ = vpB + sl_cur * AT2_VSLOT;
      VRD(0); VRD(1); VRD(2); VRD(3); VRD(4); VRD(5); VRD(6); VRD(7);
      o0 = MFMA32(vf[0], PAF(0), o0); o1 = MFMA32(vf[1], PAF(0), o1); o0 = MFMA32(vf[2], PAF(1), o0); o1 = MFMA32(vf[3], PAF(1), o1);
      o0 = MFMA32(vf[4], PAF(2), o0); o1 = MFMA32(vf[5], PAF(2), o1); o0 = MFMA32(vf[6], PAF(3), o0); o1 = MFMA32(vf[7], PAF(3), o1); }
    float ltot; { const unsigned u_ = __float_as_uint(l_reg); auto rr_ = __builtin_amdgcn_permlane32_swap(u_, u_, false, false); ltot = __uint_as_float(rr_[0]) + __uint_as_float(rr_[1]); }
    const float il = __builtin_amdgcn_rcpf(ltot);
    bf16* orow = mix + (size_t)(b * T + q0 + qrel) * D + 768 + hq * 64;
#pragma unroll
    for (int g = 0; g < 4; ++g) { v2u w; w.x = cvtpk(o0[4 * g] * il, o0[4 * g + 1] * il); w.y = cvtpk(o0[4 * g + 2] * il, o0[4 * g + 3] * il); *(v2u*)(orow + 8 * g + 4 * h) = w; }
#pragma unroll
    for (int g = 0; g < 4; ++g) { v2u w; w.x = cvtpk(o1[4 * g] * il, o1[4 * g + 1] * il); w.y = cvtpk(o1[4 * g + 2] * il, o1[4 * g + 3] * il); *(v2u*)(orow + 32 + 8 * g + 4 * h) = w; }
#undef RFL
#undef DMA_K
#undef DMA_V
#undef ROT
#undef EX
#undef RESC
#undef PKW
#undef PAF
#undef VOFF
#undef VRD
#undef KRD
#undef GAPA3
#undef GAPB
#undef WAITN
#undef WAIT2
#undef STEP
#undef ENDW
}

constexpr size_t WS_XA = WS_R;
constexpr size_t WS_XL = WS_LW;
constexpr size_t WS_SMALLW = 6 * MiB;
constexpr int O_W2T = 0, O_A2T = 32768, O_G2T = 65536, O_V2T = 147456, O_POOLT = 163840, O_WQT = 180224, O_WKVT = 278528, LAYER_SMALLW = 344064;
constexpr int PZ_XW = 0, PZ_XA = 4096, PZ_XG = 8192  , PZ_XV = 18432  , PZ_PP = 20480  , PZ_QN = 36864  , PZ_KVN = 53248  , PZ_END = 61440;
template <int PITCH> __device__ __forceinline__ int pz_addr(int row, int chunk) {
    if constexpr (PITCH == 128) return row * 128 + ((chunk ^ ((row >> 1) & 7)) << 4);
    else if constexpr (PITCH == 64 || PITCH == 320) return row * PITCH + ((chunk ^ ((row >> 2) & 3)) << 4);
    else return row * PITCH + ((chunk ^ (row & 15)) << 4);
}
template <int PITCH> __device__ __forceinline__ void pz_put(LAS unsigned char* tile, int row, int k, float v) { *(LAS bf16*)(tile + pz_addr<PITCH>(row, k >> 3) + (k & 7) * 2) = (bf16)f2bf(v); }

__device__ __forceinline__ unsigned wfrag_off(int n, int k8, int K) { return (unsigned)(((((n >> 5) * (K >> 4) + (k8 >> 1)) * 2 + (k8 & 1)) * 32 + (n & 31)) * 8); }
__device__ __forceinline__ void small_transpose(const float* src, int K, int N, bf16* dst, int gtid, int GT) {
    const int k8n = K / 8;
    for (int it = gtid; it < N * k8n; it += GT) { const int n = it / k8n, k0 = (it % k8n) * 8;
        v4u o; o.x = pk2(src[(size_t)(k0 + 0) * N + n], src[(size_t)(k0 + 1) * N + n]); o.y = pk2(src[(size_t)(k0 + 2) * N + n], src[(size_t)(k0 + 3) * N + n]);
        o.z = pk2(src[(size_t)(k0 + 4) * N + n], src[(size_t)(k0 + 5) * N + n]); o.w = pk2(src[(size_t)(k0 + 6) * N + n], src[(size_t)(k0 + 7) * N + n]);
        *(v4u*)(dst + wfrag_off(n, k0 >> 3, K)) = o; }
}
__device__ __forceinline__ void ph_small_weights(const Args& a, unsigned char* ws, int gtid, int GT) {
    for (int l = 0; l < 2; ++l) {
        bf16* base = (bf16*)(ws + WS_SMALLW) + (size_t)l * LAYER_SMALLW;
        small_transpose(a.in[I_RW2] + (size_t)l * 64 * RW, 64, RW, base + O_W2T, gtid, GT);
        small_transpose(a.in[I_RA2] + (size_t)l * 64 * RW, 64, RW, base + O_A2T, gtid, GT);
        small_transpose(a.in[I_RG2] + (size_t)l * 160 * RW, 160, RW, base + O_G2T, gtid, GT);
        if (l == 1) small_transpose(a.in[I_RV2], 32, RW, base + O_V2T, gtid, GT);
        for (int g = 0; g < 4; ++g) small_transpose(a.in[I_POOLW] + (size_t)(l * 4 + g) * 4096, 64, 64, base + O_POOLT + g * 4096, gtid, GT);
        small_transpose(a.in[I_WQUP] + (size_t)l * 256 * 384, 256, 384, base + O_WQT, gtid, GT);
        small_transpose(a.in[I_WKVUP] + (size_t)l * 128 * 512, 128, 512, base + O_WKVT, gtid, GT);
    }
}

template <int PITCH, int KSTEPS, int NTILES, int KG = 2>
__device__ __forceinline__ void pz_gemm(f32x16 (&acc)[NTILES], const LAS unsigned char* X, const bf16* WT, int K, int n0, int p, int h, int kc0 = 0) {
    constexpr int NG = KSTEPS / KG;
    static_assert(KSTEPS % KG == 0, "k-steps");
    bf16x8 wb[2][KG][NTILES];
#pragma unroll
    for (int q = 0; q < KG; ++q)
#pragma unroll
        for (int jt = 0; jt < NTILES; ++jt) wb[0][q][jt] = *(const bf16x8*)(WT + wfrag_off(n0 + 32 * jt + (p & 31), 2 * q + (h & 1), K));
#pragma unroll
    for (int g = 0; g < NG; ++g) {
        if (g + 1 < NG) {
#pragma unroll
            for (int q = 0; q < KG; ++q)
#pragma unroll
                for (int jt = 0; jt < NTILES; ++jt) wb[(g + 1) & 1][q][jt] = *(const bf16x8*)(WT + wfrag_off(n0 + 32 * jt + (p & 31), 2 * ((g + 1) * KG + q) + (h & 1), K));
        }
#pragma unroll
        for (int q = 0; q < KG; ++q) {
            const bf16x8 xa = *(const LAS bf16x8*)(X + pz_addr<PITCH>(p, kc0 + 2 * (g * KG + q) + h));
#pragma unroll
            for (int jt = 0; jt < NTILES; ++jt) acc[jt] = MFMA32(xa, wb[g & 1][q][jt], acc[jt]);
        }
        asm volatile("" ::: "memory");
    }
}


template <int WIN>
__device__ __forceinline__ void pool_wave(const bf16* zc, int tt0, int i0, LAS unsigned char* PP, int gi, int lane) {
    float u[16 + WIN - 1];
    bf16 raw[16 + WIN - 1];
#pragma unroll
    for (int k = 0; k < 16 + WIN - 1; ++k) { const int off = i0 + k - (WIN - 1); const int offc = (tt0 + off >= 0) ? off : -tt0; raw[k] = zc[(ptrdiff_t)offc * NZ]; }
    __builtin_amdgcn_sched_barrier(0);
#pragma unroll
    for (int k = 0; k < 16 + WIN - 1; ++k) { const int off = i0 + k - (WIN - 1); u[k] = (tt0 + off >= 0) ? bf2f(raw[k]) : 0.f; }
    float s = 0.f;
#pragma unroll
    for (int k = 0; k < WIN - 1; ++k) s += u[k];
#pragma unroll
    for (int j = 0; j < 16; ++j) { s += u[WIN - 1 + j]; const int tt = tt0 + i0 + j; const int cnt = (tt + 1) < WIN ? (tt + 1) : WIN;
        pz_put<512>(PP, i0 + j, gi * 64 + lane, s * rcp_((float)cnt) - u[WIN - 1 + j]); s -= u[j]; }
}

#ifndef PZ_ABL
#define PZ_ABL 0
#endif
#ifndef PZ_PART
#define PZ_PART 7
#endif
template <int l>
__device__ __forceinline__ void ph_postz_mfma(const Args& a, unsigned char* ws, LAS unsigned char* lds, int G, int tid, int wave, int lane_in, bool dry) {
    LAS unsigned char* L = lds + RING_OFF;
    const bf16* z = (const bf16*)(ws + WS_Z);
    const float* mu = a.in[I_MU] + l * SHIFT_COLS; const float* muv = a.in[I_MUV];
    const float* rvec = a.in[I_RVEC] + l * 7 * RW; const float* v0p = a.in[I_RV0];
    const bf16* SW = (const bf16*)(ws + WS_SMALLW) + (size_t)l * LAYER_SMALLW;
    bf16* Rr = (bf16*)(ws + WS_R); bf16* Kr = (bf16*)(ws + WS_K); bf16* Vr = (bf16*)(ws + WS_V); bf16* KKr = (bf16*)(ws + WS_KK); bf16* Ar = (bf16*)(ws + WS_A);
    float* LWr = (float*)(ws + WS_LW); bf16* Gr = (bf16*)(ws + WS_G); bf16* VF = (bf16*)(ws + WS_VF); bf16* mix = (bf16*)(ws + WS_MIX); float* BON = (float*)(ws + WS_BON);
    bf16* QM = (bf16*)(ws + WS_QM); bf16* KM = (bf16*)(ws + WS_KM); bf16* VM = (bf16*)(ws + WS_VM);
    const float* pools = a.in[I_POOLS] + l * 256; const float* qlg = a.in[I_QLG] + l * 256; const float* kvlg = a.in[I_KVLG] + l * 128;
    const float* qkg = a.in[I_QKG] + l * 2 * 96; const float* ct = (const float*)(ws + WS_COS); const float* st = (const float*)(ws + WS_SIN);
    const f32x16 zero16 = {0.f, 0.f, 0.f, 0.f, 0.f, 0.f, 0.f, 0.f, 0.f, 0.f, 0.f, 0.f, 0.f, 0.f, 0.f, 0.f};
    for (int unit = blockIdx.x; unit < M / 32; unit += G) {
        const int lane = fresh_lane();
        const int p = lane & 31, h = lane >> 5;
        LAS unsigned char* ST = L + PZ_END + wave * 8192;
        const int t0 = unit * 32; const int tt0 = t0 % T;
        const bf16* zu = z + (size_t)t0 * NZ;
        bf16* Ru = Rr + (size_t)t0 * RW; bf16* Ku = Kr + (size_t)t0 * RW; bf16* Vu = Vr + (size_t)t0 * RW; bf16* KKu = KKr + (size_t)t0 * RW; bf16* Au = Ar + (size_t)t0 * RW;
        float* LWu = LWr + (size_t)t0 * RW; bf16* Gu = Gr + (size_t)t0 * RW; bf16* VFu = VF + (size_t)t0 * RW; bf16* mixu = mix + (size_t)t0 * D; float* BONu = BON + (size_t)t0 * 8;
        bf16* QMu = QM + (size_t)t0 * 384; bf16* KMu = KM + (size_t)t0 * 384; bf16* VMu = VM + (size_t)t0 * 256; const float* ctu = ct + (size_t)t0 * 16; const float* stu = st + (size_t)t0 * 16;
        __syncthreads();
        if (dry && (PZ_ABL & 4)) {} else {
            { const int gi = wave & 3, i0 = (wave >> 2) * 16; const bf16* zc = z + (size_t)t0 * NZ + OFF_POOL + gi * 64 + lane;
              if (gi == 0) pool_wave<2>(zc, tt0, i0, L + PZ_PP, gi, lane); else if (gi == 1) pool_wave<4>(zc, tt0, i0, L + PZ_PP, gi, lane);
              else if (gi == 2) pool_wave<8>(zc, tt0, i0, L + PZ_PP, gi, lane); else pool_wave<16>(zc, tt0, i0, L + PZ_PP, gi, lane); }
            float cW[4], pW[4], cA[4], pA[4], cG0[4], pG0[4], cG1[4], pG1[4], cG2[4], pG2[4], cV[4], pV[4], q4[4][4], k2[4][2];
            int wv; asm volatile("v_mov_b32 %0, %1" : "=v"(wv) : "s"(wave));
#pragma unroll
            for (int t4 = 0; t4 < 4; ++t4) { const int i = wv * 4 + t4; const bool hp = (tt0 + i) > 0;
                const bf16* zb = zu - NZ;
                const unsigned oc = (unsigned)((i + 1) * NZ) + (unsigned)lane, op = hp ? oc - NZ : oc; const unsigned l31 = (unsigned)(lane & 31), oc31 = (unsigned)((i + 1) * NZ) + l31, op31 = hp ? oc31 - NZ : oc31;
                cW[t4] = bf2f(zb[oc + OFF_WD]); pW[t4] = bf2f(zb[op + OFF_WD]); cA[t4] = bf2f(zb[oc + OFF_AD]); pA[t4] = bf2f(zb[op + OFF_AD]);
                cG0[t4] = bf2f(zb[oc + OFF_GD]); pG0[t4] = bf2f(zb[op + OFF_GD]); cG1[t4] = bf2f(zb[oc + OFF_GD + 64]); pG1[t4] = bf2f(zb[op + OFF_GD + 64]);
                cG2[t4] = bf2f(zb[oc31 + OFF_GD + 128]); pG2[t4] = bf2f(zb[op31 + OFF_GD + 128]);
                if (l > 0) { cV[t4] = bf2f(zb[oc31 + OFF_VD]); pV[t4] = bf2f(zb[op31 + OFF_VD]); } else { cV[t4] = 0.f; pV[t4] = 0.f; }
#pragma unroll
                for (int j = 0; j < 4; ++j) q4[t4][j] = bf2f(zb[oc + OFF_QLAT + 64 * j]);
#pragma unroll
                for (int j = 0; j < 2; ++j) k2[t4][j] = bf2f(zb[oc + OFF_KVLAT + 64 * j]); }
            const float muW = mu[OFF_WD + lane], muA = mu[OFF_AD + lane], muG0 = mu[OFF_GD + lane], muG1 = mu[OFF_GD + 64 + lane], muG2 = mu[OFF_GD + 128 + (lane & 31)], muV = l > 0 ? muv[lane & 31] : 0.f;
#pragma unroll
            for (int t4 = 0; t4 < 4; ++t4) { const int i = wv * 4 + t4; const float pm = (tt0 + i) > 0 ? 1.f : 0.f;
#define SH(c_, p_, m_) ((c_) + (m_) * (pm * (p_) - (c_)))
                pz_put<128>(L + PZ_XW, i, lane, tanhf_(SH(cW[t4], pW[t4], muW))); pz_put<128>(L + PZ_XA, i, lane, SH(cA[t4], pA[t4], muA));
                pz_put<320>(L + PZ_XG, i, lane, sigmoidf_(SH(cG0[t4], pG0[t4], muG0))); pz_put<320>(L + PZ_XG, i, lane + 64, sigmoidf_(SH(cG1[t4], pG1[t4], muG1)));
                if (lane < 32) pz_put<320>(L + PZ_XG, i, lane + 128, sigmoidf_(SH(cG2[t4], pG2[t4], muG2)));
                if (l > 0 && lane < 32) pz_put<64>(L + PZ_XV, i, lane, SH(cV[t4], pV[t4], muV));
#undef SH
                float s = 0.f;
#pragma unroll
                for (int j = 0; j < 4; ++j) s += q4[t4][j] * q4[t4][j];
                const float rs = rsq_(wave_sum(s) * (1.f / 256.f) + 1e-6f);
#pragma unroll
                for (int j = 0; j < 4; ++j) pz_put<512>(L + PZ_QN, i, lane + 64 * j, q4[t4][j] * rs * qlg[lane + 64 * j]);
                s = 0.f;
#pragma unroll
                for (int j = 0; j < 2; ++j) s += k2[t4][j] * k2[t4][j];
                const float rk = rsq_(wave_sum(s) * (1.f / 128.f) + 1e-6f);
#pragma unroll
                for (int j = 0; j < 2; ++j) pz_put<256>(L + PZ_KVN, i, lane + 64 * j, k2[t4][j] * rk * kvlg[lane + 64 * j]);
            }
        }
        __syncthreads();
        if (dry && (PZ_ABL & 2)) {} else if ((PZ_PART & 2) && wave < 4) {
            const int hq = wave; const int fi = p & 15;
            { f32x16 aq[3] = {zero16, zero16, zero16};
              { f32x16 a01[2] = {zero16, zero16}; pz_gemm<512, 16, 2, 4>(a01, L + PZ_QN, SW + O_WQT, 256, hq * 96, p, h); aq[0] = a01[0]; aq[1] = a01[1]; }
              { f32x16 a2[1] = {zero16}; pz_gemm<512, 16, 1, 4>(a2, L + PZ_QN, SW + O_WQT, 256, hq * 96 + 64, p, h); aq[2] = a2[0]; }
              const float C2 = 0.10206207261596577f * 1.4426950408889634f; const float gq0 = qkg[p] * C2, gq1 = qkg[32 + p] * C2, gq2 = qkg[64 + p] * C2;
              float csv[16], snv[16];
#pragma unroll
              for (int r = 0; r < 16; ++r) { csv[r] = ctu[qrow(r, h) * 16 + fi]; snv[r] = stu[qrow(r, h) * 16 + fi]; }
#pragma unroll
              for (int r = 0; r < 16; ++r) {
                const int i = qrow(r, h);
                const float cs = csv[r], sn = snv[r];
                const float xq = aq[2][r], xqo = __int_as_float(__builtin_amdgcn_ds_swizzle(__float_as_int(xq), 0x401F));
                const float qpe = p < 16 ? xq * cs - xqo * sn : xqo * sn + xq * cs;
                const float q0 = aq[0][r], q1 = aq[1][r];
                const float rq = rsq_(half_sum32(q0 * q0 + q1 * q1 + qpe * qpe) * (1.f / 96.f) + 1e-6f);
                st_put(ST, i, p, q0 * rq * gq0); st_put(ST, i, 32 + p, q1 * rq * gq1); st_put(ST, i, 64 + p, qpe * rq * gq2);
                if ((r & 3) == 3) asm volatile("" ::: "memory");
              }
              st_flush<96>(ST, QMu + hq * 96, 384, lane, dry); }
        } else if (PZ_PART & 6) {
            const int hq = wave - 4, gi = wave - 4; const int fi = p & 15;
            { f32x16 ak[2] = {zero16, zero16};
              pz_gemm<256, 8, 2, 4>(ak, L + PZ_KVN, SW + O_WKVT, 128, hq * 128, p, h);
              const float gk0 = qkg[96 + p], gk1 = qkg[96 + 32 + p], gk2 = qkg[96 + 64 + p];
              float csv[16], snv[16]; bf16 xkv[16];
#pragma unroll
              for (int r = 0; r < 16; ++r) { csv[r] = ctu[qrow(r, h) * 16 + fi]; snv[r] = stu[qrow(r, h) * 16 + fi]; xkv[r] = zu[(unsigned)(qrow(r, h) * NZ + OFF_KROPE + p)]; }
#pragma unroll
              for (int r = 0; r < 16; ++r) {
                const int i = qrow(r, h);
                const float cs = csv[r], sn = snv[r];
                const float xk = bf2f(xkv[r]), xko = __int_as_float(__builtin_amdgcn_ds_swizzle(__float_as_int(xk), 0x401F));
                const float kpe = p < 16 ? xk * cs - xko * sn : xko * sn + xk * cs;
                const float k0 = ak[0][r], k1 = ak[1][r];
                const float rk = rsq_(half_sum32(k0 * k0 + k1 * k1 + kpe * kpe) * (1.f / 96.f) + 1e-6f);
                st_put(ST, i, p, k0 * rk * gk0); st_put(ST, i, 32 + p, k1 * rk * gk1); st_put(ST, i, 64 + p, kpe * rk * gk2);
                if ((r & 3) == 3) asm volatile("" ::: "memory");
              }
              st_flush_kimg(ST, KM + ((size_t)(((t0 / T) * 4 + hq) * 64 + (tt0 >> 6)) * 6144 + (unsigned)((tt0 & 63) * 8)), lane, dry); }
            { f32x16 av[2] = {zero16, zero16};
              pz_gemm<256, 8, 2, 4>(av, L + PZ_KVN, SW + O_WKVT, 128, hq * 128 + 64, p, h);
              { bf16* vt = (bf16*)(ws + WS_VT) + (size_t)(((t0 / T) * 4 + hq) * 128 + tt0 / 32) * 2048;
#pragma unroll
                for (int jt = 0; jt < 2; ++jt)
#pragma unroll
                    for (int s2 = 0; s2 < 2; ++s2) if (!dry) { *(bf16x8*)(vt + (unsigned)(((jt * 2 + s2) * 64 + (((h & 1) << 5) | p)) * 8)) = accfrag(av[jt], s2); } }
              asm volatile("" ::: "memory"); }

            f32x16 ap[2] = {zero16, zero16};
            pz_gemm<512, 4, 2>(ap, L + PZ_PP, SW + O_POOLT + gi * 4096, 64, 0, p, h, 8 * gi);
            const float ps0 = pools[gi * 64 + p], ps1 = pools[gi * 64 + 32 + p];
#pragma unroll
            for (int r = 0; r < 16; ++r) { st_put(ST, qrow(r, h), p, ap[0][r] * ps0); st_put(ST, qrow(r, h), 32 + p, ap[1][r] * ps1); }
            st_flush<64>(ST, mixu + 512 + gi * 64, D, lane, dry);
        }
        if (!(dry && (PZ_ABL & 1))) {
            const int hh = wave;
            { f32x16 aG[2] = {zero16, zero16};
              pz_gemm<320, 10, 2, 5>(aG, L + PZ_XG, SW + O_G2T, 160, hh * 64, p, h);
              { unsigned char* XGb = ws + WS_G + ((size_t)unit * NH + hh) * (4 * 64 * 16); const unsigned lo16 = (unsigned)lane * 16u;
#pragma unroll
                for (int jt = 0; jt < 2; ++jt)
#pragma unroll
                    for (int hq = 0; hq < 2; ++hq) if (!dry) *(v4u*)(XGb + (lo16 + (unsigned)((jt * 2 + hq) * 1024))) = (v4u){cvtpk(aG[jt][8 * hq], aG[jt][8 * hq + 1]), cvtpk(aG[jt][8 * hq + 2], aG[jt][8 * hq + 3]), cvtpk(aG[jt][8 * hq + 4], aG[jt][8 * hq + 5]), cvtpk(aG[jt][8 * hq + 6], aG[jt][8 * hq + 7])}; }
              asm volatile("" ::: "memory"); }
            float lwv[2][16]; unsigned pkk[2][8], paa[2][8], pkf[2][8], prr[2][8], pvv[2][8], pgv[2][8];
            { f32x16 aA[2] = {zero16, zero16};
              pz_gemm<128, 4, 2>(aA, L + PZ_XA, SW + O_A2T, 64, hh * 64, p, h);
#pragma unroll
              for (int jt = 0; jt < 2; ++jt) { const float a0 = rvec[RW + hh * 64 + 32 * jt + p];
#pragma unroll
                  for (int q = 0; q < 8; ++q) paa[jt][q] = cvtpk(sigmoidf_(a0 + aA[jt][2 * q]), sigmoidf_(a0 + aA[jt][2 * q + 1])); } }
            if (l > 0) { f32x16 aV[2] = {zero16, zero16};
              pz_gemm<64, 2, 2>(aV, L + PZ_XV, SW + O_V2T, 32, hh * 64, p, h);
#pragma unroll
              for (int jt = 0; jt < 2; ++jt) { const float v0c = v0p[hh * 64 + 32 * jt + p];
#pragma unroll
                  for (int q = 0; q < 8; ++q) pgv[jt][q] = cvtpk(sigmoidf_(v0c + aV[jt][2 * q]), sigmoidf_(v0c + aV[jt][2 * q + 1])); } }
            unsigned char* XAb = ws + WS_XV + ((size_t)unit * NH + hh) * (4 * 64 * 16);
            {
            LAS unsigned* stash = (LAS unsigned*)ST + lane;
            float mr[2], mk[2], mv[2], kkc[2], kac[2], rkc[2];
#pragma unroll
            for (int jt = 0; jt < 2; ++jt) { const int c = hh * 64 + 32 * jt + p; mr[jt] = mu[c]; mk[jt] = mu[512 + c]; mv[jt] = mu[1024 + c];
                kkc[jt] = rvec[2 * RW + c]; kac[jt] = rvec[3 * RW + c]; rkc[jt] = rvec[4 * RW + c]; }
            bf16 rw[2][2][7];
#define ZL_LOAD(BUF, R) do { int hv_ = h; asm volatile("" : "+v"(hv_)); const int i_ = qrow((R), hv_); const bool hp_ = (tt0 + i_) > 0; \
                const bf16* zc_ = zu + (i_ * NZ + hh * 64 + p); const bf16* zp_ = hp_ ? zc_ - NZ : zc_; const unsigned ov_ = (unsigned)(i_ * RW + hh * 64 + p); \
                _Pragma("unroll") for (int jt_ = 0; jt_ < 2; ++jt_) { rw[BUF][jt_][0] = zc_[32 * jt_]; rw[BUF][jt_][1] = zc_[512 + 32 * jt_]; rw[BUF][jt_][2] = zc_[1024 + 32 * jt_]; \
                    rw[BUF][jt_][3] = zp_[32 * jt_]; rw[BUF][jt_][4] = zp_[512 + 32 * jt_]; rw[BUF][jt_][5] = zp_[1024 + 32 * jt_]; rw[BUF][jt_][6] = l > 0 ? VFu[ov_ + 32u * jt_] : (bf16)0; } } while (0)
            ZL_LOAD(0, 0);
#pragma unroll
            for (int rp = 0; rp < 8; ++rp) {
                float kk2[2][2], k2[2][2], r2[2][2], v2[2][2];
#pragma unroll
                for (int rr = 0; rr < 2; ++rr) {
                    const int r = 2 * rp + rr;
                    if (r + 1 < 16) ZL_LOAD((r + 1) & 1, r + 1);
                    int hv = h; asm volatile("" : "+v"(hv));
                    const int i = qrow(r, hv); const bool hp = (tt0 + i) > 0;
                    const float pm = hp ? 1.f : 0.f;
                    const unsigned ov = (unsigned)(i * RW + hh * 64 + p);
                    float kkr[2]; float n2 = 0.f, bs = 0.f;
#pragma unroll
                    for (int jt = 0; jt < 2; ++jt) {
                        const bf16* w_ = rw[r & 1][jt];
                        const float zr_ = bf2f(w_[0]), zk_ = bf2f(w_[1]), zv_ = bf2f(w_[2]);
                        const float pr_ = pm * bf2f(w_[3]), pk_ = pm * bf2f(w_[4]), pv_ = pm * bf2f(w_[5]);
                        const float rv = zr_ + mr[jt] * (pr_ - zr_), k0 = zk_ + mk[jt] * (pk_ - zk_), v0 = zv_ + mv[jt] * (pv_ - zv_);
                        float v = v0;
                        if (l == 0) { if (!dry) { VFu[ov + 32u * jt] = (bf16)f2bf(v0); } }
                        else { const float vf = bf2f(w_[6]); v = v0 + (vf - v0) * (rr ? bfhi(pgv[jt][rp]) : bflo(pgv[jt][rp])); }
                        const float aa = rr ? bfhi(paa[jt][rp]) : bflo(paa[jt][rp]);
                        kkr[jt] = k0 * kkc[jt]; n2 += kkr[jt] * kkr[jt];
                        const float k = k0 * (1.f + (aa - 1.f) * kac[jt]);
                        r2[jt][rr] = bf2f((bf16)f2bf(rv)); k2[jt][rr] = bf2f((bf16)f2bf(k)); v2[jt][rr] = bf2f((bf16)f2bf(v));
                        bs += r2[jt][rr] * k2[jt][rr] * rkc[jt];
                    }
                    n2 = half_sum32(n2); bs = half_sum32(bs);
                    const float inv = rsq_(fmaxf(n2, 1e-24f));
                    kk2[0][rr] = kkr[0] * inv; kk2[1][rr] = kkr[1] * inv;
                    if (p == 0) if (!dry) { BONu[(unsigned)(i * 8 + hh)] = bs; }
                }
#pragma unroll
                for (int jt = 0; jt < 2; ++jt) { pkk[jt][rp] = cvtpk(kk2[jt][0], kk2[jt][1]); pkf[jt][rp] = cvtpk(k2[jt][0], k2[jt][1]);
                    prr[jt][rp] = cvtpk(r2[jt][0], r2[jt][1]); pvv[jt][rp] = cvtpk(v2[jt][0], v2[jt][1]); }
                asm volatile("" ::: "memory");
                if (rp == 3) {
#pragma unroll
                    for (int jt = 0; jt < 2; ++jt)
#pragma unroll
                        for (int q = 0; q < 4; ++q) { stash[((jt * 4 + q) * 4 + 0) * 64] = pkk[jt][q]; stash[((jt * 4 + q) * 4 + 1) * 64] = pkf[jt][q]; stash[((jt * 4 + q) * 4 + 2) * 64] = prr[jt][q]; stash[((jt * 4 + q) * 4 + 3) * 64] = pvv[jt][q]; }
                    asm volatile("" ::: "memory");
                }
            }
#undef ZL_LOAD
            LDS_WAIT();
#pragma unroll
            for (int jt = 0; jt < 2; ++jt)
#pragma unroll
                for (int q = 0; q < 4; ++q) { pkk[jt][q] = stash[((jt * 4 + q) * 4 + 0) * 64]; pkf[jt][q] = stash[((jt * 4 + q) * 4 + 1) * 64]; prr[jt][q] = stash[((jt * 4 + q) * 4 + 2) * 64]; pvv[jt][q] = stash[((jt * 4 + q) * 4 + 3) * 64]; }
#pragma unroll
            for (int jt = 0; jt < 2; ++jt) { if (!dry) { const unsigned lo16 = (unsigned)lane * 16u; *(v4u*)(XAb + (lo16 + (unsigned)((jt * 2) * 1024))) = (v4u){pvv[jt][0], pvv[jt][1], pvv[jt][2], pvv[jt][3]}; *(v4u*)(XAb + (lo16 + (unsigned)((jt * 2 + 1) * 1024))) = (v4u){pvv[jt][4], pvv[jt][5], pvv[jt][6], pvv[jt][7]}; } }
            }
            { f32x16 aW[2] = {zero16, zero16};
              int p_ = p, h_ = h; asm volatile("" : "+v"(p_), "+v"(h_));
              pz_gemm<128, 4, 2>(aW, L + PZ_XW, SW + O_W2T, 64, hh * 64, p_, h_);
#pragma unroll
              for (int jt = 0; jt < 2; ++jt) { const float w0 = rvec[hh * 64 + 32 * jt + p];
#pragma unroll
                  for (int r = 0; r < 16; ++r) lwv[jt][r] = -0.6065306597126334f * sigmoidf_(w0 + aW[jt][r]); } }
            __syncthreads();
            if (!dry) {
            const size_t item_ = (size_t)unit * NH + hh;
            LAS unsigned char* TT = L + wave * 16384; LAS float* gC = (LAS float*)(lds + LDSCTL_OFF + 4096) + wave * 64;
            bf16x8 fAT[2][2], fBT[2][2], fKT[2][2], fRT[2][2], fVT[2][2];
#pragma unroll
            for (int jt = 0; jt < 2; ++jt) {
                float cum[16], tot[4], oth[4];
#pragma unroll
                for (int g = 0; g < 4; ++g) { cum[4 * g] = lwv[jt][4 * g]; cum[4 * g + 1] = cum[4 * g] + lwv[jt][4 * g + 1]; cum[4 * g + 2] = cum[4 * g + 1] + lwv[jt][4 * g + 2]; cum[4 * g + 3] = cum[4 * g + 2] + lwv[jt][4 * g + 3];
                    tot[g] = cum[4 * g + 3]; oth[g] = other_half(tot[g]); }
                float run = 0.f;
#pragma unroll
                for (int g = 0; g < 4; ++g) { const float base = run + (h ? oth[g] : 0.f);
#pragma unroll
                    for (int b4 = 0; b4 < 4; ++b4) cum[4 * g + b4] += base;
                    run += tot[g] + oth[g]; }
                gC[32 * jt + p] = __expf(run);
#pragma unroll
                for (int s2 = 0; s2 < 2; ++s2) {
                    unsigned da[4], db[4], dk[4], dr[4];
#pragma unroll
                    for (int qq = 0; qq < 4; ++qq) { const int q = 4 * s2 + qq;
                        float at2[2], bt2[2], kt2[2], rt2[2];
#pragma unroll
                        for (int rr = 0; rr < 2; ++rr) { const int r = 2 * q + rr; const float cv = cum[r], cx = cv - lwv[jt][r];
                            const float ea = __expf(cx), eb = __expf(-cv), er = __expf(cv);
                            const float kk = rr ? bfhi(pkk[jt][q]) : bflo(pkk[jt][q]), aa = rr ? bfhi(paa[jt][q]) : bflo(paa[jt][q]);
                            const float kf = rr ? bfhi(pkf[jt][q]) : bflo(pkf[jt][q]), rv = rr ? bfhi(prr[jt][q]) : bflo(prr[jt][q]);
                            at2[rr] = -kk * ea; bt2[rr] = kk * aa * eb; kt2[rr] = kf * eb; rt2[rr] = rv * er; }
                        da[qq] = cvtpk(at2[0], at2[1]); db[qq] = cvtpk(bt2[0], bt2[1]); dk[qq] = cvtpk(kt2[0], kt2[1]); dr[qq] = cvtpk(rt2[0], rt2[1]); }
                    fAT[jt][s2] = mkfrag(da[0], da[1], da[2], da[3]); fBT[jt][s2] = mkfrag(db[0], db[1], db[2], db[3]); fKT[jt][s2] = mkfrag(dk[0], dk[1], dk[2], dk[3]); fRT[jt][s2] = mkfrag(dr[0], dr[1], dr[2], dr[3]);
                    fVT[jt][s2] = mkfrag(pvv[jt][4 * s2], pvv[jt][4 * s2 + 1], pvv[jt][4 * s2 + 2], pvv[jt][4 * s2 + 3]);
                }
            }
            const int wbase = h * 512 + p * 2, rbase = p * 128 + h * 16;
#define TM_PUT(TILE, ARR) do { _Pragma("unroll") for (int jt = 0; jt < 2; ++jt) _Pragma("unroll") for (int r = 0; r < 16; ++r) \
                *(LAS bf16*)(TT + wbase + ((TILE) * 4096 + ((r & 3) + 8 * (r >> 2)) * 128 + jt * 64)) = (bf16)ARR[jt][r >> 3][r & 7]; } while (0)
            LDS_WAIT();
            TM_PUT(0, fAT); TM_PUT(1, fBT); TM_PUT(2, fKT); TM_PUT(3, fRT);
            LDS_WAIT();
#undef TM_PUT
            f32x16 Aab = zero16, AabT = zero16, Aak = zero16, Arb = zero16, Ark = zero16;
#pragma unroll
            for (int s4 = 0; s4 < 4; ++s4) {
                const bf16x8 fa = *(const LAS bf16x8*)(TT + rbase + s4 * 32), fb = *(const LAS bf16x8*)(TT + rbase + 4096 + s4 * 32), fk = *(const LAS bf16x8*)(TT + rbase + 8192 + s4 * 32), fr = *(const LAS bf16x8*)(TT + rbase + 12288 + s4 * 32);
                Aab = MFMA32(fb, fa, Aab); AabT = MFMA32(fa, fb, AabT); Aak = MFMA32(fk, fa, Aak); Arb = MFMA32(fb, fr, Arb); Ark = MFMA32(fk, fr, Ark);
            }
#pragma unroll
            for (int r = 0; r < 16; ++r) { const int q = qrow(r, h);
                Aab[r] = (q < p) ? Aab[r] : 0.f;  Aak[r] = (q < p) ? Aak[r] : 0.f; AabT[r] = (p < q) ? AabT[r] : 0.f;
                Arb[r] = (q <= p) ? Arb[r] : 0.f; Ark[r] = (q <= p) ? Ark[r] : 0.f; }
            f32x16 Tm = Aab;
#pragma unroll
            for (int r = 0; r < 16; ++r) Tm[r] += (qrow(r, h) == p) ? 1.f : 0.f;
            bf16x8 X0 = accfrag(Aab, 0), X1 = accfrag(Aab, 1), XT0 = accfrag(AabT, 0), XT1 = accfrag(AabT, 1);
#pragma unroll
            for (int it = 0; it < 4; ++it) {
                f32x16 X2T = MFMA32(X0, XT0, zero16); X2T = MFMA32(X1, XT1, X2T);
                const bf16x8 T0 = accfrag(Tm, 0), T1 = accfrag(Tm, 1);
                const bf16x8 Y0 = accfrag(X2T, 0), Y1 = accfrag(X2T, 1);
                Tm = MFMA32(Y0, T0, Tm); Tm = MFMA32(Y1, T1, Tm);
                if (it < 3) { f32x16 X2 = MFMA32(XT0, X0, zero16); X2 = MFMA32(XT1, X1, X2); X0 = accfrag(X2, 0); X1 = accfrag(X2, 1); XT0 = Y0; XT1 = Y1; }
            }
            const bf16x8 Tf0 = accfrag(Tm, 0), Tf1 = accfrag(Tm, 1);
            const bf16x8 Akf0 = accfrag(Aak, 0), Akf1 = accfrag(Aak, 1), Abf0 = accfrag(Arb, 0), Abf1 = accfrag(Arb, 1), Arf0 = accfrag(Ark, 0), Arf1 = accfrag(Ark, 1);
            bf16x8 fPT[2][2], fQT[2][2];
#pragma unroll
            for (int ct = 0; ct < 2; ++ct) {
                f32x16 a_ = MFMA32(Tf0, fAT[ct][0], zero16); a_ = MFMA32(Tf1, fAT[ct][1], a_); fPT[ct][0] = accfrag(a_, 0); fPT[ct][1] = accfrag(a_, 1);
                f32x16 b_ = MFMA32(Akf0, fVT[ct][0], zero16); b_ = MFMA32(Akf1, fVT[ct][1], b_);
                const bf16x8 av0 = accfrag(b_, 0), av1 = accfrag(b_, 1);
                f32x16 c_ = MFMA32(Tf0, av0, zero16); c_ = MFMA32(Tf1, av1, c_); fQT[ct][0] = accfrag(c_, 0); fQT[ct][1] = accfrag(c_, 1);
            }
            const int ln_ = ((h & 1) << 5) | p;
            bf16* RPo = (bf16*)(ws + WS_SRP) + item_ * 2048; bf16* YLo = (bf16*)(ws + WS_SYL) + item_ * 2048;
            bf16* Mo = (bf16*)(ws + WS_SM) + item_ * 4096; bf16* NTo = (bf16*)(ws + WS_SNT) + item_ * 4096;
#pragma unroll
            for (int ct = 0; ct < 2; ++ct) {
                f32x16 a_;
#pragma unroll
                for (int g = 0; g < 4; ++g) { const v2u w = *(const LAS v2u*)(TT + (p * 128 + 8 * h) + (12288 + (4 * ct + g) * 16));
                    a_[4 * g] = bflo(w.x); a_[4 * g + 1] = bfhi(w.x); a_[4 * g + 2] = bflo(w.y); a_[4 * g + 3] = bfhi(w.y); }
                a_ = MFMA32(fPT[ct][0], Abf0, a_); a_ = MFMA32(fPT[ct][1], Abf1, a_);
#pragma unroll
                for (int s2 = 0; s2 < 2; ++s2) *(bf16x8*)(RPo + (unsigned)(((2 * ct + s2) * 64 + ln_) * 8)) = accfrag(a_, s2);
                f32x16 y_ = MFMA32(Abf0, fQT[ct][0], zero16); y_ = MFMA32(Abf1, fQT[ct][1], y_); y_ = MFMA32(Arf0, fVT[ct][0], y_); y_ = MFMA32(Arf1, fVT[ct][1], y_);
#pragma unroll
                for (int s2 = 0; s2 < 2; ++s2) *(bf16x8*)(YLo + (unsigned)(((2 * ct + s2) * 64 + ln_) * 8)) = accfrag(y_, s2);
            }
            LDS_WAIT();
#pragma unroll
            for (int ctp = 0; ctp < 2; ++ctp) {
                const float gl = gC[32 * ctp + p];
#pragma unroll
                for (int ct = 0; ct < 2; ++ct) {
                    f32x16 m_ = MFMA32(fPT[ct][0], fBT[ctp][0], zero16); m_ = MFMA32(fPT[ct][1], fBT[ctp][1], m_);
#pragma unroll
                    for (int r = 0; r < 16; ++r) m_[r] = (m_[r] + ((ct == ctp && qrow(r, h) == p) ? 1.f : 0.f)) * gl;
#pragma unroll
                    for (int s2 = 0; s2 < 2; ++s2) *(bf16x8*)(Mo + (unsigned)(((4 * ctp + 2 * ct + s2) * 64 + ln_) * 8)) = accfrag(m_, s2);
                    __builtin_amdgcn_sched_barrier(0);
                }
            }
#pragma unroll
            for (int ctd = 0; ctd < 2; ++ctd)
#pragma unroll
                for (int ctp = 0; ctp < 2; ++ctp) {
                    f32x16 n_ = MFMA32(fBT[ctp][0], fQT[ctd][0], zero16); n_ = MFMA32(fBT[ctp][1], fQT[ctd][1], n_); n_ = MFMA32(fKT[ctp][0], fVT[ctd][0], n_); n_ = MFMA32(fKT[ctp][1], fVT[ctd][1], n_);
#pragma unroll
                    for (int g = 0; g < 4; ++g) { const f32x4 gv = *(const LAS f32x4*)(gC + 4 * h + (32 * ctp + 8 * g)); n_[4 * g] *= gv.x; n_[4 * g + 1] *= gv.y; n_[4 * g + 2] *= gv.z; n_[4 * g + 3] *= gv.w; }
#pragma unroll
                    for (int s2 = 0; s2 < 2; ++s2) *(bf16x8*)(NTo + (unsigned)(((4 * ctd + 2 * ctp + s2) * 64 + ln_) * 8)) = accfrag(n_, s2);
                    __builtin_amdgcn_sched_barrier(0);
                }

            }
        }
    }
}

__device__ __forceinline__ void scan_local2_item(unsigned char* ws, int item_i, LAS unsigned char* TT, LAS float* gC, int lane) {
    const size_t item = (size_t)item_i; const int p = lane & 31, h = lane >> 5;
    const f32x16 zero16 = {0.f, 0.f, 0.f, 0.f, 0.f, 0.f, 0.f, 0.f, 0.f, 0.f, 0.f, 0.f, 0.f, 0.f, 0.f, 0.f};
    float lwv[2][16]; unsigned pkk[2][8], paa[2][8], pkf[2][8], prr[2][8], pvv[2][8];
    { const v4u* XA = (const v4u*)(ws + WS_XA) + (item * 20) * 64 + lane; const v4u* XL = (const v4u*)(ws + WS_XL) + (item * 8) * 64 + lane;
#pragma unroll
      for (int jt = 0; jt < 2; ++jt)
#pragma unroll
          for (int hq = 0; hq < 2; ++hq) {
              { const v4u w = XA[(0 * 4 + jt * 2 + hq) * 64]; pkk[jt][4 * hq] = w.x; pkk[jt][4 * hq + 1] = w.y; pkk[jt][4 * hq + 2] = w.z; pkk[jt][4 * hq + 3] = w.w; }
              { const v4u w = XA[(1 * 4 + jt * 2 + hq) * 64]; paa[jt][4 * hq] = w.x; paa[jt][4 * hq + 1] = w.y; paa[jt][4 * hq + 2] = w.z; paa[jt][4 * hq + 3] = w.w; }
              { const v4u w = XA[(2 * 4 + jt * 2 + hq) * 64]; pkf[jt][4 * hq] = w.x; pkf[jt][4 * hq + 1] = w.y; pkf[jt][4 * hq + 2] = w.z; pkf[jt][4 * hq + 3] = w.w; }
              { const v4u w = XA[(3 * 4 + jt * 2 + hq) * 64]; prr[jt][4 * hq] = w.x; prr[jt][4 * hq + 1] = w.y; prr[jt][4 * hq + 2] = w.z; prr[jt][4 * hq + 3] = w.w; }
              { const v4u w = XA[(4 * 4 + jt * 2 + hq) * 64]; pvv[jt][4 * hq] = w.x; pvv[jt][4 * hq + 1] = w.y; pvv[jt][4 * hq + 2] = w.z; pvv[jt][4 * hq + 3] = w.w; } }
#pragma unroll
      for (int jt = 0; jt < 2; ++jt)
#pragma unroll
          for (int g = 0; g < 4; ++g) { const v4u w = XL[(jt * 4 + g) * 64]; lwv[jt][4 * g] = __uint_as_float(w.x); lwv[jt][4 * g + 1] = __uint_as_float(w.y); lwv[jt][4 * g + 2] = __uint_as_float(w.z); lwv[jt][4 * g + 3] = __uint_as_float(w.w); } }
    {
            bf16x8 fAT[2][2], fBT[2][2], fKT[2][2], fRT[2][2], fVT[2][2];
#pragma unroll
            for (int jt = 0; jt < 2; ++jt) {
                float cum[16], tot[4], oth[4];
#pragma unroll
                for (int g = 0; g < 4; ++g) { cum[4 * g] = lwv[jt][4 * g]; cum[4 * g + 1] = cum[4 * g] + lwv[jt][4 * g + 1]; cum[4 * g + 2] = cum[4 * g + 1] + lwv[jt][4 * g + 2]; cum[4 * g + 3] = cum[4 * g + 2] + lwv[jt][4 * g + 3];
                    tot[g] = cum[4 * g + 3]; oth[g] = other_half(tot[g]); }
                float run = 0.f;
#pragma unroll
                for (int g = 0; g < 4; ++g) { const float base = run + (h ? oth[g] : 0.f);
#pragma unroll
                    for (int b4 = 0; b4 < 4; ++b4) cum[4 * g + b4] += base;
                    run += tot[g] + oth[g]; }
                gC[32 * jt + p] = __expf(run);
#pragma unroll
                for (int s2 = 0; s2 < 2; ++s2) {
                    unsigned da[4], db[4], dk[4], dr[4];
#pragma unroll
                    for (int qq = 0; qq < 4; ++qq) { const int q = 4 * s2 + qq;
                        float at2[2], bt2[2], kt2[2], rt2[2];
#pragma unroll
                        for (int rr = 0; rr < 2; ++rr) { const int r = 2 * q + rr; const float cv = cum[r], cx = cv - lwv[jt][r];
                            const float ea = __expf(cx), eb = __expf(-cv), er = __expf(cv);
                            const float kk = rr ? bfhi(pkk[jt][q]) : bflo(pkk[jt][q]), aa = rr ? bfhi(paa[jt][q]) : bflo(paa[jt][q]);
                            const float kf = rr ? bfhi(pkf[jt][q]) : bflo(pkf[jt][q]), rv = rr ? bfhi(prr[jt][q]) : bflo(prr[jt][q]);
                            at2[rr] = -kk * ea; bt2[rr] = kk * aa * eb; kt2[rr] = kf * eb; rt2[rr] = rv * er; }
                        da[qq] = cvtpk(at2[0], at2[1]); db[qq] = cvtpk(bt2[0], bt2[1]); dk[qq] = cvtpk(kt2[0], kt2[1]); dr[qq] = cvtpk(rt2[0], rt2[1]); }
                    fAT[jt][s2] = mkfrag(da[0], da[1], da[2], da[3]); fBT[jt][s2] = mkfrag(db[0], db[1], db[2], db[3]); fKT[jt][s2] = mkfrag(dk[0], dk[1], dk[2], dk[3]); fRT[jt][s2] = mkfrag(dr[0], dr[1], dr[2], dr[3]);
                    fVT[jt][s2] = mkfrag(pvv[jt][4 * s2], pvv[jt][4 * s2 + 1], pvv[jt][4 * s2 + 2], pvv[jt][4 * s2 + 3]);
                }
            }
            const int wbase = h * 512 + p * 2, rbase = p * 128 + h * 16;
#define TM_PUT(TILE, ARR) do { _Pragma("unroll") for (int jt = 0; jt < 2; ++jt) _Pragma("unroll") for (int r = 0; r < 16; ++r) \
                *(LAS bf16*)(TT + wbase + ((TILE) * 4096 + ((r & 3) + 8 * (r >> 2)) * 128 + jt * 64)) = (bf16)ARR[jt][r >> 3][r & 7]; } while (0)
            LDS_WAIT();
            TM_PUT(0, fAT); TM_PUT(1, fBT); TM_PUT(2, fKT); TM_PUT(3, fRT);
            LDS_WAIT();
#undef TM_PUT
            f32x16 Aab = zero16, AabT = zero16, Aak = zero16, Arb = zero16, Ark = zero16;
#pragma unroll
            for (int s4 = 0; s4 < 4; ++s4) {
                const bf16x8 fa = *(const LAS bf16x8*)(TT + rbase + s4 * 32), fb = *(const LAS bf16x8*)(TT + rbase + 4096 + s4 * 32), fk = *(const LAS bf16x8*)(TT + rbase + 8192 + s4 * 32), fr = *(const LAS bf16x8*)(TT + rbase + 12288 + s4 * 32);
                Aab = MFMA32(fb, fa, Aab); AabT = MFMA32(fa, fb, AabT); Aak = MFMA32(fk, fa, Aak); Arb = MFMA32(fb, fr, Arb); Ark = MFMA32(fk, fr, Ark);
            }
#pragma unroll
            for (int r = 0; r < 16; ++r) { const int q = qrow(r, h);
                Aab[r] = (q < p) ? Aab[r] : 0.f;  Aak[r] = (q < p) ? Aak[r] : 0.f; AabT[r] = (p < q) ? AabT[r] : 0.f;
                Arb[r] = (q <= p) ? Arb[r] : 0.f; Ark[r] = (q <= p) ? Ark[r] : 0.f; }
            f32x16 Tm = Aab;
#pragma unroll
            for (int r = 0; r < 16; ++r) Tm[r] += (qrow(r, h) == p) ? 1.f : 0.f;
            bf16x8 X0 = accfrag(Aab, 0), X1 = accfrag(Aab, 1), XT0 = accfrag(AabT, 0), XT1 = accfrag(AabT, 1);
#pragma unroll
            for (int it = 0; it < 4; ++it) {
                f32x16 X2T = MFMA32(X0, XT0, zero16); X2T = MFMA32(X1, XT1, X2T);
                const bf16x8 T0 = accfrag(Tm, 0), T1 = accfrag(Tm, 1);
                const bf16x8 Y0 = accfrag(X2T, 0), Y1 = accfrag(X2T, 1);
                Tm = MFMA32(Y0, T0, Tm); Tm = MFMA32(Y1, T1, Tm);
                if (it < 3) { f32x16 X2 = MFMA32(XT0, X0, zero16); X2 = MFMA32(XT1, X1, X2); X0 = accfrag(X2, 0); X1 = accfrag(X2, 1); XT0 = Y0; XT1 = Y1; }
            }
            const bf16x8 Tf0 = accfrag(Tm, 0), Tf1 = accfrag(Tm, 1);
            const bf16x8 Akf0 = accfrag(Aak, 0), Akf1 = accfrag(Aak, 1), Abf0 = accfrag(Arb, 0), Abf1 = accfrag(Arb, 1), Arf0 = accfrag(Ark, 0), Arf1 = accfrag(Ark, 1);
            bf16x8 fPT[2][2], fQT[2][2];
#pragma unroll
            for (int ct = 0; ct < 2; ++ct) {
                f32x16 a_ = MFMA32(Tf0, fAT[ct][0], zero16); a_ = MFMA32(Tf1, fAT[ct][1], a_); fPT[ct][0] = accfrag(a_, 0); fPT[ct][1] = accfrag(a_, 1);
                f32x16 b_ = MFMA32(Akf0, fVT[ct][0], zero16); b_ = MFMA32(Akf1, fVT[ct][1], b_);
                const bf16x8 av0 = accfrag(b_, 0), av1 = accfrag(b_, 1);
                f32x16 c_ = MFMA32(Tf0, av0, zero16); c_ = MFMA32(Tf1, av1, c_); fQT[ct][0] = accfrag(c_, 0); fQT[ct][1] = accfrag(c_, 1);
            }
            bf16* RPo = (bf16*)(ws + WS_SRP) + item * 2048; bf16* YLo = (bf16*)(ws + WS_SYL) + item * 2048;
            bf16* Mo = (bf16*)(ws + WS_SM) + item * 4096; bf16* NTo = (bf16*)(ws + WS_SNT) + item * 4096;
#pragma unroll
            for (int ct = 0; ct < 2; ++ct) {
                f32x16 a_;
#pragma unroll
                for (int g = 0; g < 4; ++g) { const v2u w = *(const LAS v2u*)(TT + (p * 128 + 8 * h) + (12288 + (4 * ct + g) * 16));
                    a_[4 * g] = bflo(w.x); a_[4 * g + 1] = bfhi(w.x); a_[4 * g + 2] = bflo(w.y); a_[4 * g + 3] = bfhi(w.y); }
                a_ = MFMA32(fPT[ct][0], Abf0, a_); a_ = MFMA32(fPT[ct][1], Abf1, a_);
#pragma unroll
                for (int s2 = 0; s2 < 2; ++s2) *(bf16x8*)(RPo + (unsigned)(p * 64 + (4 * ct + 2 * s2 + h) * 8)) = accfrag(a_, s2);
                f32x16 y_ = MFMA32(Abf0, fQT[ct][0], zero16); y_ = MFMA32(Abf1, fQT[ct][1], y_); y_ = MFMA32(Arf0, fVT[ct][0], y_); y_ = MFMA32(Arf1, fVT[ct][1], y_);
#pragma unroll
                for (int s2 = 0; s2 < 2; ++s2) *(bf16x8*)(YLo + (unsigned)((32 * ct + p) * 32 + (2 * s2 + h) * 8)) = accfrag(y_, s2);
            }
            LDS_WAIT();
#pragma unroll
            for (int ctp = 0; ctp < 2; ++ctp) {
                const float gl = gC[32 * ctp + p];
#pragma unroll
                for (int ct = 0; ct < 2; ++ct) {
                    f32x16 m_ = MFMA32(fPT[ct][0], fBT[ctp][0], zero16); m_ = MFMA32(fPT[ct][1], fBT[ctp][1], m_);
#pragma unroll
                    for (int r = 0; r < 16; ++r) m_[r] = (m_[r] + ((ct == ctp && qrow(r, h) == p) ? 1.f : 0.f)) * gl;
#pragma unroll
                    for (int s2 = 0; s2 < 2; ++s2) *(bf16x8*)(Mo + (unsigned)((32 * ctp + p) * 64 + (4 * ct + 2 * s2 + h) * 8)) = accfrag(m_, s2);
                    __builtin_amdgcn_sched_barrier(0);
                }
            }
#pragma unroll
            for (int ctd = 0; ctd < 2; ++ctd)
#pragma unroll
                for (int ctp = 0; ctp < 2; ++ctp) {
                    f32x16 n_ = MFMA32(fBT[ctp][0], fQT[ctd][0], zero16); n_ = MFMA32(fBT[ctp][1], fQT[ctd][1], n_); n_ = MFMA32(fKT[ctp][0], fVT[ctd][0], n_); n_ = MFMA32(fKT[ctp][1], fVT[ctd][1], n_);
#pragma unroll
                    for (int g = 0; g < 4; ++g) { const f32x4 gv = *(const LAS f32x4*)(gC + 4 * h + (32 * ctp + 8 * g)); n_[4 * g] *= gv.x; n_[4 * g + 1] *= gv.y; n_[4 * g + 2] *= gv.z; n_[4 * g + 3] *= gv.w; }
#pragma unroll
                    for (int s2 = 0; s2 < 2; ++s2) *(bf16x8*)(NTo + (unsigned)((32 * ctd + p) * 64 + (4 * ctp + 2 * s2 + h) * 8)) = accfrag(n_, s2);
                    __builtin_amdgcn_sched_barrier(0);
                }
    }
}
__device__ __forceinline__ void ph_scan_local2(unsigned char* ws, LAS unsigned char* lds, int gw, int NGW, int wave, int lane_in) {
    LAS unsigned char* TT = lds + RING_OFF + wave * 16384;
    LAS float* gC = (LAS float*)(lds + LDSCTL_OFF + 4096) + wave * 64;
    for (int item = gw; item < BATCH * NCHK * NH; item += NGW) { int lane = lane_in; asm volatile("" : "+v"(lane)); scan_local2_item(ws, item, TT, gC, lane); }
}
#ifndef DRY_REP
#define DRY_REP 0
#endif
#ifndef CARRY_ONLY_REP
#define CARRY_ONLY_REP 0
#endif
#ifndef ATTN_ONLY_REP
#define ATTN_ONLY_REP 0
#endif


__device__ __forceinline__ double rope_inv_freq(int i) {
    const double q = (i & 3) == 0 ? 1.0 : (i & 3) == 1 ? 0.5623413251903491 : (i & 3) == 2 ? 0.31622776601683794 : 0.1778279410038923;
    const double p = (i >> 2) == 0 ? 1.0 : (i >> 2) == 1 ? 0.1 : (i >> 2) == 2 ? 0.01 : 0.001;
    return q * p;
}
__device__ __forceinline__ void ph_mod_rope(const Args& a, unsigned char* ws, LAS unsigned char* lds, int gw, int NGW, int tid, int lane, int gtid, int GT) {
    const float* c = a.in[I_C]; const float* wada = a.in[I_WADA]; const float* bada = a.in[I_BADA];
    float* mod = (float*)(ws + WS_MOD);
    LAS float* cs = (LAS float*)(lds + RING_OFF);
    for (int i = tid; i < 8 * 1024; i += NWAVES * 64) { const float cv = c[i]; cs[i] = cv * sigmoidf_(cv); }
    __syncthreads();
    LAS float* red = cs + 8 * 1024;
    const int wave = tid >> 6;
    for (int it = blockIdx.x; it < 2 * 96; it += gridDim.x) {
        const int l = it / 96, jb = it % 96, kc = wave; const int j0 = jb * 64 + lane;
        float acc[8];
#pragma unroll
        for (int b = 0; b < 8; ++b) acc[b] = 0.f;
        const float* wp = wada + ((size_t)l * 1024 + kc * 128) * 6144 + j0;
#pragma unroll 16
        for (int k = 0; k < 128; ++k) { const float w = wp[(size_t)k * 6144];
#pragma unroll
            for (int b = 0; b < 8; ++b) acc[b] += w * cs[b * 1024 + kc * 128 + k]; }
        __syncthreads();
#pragma unroll
        for (int b = 0; b < 8; ++b) red[(wave * 8 + b) * 64 + lane] = acc[b];
        __syncthreads();
        { const int b = tid >> 6, j = tid & 63; float s = bada[l * 6144 + jb * 64 + j];
#pragma unroll
          for (int w = 0; w < 8; ++w) s += red[(w * 8 + b) * 64 + j];
          mod[(size_t)(l * 8 + b) * 6144 + jb * 64 + j] = s; }
    }
    const int* pos = (const int*)a.in[I_POS];
    float* ct = (float*)(ws + WS_COS); float* st = (float*)(ws + WS_SIN);
    for (int it = gtid; it < M * 16; it += GT) {
        const int t = it >> 4, i = it & 15;
        const double inv = rope_inv_freq(i);
        double rev = (double)pos[t] * inv * 0.15915494309189535;
        rev -= floor(rev);
        const float rf = (float)rev;
        ct[it] = __builtin_amdgcn_cosf(rf); st[it] = __builtin_amdgcn_sinf(rf);
    }
}

__device__ __forceinline__ void cvt_item(const float* W, int Nsrc, int K, bf16* WT, int dst_row0, int src_col0, int k0, LAS float* scr, int lane) {
    if (src_col0 >= 0) {
        const int lr = lane >> 3, lc = (lane & 7) * 4; f32x4 v[8];
        const float* src = W + (size_t)(k0 + lr) * Nsrc + src_col0 + lc;
#pragma unroll
        for (int i = 0; i < 8; ++i) v[i] = *(const f32x4*)(src + (size_t)(8 * i) * Nsrc);
#pragma unroll
        for (int i = 0; i < 8; ++i) { LAS float* dd = scr + (8 * i + lr) * 33 + lc; dd[0] = v[i].x; dd[1] = v[i].y; dd[2] = v[i].z; dd[3] = v[i].w; }
    } else {
#pragma unroll 8
        for (int i = 0; i < 32; ++i) { const int kk = 2 * i + (lane >> 5); scr[kk * 33 + (lane & 31)] = 0.f; }
    }
    LDS_WAIT();
    const int c = lane & 7;
#pragma unroll
    for (int j = 0; j < 4; ++j) { const int n = (lane >> 3) + 8 * j; const LAS float* s = scr + (8 * c) * 33 + n;
        v4u o; o.x = pk2(s[0 * 33], s[1 * 33]); o.y = pk2(s[2 * 33], s[3 * 33]); o.z = pk2(s[4 * 33], s[5 * 33]); o.w = pk2(s[6 * 33], s[7 * 33]);
        *(v4u*)(WT + (size_t)(dst_row0 + n) * K + k0 + 8 * c) = o; }
    LDS_WAIT();
}
__device__ __forceinline__ int swiglu_src_col(int nrow, int F) { const int pn = nrow >> 8, within = nrow & 255; return (within >> 7) * F + pn * 128 + (within & 127); }

__device__ __forceinline__ void cvt_item_f8(const float* W, int Nsrc, int K, unsigned char* WT, int dst_row0, int src_col0, int k0, LAS float* scr, int lane) {
    { const int lr = lane >> 3, lc = (lane & 7) * 4; f32x4 v[8];
      const float* src = W + (size_t)(k0 + lr) * Nsrc + src_col0 + lc;
#pragma unroll
      for (int i = 0; i < 8; ++i) v[i] = *(const f32x4*)(src + (size_t)(8 * i) * Nsrc);
#pragma unroll
      for (int i = 0; i < 8; ++i) { LAS float* dd = scr + (8 * i + lr) * 33 + lc; dd[0] = v[i].x * F8_WSCALE; dd[1] = v[i].y * F8_WSCALE; dd[2] = v[i].z * F8_WSCALE; dd[3] = v[i].w * F8_WSCALE; } }
    LDS_WAIT();
    const int c = lane & 3;
#pragma unroll
    for (int j = 0; j < 2; ++j) { const int n = (lane >> 2) + 16 * j; const LAS float* s = scr + (16 * c) * 33 + n;
        v4u o; o.x = f8pk4(s[0 * 33], s[1 * 33], s[2 * 33], s[3 * 33]); o.y = f8pk4(s[4 * 33], s[5 * 33], s[6 * 33], s[7 * 33]);
        o.z = f8pk4(s[8 * 33], s[9 * 33], s[10 * 33], s[11 * 33]); o.w = f8pk4(s[12 * 33], s[13 * 33], s[14 * 33], s[15 * 33]);
        *(v4u*)(WT + (size_t)(dst_row0 + n) * K + k0 + 16 * c) = o; }
    LDS_WAIT();
}
__device__ __forceinline__ void cvt_f8_load(f32x4 (&v)[8], const float* W, int Nsrc, int src_col0, int k0, int lane) {
    const int lr = lane >> 3, lc = (lane & 7) * 4; const float* src = W + (size_t)(k0 + lr) * Nsrc + src_col0 + lc;
#pragma unroll
    for (int i = 0; i < 8; ++i) v[i] = *(const f32x4*)(src + (size_t)(8 * i) * Nsrc);
}
__device__ __forceinline__ void cvt_f8_finish(const f32x4 (&v)[8], int K, unsigned char* WT, int dst_row0, int k0, LAS float* scr, int lane) {
    { const int lr = lane >> 3, lc = (lane & 7) * 4;
#pragma unroll
      for (int i = 0; i < 8; ++i) { LAS float* dd = scr + (8 * i + lr) * 33 + lc; dd[0] = v[i].x * F8_WSCALE; dd[1] = v[i].y * F8_WSCALE; dd[2] = v[i].z * F8_WSCALE; dd[3] = v[i].w * F8_WSCALE; } }
    LDS_WAIT();
    const int c = lane & 3;
#pragma unroll
    for (int j = 0; j < 2; ++j) { const int n = (lane >> 2) + 16 * j; const LAS float* s = scr + (16 * c) * 33 + n;
        v4u o; o.x = f8pk4(s[0 * 33], s[1 * 33], s[2 * 33], s[3 * 33]); o.y = f8pk4(s[4 * 33], s[5 * 33], s[6 * 33], s[7 * 33]);
        o.z = f8pk4(s[8 * 33], s[9 * 33], s[10 * 33], s[11 * 33]); o.w = f8pk4(s[12 * 33], s[13 * 33], s[14 * 33], s[15 * 33]);
        *(v4u*)(WT + (size_t)(dst_row0 + n) * K + k0 + 16 * c) = o; }
    LDS_WAIT();
}
__device__ __forceinline__ void ph_convert(const Args& a, unsigned char* ws, LAS unsigned char* lds, int gw, int NGW, int wave, int lane, int part) {
    LAS float* scr = (LAS float*)(lds + RING_OFF + wave * 16384);
    constexpr int I_WIN = 80 * 16;
    constexpr int I_WO = 32 * 16;
    constexpr int I_FI = 176 * 16;
    constexpr int I_FO = 32 * 44;
    constexpr int I_MI = 224 * 16;
    constexpr int I_MO = 32 * 56;
    constexpr int NITEMS = 2 * I_WIN + 2 * I_WO + I_FI + I_FO + 8 * I_MI + 8 * I_MO;
    constexpr int NDENSE = 2 * I_WIN + 2 * I_WO + I_FI + I_FO, HALFMOE = (NITEMS - NDENSE) / 2;
    static_assert((NITEMS - NDENSE) % 2 == 0, "MoE items");
    constexpr int NMIX = 2 * I_WIN + 2 * I_WO;
    const int lo = part == 0 ? 0 : NDENSE + (part - 1) * HALFMOE, hi = part == 0 ? NMIX : lo + HALFMOE;
    if (part == 1) {
        for (int it = NMIX + gw; it < NDENSE; it += NGW) { int r = it - NMIX;
            if (r < I_FI) { const int nb = r / 16, kb = r % 16;
                cvt_item(a.in[I_FFI], 2 * DFF, 1024, (bf16*)(ws + WS_WFFI), nb * 32, swiglu_src_col(nb * 32, DFF), kb * 64, scr, lane); continue; }
            r -= I_FI;
            { const int nb = r / 44, kb = r % 44;
              cvt_item(a.in[I_FFO], 1024, DFF, (bf16*)(ws + WS_WFFO), nb * 32, nb * 32, kb * 64, scr, lane); } }
    }
    if (part != 0) {
        const float* Wc; int Nc, Kc, drc, scc, k0c; unsigned char* WTc;
#define MOE_DECODE(it_, W_, N_, K_, WT_, dr_, sc_, k0_) do { int r_ = (it_) - NDENSE; \
            if (r_ < 8 * I_MI) { const int e_ = r_ / I_MI; r_ %= I_MI; const int nb_ = r_ / 16, kb_ = r_ % 16; W_ = a.in[I_MOEI] + (size_t)e_ * 1024 * 2 * DFFE; N_ = 2 * DFFE; K_ = 1024; \
                WT_ = ws + WS_WMI + (size_t)e_ * 2 * DFFE * 1024; dr_ = nb_ * 32; sc_ = swiglu_src_col(nb_ * 32, DFFE); k0_ = kb_ * 64; } \
            else { r_ -= 8 * I_MI; const int e_ = r_ / I_MO; r_ %= I_MO; const int nb_ = r_ / 56, kb_ = r_ % 56; W_ = a.in[I_MOEO] + (size_t)e_ * DFFE * 1024; N_ = 1024; K_ = DFFE; \
                WT_ = ws + WS_WMO + (size_t)e_ * 1024 * DFFE; dr_ = nb_ * 32; sc_ = nb_ * 32; k0_ = kb_ * 64; } } while (0)
        int it = lo + gw; if (it >= hi) return;
        f32x4 va[8], vb[8];
        MOE_DECODE(it, Wc, Nc, Kc, WTc, drc, scc, k0c); cvt_f8_load(va, Wc, Nc, scc, k0c, lane);
        for (;;) {
            const int itn = it + NGW; const bool more = itn < hi;
            const float* Wn = Wc; int Nn = Nc, Kn = Kc, drn = drc, scn = scc, k0n = k0c; unsigned char* WTn = WTc;
            if (more) { MOE_DECODE(itn, Wn, Nn, Kn, WTn, drn, scn, k0n); cvt_f8_load(vb, Wn, Nn, scn, k0n, lane); }
            cvt_f8_finish(va, Kc, WTc, drc, k0c, scr, lane);
            if (!more) break;
#pragma unroll
            for (int i = 0; i < 8; ++i) va[i] = vb[i];
            Wc = Wn; Nc = Nn; Kc = Kn; WTc = WTn; drc = drn; scc = scn; k0c = k0n; it = itn;
        }
#undef MOE_DECODE
        return;
    }
    for (int it = lo + gw; it < hi; it += NGW) {
        int r = it;
        if (r < 2 * I_WIN) { const int l = r / I_WIN; r %= I_WIN; const int nb = r / 16, kb = r % 16;
            const int nvalid = l == 0 ? N_IN0 / 32 : N_IN1 / 32;
            cvt_item(a.in[l == 0 ? I_WIN0 : I_WIN1], l == 0 ? N_IN0 : N_IN1, 1024, (bf16*)(ws + WS_WIN) + (size_t)l * NZ * 1024, nb * 32, nb < nvalid ? nb * 32 : -1, kb * 64, scr, lane); continue; }
        r -= 2 * I_WIN;
        if (r < 2 * I_WO) { const int l = r / I_WO; r %= I_WO; const int nb = r / 16, kb = r % 16;
            cvt_item(a.in[I_WOUT] + (size_t)l * 1024 * 1024, 1024, 1024, (bf16*)(ws + WS_WOUT) + (size_t)l * 1024 * 1024, nb * 32, nb * 32, kb * 64, scr, lane); continue; }
        r -= 2 * I_WO;
        if (r < I_FI) { const int nb = r / 16, kb = r % 16;
            cvt_item(a.in[I_FFI], 2 * DFF, 1024, (bf16*)(ws + WS_WFFI), nb * 32, swiglu_src_col(nb * 32, DFF), kb * 64, scr, lane); continue; }
        r -= I_FI;
        if (r < I_FO) { const int nb = r / 44, kb = r % 44;
            cvt_item(a.in[I_FFO], 1024, DFF, (bf16*)(ws + WS_WFFO), nb * 32, nb * 32, kb * 64, scr, lane); continue; }
        r -= I_FO;
        if (r < 8 * I_MI) { const int e = r / I_MI; r %= I_MI; const int nb = r / 16, kb = r % 16;
            cvt_item_f8(a.in[I_MOEI] + (size_t)e * 1024 * 2 * DFFE, 2 * DFFE, 1024, ws + WS_WMI + (size_t)e * 2 * DFFE * 1024, nb * 32, swiglu_src_col(nb * 32, DFFE), kb * 64, scr, lane); continue; }
        r -= 8 * I_MI;
        { const int e = r / I_MO; r %= I_MO; const int nb = r / 56, kb = r % 56;
            cvt_item_f8(a.in[I_MOEO] + (size_t)e * DFFE * 1024, 1024, DFFE, ws + WS_WMO + (size_t)e * 1024 * DFFE, nb * 32, nb * 32, kb * 64, scr, lane); }
    }
}

template <bool XB16> __device__ __forceinline__ f32x4 ld_x4(const void* x, size_t row, int idx) {
    if constexpr (XB16) { const v2u r = ((const v2u*)((const bf16*)x + row * D))[idx]; return (f32x4){bflo(r.x), bfhi(r.x), bflo(r.y), bfhi(r.y)}; }
    else return ((const f32x4*)((const float*)x + row * D))[idx];
}
template <bool ROUTE, bool F8OUT = false, bool XB16 = false>
__device__ __forceinline__ void ph_norm(const void* x, const float* gain, const float* mod_shift  , bf16* h,
                                        const float* router, unsigned char* ws, int gw, int NGW, int lane, LAS unsigned char* lds = nullptr) {
    if constexpr (!ROUTE) {
        for (int m0 = gw; m0 < M; m0 += 2 * NGW) {
            const int m1 = m0 + NGW < M ? m0 + NGW : m0;
            f32x4 v0[4], v1[4]; float s0 = 0.f, s1 = 0.f;
#pragma unroll
            for (int j = 0; j < 4; ++j) { v0[j] = ld_x4<XB16>(x, (size_t)m0, lane + 64 * j); v1[j] = ld_x4<XB16>(x, (size_t)m1, lane + 64 * j); }
#pragma unroll
            for (int j = 0; j < 4; ++j) { s0 += (v0[j].x * v0[j].x + v0[j].y * v0[j].y) + (v0[j].z * v0[j].z + v0[j].w * v0[j].w); s1 += (v1[j].x * v1[j].x + v1[j].y * v1[j].y) + (v1[j].z * v1[j].z + v1[j].w * v1[j].w); }
            const int b0 = m0 / T, b1 = m1 / T;
            const f32x4* gp = (const f32x4*)gain + lane;
            const f32x4* sh0 = (const f32x4*)(mod_shift + (size_t)b0 * 6144) + lane; const f32x4* sc0 = (const f32x4*)(mod_shift + (size_t)b0 * 6144 + 1024) + lane;
            const f32x4* sh1 = (const f32x4*)(mod_shift + (size_t)b1 * 6144) + lane; const f32x4* sc1 = (const f32x4*)(mod_shift + (size_t)b1 * 6144 + 1024) + lane;
            f32x4 gq[4], h0[4], c0[4], h1[4], c1[4];
#pragma unroll
            for (int j = 0; j < 4; ++j) { gq[j] = gp[64 * j]; h0[j] = sh0[64 * j]; c0[j] = sc0[64 * j]; h1[j] = sh1[64 * j]; c1[j] = sc1[64 * j]; }
            const float rs0 = 1.f / sqrtf(wave_sum(s0) * (1.f / D) + 1e-6f), rs1 = 1.f / sqrtf(wave_sum(s1) * (1.f / D) + 1e-6f);
            unsigned long long* o0 = (unsigned long long*)(h + (size_t)m0 * D) + lane; unsigned long long* o1 = (unsigned long long*)(h + (size_t)m1 * D) + lane;
#pragma unroll
            for (int j = 0; j < 4; ++j) { const f32x4 g = gq[j];
                const f32x4 a0 = (v0[j] * rs0) * g * (c0[j] + 1.f) + h0[j], a1 = (v1[j] * rs1) * g * (c1[j] + 1.f) + h1[j];
                if constexpr (F8OUT) { ((unsigned*)((unsigned char*)h + (size_t)m0 * D))[lane + 64 * j] = f8pk4(a0.x * F8_HSCALE, a0.y * F8_HSCALE, a0.z * F8_HSCALE, a0.w * F8_HSCALE);
                                       ((unsigned*)((unsigned char*)h + (size_t)m1 * D))[lane + 64 * j] = f8pk4(a1.x * F8_HSCALE, a1.y * F8_HSCALE, a1.z * F8_HSCALE, a1.w * F8_HSCALE); }
                else {
                o0[64 * j] = (unsigned long long)pk2(a0.x, a0.y) | ((unsigned long long)pk2(a0.z, a0.w) << 32);
                o1[64 * j] = (unsigned long long)pk2(a1.x, a1.y) | ((unsigned long long)pk2(a1.z, a1.w) << 32); } }
        }
        return;
    }
    int se0 = 0, se1 = 0, sm = 0, nb = 0; float sg0 = 0.f, sg1 = 0.f;
    LAS float* rt = (LAS float*)(lds + RING_OFF);
    for (int i = tidx_(); i < 1024 * 8 / 4; i += NWAVES * 64) ((LAS f32x4*)rt)[i] = ((const f32x4*)router)[i];
    __syncthreads();
    for (int m = gw; m < M; m += NGW) {
        const int b = m / T;
        const f32x4* gp = (const f32x4*)gain + lane; const f32x4* shp = (const f32x4*)(mod_shift + (size_t)b * 6144) + lane; const f32x4* scp = (const f32x4*)(mod_shift + (size_t)b * 6144 + 1024) + lane;
        f32x4 v[4], gq[4], hq_[4], cq[4]; float s = 0.f;
#pragma unroll
        for (int j = 0; j < 4; ++j) { v[j] = ld_x4<XB16>(x, (size_t)m, lane + 64 * j); gq[j] = gp[64 * j]; hq_[j] = shp[64 * j]; cq[j] = scp[64 * j]; }
#pragma unroll
        for (int j = 0; j < 4; ++j) s += (v[j].x * v[j].x + v[j].y * v[j].y) + (v[j].z * v[j].z + v[j].w * v[j].w);
        const float rs = 1.f / sqrtf(wave_sum(s) * (1.f / D) + 1e-6f);
        unsigned long long* o8 = (unsigned long long*)(h + (size_t)m * D) + lane;
#pragma unroll
        for (int j = 0; j < 4; ++j) { const f32x4 g = gq[j], sh = hq_[j], sc = cq[j];
            v[j] = (v[j] * rs) * g * (sc + 1.f) + sh;
            if constexpr (F8OUT) ((unsigned*)((unsigned char*)h + (size_t)m * D))[lane + 64 * j] = f8pk4(v[j].x * F8_HSCALE, v[j].y * F8_HSCALE, v[j].z * F8_HSCALE, v[j].w * F8_HSCALE);
            else o8[64 * j] = (unsigned long long)pk2(v[j].x, v[j].y) | ((unsigned long long)pk2(v[j].z, v[j].w) << 32); }
        if constexpr (ROUTE) {
            float lg[8];
#pragma unroll
            for (int e = 0; e < 8; ++e) lg[e] = 0.f;
#pragma unroll
            for (int j = 0; j < 4; ++j)
#pragma unroll
                for (int q = 0; q < 4; ++q) { const int d = 256 * j + 4 * lane + q; const f32x4 r0 = *(const LAS f32x4*)(rt + d * 8), r1 = *(const LAS f32x4*)(rt + d * 8 + 4); const float hv = v[j][q];
                    lg[0] += hv * r0.x; lg[1] += hv * r0.y; lg[2] += hv * r0.z; lg[3] += hv * r0.w; lg[4] += hv * r1.x; lg[5] += hv * r1.y; lg[6] += hv * r1.z; lg[7] += hv * r1.w; }
#pragma unroll
            for (int e = 0; e < 8; ++e) lg[e] = wave_sum(lg[e]);
            int i0 = 0; float v0 = lg[0];
#pragma unroll
            for (int e = 1; e < 8; ++e) if (lg[e] > v0) { v0 = lg[e]; i0 = e; }
            int i1 = -1; float v1 = -3.0e38f;
#pragma unroll
            for (int e = 0; e < 8; ++e) if (e != i0 && lg[e] > v1) { v1 = lg[e]; i1 = e; }
            const float e1 = __expf(v1 - v0), g0 = 1.f / (1.f + e1), g1 = e1 / (1.f + e1);
            if (lane == nb) { se0 = i0; se1 = i1; sg0 = g0; sg1 = g1; sm = m; }
            ++nb;
        }
        if constexpr (ROUTE) {
            if (nb == 16 || m + NGW >= M) {
                const bool act = lane < nb; const unsigned long long lt = (1ull << lane) - 1ull;
                unsigned long long m0[8], m1[8]; unsigned myc = 0;
#pragma unroll
                for (int e = 0; e < 8; ++e) { m0[e] = __ballot(act && se0 == e); m1[e] = __ballot(act && se1 == e); const unsigned ce = (unsigned)(__popcll(m0[e]) + __popcll(m1[e])); myc = (lane == e) ? ce : myc; }
                unsigned base = 0;
                if (lane < 8) base = __hip_atomic_fetch_add((unsigned*)ws + CW_MOE + 64 * lane, myc, RLX_AGENT);
                int p0 = 0, p1 = 0;
#pragma unroll
                for (int e = 0; e < 8; ++e) { const unsigned be = (unsigned)__shfl((int)base, e);
                    if (se0 == e) p0 = (int)(be + (unsigned)__popcll(m0[e] & lt));
                    if (se1 == e) p1 = (int)(be + (unsigned)__popcll(m0[e]) + (unsigned)__popcll(m1[e] & lt)); }
                if (act) { ((int*)(ws + WS_TOK))[se0 * MOE_CAP + p0] = sm; ((float*)(ws + WS_GATE))[se0 * MOE_CAP + p0] = sg0; ((int*)(ws + WS_ASG))[sm * 2] = se0 * MOE_CAP + p0;
                           ((int*)(ws + WS_TOK))[se1 * MOE_CAP + p1] = sm; ((float*)(ws + WS_GATE))[se1 * MOE_CAP + p1] = sg1; ((int*)(ws + WS_ASG))[sm * 2 + 1] = se1 * MOE_CAP + p1; }
                nb = 0;
            }
        }
    }
}

__device__ __forceinline__ void ph_postz(const Args& a, unsigned char* ws, LAS unsigned char* lds, int l, int gw, int NGW, int wave, int lane) {
    LAS float* S = (LAS float*)(lds + RING_OFF + wave * 16384);
    LAS float* xw = S, *xa = S + 64, *xg = S + 128, *xv = S + 288, *pp = S + 320, *qn = S + 576, *kvn = S + 832, *qb = S + 960, *kvb = S + 1344, *kpe = S + 1856, *qpe = S + 1888;
    const bf16* z = (const bf16*)(ws + WS_Z);
    const float* mu = a.in[I_MU] + l * SHIFT_COLS; const float* muv = a.in[I_MUV];
    const float* rvec = a.in[I_RVEC] + l * 7 * RW; const float* w2 = a.in[I_RW2] + (size_t)l * 64 * RW; const float* a2 = a.in[I_RA2] + (size_t)l * 64 * RW;
    const float* g2 = a.in[I_RG2] + (size_t)l * 160 * RW; const float* v2 = a.in[I_RV2]; const float* v0p = a.in[I_RV0];
    bf16* Rr = (bf16*)(ws + WS_R); bf16* Kr = (bf16*)(ws + WS_K); bf16* Vr = (bf16*)(ws + WS_V); bf16* KKr = (bf16*)(ws + WS_KK); bf16* Ar = (bf16*)(ws + WS_A);
    float* LWr = (float*)(ws + WS_LW); bf16* Gr = (bf16*)(ws + WS_G); bf16* VF = (bf16*)(ws + WS_VF); bf16* mix = (bf16*)(ws + WS_MIX);
    bf16* QM = (bf16*)(ws + WS_QM); bf16* KM = (bf16*)(ws + WS_KM); bf16* VM = (bf16*)(ws + WS_VM);
    const float* poolw = a.in[I_POOLW] + (size_t)l * 4 * 64 * 64; const float* pools = a.in[I_POOLS] + l * 256;
    const float* qlg = a.in[I_QLG] + l * 256; const float* kvlg = a.in[I_KVLG] + l * 128; const float* wqup = a.in[I_WQUP] + (size_t)l * 256 * 384; const float* wkvup = a.in[I_WKVUP] + (size_t)l * 128 * 512;
    const float* qkg = a.in[I_QKG] + l * 2 * 96; const float* ct = (const float*)(ws + WS_COS); const float* st = (const float*)(ws + WS_SIN);
    for (int m = gw; m < M; m += NGW) {
        const int tt = m % T; const bool hp = tt > 0;
        const bf16* zr = z + (size_t)m * NZ; const bf16* zp = zr - NZ;
#define ZS(col) ({ const int c_ = (col); const float zc_ = bf2f(zr[c_]); const float zq_ = hp ? bf2f(zp[c_]) : 0.f; zc_ + mu[c_] * (zq_ - zc_); })
        LDS_WAIT();
        xw[lane] = tanhf_(ZS(OFF_WD + lane)); xa[lane] = ZS(OFF_AD + lane);
        xg[lane] = sigmoidf_(ZS(OFF_GD + lane)); xg[lane + 64] = sigmoidf_(ZS(OFF_GD + 64 + lane)); if (lane < 32) xg[lane + 128] = sigmoidf_(ZS(OFF_GD + 128 + lane));
        if (l > 0 && lane < 32) { const float zc = bf2f(zr[OFF_VD + lane]); const float zq = hp ? bf2f(zp[OFF_VD + lane]) : 0.f; xv[lane] = zc + muv[lane] * (zq - zc); }
#pragma unroll
        for (int gi = 0; gi < 4; ++gi) { const int win = 2 << gi; const int cnt = (tt + 1) < win ? (tt + 1) : win; const int col = OFF_POOL + gi * 64 + lane;
            float s = 0.f; for (int q = 0; q < cnt; ++q) s += bf2f(zr[col - q * NZ]);
            pp[gi * 64 + lane] = s / (float)cnt - bf2f(zr[col]); }
        { float q4[4]; float s = 0.f;
#pragma unroll
          for (int j = 0; j < 4; ++j) { q4[j] = bf2f(zr[OFF_QLAT + lane + 64 * j]); s += q4[j] * q4[j]; }
          const float rs = 1.f / sqrtf(wave_sum(s) * (1.f / 256.f) + 1e-6f);
#pragma unroll
          for (int j = 0; j < 4; ++j) qn[lane + 64 * j] = q4[j] * rs * qlg[lane + 64 * j];
          float k2[2]; s = 0.f;
#pragma unroll
          for (int j = 0; j < 2; ++j) { k2[j] = bf2f(zr[OFF_KVLAT + lane + 64 * j]); s += k2[j] * k2[j]; }
          const float rk = 1.f / sqrtf(wave_sum(s) * (1.f / 128.f) + 1e-6f);
#pragma unroll
          for (int j = 0; j < 2; ++j) kvn[lane + 64 * j] = k2[j] * rk * kvlg[lane + 64 * j];
          if (lane < 16) { const float x1 = bf2f(zr[OFF_KROPE + lane]), x2 = bf2f(zr[OFF_KROPE + 16 + lane]); const float cs = ct[m * 16 + lane], sn = st[m * 16 + lane];
              kpe[lane] = x1 * cs - x2 * sn; kpe[lane + 16] = x1 * sn + x2 * cs; } }
        LDS_WAIT();
#pragma nounroll
        for (int hh = 0; hh < NH; ++hh) {
            const int c = hh * 64 + lane;
            const float r = ZS(c), k0 = ZS(512 + c), v0 = ZS(1024 + c);
            float wlo = 0.f, alo = 0.f, gg = 0.f;
#pragma unroll 4
            for (int i = 0; i < 64; ++i) { wlo += xw[i] * w2[i * RW + c]; alo += xa[i] * a2[i * RW + c]; }
#pragma unroll 4
            for (int i = 0; i < 160; ++i) gg += xg[i] * g2[i * RW + c];
            float v = v0;
            if (l == 0) { VF[(size_t)m * RW + c] = (bf16)f2bf(v0); }
            else { float vlo = 0.f;
#pragma unroll 4
                for (int i = 0; i < 32; ++i) vlo += xv[i] * v2[i * RW + c]; const float vf = bf2f(VF[(size_t)m * RW + c]); v = v0 + (vf - v0) * sigmoidf_(v0p[c] + vlo); }
            const float lw = -0.6065306597126334f * sigmoidf_(rvec[0 * RW + c] + wlo);
            const float aa = sigmoidf_(rvec[1 * RW + c] + alo);
            const float kkr = k0 * rvec[2 * RW + c];
            const float nrm = sqrtf(wave_sum(kkr * kkr));
            const float kk = kkr / fmaxf(nrm, 1e-12f);
            const float k = k0 * (1.f + (aa - 1.f) * rvec[3 * RW + c]);
            { const float bsum = wave_sum(bf2f((bf16)f2bf(r)) * bf2f((bf16)f2bf(k)) * rvec[4 * RW + c]); if (lane == 0) ((float*)(ws + WS_BON))[(size_t)m * 8 + hh] = bsum; }
            const size_t o = (size_t)m * RW + c;
            Rr[o] = (bf16)f2bf(r); Kr[o] = (bf16)f2bf(k); Vr[o] = (bf16)f2bf(v); KKr[o] = (bf16)f2bf(kk); Ar[o] = (bf16)f2bf(aa); LWr[o] = lw; Gr[o] = (bf16)f2bf(gg);
        }
#pragma nounroll
        for (int gi = 0; gi < 4; ++gi) { float y = 0.f; const float* wp = poolw + gi * 4096 + lane;
#pragma unroll 4
            for (int c = 0; c < 64; ++c) y += pp[gi * 64 + c] * wp[c * 64];
            mix[(size_t)m * D + 512 + gi * 64 + lane] = (bf16)f2bf(y * pools[gi * 64 + lane]); }
        { float ac[6];
#pragma unroll
          for (int j = 0; j < 6; ++j) ac[j] = 0.f;
#pragma unroll 2
          for (int i = 0; i < 256; ++i) { const float xv_ = qn[i];
#pragma unroll
              for (int j = 0; j < 6; ++j) ac[j] += xv_ * wqup[i * 384 + lane + 64 * j]; }
#pragma unroll
          for (int j = 0; j < 6; ++j) qb[lane + 64 * j] = ac[j]; }
        { float ac[8];
#pragma unroll
          for (int j = 0; j < 8; ++j) ac[j] = 0.f;
#pragma unroll 2
          for (int i = 0; i < 128; ++i) { const float xv_ = kvn[i];
#pragma unroll
              for (int j = 0; j < 8; ++j) ac[j] += xv_ * wkvup[i * 512 + lane + 64 * j]; }
#pragma unroll
          for (int j = 0; j < 8; ++j) kvb[lane + 64 * j] = ac[j]; }
        LDS_WAIT();
        { const int hq = lane >> 4, i = lane & 15; const float x1 = qb[hq * 96 + 64 + i], x2 = qb[hq * 96 + 80 + i]; const float cs = ct[m * 16 + i], sn = st[m * 16 + i];
          qpe[hq * 32 + i] = x1 * cs - x2 * sn; qpe[hq * 32 + 16 + i] = x1 * sn + x2 * cs; }
        LDS_WAIT();
#pragma unroll
        for (int hq = 0; hq < MLA_H; ++hq) {
            const float qa = qb[hq * 96 + lane], qr_ = lane < 32 ? qpe[hq * 32 + lane] : 0.f;
            const float ka = kvb[hq * 128 + lane], kr_ = lane < 32 ? kpe[lane] : 0.f;
            const float rq = 1.f / sqrtf(wave_sum(qa * qa + qr_ * qr_) * (1.f / 96.f) + 1e-6f);
            const float rk = 1.f / sqrtf(wave_sum(ka * ka + kr_ * kr_) * (1.f / 96.f) + 1e-6f);
            QM[(size_t)m * 384 + hq * 96 + lane] = (bf16)f2bf(qa * rq * qkg[lane]); KM[(size_t)m * 384 + hq * 96 + lane] = (bf16)f2bf(ka * rk * qkg[96 + lane]);
            if (lane < 32) { QM[(size_t)m * 384 + hq * 96 + 64 + lane] = (bf16)f2bf(qr_ * rq * qkg[64 + lane]); KM[(size_t)m * 384 + hq * 96 + 64 + lane] = (bf16)f2bf(kr_ * rk * qkg[96 + 64 + lane]); }
            VM[(size_t)m * 256 + hq * 64 + lane] = (bf16)f2bf(kvb[hq * 128 + 64 + lane]);
        }
#undef ZS
    }
}

__device__ __forceinline__ void ph_scan_naive(const Args& a, unsigned char* ws, int l, int bh, int lane) {
    const int b = bh / NH, hh = bh % NH; const int c = hh * 64 + lane;
    const bf16* Rr = (const bf16*)(ws + WS_R); const bf16* Kr = (const bf16*)(ws + WS_K); const bf16* Vr = (const bf16*)(ws + WS_V); const bf16* KKr = (const bf16*)(ws + WS_KK); const bf16* Ar = (const bf16*)(ws + WS_A);
    const float* LWr = (const float*)(ws + WS_LW); const bf16* Gr = (const bf16*)(ws + WS_G); bf16* mix = (bf16*)(ws + WS_MIX);
    const float* rvec = a.in[I_RVEC] + l * 7 * RW; const float rk_ = rvec[4 * RW + c], lng = rvec[5 * RW + c], lnb = rvec[6 * RW + c];
    float S[64];
#pragma unroll
    for (int j = 0; j < 64; ++j) S[j] = 0.f;
    size_t o = (size_t)(b * T) * RW + c;
    float r = bf2f(Rr[o]), k = bf2f(Kr[o]), v = bf2f(Vr[o]), kk = bf2f(KKr[o]), aa = bf2f(Ar[o]), lw = LWr[o], g = bf2f(Gr[o]);
    for (int t = 0; t < T; ++t) {
        const size_t on = o + (t + 1 < T ? RW : 0);
        const float rn = bf2f(Rr[on]), kn = bf2f(Kr[on]), vn = bf2f(Vr[on]), kkn = bf2f(KKr[on]), aan = bf2f(Ar[on]), lwn = LWr[on], gn = bf2f(Gr[on]);
        const float w = __expf(lw), na = -kk, bb = kk * aa;
        float sa = 0.f;
#pragma unroll
        for (int j = 0; j < 64; ++j) sa += S[j] * __int_as_float(__builtin_amdgcn_readlane(__float_as_int(na), j));
        float y = 0.f;
#pragma unroll
        for (int j = 0; j < 64; ++j) {
            const float wj = __int_as_float(__builtin_amdgcn_readlane(__float_as_int(w), j)), bj = __int_as_float(__builtin_amdgcn_readlane(__float_as_int(bb), j));
            const float kj = __int_as_float(__builtin_amdgcn_readlane(__float_as_int(k), j)), rj = __int_as_float(__builtin_amdgcn_readlane(__float_as_int(r), j));
            S[j] = S[j] * wj + sa * bj + v * kj; y += S[j] * rj; }
        const float mu = wave_sum(y) * (1.f / 64.f); const float dy = y - mu; const float var = wave_sum(dy * dy) * (1.f / 64.f);
        const float yn = dy * (1.f / sqrtf(var + 64e-5f)) * lng + lnb;
        const float bon = wave_sum(r * k * rk_) * v;
        mix[(size_t)(b * T + t) * D + c] = (bf16)f2bf((yn + bon) * g);
        o = on; r = rn; k = kn; v = vn; kk = kkn; aa = aan; lw = lwn; g = gn;
    }
}

__device__ __forceinline__ void ph_attn_naive(unsigned char* ws, LAS unsigned char* lds, int unit, int tid) {
    const int bh = unit >> 3, qb = unit & 7; const int b = bh >> 2, hq = bh & 3;
    const bf16* QM = (const bf16*)(ws + WS_QM); const bf16* KM = (const bf16*)(ws + WS_KM); const bf16* VM = (const bf16*)(ws + WS_VM); bf16* mix = (bf16*)(ws + WS_MIX);
    LAS float* Ks = (LAS float*)(lds + RING_OFF);
    LAS float* Vs = Ks + 64 * 96;
    const int qpos = qb * 512 + tid; const size_t qrow = (size_t)(b * T + qpos);
    float q[96];
    const float sc = 1.f;
#pragma unroll
    for (int d = 0; d < 96; ++d) q[d] = bf2f(QM[qrow * 384 + hq * 96 + d]) * sc;
    float o[64];
#pragma unroll
    for (int d = 0; d < 64; ++d) o[d] = 0.f;
    float mx = -3.0e38f, lsum = 0.f;
    const int ntile = (qb * 512 + 511) / 64 + 1;
    const int wave_qmax = qb * 512 + (tid | 63);
    for (int kt = 0; kt < ntile; ++kt) {
        __syncthreads();
        for (int i = tid; i < 64 * 96; i += 512) { const int kr = i / 96, d = i % 96; Ks[i] = bf2f(KM[(size_t)(b * T + kt * 64 + kr) * 384 + hq * 96 + d]); }
        for (int i = tid; i < 64 * 64; i += 512) { const int kr = i >> 6, d = i & 63; Vs[i] = bf2f(VM[(size_t)(b * T + kt * 64 + kr) * 256 + hq * 64 + d]); }
        __syncthreads();
        if (kt * 64 > wave_qmax) continue;
        for (int j = 0; j < 64; ++j) {
            const int kpos = kt * 64 + j;
            float s = 0.f;
#pragma unroll
            for (int d = 0; d < 96; d += 4) { const f32x4 kv = *(const LAS f32x4*)(Ks + j * 96 + d); s += q[d] * kv.x + q[d + 1] * kv.y + q[d + 2] * kv.z + q[d + 3] * kv.w; }
            if (kpos > qpos) s = -3.0e38f;
            const float mn = fmaxf(mx, s); const float corr = exp2f(mx - mn), p = exp2f(s - mn);
            lsum = lsum * corr + p; mx = mn;
#pragma unroll
            for (int d = 0; d < 64; d += 4) { const f32x4 vv = *(const LAS f32x4*)(Vs + j * 64 + d); o[d] = o[d] * corr + p * vv.x; o[d + 1] = o[d + 1] * corr + p * vv.y; o[d + 2] = o[d + 2] * corr + p * vv.z; o[d + 3] = o[d + 3] * corr + p * vv.w; }
        }
    }
    const float il = 1.f / lsum;
#pragma unroll
    for (int d = 0; d < 64; d += 2) *(unsigned*)(mix + qrow * D + 768 + hq * 64 + d) = pk2(o[d] * il, o[d + 1] * il);
    __syncthreads();
}

__device__ __forceinline__ unsigned moe_cnt(unsigned char* ws, int e) { return __hip_atomic_load((unsigned*)ws + CW_MOE + 64 * e, RLX_AGENT); }
__device__ __forceinline__ volatile LAS int* moe_tiles_lds(unsigned char* ws, LAS unsigned char* lds) {
    volatile LAS int* TS = (volatile LAS int*)(lds + MISC_OFF) + 16;
    __syncthreads();
    if (tidx_() < 8) TS[9 + tidx_()] = (int)moe_cnt(ws, (int)tidx_());
    __syncthreads();
    if (tidx_() == 0) { int acc = 0; for (int e = 0; e < 8; ++e) { TS[e] = acc; acc += (TS[9 + e] + 255) >> 8; } TS[8] = acc; }
    __syncthreads();
    return TS;
}
__device__ __forceinline__ int exp_of_tile(volatile LAS int* TS, int rt) { int e = 0;
#pragma unroll
    for (int k = 1; k < 8; ++k) e += (rt >= TS[k]);
    return e; }
__device__ __forceinline__ void ph_moe_gather(unsigned char* ws, LAS unsigned char* lds, int gw, int NGW, int lane) {
    volatile LAS int* TS = moe_tiles_lds(ws, lds);
    const int nrows = TS[8] * 256;
    const int* tok = (const int*)(ws + WS_TOK); const unsigned char* h = (const unsigned char*)(ws + WS_H); unsigned char* xg = (unsigned char*)(ws + WS_XG);
    constexpr int GR = 16;
    for (int r0 = gw; r0 < nrows; r0 += GR * NGW) {
        int tk[GR]; bool ok[GR];
#pragma unroll
        for (int j = 0; j < GR; ++j) { const int r = r0 + j * NGW; const int rc = r < nrows ? r : r0; const int rt = rc >> 8; const int e = exp_of_tile(TS, rt);
            const int local = rc - TS[e] * 256; ok[j] = r < nrows && local < TS[9 + e]; tk[j] = tok[e * MOE_CAP + (ok[j] ? local : 0)]; }
        v4u v[GR];
#pragma unroll
        for (int j = 0; j < GR; ++j) v[j] = ((const v4u*)(h + (size_t)(ok[j] ? tk[j] : 0) * D))[lane];
#pragma unroll
        for (int j = 0; j < GR; ++j) { const int r = r0 + j * NGW; if (r < nrows) ((v4u*)(xg + (size_t)r * D))[lane] = ok[j] ? v[j] : (v4u){0u, 0u, 0u, 0u}; }
    }
}
__device__ __forceinline__ void ph_moe_combine(unsigned char* ws, LAS unsigned char* lds, float* out, const float* gate2  , int gw, int NGW, int lane) {
    volatile LAS int* TS = moe_tiles_lds(ws, lds);
    const int* asg = (const int*)(ws + WS_ASG); const float* gt = (const float*)(ws + WS_GATE); const bf16* yr = (const bf16*)(ws + WS_YR);
    constexpr int CT = 4;
    for (int m0 = gw; m0 < M; m0 += CT * NGW) {
        int mm[CT]; size_t ra[CT], rb[CT]; float ga[CT], gbv[CT];
#pragma unroll
        for (int u = 0; u < CT; ++u) { mm[u] = m0 + u * NGW < M ? m0 + u * NGW : m0; const int s0 = asg[mm[u] * 2], s1 = asg[mm[u] * 2 + 1];
            const int e0 = s0 / MOE_CAP, p0 = s0 % MOE_CAP, e1 = s1 / MOE_CAP, p1 = s1 % MOE_CAP;
            ra[u] = (size_t)TS[e0] * 256 + p0; rb[u] = (size_t)TS[e1] * 256 + p1; ga[u] = gt[s0]; gbv[u] = gt[s1]; }
        v4u a0[CT][2], a1[CT][2], xq[CT][2]; const bf16* xb = (const bf16*)(ws + WS_XB);
#pragma unroll
        for (int u = 0; u < CT; ++u)
#pragma unroll
            for (int j = 0; j < 2; ++j) { const int col = (j * 64 + lane) * 8;
                a0[u][j] = *(const v4u*)(yr + ra[u] * D + col); a1[u][j] = *(const v4u*)(yr + rb[u] * D + col);
                xq[u][j] = *(const v4u*)(xb + (size_t)mm[u] * D + col); }
#pragma unroll
        for (int u = 0; u < CT; ++u) { if (u > 0 && m0 + u * NGW >= M) break;
            const float* gb = gate2 + (size_t)(mm[u] / T) * 6144; const float g0 = ga[u], g1 = gbv[u];
#pragma unroll
            for (int j = 0; j < 2; ++j) { const int col = (j * 64 + lane) * 8; const f32x4* gp = (const f32x4*)(gb + col); const f32x4 gg0 = gp[0], gg1 = gp[1];
                const v4u A0 = a0[u][j], A1 = a1[u][j], XQ = xq[u][j]; f32x4 X0 = {bflo(XQ.x), bfhi(XQ.x), bflo(XQ.y), bfhi(XQ.y)}, X1 = {bflo(XQ.z), bfhi(XQ.z), bflo(XQ.w), bfhi(XQ.w)};
                X0.x += gg0.x * (g0 * bflo(A0.x) + g1 * bflo(A1.x)); X0.y += gg0.y * (g0 * bfhi(A0.x) + g1 * bfhi(A1.x)); X0.z += gg0.z * (g0 * bflo(A0.y) + g1 * bflo(A1.y)); X0.w += gg0.w * (g0 * bfhi(A0.y) + g1 * bfhi(A1.y));
                X1.x += gg1.x * (g0 * bflo(A0.z) + g1 * bflo(A1.z)); X1.y += gg1.y * (g0 * bfhi(A0.z) + g1 * bfhi(A1.z)); X1.z += gg1.z * (g0 * bflo(A0.w) + g1 * bflo(A1.w)); X1.w += gg1.w * (g0 * bfhi(A0.w) + g1 * bfhi(A1.w));
                f32x4* op = (f32x4*)(out + (size_t)mm[u] * D + col); op[0] = X0; op[1] = X1; } }
    }
}

#define LANE_ fresh_lane()
#define TID_ tidx_()
constexpr int NPHASE = 23;
#ifndef PH_MASK
#define PH_MASK 0xFFFFFFFFu
#endif
#define EN(b) ((PH_MASK >> (b)) & 1u)

#define IN(k) (lo <= (k) && (k) < hi)
#define SEAM(k) do { if (IN(k) && IN((k) + 1)) xcd_barrier(bar); } while (0)
template <int l>
__device__ __forceinline__ void layer_phases(const Args& args, unsigned char* ws, LAS unsigned char* lds, float* out, const float* mod, bf16* H, const XcdBarrier& bar,
                                             int lo, int hi, int li, int wave, int G, int gw, int NGW) {

        const int pb = 2 + 10 * l;
        const float* modl = mod + (size_t)l * 8 * 6144;
        if (EN(0) && IN(pb + 0)) {
            pg8::Gemm g{H, (const bf16*)(ws + WS_WIN) + (size_t)l * NZ * 1024, M, NZ, 1024}; pg8::StaticOrder S; S.init(M, NZ, G, (int)blockIdx.x);
            pg8::EpiBf16<0> E{(bf16*)(ws + WS_Z), NZ, nullptr, 0, 0, 1.f};
            pg8::gemm_phase<pg8::EpiBf16<0>, pg8::StaticOrder, true, true>(lds + RING_OFF, g, S, E);
        } SEAM(pb + 0);
        if (EN(1) && IN(pb + 1)) {
#if POSTZ_NAIVE
            ph_postz(args, ws, lds, l, gw, NGW, wave, LANE_);
#else
            ph_postz_mfma<l>(args, ws, lds, G, TID_, wave, LANE_, DRY_REP && li == 1);
#endif
        } SEAM(pb + 1);
        if (IN(pb + 3)) {
            if (EN(14) && blockIdx.x >= 64 && blockIdx.x < 128) ph_convert(args, ws, lds, ((int)blockIdx.x - 64) * 8 + wave, 64 * 8, wave, LANE_, 1 + l);
            if (EN(2) && blockIdx.x < 64 && wave < 2 && !(ATTN_ONLY_REP && li == 1)) scan_carry(ws, (int)blockIdx.x, wave, LANE_);
            __syncthreads();
            #if ATTN_NAIVE
            if (EN(3)) for (int u = blockIdx.x; u < 256; u += G) ph_attn_naive(ws, lds, u, TID_);
#else
            if (EN(3) && !(CARRY_ONLY_REP && li == 1)) { volatile LAS unsigned* qw = (volatile LAS unsigned*)(lds + MISC_OFF) + 26;
                for (;;) { __syncthreads(); if (TID_ == 0) qw[0] = __hip_atomic_fetch_add((unsigned*)ws + CW_ATQ + 64 * (l + 2 * (li & 1)), 1u, RLX_AGENT); __syncthreads();
                    const unsigned u = qw[0]; if (u >= 512u) break; ph_attn_pipe(ws, lds, (int)(u & 31u), 15 - (int)(u >> 5), wave, LANE_); } }
#endif
        } SEAM(pb + 3);
        if (EN(2) && IN(pb + 4)) { ph_scan_out(args, ws, lds, l, gw, NGW, wave, LANE_); } SEAM(pb + 4);
        if (EN(4) && IN(pb + 5)) {
            pg8::Gemm g{(const bf16*)(ws + WS_MIX), (const bf16*)(ws + WS_WOUT) + (size_t)l * 1024 * 1024, M, D, D}; pg8::StaticOrder S; S.init(M, D, G, (int)blockIdx.x);
            pg8::EpiResB<l == 0> E{l == 0 ? (const void*)args.in[I_X] : (const void*)(ws + WS_XB), (pg8::bf16_t*)(ws + WS_XB), modl + 2 * 1024};
            pg8::gemm_phase<pg8::EpiResB<l == 0>, pg8::StaticOrder, true, true>(lds + RING_OFF, g, S, E);
        } SEAM(pb + 5);
        if constexpr (l == 0) {
            if (EN(5) && IN(pb + 6)) { ph_norm<false, false, true>(ws + WS_XB, args.in[I_NGAIN] + 1024, modl + 3 * 1024, H, nullptr, ws, gw, NGW, LANE_); } SEAM(pb + 6);
            if (EN(6) && IN(pb + 7)) {
                pg8::Gemm g{H, (const bf16*)(ws + WS_WFFI), M, 2 * DFF, D}; pg8::StaticOrder S; S.init(M, 2 * DFF, G, (int)blockIdx.x);
                pg8::EpiSwiglu E{(bf16*)(ws + WS_ACT), DFF, 1 << 20};
                pg8::gemm_phase<pg8::EpiSwiglu, pg8::StaticOrder, true, true>(lds + RING_OFF, g, S, E);
            } SEAM(pb + 7);
            if (EN(7) && IN(pb + 8)) {
                pg8::Gemm g{(const bf16*)(ws + WS_ACT), (const bf16*)(ws + WS_WFFO), M, D, DFF}; pg8::StaticOrder S; S.init(M, D, G, (int)blockIdx.x);
                pg8::EpiResB<false> E{(const void*)(ws + WS_XB), (pg8::bf16_t*)(ws + WS_XB), modl + 5 * 1024};
                pg8::gemm_phase<pg8::EpiResB<false>, pg8::StaticOrder, true, true>(lds + RING_OFF, g, S, E);
            } SEAM(pb + 8);
            if (EN(5) && IN(pb + 9)) { ph_norm<false, false, true>(ws + WS_XB, args.in[I_NGAIN] + 2048, mod + (size_t)8 * 6144, H, nullptr, ws, gw, NGW, LANE_); } SEAM(pb + 9);
        } else {
            if (EN(8) && IN(pb + 6)) { ph_norm<true, true, true>(ws + WS_XB, args.in[I_NGAIN] + 3072, modl + 3 * 1024, H, args.in[I_ROUTER], ws, gw, NGW, LANE_, lds); } SEAM(pb + 6);
            if (EN(9) && IN(pb + 7)) { ph_moe_gather(ws, lds, gw, NGW, LANE_); } SEAM(pb + 7);
            if (EN(10) && IN(pb + 8)) {
                volatile LAS int* TS = moe_tiles_lds(ws, lds);
                pg8::Gemm g{(const bf16*)(ws + WS_XG), (const bf16*)(ws + WS_WMI), 0, 0, D / 2};
                pg8::MoeOrder S{28, TS[8] * 28, G, (int)blockIdx.x, TS[1], TS[2], TS[3], TS[4], TS[5], TS[6], TS[7]};
                pg8::EpiSwigluF8 E{ws + WS_MACT, DFFE, 28};
                pg8::gemm_phase_f8<pg8::EpiSwigluF8, pg8::MoeOrder, true, true>(lds + RING_OFF, g, S, E, F8_WEXP, F8_HEXP);
            } SEAM(pb + 8);
            if (EN(11) && IN(pb + 9)) {
                volatile LAS int* TS = moe_tiles_lds(ws, lds);
                pg8::Gemm g{(const bf16*)(ws + WS_MACT), (const bf16*)(ws + WS_WMO), 0, 0, DFFE / 2};
                pg8::MoeOrder S{4, TS[8] * 4, G, (int)blockIdx.x, TS[1], TS[2], TS[3], TS[4], TS[5], TS[6], TS[7]};
                pg8::EpiMoeOut E{(bf16*)(ws + WS_YR)};
                pg8::gemm_phase_f8<pg8::EpiMoeOut, pg8::MoeOrder, true, true>(lds + RING_OFF, g, S, E, F8_WEXP, F8_AEXP);
            } SEAM(pb + 9);
            if (EN(12) && IN(pb + 10)) { ph_moe_combine(ws, lds, out, modl + 5 * 1024, gw, NGW, LANE_); }
        }
    }
#undef IN
#undef SEAM
#ifndef ATTN_NAIVE
#define ATTN_NAIVE 0
#endif
#ifndef POSTZ_NAIVE
#define POSTZ_NAIVE 0
#endif
#ifndef SCAN_NAIVE
#define SCAN_NAIVE 0
#endif
#ifndef MK_SPLIT
#define MK_SPLIT 0
#endif
__global__ void __launch_bounds__(NWAVES * 64, 2) fwd_kernel(Args args) {
    LAS unsigned char* lds = (LAS unsigned char*)lds_raw;
    const int wave = __builtin_amdgcn_readfirstlane((int)threadIdx.x >> 6);
    const int G = gridDim.x, gw = blockIdx.x * NWAVES + wave, NGW = G * NWAVES, GT = G * NWAVES * 64;
#define GTID_ ((int)blockIdx.x * (NWAVES * 64) + TID_)
    unsigned char* ws = args.ws;
    for (int u = threadIdx.x; u < (LDS_BYTES - LDSCTL_OFF) / 4; u += NWAVES * 64) ((LAS unsigned*)(lds + LDSCTL_OFF))[u] = 0u;
    __syncthreads();
    if ((threadIdx.x & 63) == 0) ((volatile LAS int*)(lds + WMAP_OFF))[hw_slot_()] = wave;
    __syncthreads();
    XcdBarrier bar; bar.bar = (unsigned*)ws + CW_BAR + args.li * XCD_BAR_WORDS; bar.x = 0; bar.st = nullptr;
    if (!MK_SPLIT) bar = xcd_barrier_post((unsigned*)ws + CW_BAR + args.li * XCD_BAR_WORDS, (volatile LAS unsigned*)(lds + MISC_OFF) + 8);
    const int lo = args.ph_lo, hi = args.ph_hi;
#define IN(k) (lo <= (k) && (k) < hi)
#define SEAM(k) do { if (IN(k) && IN((k) + 1)) xcd_barrier(bar); } while (0)
    float* out = args.out;
    const float* mod = (const float*)(ws + WS_MOD);
    bf16* H = (bf16*)(ws + WS_H);

    if (EN(13) && IN(0)) { ph_mod_rope(args, ws, lds, gw, NGW, TID_, LANE_, GTID_, GT); } SEAM(0);
    if (IN(1)) { if (EN(14)) { ph_convert(args, ws, lds, gw, NGW, wave, LANE_, 0); ph_small_weights(args, ws, GTID_, GT); }
                 if (EN(5)) ph_norm<false>(args.in[I_X], args.in[I_NGAIN], mod, H, nullptr, ws, gw, NGW, LANE_); } SEAM(1);

    layer_phases<0>(args, ws, lds, out, mod, H, bar, lo, hi, args.li, wave, G, gw, NGW);
    layer_phases<1>(args, ws, lds, out, mod, H, bar, lo, hi, args.li, wave, G, gw, NGW);
#undef IN
#undef SEAM
}

extern "C" void kernel_launch(void* const* d_in, const int* in_sizes, int n_in, void* d_out, int out_size, void* d_ws, size_t ws_size, hipStream_t stream) {
    static int grid = 0;
    if (grid == 0) {
        if (n_in != 29 || out_size != M * D || ws_size < WS_END || ws_size < WS_MIX_END) { fprintf(stderr, "kernel_launch: unexpected shapes (n_in %d out %d ws %zu)\n", n_in, out_size, ws_size); grid = -1; return; }
        int dev = 0, cus = 0, per_cu = 0;
        if (hipGetDevice(&dev) != hipSuccess || hipDeviceGetAttribute(&cus, hipDeviceAttributeMultiprocessorCount, dev) != hipSuccess) { grid = -1; return; }
        if (hipFuncSetAttribute((const void*)fwd_kernel, hipFuncAttributeMaxDynamicSharedMemorySize, LDS_BYTES) != hipSuccess) { fprintf(stderr, "kernel_launch: hipFuncSetAttribute failed\n"); grid = -1; return; }
        if (hipOccupancyMaxActiveBlocksPerMultiprocessor(&per_cu, (const void*)fwd_kernel, NWAVES * 64, LDS_BYTES) != hipSuccess || per_cu < 1) fprintf(stderr, "kernel_launch: occupancy query says %d\n", per_cu);
        (void)hipGetLastError();
        grid = cus;
    }
    if (grid < 0) return;
    (void)hipMemsetAsync((char*)d_ws + WS_CTL, 0, CTL_ZERO_BYTES, stream);
    Args a{};
    for (int i = 0; i < 29; ++i) a.in[i] = (const float*)d_in[i];
    a.out = (float*)d_out; a.ws = (unsigned char*)d_ws;
#if defined(TIME_PHASE)
    { const int K = TIME_PHASE; const int cuts[4] = {0, K + 1, K, NPHASE};
      a.ph_lo = 0; a.ph_hi = K + 1; a.li = 0; hipLaunchKernelGGL(fwd_kernel, dim3(grid), dim3(NWAVES * 64), LDS_BYTES, stream, a);
      a.ph_lo = K; a.ph_hi = K + 1; a.li = 1; hipLaunchKernelGGL(fwd_kernel, dim3(grid), dim3(NWAVES * 64), LDS_BYTES, stream, a);
      a.ph_lo = K + 1; a.ph_hi = NPHASE; a.li = 2; hipLaunchKernelGGL(fwd_kernel, dim3(grid), dim3(NWAVES * 64), LDS_BYTES, stream, a); (void)cuts; }
#else
    a.ph_lo = 0; a.ph_hi = NPHASE; a.li = 0;
    hipLaunchKernelGGL(fwd_kernel, dim3(grid), dim3(NWAVES * 64), LDS_BYTES, stream, a);
#endif
}
```

```cpp
#include <hip/hip_runtime.h>
#include <cstdio>
#include <cstdint>

extern __shared__ __attribute__((aligned(16))) unsigned char lds_raw[];
#define WMAP_OFF (131072 + 512)
__device__ __forceinline__ int hw_slot_() { return (int)__builtin_amdgcn_s_getreg((5 << 11) | (0 << 6) | 4); }
__device__ __forceinline__ int lane_id_() { int l; asm volatile("v_mbcnt_lo_u32_b32 %0, -1, 0\n\tv_mbcnt_hi_u32_b32 %0, -1, %0" : "=v"(l)); return l; }
__device__ __forceinline__ int wave_id_() { return __builtin_amdgcn_readfirstlane(((volatile __attribute__((address_space(3))) int*)((__attribute__((address_space(3))) unsigned char*)lds_raw + WMAP_OFF))[hw_slot_()]); }
__device__ __forceinline__ int tidx_() { return wave_id_() * 64 + lane_id_(); }

namespace pg8 {
#define PG8_LAS __attribute__((address_space(3)))
typedef unsigned short bf16_t;
typedef short bf16x8 __attribute__((ext_vector_type(8)));
typedef float f32x4 __attribute__((ext_vector_type(4)));
typedef unsigned u32x4 __attribute__((ext_vector_type(4)));
constexpr int BM = 256, BK = 64, HALF = 128, HTB = HALF * BK * 2  , STAGE_BYTES = 8 * HTB, NXCD = 8, WGM = 8;

__host__ __device__ __forceinline__ int lds_byte(int r, int c) { const int st = (r >> 4) * 2 + (c >> 5), rr = r & 15, cc = c & 31, ob = rr * 64 + cc * 2; return st * 1024 + (ob ^ (((ob >> 9) & 1) << 5)); }
__host__ __device__ __forceinline__ void stage_rc(int b, int& R, int& C) { const int st = b / 1024, sb = b % 1024, swz = sb ^ (((sb >> 9) & 1) << 5); R = (st >> 1) * 16 + swz / 64; C = (st & 1) * 32 + (swz % 64) / 2; }
__host__ __device__ __forceinline__ int perm32(int rho) { const int n = rho >> 4, i = rho & 15; return 8 * (i >> 2) + 4 * n + (i & 3); }

struct Unit { int pm, pn; };
struct Gemm { const bf16_t* A; const bf16_t* Bt; int M, N, K; };

struct StaticOrder {
    int nM, nN, nwg, G, c;
    __host__ __device__ void init(int M, int N, int G_, int c_) { nM = M / BM; nN = N / BM; nwg = nM * nN; G = G_; c = c_; }
    __host__ __device__ bool next(int i, Unit& u) const {
        const long L = (long)i * G + c; if (L >= nwg) return false;
        int wgid = (int)L; { const int q = nwg / NXCD, r = nwg % NXCD, xcd = wgid % NXCD, off = wgid / NXCD; wgid = (xcd < r ? xcd * (q + 1) : r * (q + 1) + (xcd - r) * q) + off; }
        const int nig = WGM * nN, gid = wgid / nig, fm = gid * WGM, gsz = (nM - fm) < WGM ? (nM - fm) : WGM;
        u.pm = fm + ((wgid % nig) % gsz); u.pn = (wgid % nig) / gsz; return true;
    }
    __device__ __forceinline__ void a_ready(const Unit&) const {}
    __device__ __forceinline__ void done(const Unit&) const {}
};

__device__ __forceinline__ unsigned cvt_pk_bf16(float lo, float hi) { unsigned r; asm volatile("v_cvt_pk_bf16_f32 %0, %1, %2" : "=v"(r) : "v"(lo), "v"(hi)); return r; }
typedef float f32x2 __attribute__((ext_vector_type(2)));
__device__ __forceinline__ f32x2 gelu_pk(f32x2 v) {
    const f32x2 av = __builtin_elementwise_abs(v), d = av * 0.2316418882f + 1.0f;
    f32x2 t; t.x = __builtin_amdgcn_rcpf(d.x); t.y = __builtin_amdgcn_rcpf(d.y);
    f32x2 q = t * 0.5307027145f + (-0.7265760135f); q = q * t + 0.7107068705f; q = q * t + (-0.142248368f); q = q * t + 0.127414796f; q = q * t;
    const f32x2 s = (v * v) * (-0.72134752044f);
    f32x2 e; e.x = __builtin_amdgcn_exp2f(s.x); e.y = __builtin_amdgcn_exp2f(s.y);
    const f32x2 m = v * (q * e), r = v - m;
    f32x2 o; o.x = v.x < 0.f ? m.x : r.x; o.y = v.y < 0.f ? m.y : r.y; return o;
}

template <int ACT  > struct EpiBf16 {
    static constexpr bool PERM = true, AFTER_DRAIN = false; static_assert(ACT == 0 || ACT == 1, "EpiBf16: ACT is 0 (none) or 1 (gelu_pk)");
    bf16_t* O; int ldc; const float* bias; int split_cols; size_t split_stride; float scale0;
    __device__ __forceinline__ void operator()(const f32x4 (&acc)[2][2][4][2], const Unit& u, int wr, int wc, int fr, int fq) const {
        const int row0 = u.pm * BM + wr * 64 + fr; int colt = u.pn * BM; bf16_t* base = O;
        float sc = 1.f; if (split_cols) { const int t = colt / split_cols; base += (size_t)t * split_stride; colt -= t * split_cols; if (t == 0) sc = scale0; }
        const int col0 = colt + wc * 32 + 8 * fq, bcol0 = u.pn * BM + wc * 32 + 8 * fq;
        f32x4 bv[2][2];
#pragma unroll
        for (int bj = 0; bj < 2; ++bj)
#pragma unroll
            for (int n = 0; n < 2; ++n) bv[bj][n] = bias ? *(const f32x4*)(bias + bcol0 + bj * HALF + 4 * n) : (f32x4){0.f, 0.f, 0.f, 0.f};
#pragma unroll
        for (int ai = 0; ai < 2; ++ai)
#pragma unroll
            for (int m = 0; m < 4; ++m) { bf16_t* rowp = base + (size_t)(row0 + ai * HALF + m * 16) * ldc + col0;
#pragma unroll
                for (int bj = 0; bj < 2; ++bj) { f32x4 v0 = acc[ai][bj][m][0] + bv[bj][0], v1 = acc[ai][bj][m][1] + bv[bj][1];
                    if (ACT == 1) { f32x2 a = gelu_pk((f32x2){v0[0], v0[1]}), b = gelu_pk((f32x2){v0[2], v0[3]}), c = gelu_pk((f32x2){v1[0], v1[1]}), d = gelu_pk((f32x2){v1[2], v1[3]});
                        v0 = (f32x4){a.x, a.y, b.x, b.y}; v1 = (f32x4){c.x, c.y, d.x, d.y}; }
                    v0 = v0 * sc; v1 = v1 * sc; u32x4 w; w.x = cvt_pk_bf16(v0[0], v0[1]); w.y = cvt_pk_bf16(v0[2], v0[3]); w.z = cvt_pk_bf16(v1[0], v1[1]); w.w = cvt_pk_bf16(v1[2], v1[3]);
                    *(u32x4*)(rowp + bj * HALF) = w; } }
    }
};

template <class Epi, class Sched, bool ALIGN_EPI = false, bool SP2 = false>
__device__ __forceinline__ void gemm_phase(PG8_LAS unsigned char* lds, const Gemm g, const Sched& S, const Epi& E) {
    int tid_ = tidx_(); asm volatile("" : "+v"(tid_));
    const int tid = tid_, wid = __builtin_amdgcn_readfirstlane(tid >> 6), lane = tid & 63, wr = wid >> 2, wc = wid & 3, fr = lane & 15, fq = lane >> 4;
    const int K = g.K, nt = K / BK;
    unsigned voffA[2], voffB[2];
#pragma unroll
    for (int i = 0; i < 2; ++i) { int R, C; stage_rc(tid * 16 + i * 8192, R, C); const int Rb = Epi::PERM ? ((R & ~31) + perm32(R & 31)) : R;
        voffA[i] = (unsigned)(R * K + C) * 2u; voffB[i] = (unsigned)(Rb * K + C) * 2u; }
    const size_t kstep = (size_t)(BK * 2);
    const size_t hstep = (size_t)HALF * K * 2;
    const size_t tstep = 2 * hstep;
    const unsigned ldsw = (unsigned)wid * 1024u;
    const int aoff = lds_byte(wr * 64 + fr, fq * 8), boff = lds_byte(wc * 32 + fr, fq * 8);
#define PG8_SA(b, h) (((b) * 2 + (h)) * HTB)
#define PG8_SB(b, h) ((4 + (b) * 2 + (h)) * HTB)
#define PG8_STAGE(bufoff, gbase, voff) do { _Pragma("unroll") for (int _i = 0; _i < 2; ++_i) \
        __builtin_amdgcn_global_load_lds((const unsigned*)((const char*)(gbase) + (voff)[_i]), (PG8_LAS unsigned*)(lds + (bufoff) + ldsw + _i * 8192), 16, 0, 0); } while (0)
#define PG8_LDA(dst, b, h) do { _Pragma("unroll") for (int m = 0; m < 4; ++m) _Pragma("unroll") for (int k = 0; k < 2; ++k) dst[m][k] = *(const PG8_LAS bf16x8*)(lds + PG8_SA(b, h) + aoff + m * 2048 + k * 1024); } while (0)
#define PG8_LDB(dst, b, h) do { _Pragma("unroll") for (int n = 0; n < 2; ++n) _Pragma("unroll") for (int k = 0; k < 2; ++k) dst[n][k] = *(const PG8_LAS bf16x8*)(lds + PG8_SB(b, h) + boff + n * 2048 + k * 1024); } while (0)
#define PG8_MMA(ai, bj, At, Bt) do { __builtin_amdgcn_s_setprio(1); _Pragma("unroll") for (int m = 0; m < 4; ++m) _Pragma("unroll") for (int n = 0; n < 2; ++n) _Pragma("unroll") for (int k = 0; k < 2; ++k) \
        acc[ai][bj][m][n] = __builtin_amdgcn_mfma_f32_16x16x32_bf16(Bt[n][k], At[m][k], acc[ai][bj][m][n], 0, 0, 0); __builtin_amdgcn_s_setprio(0); } while (0)
#define PG8_WAIT_V(n) asm volatile("s_waitcnt vmcnt(" #n ")" ::: "memory")
#define PG8_WAIT_L(n) asm volatile("s_waitcnt lgkmcnt(" #n ")" ::: "memory")
#define PG8_BAR __builtin_amdgcn_s_barrier()
#define PG8_SCHED __builtin_amdgcn_sched_barrier(0)
    Unit cur, nxt; int ui = 0;
    if (!S.next(0, cur)) return;
    f32x4 acc[2][2][4][2];
#pragma unroll
    for (int a = 0; a < 2; ++a)
#pragma unroll
        for (int b = 0; b < 2; ++b)
#pragma unroll
            for (int m = 0; m < 4; ++m)
#pragma unroll
                for (int n = 0; n < 2; ++n) acc[a][b][m][n] = (f32x4){0.f, 0.f, 0.f, 0.f};
    bf16x8 At[4][2], B0[2][2], B1[2][2];
    const char* cA = (const char*)g.A + (size_t)cur.pm * tstep; const char* cB = (const char*)g.Bt + (size_t)cur.pn * tstep;
    S.a_ready(cur);
    if constexpr (SP2) {
        PG8_STAGE(PG8_SB(0, 0), cB, voffB); PG8_STAGE(PG8_SB(0, 1), cB + hstep, voffB); PG8_STAGE(PG8_SA(0, 0), cA, voffA); PG8_STAGE(PG8_SA(0, 1), cA + hstep, voffA);
        if (wr == 1) PG8_BAR;
        PG8_WAIT_V(2); PG8_BAR;
        PG8_STAGE(PG8_SB(1, 0), cB + kstep, voffB); PG8_STAGE(PG8_SA(1, 0), cA + kstep, voffA); PG8_STAGE(PG8_SB(1, 1), cB + hstep + kstep, voffB);
        PG8_WAIT_V(6); PG8_BAR;
    } else {
        PG8_STAGE(PG8_SB(0, 0), cB, voffB); PG8_STAGE(PG8_SA(0, 0), cA, voffA); PG8_STAGE(PG8_SB(0, 1), cB + hstep, voffB); PG8_STAGE(PG8_SA(0, 1), cA + hstep, voffA);
        if (wr == 1) PG8_BAR;
        PG8_WAIT_V(4); PG8_BAR;
        PG8_STAGE(PG8_SB(1, 0), cB + kstep, voffB); PG8_STAGE(PG8_SA(1, 0), cA + kstep, voffA); PG8_STAGE(PG8_SB(1, 1), cB + hstep + kstep, voffB);
        PG8_WAIT_V(6); PG8_BAR;
    }
    for (;;) {
        const bool has_next = S.next(ui + 1, nxt);
        const char* nA = has_next ? (const char*)g.A + (size_t)nxt.pm * tstep : cA; const char* nB = has_next ? (const char*)g.Bt + (size_t)nxt.pn * tstep : cB;
        for (int t = 0; t < nt; t += 2) {
            const bool last = (t == nt - 2);
            const char* a1 = cA + (size_t)(t + 1) * kstep;
            const char* a2 = last ? nA : cA + (size_t)(t + 2) * kstep; const char* b2 = last ? nB : cB + (size_t)(t + 2) * kstep;
            const char* a3 = a2 + kstep; const char* b3 = b2 + kstep;
            if (last && has_next) S.a_ready(nxt);
            if constexpr (SP2) {
            PG8_LDB(B0, 0, 0); PG8_LDB(B1, 0, 1); PG8_SCHED; PG8_LDA(At, 0, 0); PG8_STAGE(PG8_SA(1, 1), a1 + hstep, voffA);
            PG8_WAIT_V(8); PG8_WAIT_L(0); PG8_BAR; PG8_MMA(0, 0, At, B0); PG8_MMA(0, 1, At, B1); PG8_BAR; PG8_SCHED;
            PG8_LDA(At, 0, 1); PG8_STAGE(PG8_SB(0, 0), b2, voffB); PG8_STAGE(PG8_SB(0, 1), b2 + hstep, voffB); PG8_STAGE(PG8_SA(0, 0), a2, voffA);
            PG8_WAIT_V(8); PG8_WAIT_L(0); PG8_BAR; PG8_MMA(1, 0, At, B0); PG8_MMA(1, 1, At, B1); PG8_BAR; PG8_SCHED;
            PG8_LDB(B0, 1, 0); PG8_LDB(B1, 1, 1); PG8_SCHED; PG8_LDA(At, 1, 0); PG8_STAGE(PG8_SA(0, 1), a2 + hstep, voffA);
            PG8_WAIT_V(8); PG8_WAIT_L(0); PG8_BAR; PG8_MMA(0, 0, At, B0); PG8_MMA(0, 1, At, B1); PG8_BAR; PG8_SCHED;
            PG8_LDA(At, 1, 1); PG8_STAGE(PG8_SB(1, 0), b3, voffB); PG8_STAGE(PG8_SB(1, 1), b3 + hstep, voffB); PG8_STAGE(PG8_SA(1, 0), a3, voffA);
            PG8_WAIT_V(8); PG8_WAIT_L(0); PG8_BAR; PG8_MMA(1, 0, At, B0); PG8_MMA(1, 1, At, B1); PG8_BAR; PG8_SCHED;
            } else {
            PG8_LDB(B0, 0, 0); PG8_SCHED; PG8_LDA(At, 0, 0); PG8_STAGE(PG8_SA(1, 1), a1 + hstep, voffA);
            PG8_WAIT_L(8); PG8_BAR; PG8_WAIT_L(0); PG8_MMA(0, 0, At, B0); PG8_BAR; PG8_SCHED;
            PG8_LDB(B1, 0, 1); PG8_STAGE(PG8_SB(0, 0), b2, voffB);
            PG8_BAR; PG8_WAIT_L(0); PG8_MMA(0, 1, At, B1); PG8_BAR;
            PG8_LDA(At, 0, 1); PG8_STAGE(PG8_SA(0, 0), a2, voffA);
            PG8_BAR; PG8_WAIT_L(0); PG8_MMA(1, 0, At, B0); PG8_BAR; PG8_SCHED;
            PG8_STAGE(PG8_SB(0, 1), b2 + hstep, voffB);
            PG8_WAIT_V(6); PG8_BAR; PG8_MMA(1, 1, At, B1); PG8_BAR;
            PG8_LDB(B0, 1, 0); PG8_SCHED; PG8_LDA(At, 1, 0); PG8_STAGE(PG8_SA(0, 1), a2 + hstep, voffA);
            PG8_WAIT_L(8); PG8_BAR; PG8_WAIT_L(0); PG8_MMA(0, 0, At, B0); PG8_BAR; PG8_SCHED;
            PG8_LDB(B1, 1, 1); PG8_STAGE(PG8_SB(1, 0), b3, voffB);
            PG8_BAR; PG8_WAIT_L(0); PG8_MMA(0, 1, At, B1); PG8_BAR;
            PG8_LDA(At, 1, 1); PG8_STAGE(PG8_SA(1, 0), a3, voffA);
            PG8_BAR; PG8_WAIT_L(0); PG8_MMA(1, 0, At, B0); PG8_BAR; PG8_SCHED;
            PG8_STAGE(PG8_SB(1, 1), b3 + hstep, voffB);
            PG8_WAIT_V(6); PG8_BAR; PG8_MMA(1, 1, At, B1); PG8_BAR;
            }
        }
        if constexpr (ALIGN_EPI) { if (wr == 0) PG8_BAR; }
        if constexpr (!Epi::AFTER_DRAIN) { E(acc, cur, wr, wc, fr, fq); S.done(cur); }
        if (!has_next) break;
#pragma unroll
        for (int a = 0; a < 2; ++a)
#pragma unroll
            for (int b = 0; b < 2; ++b)
#pragma unroll
                for (int m = 0; m < 4; ++m)
#pragma unroll
                    for (int n = 0; n < 2; ++n) acc[a][b][m][n] = (f32x4){0.f, 0.f, 0.f, 0.f};
        cur = nxt; cA = nA; cB = nB; ++ui;
        if constexpr (ALIGN_EPI) { if (wr == 1) PG8_BAR; }
    }
    PG8_WAIT_V(0);
    if constexpr (!ALIGN_EPI) { if (wr == 0) PG8_BAR; }
    PG8_BAR;
    if constexpr (Epi::AFTER_DRAIN) { E.fused(acc, cur, wr, wc, fr, fq, lds, wid, lane); S.done(cur); }
#undef PG8_SA
#undef PG8_SB
#undef PG8_STAGE
#undef PG8_LDA
#undef PG8_LDB
#undef PG8_MMA
#undef PG8_WAIT_V
#undef PG8_WAIT_L
#undef PG8_BAR
#undef PG8_SCHED
}
typedef int v8i_t __attribute__((ext_vector_type(8)));
template <class Epi, class Sched, bool ALIGN_EPI = false, bool SP2 = false>
__device__ __forceinline__ void gemm_phase_f8(PG8_LAS unsigned char* lds, const Gemm g, const Sched& S, const Epi& E, int sexp_w, int sexp_a) {
    int tid_ = tidx_(); asm volatile("" : "+v"(tid_));
    const int tid = tid_, wid = __builtin_amdgcn_readfirstlane(tid >> 6), lane = tid & 63, wr = wid >> 2, wc = wid & 3, fr = lane & 15, fq = lane >> 4;
    const int K = g.K, nt = K / BK;
    unsigned voffA[2], voffB[2];
#pragma unroll
    for (int i = 0; i < 2; ++i) { int R, C; stage_rc(tid * 16 + i * 8192, R, C); const int Rb = Epi::PERM ? ((R & ~31) + perm32(R & 31)) : R;
        voffA[i] = (unsigned)(R * K + C) * 2u; voffB[i] = (unsigned)(Rb * K + C) * 2u; }
    const size_t kstep = (size_t)(BK * 2);
    const size_t hstep = (size_t)HALF * K * 2;
    const size_t tstep = 2 * hstep;
    const unsigned ldsw = (unsigned)wid * 1024u;
    const int sexp_both = sexp_w | (sexp_a << 8);
    const int fo8 = (fq >> 1) * 1024 + ((fr * 64 + 32 * (fq & 1)) ^ ((fr >> 3) << 5));
    const int sw8 = (fq & 1) << 4;
    const int aoff = wr * 8192 + fo8 + sw8, boff = wc * 4096 + fo8 + sw8, aoff2 = wr * 8192 + fo8 + (16 - sw8), boff2 = wc * 4096 + fo8 + (16 - sw8);
#define PG8_SA(b, h) (((b) * 2 + (h)) * HTB)
#define PG8_SB(b, h) ((4 + (b) * 2 + (h)) * HTB)
#define PG8_STAGE(bufoff, gbase, voff) do { _Pragma("unroll") for (int _i = 0; _i < 2; ++_i) \
        __builtin_amdgcn_global_load_lds((const unsigned*)((const char*)(gbase) + (voff)[_i]), (PG8_LAS unsigned*)(lds + (bufoff) + ldsw + _i * 8192), 16, 0, 0); } while (0)
#define PG8_LDA(dst, b, h) do { _Pragma("unroll") for (int m = 0; m < 4; ++m) { const u32x4 lo_ = *(const PG8_LAS u32x4*)(lds + PG8_SA(b, h) + aoff + m * 2048), hi_ = *(const PG8_LAS u32x4*)(lds + PG8_SA(b, h) + aoff2 + m * 2048); struct { u32x4 a_, b_; } pr_ = {lo_, hi_}; dst[m] = __builtin_bit_cast(v8i_t, pr_); } } while (0)
#define PG8_LDB(dst, b, h) do { _Pragma("unroll") for (int n = 0; n < 2; ++n) { const u32x4 lo_ = *(const PG8_LAS u32x4*)(lds + PG8_SB(b, h) + boff + n * 2048), hi_ = *(const PG8_LAS u32x4*)(lds + PG8_SB(b, h) + boff2 + n * 2048); struct { u32x4 a_, b_; } pr_ = {lo_, hi_}; dst[n] = __builtin_bit_cast(v8i_t, pr_); } } while (0)
#define PG8_MMA(ai, bj, At, Bt) do { __builtin_amdgcn_s_setprio(1); _Pragma("unroll") for (int m = 0; m < 4; ++m) _Pragma("unroll") for (int n = 0; n < 2; ++n) \
        asm volatile("v_mfma_scale_f32_16x16x128_f8f6f4 %0, %1, %2, %0, %3, %3 op_sel:[0,1,0] op_sel_hi:[0,0,0]" : "+v"(acc[ai][bj][m][n]) : "v"(Bt[n]), "v"(At[m]), "v"(sexp_both)); __builtin_amdgcn_s_setprio(0); } while (0)
#define PG8_WAIT_V(n) asm volatile("s_waitcnt vmcnt(" #n ")" ::: "memory")
#define PG8_WAIT_L(n) asm volatile("s_waitcnt lgkmcnt(" #n ")" ::: "memory")
#define PG8_BAR __builtin_amdgcn_s_barrier()
#define PG8_SCHED __builtin_amdgcn_sched_barrier(0)
    Unit cur, nxt; int ui = 0;
    if (!S.next(0, cur)) return;
    f32x4 acc[2][2][4][2];
#pragma unroll
    for (int a = 0; a < 2; ++a)
#pragma unroll
        for (int b = 0; b < 2; ++b)
#pragma unroll
            for (int m = 0; m < 4; ++m)
#pragma unroll
                for (int n = 0; n < 2; ++n) acc[a][b][m][n] = (f32x4){0.f, 0.f, 0.f, 0.f};
    v8i_t At[4], B0[2], B1[2];
    const char* cA = (const char*)g.A + (size_t)cur.pm * tstep; const char* cB = (const char*)g.Bt + (size_t)cur.pn * tstep;
    S.a_ready(cur);
    if constexpr (SP2) {
        PG8_STAGE(PG8_SB(0, 0), cB, voffB); PG8_STAGE(PG8_SB(0, 1), cB + hstep, voffB); PG8_STAGE(PG8_SA(0, 0), cA, voffA); PG8_STAGE(PG8_SA(0, 1), cA + hstep, voffA);
        if (wr == 1) PG8_BAR;
        PG8_WAIT_V(2); PG8_BAR;
        PG8_STAGE(PG8_SB(1, 0), cB + kstep, voffB); PG8_STAGE(PG8_SA(1, 0), cA + kstep, voffA); PG8_STAGE(PG8_SB(1, 1), cB + hstep + kstep, voffB);
        PG8_WAIT_V(6); PG8_BAR;
    } else {
        PG8_STAGE(PG8_SB(0, 0), cB, voffB); PG8_STAGE(PG8_SA(0, 0), cA, voffA); PG8_STAGE(PG8_SB(0, 1), cB + hstep, voffB); PG8_STAGE(PG8_SA(0, 1), cA + hstep, voffA);
        if (wr == 1) PG8_BAR;
        PG8_WAIT_V(4); PG8_BAR;
        PG8_STAGE(PG8_SB(1, 0), cB + kstep, voffB); PG8_STAGE(PG8_SA(1, 0), cA + kstep, voffA); PG8_STAGE(PG8_SB(1, 1), cB + hstep + kstep, voffB);
        PG8_WAIT_V(6); PG8_BAR;
    }
    for (;;) {
        const bool has_next = S.next(ui + 1, nxt);
        const char* nA = has_next ? (const char*)g.A + (size_t)nxt.pm * tstep : cA; const char* nB = has_next ? (const char*)g.Bt + (size_t)nxt.pn * tstep : cB;
#pragma nounroll
        for (int t = 0; t < nt; t += 2) {
            const bool last = (t == nt - 2);
            const char* a1 = cA + (size_t)(t + 1) * kstep;
            const char* a2 = last ? nA : cA + (size_t)(t + 2) * kstep; const char* b2 = last ? nB : cB + (size_t)(t + 2) * kstep;
            const char* a3 = a2 + kstep; const char* b3 = b2 + kstep;
            if (last && has_next) S.a_ready(nxt);
            if constexpr (SP2) {
            PG8_LDB(B0, 0, 0); PG8_LDB(B1, 0, 1); PG8_SCHED; PG8_LDA(At, 0, 0); PG8_STAGE(PG8_SA(1, 1), a1 + hstep, voffA);
            PG8_WAIT_V(8); PG8_WAIT_L(0); PG8_BAR; PG8_MMA(0, 0, At, B0); PG8_MMA(0, 1, At, B1); PG8_BAR; PG8_SCHED;
            PG8_LDA(At, 0, 1); PG8_STAGE(PG8_SB(0, 0), b2, voffB); PG8_STAGE(PG8_SB(0, 1), b2 + hstep, voffB); PG8_STAGE(PG8_SA(0, 0), a2, voffA);
            PG8_WAIT_V(8); PG8_WAIT_L(0); PG8_BAR; PG8_MMA(1, 0, At, B0); PG8_MMA(1, 1, At, B1); PG8_BAR; PG8_SCHED;
            PG8_LDB(B0, 1, 0); PG8_LDB(B1, 1, 1); PG8_SCHED; PG8_LDA(At, 1, 0); PG8_STAGE(PG8_SA(0, 1), a2 + hstep, voffA);
            PG8_WAIT_V(8); PG8_WAIT_L(0); PG8_BAR; PG8_MMA(0, 0, At, B0); PG8_MMA(0, 1, At, B1); PG8_BAR; PG8_SCHED;
            PG8_LDA(At, 1, 1); PG8_STAGE(PG8_SB(1, 0), b3, voffB); PG8_STAGE(PG8_SB(1, 1), b3 + hstep, voffB); PG8_STAGE(PG8_SA(1, 0), a3, voffA);
            PG8_WAIT_V(8); PG8_WAIT_L(0); PG8_BAR; PG8_MMA(1, 0, At, B0); PG8_MMA(1, 1, At, B1); PG8_BAR; PG8_SCHED;
            } else {
            PG8_LDB(B0, 0, 0); PG8_SCHED; PG8_LDA(At, 0, 0); PG8_STAGE(PG8_SA(1, 1), a1 + hstep, voffA);
            PG8_WAIT_L(8); PG8_BAR; PG8_WAIT_L(0); PG8_MMA(0, 0, At, B0); PG8_BAR; PG8_SCHED;
            PG8_LDB(B1, 0, 1); PG8_STAGE(PG8_SB(0, 0), b2, voffB);
            PG8_BAR; PG8_WAIT_L(0); PG8_MMA(0, 1, At, B1); PG8_BAR;
            PG8_LDA(At, 0, 1); PG8_STAGE(PG8_SA(0, 0), a2, voffA);
            PG8_BAR; PG8_WAIT_L(0); PG8_MMA(1, 0, At, B0); PG8_BAR; PG8_SCHED;
            PG8_STAGE(PG8_SB(0, 1), b2 + hstep, voffB);
            PG8_WAIT_V(6); PG8_BAR; PG8_MMA(1, 1, At, B1); PG8_BAR;
            PG8_LDB(B0, 1, 0); PG8_SCHED; PG8_LDA(At, 1, 0); PG8_STAGE(PG8_SA(0, 1), a2 + hstep, voffA);
            PG8_WAIT_L(8); PG8_BAR; PG8_WAIT_L(0); PG8_MMA(0, 0, At, B0); PG8_BAR; PG8_SCHED;
            PG8_LDB(B1, 1, 1); PG8_STAGE(PG8_SB(1, 0), b3, voffB);
            PG8_BAR; PG8_WAIT_L(0); PG8_MMA(0, 1, At, B1); PG8_BAR;
            PG8_LDA(At, 1, 1); PG8_STAGE(PG8_SA(1, 0), a3, voffA);
            PG8_BAR; PG8_WAIT_L(0); PG8_MMA(1, 0, At, B0); PG8_BAR; PG8_SCHED;
            PG8_STAGE(PG8_SB(1, 1), b3 + hstep, voffB);
            PG8_WAIT_V(6); PG8_BAR; PG8_MMA(1, 1, At, B1); PG8_BAR;
            }
        }
        if constexpr (ALIGN_EPI) { if (wr == 0) PG8_BAR; }
        asm volatile("s_nop 15\n\ts_nop 15" ::: "memory");
        if constexpr (!Epi::AFTER_DRAIN) { int t2_ = tidx_(); asm volatile("" : "+v"(t2_)); const int w2_ = __builtin_amdgcn_readfirstlane(t2_ >> 6), l2_ = t2_ & 63;
            E(acc, cur, w2_ >> 2, w2_ & 3, l2_ & 15, l2_ >> 4); S.done(cur); }
        if (!has_next) break;
#pragma unroll
        for (int a = 0; a < 2; ++a)
#pragma unroll
            for (int b = 0; b < 2; ++b)
#pragma unroll
                for (int m = 0; m < 4; ++m)
#pragma unroll
                    for (int n = 0; n < 2; ++n) acc[a][b][m][n] = (f32x4){0.f, 0.f, 0.f, 0.f};
        cur = nxt; cA = nA; cB = nB; ++ui;
        if constexpr (ALIGN_EPI) { if (wr == 1) PG8_BAR; }
    }
    PG8_WAIT_V(0);
    if constexpr (!ALIGN_EPI) { if (wr == 0) PG8_BAR; }
    PG8_BAR;
    if constexpr (Epi::AFTER_DRAIN) { E.fused(acc, cur, wr, wc, fr, fq, lds, wid, lane); S.done(cur); }
#undef PG8_SA
#undef PG8_SB
#undef PG8_STAGE
#undef PG8_LDA
#undef PG8_LDB
#undef PG8_MMA
#undef PG8_WAIT_V
#undef PG8_WAIT_L
#undef PG8_BAR
#undef PG8_SCHED
}
}

constexpr int NWAVES = 8;
constexpr int BATCH = 8, T = 4096, D = 1024, M = BATCH * T;
constexpr int RW = 512, NH = 8, HD = 64;
constexpr int NZ = 2560;
constexpr int OFF_WD = 1536, OFF_AD = 1600, OFF_GD = 1664, SHIFT_COLS = 1824;
constexpr int OFF_POOL = 1824, OFF_QLAT = 2080, OFF_KVLAT = 2336, OFF_KROPE = 2464, OFF_VD = 2496;
constexpr int N_IN0 = 2496, N_IN1 = 2528;
constexpr int DFF = 2816, NEXP = 8, DFFE = 3584;
constexpr int MLA_H = 4, QK = 96, VD = 64;
constexpr int MOE_CAP = M;
constexpr int MOE_MAXTILES = (2 * M) / 256 + NEXP;

constexpr size_t MiB = 1u << 20;
constexpr size_t WS_CTL = 0, CTL_ZERO_BYTES = 1 * MiB;
constexpr size_t WS_MOD = 1 * MiB;
constexpr size_t WS_COS = 2 * MiB, WS_SIN = 4 * MiB;
constexpr size_t WS_TOK = 8 * MiB;
constexpr size_t WS_GATE = 9 * MiB;
constexpr size_t WS_ASG = 10 * MiB;
constexpr size_t WS_WIN = 16 * MiB;
constexpr size_t WS_WOUT = 26 * MiB;
constexpr size_t WS_WFFI = 30 * MiB;
constexpr size_t WS_WFFO = 41 * MiB;
constexpr size_t WS_WMI = 48 * MiB;
constexpr size_t WS_XB = 112 * MiB;
constexpr size_t WS_WMO = 188 * MiB;
constexpr size_t WS_H = 216 * MiB;
constexpr size_t WS_VF = 280 * MiB;
constexpr size_t WS_BIG = 312 * MiB;
constexpr size_t WS_Z = WS_BIG;
constexpr size_t WS_R = WS_BIG + 160 * MiB;
constexpr size_t WS_K = WS_R + 32 * MiB, WS_V = WS_R + 64 * MiB, WS_KK = WS_R + 96 * MiB, WS_A = WS_R + 128 * MiB;
constexpr size_t WS_LW = WS_R + 160 * MiB;
constexpr size_t WS_G = WS_LW + 64 * MiB;
constexpr size_t WS_QM = WS_G + 32 * MiB;
constexpr size_t WS_KM = WS_QM + 24 * MiB;
constexpr size_t WS_VM = WS_KM + 24 * MiB;
constexpr size_t WS_MIX = WS_VM + 16 * MiB;
constexpr size_t WS_MIX_END = WS_MIX + 64 * MiB;
constexpr size_t WS_ACT = WS_BIG;
constexpr size_t WS_XG = WS_VF;
constexpr size_t WS_YR = WS_VF;
constexpr size_t WS_MACT = WS_VF + 132 * MiB;
constexpr size_t WS_END = WS_MACT + 462 * MiB;
static_assert(WS_MIX_END <= 896 * MiB && WS_END <= 896 * MiB, "d_ws map");
static_assert((size_t)MOE_MAXTILES * 256 * 1024 * 2 <= 132 * MiB && (size_t)MOE_MAXTILES * 256 * 3584 * 2 <= 462 * MiB, "moe buffers");
constexpr int CW_BAR = 4096;
constexpr int CW_MOE = 16384;
constexpr int CW_ATQ = 20480;
static_assert((CW_ATQ + 128) * 4 <= (int)CTL_ZERO_BYTES, "ctl map");

constexpr int RING_OFF = 0, RING_BYTES = 131072;
constexpr int LDSCTL_OFF = RING_BYTES, MISC_OFF = LDSCTL_OFF + 320;
constexpr int LDS_BYTES = 147456;

#define GAS __attribute__((address_space(1)))
#define LAS __attribute__((address_space(3)))
typedef unsigned short bf16;
typedef unsigned v4u __attribute__((ext_vector_type(4)));
typedef unsigned v2u __attribute__((ext_vector_type(2)));
typedef float f32x4 __attribute__((ext_vector_type(4)));
typedef short bf16x8 __attribute__((ext_vector_type(8)));
typedef GAS unsigned gu32;
#define RLX_AGENT __ATOMIC_RELAXED, __HIP_MEMORY_SCOPE_AGENT
#define LDS_WAIT() asm volatile("s_waitcnt lgkmcnt(0)" ::: "memory")
#define VM_WAIT() asm volatile("s_waitcnt vmcnt(0)" ::: "memory")
__device__ __forceinline__ unsigned cvtpk(float lo, float hi) { typedef float f2_t __attribute__((ext_vector_type(2))); typedef __bf16 b2_t __attribute__((ext_vector_type(2)));
    f2_t v = {lo, hi}; b2_t b = __builtin_convertvector(v, b2_t); return __builtin_bit_cast(unsigned, b); }
__device__ __forceinline__ unsigned f2bf(float f) { return cvtpk(f, f) & 0xffffu; }
__device__ __forceinline__ unsigned pk2(float lo, float hi) { return cvtpk(lo, hi); }
__device__ __forceinline__ float bf2f(bf16 v) { return __uint_as_float(((unsigned)v) << 16); }
__device__ __forceinline__ float bflo(unsigned w) { return __uint_as_float(w << 16); }
__device__ __forceinline__ float bfhi(unsigned w) { return __uint_as_float(w & 0xffff0000u); }
__device__ __forceinline__ unsigned f8pk2(float a, float b) { a = fminf(fmaxf(a, -448.f), 448.f); b = fminf(fmaxf(b, -448.f), 448.f); return (unsigned)__builtin_amdgcn_cvt_pk_fp8_f32(a, b, 0, false) & 0xffffu; }
__device__ __forceinline__ unsigned f8pk4(float a, float b, float c_, float d) { a = fminf(fmaxf(a, -448.f), 448.f); b = fminf(fmaxf(b, -448.f), 448.f); c_ = fminf(fmaxf(c_, -448.f), 448.f); d = fminf(fmaxf(d, -448.f), 448.f);
    int w = __builtin_amdgcn_cvt_pk_fp8_f32(a, b, 0, false); w = __builtin_amdgcn_cvt_pk_fp8_f32(c_, d, w, true); return (unsigned)w; }
constexpr float F8_WSCALE = 64.f, F8_HSCALE = 8.f, F8_ASCALE = 4.f;
constexpr int F8_WEXP = 127 - 6, F8_HEXP = 127 - 3, F8_AEXP = 127 - 2;
__device__ __forceinline__ float sigmoidf_(float x) { return __builtin_amdgcn_rcpf(1.f + __expf(-x)); }
__device__ __forceinline__ float tanhf_(float x) { const float e = __expf(2.f * x); return 1.f - 2.f * __builtin_amdgcn_rcpf(1.f + e); }
__device__ __forceinline__ float half_sum32(float v) {
    v += __int_as_float(__builtin_amdgcn_mov_dpp(__float_as_int(v), 0xB1, 0xF, 0xF, true));
    v += __int_as_float(__builtin_amdgcn_mov_dpp(__float_as_int(v), 0x4E, 0xF, 0xF, true));
    v += __int_as_float(__builtin_amdgcn_mov_dpp(__float_as_int(v), 0x141, 0xF, 0xF, true));
    v += __int_as_float(__builtin_amdgcn_mov_dpp(__float_as_int(v), 0x140, 0xF, 0xF, true));
    v += __int_as_float(__builtin_amdgcn_ds_swizzle(__float_as_int(v), 0x401F));
    return v;
}
__device__ __forceinline__ float other_half(float v) { const unsigned u = __float_as_uint(v); auto rr = __builtin_amdgcn_permlane32_swap(u, u, false, false); return __uint_as_float(rr[0] == u ? rr[1] : rr[0]); }
__device__ __forceinline__ float wave_sum(float v) { v = half_sum32(v); const unsigned u = __float_as_uint(v); auto rr = __builtin_amdgcn_permlane32_swap(u, u, false, false); return __uint_as_float(rr[0]) + __uint_as_float(rr[1]); }

__device__ __forceinline__ void st_put(LAS unsigned char* ST, int i, int col, float v) { *(LAS bf16*)(ST + i * 256 + col * 2) = (bf16)f2bf(v); }
template <int NCOLS> __device__ __forceinline__ void st_flush(LAS unsigned char* ST, bf16* gbase, int rowstride, int lane, bool dry) {
    constexpr int CPR = NCOLS / 8, TOTAL = 32 * CPR;
    LDS_WAIT();
#pragma unroll
    for (int k = 0; k < (TOTAL + 63) / 64; ++k) { const int c = lane + 64 * k;
        if (c < TOTAL) { const int row = c / CPR, ch = c % CPR; const v4u v = *(const LAS v4u*)(ST + row * 256 + ch * 16); if (!dry) *(v4u*)(gbase + (unsigned)(row * rowstride + ch * 8)) = v; } }
    LDS_WAIT();
}
__device__ __forceinline__ void st_flush_kimg(LAS unsigned char* ST, bf16* gtile, int lane, bool dry) {
    LDS_WAIT();
#pragma unroll
    for (int k = 0; k < 6; ++k) { const int c = (lane & 63) + 64 * k; const int ch = c >> 5, row = c & 31;
        const v4u v = *(const LAS v4u*)(ST + row * 256 + ch * 16); if (!dry) *(v4u*)(gtile + (unsigned)(ch * 512 + row * 8)) = v; }
    LDS_WAIT();
}
__device__ __forceinline__ int fresh_lane() { return lane_id_(); }
__device__ __forceinline__ float rsq_(float x) { return __builtin_amdgcn_rsqf(x); }
__device__ __forceinline__ float rcp_(float x) { return __builtin_amdgcn_rcpf(x); }
#define XB_TMO      128
#define XB_XCNT(j)  (256  + 64 * (j))
#define XB_XSUB(j)  (1280 + 64 * (j))
#define XB_XGEN(j)  (2304 + 64 * (j))
#define XB_TOP      3328
#define XB_TOPGEN   3392
#define XCD_BAR_WORDS 3456
#define XB_SPIN_CAP (1u << 18)
__device__ __forceinline__ unsigned xb_ld(unsigned* p)              { return __hip_atomic_load(p, __ATOMIC_RELAXED, __HIP_MEMORY_SCOPE_AGENT); }
__device__ __forceinline__ unsigned xb_add(unsigned* p, unsigned v) { return __hip_atomic_fetch_add(p, v, __ATOMIC_RELAXED, __HIP_MEMORY_SCOPE_AGENT); }
__device__ __forceinline__ unsigned xb_xcc_id() { return (unsigned)__builtin_amdgcn_s_getreg((3 << 11) | 20) & 0xFu; }
#define XB_SPIN(cond, bar) do { unsigned _sp = 0; while (cond) { __builtin_amdgcn_s_sleep(1); \
    if ((++_sp & 255u) == 0u) { if (xb_ld(&(bar)[XB_TMO])) break; if (_sp > XB_SPIN_CAP) { atomicAdd(&(bar)[XB_TMO], 1u); break; } } } } while (0)
struct XcdBarrier { unsigned* bar; unsigned x; volatile LAS unsigned* st; };
__device__ __forceinline__ XcdBarrier xcd_barrier_post(unsigned* bar, volatile LAS unsigned* st) {
    XcdBarrier b; b.bar = bar; b.x = xb_xcc_id(); b.st = st;
    if (tidx_() == 0) (void)xb_add(&bar[XB_XCNT(b.x)], 1u);
    return b;
}
__device__ __forceinline__ void xcd_barrier_complete(unsigned* bar, unsigned x, unsigned& nloc, unsigned& nx) {
    const unsigned G = gridDim.x * gridDim.y * gridDim.z;
    unsigned sum, cnt, mine, sp = 0u;
    for (;;) {
        sum = 0u; cnt = 0u; mine = 0u;
#pragma unroll
        for (unsigned j = 0; j < 16; ++j) { const unsigned c = xb_ld(&bar[XB_XCNT(j)]); sum += c; cnt += (c > 0u) ? 1u : 0u; mine = (j == x) ? c : mine; }
        if (sum == G) break;
        __builtin_amdgcn_s_sleep(1);
        if ((++sp & 255u) == 0u) { if (xb_ld(&bar[XB_TMO])) break; if (sp > XB_SPIN_CAP) { atomicAdd(&bar[XB_TMO], 1u); break; } }
    }
    nloc = mine > 0u ? mine : 1u; nx = cnt > 0u ? cnt : 1u;
}
__device__ __forceinline__ void xcd_barrier(const XcdBarrier& b) {
    asm volatile("s_waitcnt vmcnt(0)" ::: "memory");
    __syncthreads();
    if (tidx_() == 0) {
        unsigned* bar = b.bar;
        __builtin_amdgcn_s_waitcnt(0);
        unsigned nloc = b.st[0], nx = b.st[1];
        if (nloc == 0u) { xcd_barrier_complete(bar, b.x, nloc, nx); b.st[0] = nloc; b.st[1] = nx; }
        const unsigned old = xb_add(&bar[XB_XSUB(b.x)], 1u);
        const unsigned gen = old / nloc;
        if (old + 1u == (gen + 1u) * nloc) {
            __builtin_amdgcn_fence(__ATOMIC_RELEASE, "agent");
            asm volatile("s_waitcnt vmcnt(0)" ::: "memory");
            const unsigned og = xb_add(&bar[XB_TOP], 1u);
            const unsigned tg = og / nx;
            if (og + 1u == (tg + 1u) * nx) xb_add(&bar[XB_TOPGEN], 1u);
            else XB_SPIN(xb_ld(&bar[XB_TOPGEN]) == tg, bar);
            __builtin_amdgcn_fence(__ATOMIC_ACQUIRE, "agent");
            xb_add(&bar[XB_XGEN(b.x)], 1u);
            asm volatile("s_waitcnt vmcnt(0)" ::: "memory");
        } else {
            XB_SPIN(xb_ld(&bar[XB_XGEN(b.x)]) == gen, bar);
            __builtin_amdgcn_fence(__ATOMIC_ACQUIRE, "agent");
            asm volatile("s_waitcnt vmcnt(0)" ::: "memory");
        }
    }
    __syncthreads();
}

struct Args { const float* in[29]; float* out; unsigned char* ws; int ph_lo, ph_hi, li, pad; };
static_assert(sizeof(Args) == 29 * 8 + 8 + 8 + 16, "Args has no padding");
enum { I_X = 0, I_C, I_POS, I_WADA, I_BADA, I_NGAIN, I_WIN0, I_WIN1, I_MU, I_MUV, I_RVEC, I_RV0, I_RW2, I_RA2, I_RG2, I_RV2, I_POOLW, I_POOLS,
       I_QLG, I_KVLG, I_WQUP, I_WKVUP, I_QKG, I_WOUT, I_FFI, I_FFO, I_ROUTER, I_MOEI, I_MOEO };

namespace pg8 {
struct EpiRes {
    static constexpr bool PERM = false, AFTER_DRAIN = false;
    const float* xsrc; float* out; const float* gate;
    __device__ __forceinline__ void operator()(const f32x4 (&acc)[2][2][4][2], const Unit& u, int wr, int wc, int fr, int fq) const {
        const int row0 = u.pm * BM + wr * 64 + fr, col0 = u.pn * BM + wc * 32 + 4 * fq;
        const float* gb = gate + (size_t)((u.pm * BM) / T) * 6144;
        f32x4 gv[2][2];
#pragma unroll
        for (int bj = 0; bj < 2; ++bj)
#pragma unroll
            for (int n = 0; n < 2; ++n) gv[bj][n] = *(const f32x4*)(gb + col0 + bj * HALF + n * 16);
        f32x4 xs[2][2], xn[2][2];
        { const size_t off = (size_t)row0 * 1024 + col0;
#pragma unroll
          for (int bj = 0; bj < 2; ++bj)
#pragma unroll
              for (int n = 0; n < 2; ++n) xs[bj][n] = *(const f32x4*)(xsrc + off + bj * HALF + n * 16); }
#pragma unroll
        for (int g = 0; g < 8; ++g) { const int ai = g >> 2, m = g & 3;
            const size_t off = (size_t)(row0 + ai * HALF + m * 16) * 1024 + col0;
            if (g + 1 < 8) { const size_t offn = (size_t)(row0 + ((g + 1) >> 2) * HALF + ((g + 1) & 3) * 16) * 1024 + col0;
#pragma unroll
                for (int bj = 0; bj < 2; ++bj)
#pragma unroll
                    for (int n = 0; n < 2; ++n) xn[bj][n] = *(const f32x4*)(xsrc + offn + bj * HALF + n * 16); }
#pragma unroll
            for (int bj = 0; bj < 2; ++bj)
#pragma unroll
                for (int n = 0; n < 2; ++n) *(f32x4*)(out + off + bj * HALF + n * 16) = xs[bj][n] + gv[bj][n] * acc[ai][bj][m][n];
#pragma unroll
            for (int bj = 0; bj < 2; ++bj)
#pragma unroll
                for (int n = 0; n < 2; ++n) xs[bj][n] = xn[bj][n];
        }
    }
};
template <bool XF32> struct EpiResB {
    static constexpr bool PERM = true, AFTER_DRAIN = false;
    const void* xsrc; bf16_t* out; const float* gate;
    __device__ __forceinline__ void ldx(f32x4 (&d)[2][2], size_t off) const {
#pragma unroll
        for (int bj = 0; bj < 2; ++bj) {
            if constexpr (XF32) { d[bj][0] = *(const f32x4*)((const float*)xsrc + off + bj * HALF); d[bj][1] = *(const f32x4*)((const float*)xsrc + off + bj * HALF + 4); }
            else { const u32x4 r = *(const u32x4*)((const bf16_t*)xsrc + off + bj * HALF);
                   d[bj][0] = (f32x4){bflo(r.x), bfhi(r.x), bflo(r.y), bfhi(r.y)}; d[bj][1] = (f32x4){bflo(r.z), bfhi(r.z), bflo(r.w), bfhi(r.w)}; } }
    }
    __device__ __forceinline__ void operator()(const f32x4 (&acc)[2][2][4][2], const Unit& u, int wr, int wc, int fr, int fq) const {
        const int row0 = u.pm * BM + wr * 64 + fr, col0 = u.pn * BM + wc * 32 + 8 * fq;
        const float* gb = gate + (size_t)((u.pm * BM) / T) * 6144;
        f32x4 gv[2][2];
#pragma unroll
        for (int bj = 0; bj < 2; ++bj)
#pragma unroll
            for (int n = 0; n < 2; ++n) gv[bj][n] = *(const f32x4*)(gb + col0 + bj * HALF + 4 * n);
        f32x4 xs[2][2], xn[2][2];
        ldx(xs, (size_t)row0 * 1024 + col0);
#pragma unroll
        for (int g = 0; g < 8; ++g) { const int ai = g >> 2, m = g & 3;
            const size_t off = (size_t)(row0 + ai * HALF + m * 16) * 1024 + col0;
            if (g + 1 < 8) ldx(xn, (size_t)(row0 + ((g + 1) >> 2) * HALF + ((g + 1) & 3) * 16) * 1024 + col0);
#pragma unroll
            for (int bj = 0; bj < 2; ++bj) { const f32x4 y0 = xs[bj][0] + gv[bj][0] * acc[ai][bj][m][0], y1 = xs[bj][1] + gv[bj][1] * acc[ai][bj][m][1];
                u32x4 w; w.x = cvt_pk_bf16(y0[0], y0[1]); w.y = cvt_pk_bf16(y0[2], y0[3]); w.z = cvt_pk_bf16(y1[0], y1[1]); w.w = cvt_pk_bf16(y1[2], y1[3]);
                *(u32x4*)(out + off + bj * HALF) = w; }
#pragma unroll
            for (int bj = 0; bj < 2; ++bj)
#pragma unroll
                for (int n = 0; n < 2; ++n) xs[bj][n] = xn[bj][n];
        }
    }
};
__device__ __forceinline__ f32x2 swiglu_pk(f32x2 g, f32x2 u, float inv_s) {
    const f32x2 t = g * (-1.4426950408889634f);
    f32x2 e; e.x = __builtin_amdgcn_exp2f(t.x); e.y = __builtin_amdgcn_exp2f(t.y);
    const f32x2 d = e * inv_s + inv_s;
    f32x2 r; r.x = __builtin_amdgcn_rcpf(d.x); r.y = __builtin_amdgcn_rcpf(d.y);
    return (g * u) * r;
}
struct EpiSwiglu {
    static constexpr bool PERM = true, AFTER_DRAIN = false;
    bf16_t* O; int ldo; int npn;
    __device__ __forceinline__ void operator()(const f32x4 (&acc)[2][2][4][2], const Unit& u, int wr, int wc, int fr, int fq) const {
        const int row0 = u.pm * BM + wr * 64 + fr, col0 = (u.pn % npn) * HALF + wc * 32 + 8 * fq;
#pragma unroll
        for (int ai = 0; ai < 2; ++ai)
#pragma unroll
            for (int m = 0; m < 4; ++m) { bf16_t* rowp = O + (size_t)(row0 + ai * HALF + m * 16) * ldo + col0;
                float o[8];
#pragma unroll
                for (int n = 0; n < 2; ++n)
#pragma unroll
                    for (int j = 0; j < 4; j += 2) { const f32x2 r = swiglu_pk((f32x2){acc[ai][0][m][n][j], acc[ai][0][m][n][j + 1]}, (f32x2){acc[ai][1][m][n][j], acc[ai][1][m][n][j + 1]}, 1.f); o[n * 4 + j] = r.x; o[n * 4 + j + 1] = r.y; }
                u32x4 w; w.x = cvt_pk_bf16(o[0], o[1]); w.y = cvt_pk_bf16(o[2], o[3]); w.z = cvt_pk_bf16(o[4], o[5]); w.w = cvt_pk_bf16(o[6], o[7]);
                *(u32x4*)rowp = w; }
    }
};
struct EpiSwigluF8 {
    static constexpr bool PERM = true, AFTER_DRAIN = false;
    unsigned char* O; int ldo; int npn;
    __device__ __forceinline__ void operator()(const f32x4 (&acc)[2][2][4][2], const Unit& u, int wr, int wc, int fr, int fq) const {
        const int row0 = u.pm * BM + wr * 64 + fr, col0 = (u.pn % npn) * HALF + wc * 32 + 8 * fq;
#pragma unroll
        for (int ai = 0; ai < 2; ++ai)
#pragma unroll
            for (int m = 0; m < 4; ++m) { unsigned char* rowp = O + (size_t)(row0 + ai * HALF + m * 16) * ldo + col0;
                float o[8];
#pragma unroll
                for (int n = 0; n < 2; ++n)
#pragma unroll
                    for (int j = 0; j < 4; j += 2) { const f32x2 r = swiglu_pk((f32x2){acc[ai][0][m][n][j], acc[ai][0][m][n][j + 1]}, (f32x2){acc[ai][1][m][n][j], acc[ai][1][m][n][j + 1]}, 1.f / F8_ASCALE); o[n * 4 + j] = r.x; o[n * 4 + j + 1] = r.y; }
                v2u w; w.x = f8pk4(o[0], o[1], o[2], o[3]); w.y = f8pk4(o[4], o[5], o[6], o[7]);
                asm volatile("" : "+v"(w.x), "+v"(w.y));
                *(v2u*)rowp = w; }
    }
};
struct EpiMoeOut {
    static constexpr bool PERM = true, AFTER_DRAIN = false;
    bf16_t* O;
    __device__ __forceinline__ void operator()(const f32x4 (&acc)[2][2][4][2], const Unit& u, int wr, int wc, int fr, int fq) const {
        const int row0 = u.pm * BM + wr * 64 + fr, col0 = (u.pn & 3) * BM + wc * 32 + 8 * fq;
#pragma unroll
        for (int ai = 0; ai < 2; ++ai)
#pragma unroll
            for (int m = 0; m < 4; ++m) { bf16_t* rowp = O + (size_t)(row0 + ai * HALF + m * 16) * 1024 + col0;
#pragma unroll
                for (int bj = 0; bj < 2; ++bj) { const f32x4 v0 = acc[ai][bj][m][0], v1 = acc[ai][bj][m][1];
                    u32x4 w; w.x = cvt_pk_bf16(v0[0], v0[1]); w.y = cvt_pk_bf16(v0[2], v0[3]); w.z = cvt_pk_bf16(v1[0], v1[1]); w.w = cvt_pk_bf16(v1[2], v1[3]);
                    *(u32x4*)(rowp + bj * HALF) = w; } }
    }
};
struct MoeOrder {
    int npn, nunits, G, c; int ts1, ts2, ts3, ts4, ts5, ts6, ts7;
    __device__ __forceinline__ bool next(int i, Unit& u) const {
        const int s = (c & 7) * (G >> 3) + (c >> 3);
        const int L = i * G + s; if (L >= nunits) return false;
        const int nrt = nunits / npn, nig = 8 * npn, gid = L / nig, fm = gid * 8, gsz = (nrt - fm) < 8 ? (nrt - fm) : 8, r = L % nig;
        const int rt = fm + r % gsz, pl = r / gsz;
        const int e = (rt >= ts1) + (rt >= ts2) + (rt >= ts3) + (rt >= ts4) + (rt >= ts5) + (rt >= ts6) + (rt >= ts7);
        u.pm = rt; u.pn = e * npn + pl; return true;
    }
    __device__ __forceinline__ void a_ready(const Unit&) const {}
    __device__ __forceinline__ void done(const Unit&) const {}
};
}

typedef float f32x16 __attribute__((ext_vector_type(16)));
constexpr int CHK = 32, NCHK = T / CHK;
constexpr size_t WS_SM = WS_R;
constexpr size_t WS_SNT = WS_R + 64 * MiB;
constexpr size_t WS_SRP = WS_R + 128 * MiB;
constexpr size_t WS_SYL = WS_H;
constexpr size_t WS_XV = WS_H + 32 * MiB;
constexpr size_t WS_BON = WS_MIX_END;
static_assert(WS_BON + 1 * MiB <= 896 * MiB, "ws");

__device__ __forceinline__ bf16x8 mkfrag(unsigned a, unsigned b, unsigned c, unsigned d) { v4u w = {a, b, c, d}; return __builtin_bit_cast(bf16x8, w); }
__device__ __forceinline__ bf16x8 accfrag(const f32x16& a, int s2) {
    return s2 == 0 ? mkfrag(cvtpk(a[0], a[1]), cvtpk(a[2], a[3]), cvtpk(a[4], a[5]), cvtpk(a[6], a[7]))
                   : mkfrag(cvtpk(a[8], a[9]), cvtpk(a[10], a[11]), cvtpk(a[12], a[13]), cvtpk(a[14], a[15]));
}
#define MFMA32(A, B, C) __builtin_amdgcn_mfma_f32_32x32x16_bf16((A), (B), (C), 0, 0, 0)
__device__ __forceinline__ int tm_addr(int row, int chunk) { return row * 128 + ((chunk ^ ((row >> 1) & 7)) << 4); }
__device__ __forceinline__ int cm_addr(int row, int chunk) { return row * 64 + ((chunk ^ ((row >> 2) & 3)) << 4); }
__device__ __forceinline__ int qrow(int r, int h) { return (r & 3) + 8 * (r >> 2) + 4 * h; }

template <int MODE>
__device__ __forceinline__ void scan_pass(const bf16* Rg, const bf16* Kg, const bf16* Vg, const bf16* KKg, const bf16* Ag, const float* LWg, size_t base,
                                          LAS unsigned char* L, LAS float* gC, int lane) {
    float cum = 0.f;
    if constexpr (MODE == 0) {
#pragma unroll 8
        for (int t = 0; t < CHK; ++t) {
            const size_t o = base + (size_t)t * RW + lane;
            const float kk = bf2f(KKg[o]), a = bf2f(Ag[o]), k = bf2f(Kg[o]), r = bf2f(Rg[o]), lw = LWg[o];
            const float cumx = cum; cum += lw;
            const float ea = __expf(cumx), eb = __expf(-cum), er = __expf(cum);
            const int ad = tm_addr(t, lane >> 3) + (lane & 7) * 2;
            *(LAS bf16*)(L + ad) = (bf16)f2bf(-kk * ea);
            *(LAS bf16*)(L + 4096 + ad) = (bf16)f2bf(kk * a * eb);
            *(LAS bf16*)(L + 8192 + ad) = (bf16)f2bf(k * eb);
            *(LAS bf16*)(L + 12288 + ad) = (bf16)f2bf(r * er);
        }
        gC[lane] = __expf(cum);
    } else {
#pragma unroll
        for (int s2 = 0; s2 < 2; ++s2) {
            float xa[16], xv[16], xb[16], xk[16];
#pragma unroll
            for (int u = 0; u < 16; ++u) {
                const size_t o = base + (size_t)(s2 * 16 + u) * RW + lane;
                const float kk = bf2f(KKg[o]), a = bf2f(Ag[o]), k = bf2f(Kg[o]), v = bf2f(Vg[o]), lw = LWg[o];
                const float cumx = cum; cum += lw;
                const float ea = __expf(cumx), eb = __expf(-cum);
                xa[u] = -kk * ea; xv[u] = v; xb[u] = kk * a * eb; xk[u] = k * eb;
            }
#pragma unroll
            for (int h = 0; h < 2; ++h) {
                const int ad = cm_addr(lane, 2 * s2 + h); const int u0 = 4 * h, u1 = 8 + 4 * h;
                *(LAS v4u*)(L + ad) = (v4u){cvtpk(xa[u0], xa[u0 + 1]), cvtpk(xa[u0 + 2], xa[u0 + 3]), cvtpk(xa[u1], xa[u1 + 1]), cvtpk(xa[u1 + 2], xa[u1 + 3])};
                *(LAS v4u*)(L + 4096 + ad) = (v4u){cvtpk(xv[u0], xv[u0 + 1]), cvtpk(xv[u0 + 2], xv[u0 + 3]), cvtpk(xv[u1], xv[u1 + 1]), cvtpk(xv[u1 + 2], xv[u1 + 3])};
                *(LAS v4u*)(L + 8192 + ad) = (v4u){cvtpk(xb[u0], xb[u0 + 1]), cvtpk(xb[u0 + 2], xb[u0 + 3]), cvtpk(xb[u1], xb[u1 + 1]), cvtpk(xb[u1 + 2], xb[u1 + 3])};
                *(LAS v4u*)(L + 12288 + ad) = (v4u){cvtpk(xk[u0], xk[u0 + 1]), cvtpk(xk[u0 + 2], xk[u0 + 3]), cvtpk(xk[u1], xk[u1 + 1]), cvtpk(xk[u1 + 2], xk[u1 + 3])};
            }
        }
    }
}

__device__ __forceinline__ void scan_local_item(unsigned char* ws, int item, LAS unsigned char* L, LAS float* gC, int lane) {
    const int hh = item % NH, bn = item / NH;
    const size_t base = (size_t)bn * CHK * RW + hh * 64;
    const bf16* Rg = (const bf16*)(ws + WS_R); const bf16* Kg = (const bf16*)(ws + WS_K); const bf16* Vg = (const bf16*)(ws + WS_V); const bf16* KKg = (const bf16*)(ws + WS_KK); const bf16* Ag = (const bf16*)(ws + WS_A);
    const float* LWg = (const float*)(ws + WS_LW);
    const int p = lane & 31, h = lane >> 5;
    const f32x16 zero16 = {0.f, 0.f, 0.f, 0.f, 0.f, 0.f, 0.f, 0.f, 0.f, 0.f, 0.f, 0.f, 0.f, 0.f, 0.f, 0.f};
    LDS_WAIT();
    scan_pass<0>(Rg, Kg, Vg, KKg, Ag, LWg, base, L, gC, lane);
    LDS_WAIT();
    f32x16 Aab = zero16, AabT = zero16, Aak = zero16, Arb = zero16, Ark = zero16;
#pragma unroll
    for (int s = 0; s < 4; ++s) {
        const int ad = tm_addr(p, 2 * s + h);
        const bf16x8 fa = *(const LAS bf16x8*)(L + ad), fb = *(const LAS bf16x8*)(L + 4096 + ad), fk = *(const LAS bf16x8*)(L + 8192 + ad), fr = *(const LAS bf16x8*)(L + 12288 + ad);
        Aab = MFMA32(fb, fa, Aab); AabT = MFMA32(fa, fb, AabT); Aak = MFMA32(fk, fa, Aak); Arb = MFMA32(fb, fr, Arb); Ark = MFMA32(fk, fr, Ark);
    }
    unsigned rin[2][8];
#pragma unroll
    for (int ct = 0; ct < 2; ++ct)
#pragma unroll
        for (int g = 0; g < 4; ++g) { const v2u w = *(const LAS v2u*)(L + 12288 + tm_addr(p, 4 * ct + g) + 8 * h); rin[ct][2 * g] = w.x; rin[ct][2 * g + 1] = w.y; }
#pragma unroll
    for (int r = 0; r < 16; ++r) { const int q = qrow(r, h);
        Aab[r] = (q < p) ? Aab[r] : 0.f;  Aak[r] = (q < p) ? Aak[r] : 0.f;
        AabT[r] = (p < q) ? AabT[r] : 0.f;
        Arb[r] = (q <= p) ? Arb[r] : 0.f; Ark[r] = (q <= p) ? Ark[r] : 0.f; }
    f32x16 Tm = Aab;
#pragma unroll
    for (int r = 0; r < 16; ++r) Tm[r] += (qrow(r, h) == p) ? 1.f : 0.f;
    bf16x8 X0 = accfrag(Aab, 0), X1 = accfrag(Aab, 1), XT0 = accfrag(AabT, 0), XT1 = accfrag(AabT, 1);
#pragma unroll
    for (int it = 0; it < 4; ++it) {
        f32x16 X2T = MFMA32(X0, XT0, zero16); X2T = MFMA32(X1, XT1, X2T);
        const bf16x8 T0 = accfrag(Tm, 0), T1 = accfrag(Tm, 1);
        const bf16x8 Y0 = accfrag(X2T, 0), Y1 = accfrag(X2T, 1);
        Tm = MFMA32(Y0, T0, Tm); Tm = MFMA32(Y1, T1, Tm);
        if (it < 3) { f32x16 X2 = MFMA32(XT0, X0, zero16); X2 = MFMA32(XT1, X1, X2);
            X0 = accfrag(X2, 0); X1 = accfrag(X2, 1); XT0 = Y0; XT1 = Y1; }
    }
    const bf16x8 Tf0 = accfrag(Tm, 0), Tf1 = accfrag(Tm, 1);
    const bf16x8 Akf0 = accfrag(Aak, 0), Akf1 = accfrag(Aak, 1), Abf0 = accfrag(Arb, 0), Abf1 = accfrag(Arb, 1), Arf0 = accfrag(Ark, 0), Arf1 = accfrag(Ark, 1);
    LDS_WAIT();
    scan_pass<1>(Rg, Kg, Vg, KKg, Ag, LWg, base, L, gC, lane);
    LDS_WAIT();
    bf16x8 fAT[2][2], fVT[2][2], fBT[2][2], fKT[2][2];
#pragma unroll
    for (int ct = 0; ct < 2; ++ct)
#pragma unroll
        for (int s2 = 0; s2 < 2; ++s2) { const int ad = cm_addr(32 * ct + p, 2 * s2 + h);
            fAT[ct][s2] = *(const LAS bf16x8*)(L + ad); fVT[ct][s2] = *(const LAS bf16x8*)(L + 4096 + ad); fBT[ct][s2] = *(const LAS bf16x8*)(L + 8192 + ad); fKT[ct][s2] = *(const LAS bf16x8*)(L + 12288 + ad); }
    bf16x8 fPT[2][2], fQT[2][2];
#pragma unroll
    for (int ct = 0; ct < 2; ++ct) {
        f32x16 a = MFMA32(Tf0, fAT[ct][0], zero16); a = MFMA32(Tf1, fAT[ct][1], a); fPT[ct][0] = accfrag(a, 0); fPT[ct][1] = accfrag(a, 1);
        f32x16 b = MFMA32(Akf0, fVT[ct][0], zero16); b = MFMA32(Akf1, fVT[ct][1], b);
        const bf16x8 av0 = accfrag(b, 0), av1 = accfrag(b, 1);
        f32x16 c = MFMA32(Tf0, av0, zero16); c = MFMA32(Tf1, av1, c); fQT[ct][0] = accfrag(c, 0); fQT[ct][1] = accfrag(c, 1);
    }
    bf16* RPo = (bf16*)(ws + WS_SRP) + (size_t)item * 2048; bf16* YLo = (bf16*)(ws + WS_SYL) + (size_t)item * 2048;
    bf16* Mo = (bf16*)(ws + WS_SM) + (size_t)item * 4096; bf16* NTo = (bf16*)(ws + WS_SNT) + (size_t)item * 4096;
#pragma unroll
    for (int ct = 0; ct < 2; ++ct) {
        f32x16 a;
#pragma unroll
        for (int g = 0; g < 8; ++g) { a[2 * g] = bflo(rin[ct][g]); a[2 * g + 1] = bfhi(rin[ct][g]); }
        a = MFMA32(fPT[ct][0], Abf0, a); a = MFMA32(fPT[ct][1], Abf1, a);
#pragma unroll
        for (int s2 = 0; s2 < 2; ++s2) *(bf16x8*)(RPo + p * 64 + (4 * ct + 2 * s2 + h) * 8) = accfrag(a, s2);
        f32x16 y = MFMA32(Abf0, fQT[ct][0], zero16); y = MFMA32(Abf1, fQT[ct][1], y); y = MFMA32(Arf0, fVT[ct][0], y); y = MFMA32(Arf1, fVT[ct][1], y);
#pragma unroll
        for (int s2 = 0; s2 < 2; ++s2) *(bf16x8*)(YLo + (32 * ct + p) * 32 + (2 * s2 + h) * 8) = accfrag(y, s2);
    }
#pragma unroll
    for (int ctp = 0; ctp < 2; ++ctp) {
        const float gl = gC[32 * ctp + p];
#pragma unroll
        for (int ct = 0; ct < 2; ++ct) {
            f32x16 m = MFMA32(fPT[ct][0], fBT[ctp][0], zero16); m = MFMA32(fPT[ct][1], fBT[ctp][1], m);
#pragma unroll
            for (int r = 0; r < 16; ++r) m[r] = (m[r] + ((ct == ctp && qrow(r, h) == p) ? 1.f : 0.f)) * gl;
#pragma unroll
            for (int s2 = 0; s2 < 2; ++s2) *(bf16x8*)(Mo + (32 * ctp + p) * 64 + (4 * ct + 2 * s2 + h) * 8) = accfrag(m, s2);
        }
    }
#pragma unroll
    for (int ctd = 0; ctd < 2; ++ctd)
#pragma unroll
        for (int ctp = 0; ctp < 2; ++ctp) {
            f32x16 n = MFMA32(fBT[ctp][0], fQT[ctd][0], zero16); n = MFMA32(fBT[ctp][1], fQT[ctd][1], n); n = MFMA32(fKT[ctp][0], fVT[ctd][0], n); n = MFMA32(fKT[ctp][1], fVT[ctd][1], n);
#pragma unroll
            for (int r = 0; r < 16; ++r) n[r] *= gC[32 * ctp + qrow(r, h)];
#pragma unroll
            for (int s2 = 0; s2 < 2; ++s2) *(bf16x8*)(NTo + (32 * ctd + p) * 64 + (4 * ctp + 2 * s2 + h) * 8) = accfrag(n, s2);
        }
}

__device__ __forceinline__ void ph_scan_local(unsigned char* ws, LAS unsigned char* lds, int gw, int NGW, int wave, int lane) {
    LAS unsigned char* L = lds + RING_OFF + wave * 16384;
    LAS float* gC = (LAS float*)(lds + LDSCTL_OFF + 4096) + wave * 64;
    for (int item = gw; item < BATCH * NCHK * NH; item += NGW) scan_local_item(ws, item, L, gC, lane);
}

__device__ __forceinline__ f32x16 ld_acc_bf16(const bf16* p0, const bf16* p1) {
    const v4u a = *(const v4u*)p0, b = *(const v4u*)p1; f32x16 r;
    r[0] = bflo(a.x); r[1] = bfhi(a.x); r[2] = bflo(a.y); r[3] = bfhi(a.y); r[4] = bflo(a.z); r[5] = bfhi(a.z); r[6] = bflo(a.w); r[7] = bfhi(a.w);
    r[8] = bflo(b.x); r[9] = bfhi(b.x); r[10] = bflo(b.y); r[11] = bfhi(b.y); r[12] = bflo(b.z); r[13] = bfhi(b.z); r[14] = bflo(b.w); r[15] = bfhi(b.w); return r;
}
constexpr size_t WS_SS = WS_LW;
__device__ __forceinline__ void scan_carry(unsigned char* ws, int bh, int ctd, int lane) {
    const int b = bh / NH, hh = bh % NH; const int p = lane & 31, h = lane >> 5;
    const bf16* Mb = (const bf16*)(ws + WS_SM); const bf16* NTb = (const bf16*)(ws + WS_SNT); bf16* Sg = (bf16*)(ws + WS_SS);
    const f32x16 zero16 = {0.f, 0.f, 0.f, 0.f, 0.f, 0.f, 0.f, 0.f, 0.f, 0.f, 0.f, 0.f, 0.f, 0.f, 0.f, 0.f};
    f32x16 S[2] = {zero16, zero16};
    v4u m0[2][4], n0[2][2], m1[2][4], n1[2][2], m2[2][4], n2[2][2];
#define CARRY_LOAD(MQ, NQ, nn) do { const int nc_ = (nn) < NCHK ? (nn) : NCHK - 1; const size_t it_ = (size_t)(b * NCHK + nc_) * NH + hh; const bf16* Mi_ = Mb + it_ * 4096; const bf16* NTi_ = NTb + it_ * 4096 + ctd * 2048; \
      _Pragma("unroll") for (int ctp = 0; ctp < 2; ++ctp) _Pragma("unroll") for (int s4 = 0; s4 < 4; ++s4) MQ[ctp][s4] = *(const v4u*)(Mi_ + ((4 * ctp + s4) * 64 + (lane & 63)) * 8); \
      _Pragma("unroll") for (int ctp = 0; ctp < 2; ++ctp) _Pragma("unroll") for (int s2 = 0; s2 < 2; ++s2) NQ[ctp][s2] = *(const v4u*)(NTi_ + ((2 * ctp + s2) * 64 + (lane & 63)) * 8); } while (0)
#define CARRY_STEP(nn, MC, NC, MQ2, NQ2) do { \
      CARRY_LOAD(MQ2, NQ2, (nn) + 2); \
      bf16* Si_ = Sg + ((size_t)(b * NCHK + (nn)) * NH + hh) * 4096 + ctd * 2048; bf16x8 Sf[4]; \
      _Pragma("unroll") for (int s4 = 0; s4 < 4; ++s4) { Sf[s4] = accfrag(S[s4 >> 1], s4 & 1); *(bf16x8*)(Si_ + (s4 * 64 + (lane & 63)) * 8) = Sf[s4]; } \
      _Pragma("unroll") for (int ctp = 0; ctp < 2; ++ctp) { const v4u x = NC[ctp][0], y = NC[ctp][1]; f32x16 sn; \
          sn[0] = bflo(x.x); sn[1] = bfhi(x.x); sn[2] = bflo(x.y); sn[3] = bfhi(x.y); sn[4] = bflo(x.z); sn[5] = bfhi(x.z); sn[6] = bflo(x.w); sn[7] = bfhi(x.w); \
          sn[8] = bflo(y.x); sn[9] = bfhi(y.x); sn[10] = bflo(y.y); sn[11] = bfhi(y.y); sn[12] = bflo(y.z); sn[13] = bfhi(y.z); sn[14] = bflo(y.w); sn[15] = bfhi(y.w); \
          _Pragma("unroll") for (int s4 = 0; s4 < 4; ++s4) sn = MFMA32(__builtin_bit_cast(bf16x8, MC[ctp][s4]), Sf[s4], sn); \
          S[ctp] = sn; } } while (0)
    CARRY_LOAD(m0, n0, 0); CARRY_LOAD(m1, n1, 1);
    static_assert(NCHK % 3 == 2, "carry loop tail");
#pragma unroll 1
    for (int n = 0; n + 2 < NCHK; n += 3) { CARRY_STEP(n, m0, n0, m2, n2); CARRY_STEP(n + 1, m1, n1, m0, n0); CARRY_STEP(n + 2, m2, n2, m1, n1); }
    CARRY_STEP(NCHK - 2, m0, n0, m2, n2); CARRY_STEP(NCHK - 1, m1, n1, m0, n0);
#undef CARRY_LOAD
#undef CARRY_STEP
}
__device__ __forceinline__ void scan_out_item(const Args& a, unsigned char* ws, LAS unsigned char* ST, int l, int item, int lane) {
    const int hh = item % NH, bn = item / NH; const int p = lane & 31, h = lane >> 5;
    const bf16* Si = (const bf16*)(ws + WS_SS) + (size_t)item * 4096; const bf16* RPi = (const bf16*)(ws + WS_SRP) + (size_t)item * 2048; const bf16* YLi = (const bf16*)(ws + WS_SYL) + (size_t)item * 2048;
    const float* BONu = (const float*)(ws + WS_BON) + (size_t)bn * CHK * 8 + hh; bf16* mixu = (bf16*)(ws + WS_MIX) + (size_t)bn * CHK * D + hh * 64;
    const float* rvec = a.in[I_RVEC] + l * 7 * RW;
    bf16x8 rp[4], sf[2][4]; v4u yl[2][2], xv[2][2], xg[2][2]; float bon[16];
#pragma unroll
    for (int s4 = 0; s4 < 4; ++s4) rp[s4] = *(const bf16x8*)(RPi + (s4 * 64 + (lane & 63)) * 8);
#pragma unroll
    for (int ctd = 0; ctd < 2; ++ctd)
#pragma unroll
        for (int s4 = 0; s4 < 4; ++s4) sf[ctd][s4] = *(const bf16x8*)(Si + ((4 * ctd + s4) * 64 + (lane & 63)) * 8);
    { const v4u* XV = (const v4u*)(ws + WS_XV) + ((size_t)item * 4) * 64 + lane; const v4u* XG = (const v4u*)(ws + WS_G) + ((size_t)item * 4) * 64 + lane;
#pragma unroll
      for (int ctd = 0; ctd < 2; ++ctd)
#pragma unroll
          for (int hq = 0; hq < 2; ++hq) { yl[ctd][hq] = *(const v4u*)(YLi + ((2 * ctd + hq) * 64 + (lane & 63)) * 8); xv[ctd][hq] = XV[(ctd * 2 + hq) * 64]; xg[ctd][hq] = XG[(ctd * 2 + hq) * 64]; } }
#pragma unroll
    for (int r = 0; r < 16; ++r) bon[r] = BONu[qrow(r, h) * 8];
    float lng[2], lnb[2];
#pragma unroll
    for (int ctd = 0; ctd < 2; ++ctd) { lng[ctd] = rvec[5 * RW + hh * 64 + 32 * ctd + p]; lnb[ctd] = rvec[6 * RW + hh * 64 + 32 * ctd + p]; }
    f32x16 Y[2];
#define UNPK(DST, W0, W1) do { DST[0] = bflo(W0.x); DST[1] = bfhi(W0.x); DST[2] = bflo(W0.y); DST[3] = bfhi(W0.y); DST[4] = bflo(W0.z); DST[5] = bfhi(W0.z); DST[6] = bflo(W0.w); DST[7] = bfhi(W0.w); \
        DST[8] = bflo(W1.x); DST[9] = bfhi(W1.x); DST[10] = bflo(W1.y); DST[11] = bfhi(W1.y); DST[12] = bflo(W1.z); DST[13] = bfhi(W1.z); DST[14] = bflo(W1.w); DST[15] = bfhi(W1.w); } while (0)
#pragma unroll
    for (int ctd = 0; ctd < 2; ++ctd) { UNPK(Y[ctd], yl[ctd][0], yl[ctd][1]);
#pragma unroll
        for (int s4 = 0; s4 < 4; ++s4) Y[ctd] = MFMA32(rp[s4], sf[ctd][s4], Y[ctd]); }
    float vv[2][16], gg[2][16];
#pragma unroll
    for (int ctd = 0; ctd < 2; ++ctd) { UNPK(vv[ctd], xv[ctd][0], xv[ctd][1]); UNPK(gg[ctd], xg[ctd][0], xg[ctd][1]); }
#undef UNPK
#pragma unroll
    for (int r = 0; r < 16; ++r) {
        const float y0 = Y[0][r], y1 = Y[1][r];
        const float s1 = half_sum32(y0 + y1), s2 = half_sum32(y0 * y0 + y1 * y1);
        const float mean = s1 * (1.f / 64.f), var = fmaxf(s2 * (1.f / 64.f) - mean * mean, 0.f), rstd = 1.f / sqrtf(var + 64e-5f);
        const int i = qrow(r, h);
        st_put(ST, i, p, ((y0 - mean) * rstd * lng[0] + lnb[0] + bon[r] * vv[0][r]) * gg[0][r]);
        st_put(ST, i, 32 + p, ((y1 - mean) * rstd * lng[1] + lnb[1] + bon[r] * vv[1][r]) * gg[1][r]);
    }
    st_flush<64>(ST, mixu, D, lane, false);
}
__device__ __forceinline__ void ph_scan_out(const Args& a, unsigned char* ws, LAS unsigned char* lds, int l, int gw, int NGW, int wave, int lane_in) {
    LAS unsigned char* ST = lds + RING_OFF + wave * 8192;
    for (int item = gw; item < BATCH * NCHK * NH; item += NGW) { const int lane = fresh_lane(); scan_out_item(a, ws, ST, l, item, lane); }
}

constexpr size_t WS_VT = WS_BON + 1 * MiB;
static_assert(WS_VT + 16 * MiB <= 896 * MiB, "ws");
constexpr int AT_KB = 0, AT_VB = 16384, AT_STAGE = 24576;
__device__ __forceinline__ int atk_addr(int row, int chunk) { return row * 256 + ((chunk ^ (row & 15)) << 4); }

__device__ __forceinline__ const bf16* at_ksrc(const bf16* KM, int b, int hq, int kt, int c) { const int row = c / 12, ch = c % 12; return KM + (size_t)(b * T + kt * 64 + row) * 384 + hq * 96 + ch * 8; }
__device__ __forceinline__ const bf16* at_vsrc(const bf16* VTg, int b, int hq, int kt, int v) { return VTg + ((size_t)((b * 4 + hq) * 128 + 2 * kt + (v >> 8)) * 64 + ((v >> 2) & 63)) * 32 + (v & 3) * 8; }
__device__ __forceinline__ int at_kdst(int c) { const int row = c / 12, ch = c % 12; return AT_KB + atk_addr(row, ch); }
__device__ __forceinline__ int at_vdst(int v) { return AT_VB + (v >> 8) * 4096 + cm_addr((v >> 2) & 63, v & 3); }
__device__ __forceinline__ void attn_stage_load(const bf16* KM, const bf16* VTg, int b, int hq, int kt, int tid, v4u& rg0, v4u& rg1, v4u& rg2) {
    rg0 = *(const v4u*)at_ksrc(KM, b, hq, kt, tid);
    const bf16* sb = tid < 256 ? at_ksrc(KM, b, hq, kt, 512 + tid) : at_vsrc(VTg, b, hq, kt, tid - 256);
    rg1 = *(const v4u*)sb;
    if (tid < 256) rg2 = *(const v4u*)at_vsrc(VTg, b, hq, kt, 256 + tid);
}
__device__ __forceinline__ void attn_stage_store(LAS unsigned char* S, int tid, const v4u& rg0, const v4u& rg1, const v4u& rg2) {
    *(LAS v4u*)(S + at_kdst(tid)) = rg0;
    const int db = tid < 256 ? at_kdst(512 + tid) : at_vdst(tid - 256);
    *(LAS v4u*)(S + db) = rg1;
    if (tid < 256) *(LAS v4u*)(S + at_vdst(256 + tid)) = rg2;
}

__device__ __forceinline__ void ph_attn_mfma(unsigned char* ws, LAS unsigned char* lds, int bh, int qb, int tid, int wave, int lane) {
    const int b = bh >> 2, hq = bh & 3;
    const bf16* QM = (const bf16*)(ws + WS_QM); const bf16* KM = (const bf16*)(ws + WS_KM); const bf16* VTg = (const bf16*)(ws + WS_VT); bf16* mix = (bf16*)(ws + WS_MIX);
    LAS unsigned char* L = lds + RING_OFF;
    const int p = lane & 31, h = lane >> 5;
    const f32x16 zero16 = {0.f, 0.f, 0.f, 0.f, 0.f, 0.f, 0.f, 0.f, 0.f, 0.f, 0.f, 0.f, 0.f, 0.f, 0.f, 0.f};
    {
        const int q0 = qb * 256; const int ntile = 4 * (qb + 1);
        const int qrow_ = q0 + wave * 32 + p;
        const int qmax_w = q0 + wave * 32 + 31, qmin_w = q0 + wave * 32;
        bf16x8 qf[6];
#pragma unroll
        for (int s = 0; s < 6; ++s) qf[s] = *(const bf16x8*)(QM + (size_t)(b * T + qrow_) * 384 + hq * 96 + 16 * s + 8 * h);
        f32x16 O[2] = {zero16, zero16}; float mrun = -1.0e30f, lrun = 0.f;
        v4u rg0, rg1, rg2 = (v4u){0u, 0u, 0u, 0u};
        __syncthreads();
        attn_stage_load(KM, VTg, b, hq, 0, tid, rg0, rg1, rg2); attn_stage_store(L, tid, rg0, rg1, rg2);
        __syncthreads();
#pragma unroll 1
        for (int kt = 0; kt < ntile; ++kt) {
            LAS unsigned char* S = L + (kt & 1) * AT_STAGE;
            if (kt + 1 < ntile) attn_stage_load(KM, VTg, b, hq, kt + 1, tid, rg0, rg1, rg2);
            if (kt * 64 <= qmax_w) {
                f32x16 s0 = zero16, s1 = zero16;
#pragma unroll
                for (int s = 0; s < 6; ++s) {
                    const bf16x8 k0 = *(const LAS bf16x8*)(S + AT_KB + atk_addr(p, 2 * s + h)), k1 = *(const LAS bf16x8*)(S + AT_KB + atk_addr(32 + p, 2 * s + h));
                    s0 = MFMA32(k0, qf[s], s0); s1 = MFMA32(k1, qf[s], s1);
                }
                if (kt * 64 + 63 > qmin_w) {
#pragma unroll
                    for (int r = 0; r < 16; ++r) { const int kv = kt * 64 + qrow(r, h); if (kv > qrow_) s0[r] = -1.0e30f; if (kv + 32 > qrow_) s1[r] = -1.0e30f; }
                }
                float rm = fmaxf(s0[0], s1[0]);
#pragma unroll
                for (int r = 1; r < 16; ++r) rm = fmaxf(rm, fmaxf(s0[r], s1[r]));
                { const unsigned u_ = __float_as_uint(rm); auto rr_ = __builtin_amdgcn_permlane32_swap(u_, u_, false, false); rm = fmaxf(__uint_as_float(rr_[0]), __uint_as_float(rr_[1])); }
                const float mnew = fmaxf(mrun, rm); const float alpha = __builtin_amdgcn_exp2f(mrun - mnew); mrun = mnew;
                float ls = 0.f;
#pragma unroll
                for (int r = 0; r < 16; ++r) { s0[r] = __builtin_amdgcn_exp2f(s0[r] - mnew); s1[r] = __builtin_amdgcn_exp2f(s1[r] - mnew); ls += s0[r] + s1[r]; }
                lrun = lrun * alpha + ls;
#pragma unroll
                for (int r = 0; r < 16; ++r) { O[0][r] *= alpha; O[1][r] *= alpha; }
                const bf16x8 p00 = accfrag(s0, 0), p01 = accfrag(s0, 1), p10 = accfrag(s1, 0), p11 = accfrag(s1, 1);
#pragma unroll
                for (int dvt = 0; dvt < 2; ++dvt) {
                    const bf16x8 v00 = *(const LAS bf16x8*)(S + AT_VB + cm_addr(32 * dvt + p, h)), v01 = *(const LAS bf16x8*)(S + AT_VB + cm_addr(32 * dvt + p, 2 + h));
                    const bf16x8 v10 = *(const LAS bf16x8*)(S + AT_VB + 4096 + cm_addr(32 * dvt + p, h)), v11 = *(const LAS bf16x8*)(S + AT_VB + 4096 + cm_addr(32 * dvt + p, 2 + h));
                    O[dvt] = MFMA32(v00, p00, O[dvt]); O[dvt] = MFMA32(v01, p01, O[dvt]); O[dvt] = MFMA32(v10, p10, O[dvt]); O[dvt] = MFMA32(v11, p11, O[dvt]);
                }
            }
            if (kt + 1 < ntile) attn_stage_store(L + ((kt + 1) & 1) * AT_STAGE, tid, rg0, rg1, rg2);
            __syncthreads();
        }
        float ltot; { const unsigned u_ = __float_as_uint(lrun); auto rr_ = __builtin_amdgcn_permlane32_swap(u_, u_, false, false); ltot = __uint_as_float(rr_[0]) + __uint_as_float(rr_[1]); } const float il = 1.f / ltot;
        bf16* orow = mix + (size_t)(b * T + qrow_) * D + 768 + hq * 64;
#pragma unroll
        for (int dvt = 0; dvt < 2; ++dvt)
#pragma unroll
            for (int g = 0; g < 4; ++g) { v2u w; w.x = cvtpk(O[dvt][4 * g] * il, O[dvt][4 * g + 1] * il); w.y = cvtpk(O[dvt][4 * g + 2] * il, O[dvt][4 * g + 3] * il);
                *(v2u*)(orow + 32 * dvt + 8 * g + 4 * h) = w; }
    }
}

constexpr int AT2_KSLOT = 12288, AT2_VSLOT = 8192, AT2_K = 0, AT2_V = 4 * AT2_KSLOT;
__device__ __forceinline__ void glds16(const void* g, unsigned lds_base) {
    unsigned sv; asm volatile("s_mov_b32 %0, m0\n\ts_mov_b32 m0, %2\n\ts_nop 0\n\tglobal_load_lds_dwordx4 %1, off\n\ts_mov_b32 m0, %0" : "=&s"(sv) : "v"(g), "s"(lds_base) : "memory"); }
#define AT_SBAR() __builtin_amdgcn_sched_barrier(0)
#define AT_PIN(x) asm volatile("" : "+v"(x))
#define AT_WB(N) asm volatile("s_waitcnt vmcnt(" #N ") lgkmcnt(0)\n\ts_barrier" ::: "memory")
#define AT_MX3(a, b, c) __builtin_fmaxf(__builtin_fmaxf((a), (b)), (c))
__device__ __forceinline__ float at_rowmax(const f32x16& p0, const f32x16& p1) {
    float a = AT_MX3(p0[0], p0[1], p1[0]), b = AT_MX3(p0[2], p0[3], p1[1]); a = AT_MX3(a, p1[2], p1[3]);
#pragma unroll
    for (int r = 4; r < 16; r += 4) { a = AT_MX3(a, p0[r], p0[r + 1]); b = AT_MX3(b, p0[r + 2], p0[r + 3]); a = AT_MX3(a, p1[r], p1[r + 1]); b = AT_MX3(b, p1[r + 2], p1[r + 3]); }
    const float m = __builtin_fmaxf(a, b); auto rr = __builtin_amdgcn_permlane32_swap(__float_as_uint(m), __float_as_uint(m), false, false);
    return __builtin_fmaxf(__uint_as_float(rr[0]), __uint_as_float(rr[1])); }
__device__ __forceinline__ void at_cmask(f32x16& p0, f32x16& p1, int jb, int qrel, int h) {
    int d = qrel - (64 * jb + 4 * h); asm volatile("" : "+v"(d));
#pragma unroll
    for (int r = 0; r < 16; ++r) { const int c = (r & 3) + 8 * (r >> 2); if (c > d) p0[r] = -INFINITY; if (c + 32 > d) p1[r] = -INFINITY; } }
__device__ __forceinline__ void at_kload2(bf16x8* kf, const LAS unsigned char* kp, int s) { kf[2 * s] = *(const LAS bf16x8*)(kp + s * 2048); kf[2 * s + 1] = *(const LAS bf16x8*)(kp + s * 2048 + 512); }
#ifndef ATTN_THR
#define ATTN_THR 8
#endif

__device__ __forceinline__ void ph_attn_pipe(unsigned char* ws, LAS unsigned char* lds, int bh, int qb, int wave, int lane) {
    const int b = bh >> 2, hq = bh & 3;
    const bf16* QM = (const bf16*)(ws + WS_QM); const bf16* KM = (const bf16*)(ws + WS_KM); const bf16* VTg = (const bf16*)(ws + WS_VT); bf16* mix = (bf16*)(ws + WS_MIX);
    LAS unsigned char* L = lds + RING_OFF;
    const int p = lane & 31, h = lane >> 5;
    const int q0 = qb * 256, NT = 4 * (qb + 1);
    const int qrel = wave * 32 + p; const bool wlo = wave < 4;
    const bf16* ksrc = KM + (size_t)((b * 4 + hq) * 64) * 6144 + wave * 512 + (lane & 63) * 8;
    const int vrow = (wave & 3) * 16 + (lane >> 2);
    const bf16* vsrc = VTg + (size_t)((b * 4 + hq) * 128 + (wave >> 2)) * 2048 + ((((vrow >> 5) * 4 + ((lane & 3) ^ ((vrow >> 2) & 3))) * 32 + (vrow & 31)) * 8);
    const unsigned lds0 = (unsigned)(size_t)L;
    const unsigned kdst = lds0 + AT2_K + wave * 1024, vdst = lds0 + AT2_V + wave * 1024;
#define RFL(x) ((unsigned)__builtin_amdgcn_readfirstlane((int)(x)))
#define DMA_K(t, slot) do { glds16(ksrc + (size_t)(t) * 6144, RFL(kdst + (slot) * AT2_KSLOT)); if (wlo) glds16(ksrc + (size_t)(t) * 6144 + 4096, RFL(kdst + (slot) * AT2_KSLOT + 8192)); } while (0)
#define DMA_V(t, slot) glds16(vsrc + (size_t)(t) * 4096, RFL(vdst + (slot) * AT2_VSLOT))
    const int vx = (h ^ ((p >> 2) & 3));
    const LAS unsigned char* vpA = L + AT2_V + p * 64 + (vx << 4);
    const LAS unsigned char* vpB = L + AT2_V + p * 64 + ((vx ^ 2) << 4);
    const LAS unsigned char* kp0 = L + AT2_K + h * 1024 + p * 16;
    DMA_K(0, 0); DMA_V(0, 0); DMA_K(1, 1); DMA_K(2, 2); DMA_K(3, 3); DMA_V(1, 1);
    bf16x8 qf[6];
    { const bf16* Qw = QM + (size_t)(b * T + q0 + qrel) * 384 + hq * 96 + 8 * h;
#pragma unroll
      for (int s = 0; s < 6; ++s) qf[s] = *(const bf16x8*)(Qw + 16 * s); }
    float mhat = 0.f, l_reg = 0.f, fres = 1.f; f32x16 o0, o1;
    const f32x16 zero16 = {0.f, 0.f, 0.f, 0.f, 0.f, 0.f, 0.f, 0.f, 0.f, 0.f, 0.f, 0.f, 0.f, 0.f, 0.f, 0.f};
    o0 = zero16; o1 = zero16; bool resc = false;
    f32x16 pA0, pA1, pB0, pB1; bf16x8 kf[12], vf[8]; v4u pw0, pw1, pw2, pw3;
    int sl_prev = 0, sl_cur = 0, sl_next = 1;
#define ROT() do { sl_prev = sl_cur; sl_cur = sl_next; sl_next = (sl_next + 1) & 3; } while (0)
#define EX(v) __builtin_amdgcn_exp2f((v) + nmh)
#define RESC() do { if (resc) { _Pragma("unroll") for (int r = 0; r < 16; ++r) { o0[r] *= fres; o1[r] *= fres; } } } while (0)
    AT_WB(0);
#pragma unroll
    for (int s = 0; s < 6; ++s) at_kload2(kf, kp0, s);
    pA0 = MFMA32(kf[0], qf[0], zero16); pA1 = MFMA32(kf[1], qf[0], zero16);
#pragma unroll
    for (int s = 1; s < 6; ++s) { pA0 = MFMA32(kf[2 * s], qf[s], pA0); pA1 = MFMA32(kf[2 * s + 1], qf[s], pA1); }
    if (NT == 4) at_cmask(pA0, pA1, 0, qrel, h);
    { mhat = at_rowmax(pA0, pA1); const float nmh = -mhat;
#pragma unroll
      for (int r = 0; r < 16; ++r) { pA0[r] = EX(pA0[r]); pA1[r] = EX(pA1[r]); } }
    AT_WB(0);
    if (4 < NT) DMA_K(4, 0); DMA_V(2, 2); ROT();
#pragma unroll
    for (int s = 0; s < 6; ++s) at_kload2(kf, kp0 + sl_cur * AT2_KSLOT, s);
    if (4 < NT) { if (wlo) { AT_WB(3); } else { AT_WB(2); } } else { AT_WB(1); }
#define PKW(P, i) cvtpk(P[i], P[i + 1])
#define PAF(k) __builtin_bit_cast(bf16x8, pw##k)
#define VOFF(j) ((((j) >> 1) >> 1) * 4096 + ((j) & 1) * 2048)
#define VRD(j) do { vf[j] = *(const LAS bf16x8*)(((((j) >> 1) & 1) ? vpB_ : vpA_) + VOFF(j)); } while (0)
#define KRD(G, s) do { if (G) { at_kload2(kf, kp0 + sl_next * AT2_KSLOT, s); AT_SBAR(); } } while (0)
#define GAPA3(MF, a0, a1, a2, W0, W1, PW) do { MF; sacc += a0; sacc += a1; sacc += a2; W0; W1; AT_PIN(PW); AT_PIN(sacc); AT_SBAR(); } while (0)
#define GAPB(MF, X, i) do { MF; { typedef float f2_ __attribute__((ext_vector_type(2))); f2_ ta_, tb_; asm("v_pk_add_f32 %0, %1, %2" : "=v"(ta_) : "v"(__builtin_shufflevector(X, X, i, i + 1)), "v"(nm2)); asm("v_pk_add_f32 %0, %1, %2" : "=v"(tb_) : "v"(__builtin_shufflevector(X, X, i + 2, i + 3)), "v"(nm2));        \
        X[i] = __builtin_amdgcn_exp2f(ta_.x); X[i + 1] = __builtin_amdgcn_exp2f(ta_.y); X[i + 2] = __builtin_amdgcn_exp2f(tb_.x); X[i + 3] = __builtin_amdgcn_exp2f(tb_.y); } AT_PIN(X); AT_SBAR(); } while (0)
#define WAIT2() do { if (wlo) { AT_WB(6); } else { AT_WB(4); } } while (0)
#define WAITN(GK, GV) do { if (GK) { if (GV) { if (wlo) { AT_WB(3); } else { AT_WB(2); } } else { if (wlo) { AT_WB(2); } else { AT_WB(1); } } } else { if (GV) { AT_WB(1); } else { AT_WB(0); } } } while (0)
#define STEP(C0, C1, P0, P1, t, MASK, GK, GV, GL) do { AT_SBAR(); \
    const LAS unsigned char* vpA_ = vpA + sl_prev * AT2_VSLOT; const LAS unsigned char* vpB_ = vpB + sl_prev * AT2_VSLOT; \
    float sacc = P0[0] + P0[1]; \
    VRD(0); AT_SBAR(); GAPA3(C0 = MFMA32(kf[0], qf[0], zero16), P0[2], P0[3], P0[4],    pw0[0] = PKW(P0, 0),  pw0[1] = PKW(P0, 2),  pw0); \
    VRD(1); AT_SBAR(); GAPA3(C1 = MFMA32(kf[1], qf[0], zero16), P0[5], P0[6], P0[7],    pw0[2] = PKW(P0, 4),  pw0[3] = PKW(P0, 6),  pw0); \
    VRD(2); AT_SBAR(); GAPA3(C0 = MFMA32(kf[2], qf[1], C0),     P0[8], P0[9], P0[10],   pw1[0] = PKW(P0, 8),  (void)0,              pw1); \
    VRD(3); AT_SBAR(); GAPA3(C1 = MFMA32(kf[3], qf[1], C1),     P0[11], P0[12], P0[13], pw1[1] = PKW(P0, 10), pw1[2] = PKW(P0, 12), pw1); \
    VRD(4); AT_SBAR(); GAPA3(C0 = MFMA32(kf[4], qf[2], C0),     P0[14], P0[15], P1[0],  pw1[3] = PKW(P0, 14), (void)0,              pw1); \
    VRD(5); AT_SBAR(); GAPA3(C1 = MFMA32(kf[5], qf[2], C1),     P1[1], P1[2], P1[3],    pw2[0] = PKW(P1, 0),  pw2[1] = PKW(P1, 2),  pw2); \
    VRD(6); AT_SBAR(); GAPA3(C0 = MFMA32(kf[6], qf[3], C0),     P1[4], P1[5], P1[6],    pw2[2] = PKW(P1, 4),  (void)0,              pw2); \
    VRD(7); AT_SBAR(); GAPA3(C1 = MFMA32(kf[7], qf[3], C1),     P1[7], P1[8], P1[9],    pw2[3] = PKW(P1, 6),  pw3[0] = PKW(P1, 8),  pw3); \
                       GAPA3(C0 = MFMA32(kf[8], qf[4], C0),     P1[10], P1[11], P1[12], pw3[1] = PKW(P1, 10), (void)0,              pw3); \
                       GAPA3(C1 = MFMA32(kf[9], qf[4], C1),     P1[13], P1[14], P1[15], pw3[2] = PKW(P1, 12), pw3[3] = PKW(P1, 14), pw3); \
    C0 = MFMA32(kf[10], qf[5], C0); C1 = MFMA32(kf[11], qf[5], C1); AT_SBAR(); \
    l_reg += sacc; \
    if (GK) DMA_K((t) + 4, sl_cur); if (GV) DMA_V((t) + 2, (sl_next + 1) & 3); \
    if (MASK) at_cmask(C0, C1, (t) - (NT - 4), qrel, h); \
    { const float rm = at_rowmax(C0, C1) - mhat; resc = false; \
      if (__builtin_expect(__any(rm > (float)ATTN_THR), 0)) { const float dl = __builtin_fmaxf(rm, 0.f); mhat += dl; fres = __builtin_amdgcn_exp2f(-dl); l_reg *= fres; resc = true; } } \
    const float nmh = -mhat; typedef float f2n_ __attribute__((ext_vector_type(2))); const f2n_ nm2 = {nmh, nmh}; AT_SBAR(); \
    GAPB(o0 = MFMA32(vf[0], PAF(0), o0), C0, 0);               GAPB(o1 = MFMA32(vf[1], PAF(0), o1), C0, 4); \
    KRD(GL, 0); GAPB(o0 = MFMA32(vf[2], PAF(1), o0), C0, 8);   KRD(GL, 1); GAPB(o1 = MFMA32(vf[3], PAF(1), o1), C0, 12); \
    KRD(GL, 2); GAPB(o0 = MFMA32(vf[4], PAF(2), o0), C1, 0);   KRD(GL, 3); GAPB(o1 = MFMA32(vf[5], PAF(2), o1), C1, 4); \
    KRD(GL, 4); GAPB(o0 = MFMA32(vf[6], PAF(3), o0), C1, 8);   KRD(GL, 5); GAPB(o1 = MFMA32(vf[7], PAF(3), o1), C1, 12); \
    } while (0)
    int t = 1;
    for (; t + 5 < NT; t += 2) {
        STEP(pB0, pB1, pA0, pA1, t, false, true, true, true);     WAIT2(); RESC(); ROT();
        STEP(pA0, pA1, pB0, pB1, t + 1, false, true, true, true); WAIT2(); RESC(); ROT();
    }
#define ENDW(tt) do { if ((tt) + 4 < NT) { WAITN(true, true); } else if ((tt) + 2 < NT) { WAITN(false, true); } else { WAITN(false, false); } } while (0)
    for (; t + 1 < NT; t += 2) {
        STEP(pB0, pB1, pA0, pA1, t, true, (t + 4 < NT), (t + 2 < NT), (t + 1 < NT));         ENDW(t);     RESC(); ROT();
        STEP(pA0, pA1, pB0, pB1, t + 1, true, (t + 5 < NT), (t + 3 < NT), (t + 2 < NT));     ENDW(t + 1); RESC(); ROT();
    }
    STEP(pB0, pB1, pA0, pA1, NT - 1, true, false, false, false); RESC();
    { float sacc = pB0[0] + pB0[1];
#pragma unroll
      for (int r = 2; r < 16; ++r) sacc += pB0[r];
#pragma unroll
      for (int r = 0; r < 16; ++r) sacc += pB1[r];
      l_reg += sacc;
      pw0 = (v4u){PKW(pB0, 0), PKW(pB0, 2), PKW(pB0, 4), PKW(pB0, 6)}; pw1 = (v4u){PKW(pB0, 8), PKW(pB0, 10), PKW(pB0, 12), PKW(pB0, 14)};
      pw2 = (v4u){PKW(pB1, 0), PKW(pB1, 2), PKW(pB1, 4), PKW(pB1, 6)}; pw3 = (v4u){PKW(pB1, 8), PKW(pB1, 10), PKW(pB1, 12), PKW(pB1, 14)};
      const LAS unsigned char* vpA_ = vpA + sl_cur * AT2_VSLOT; const LAS unsigned char* vpB_ = vpB + sl_cur * AT2_VSLOT;
      VRD(0); VRD(1); VRD(2); VRD(3); VRD(4); VRD(5); VRD(6); VRD(7);
      o0 = MFMA32(vf[0], PAF(0), o0); o1 = MFMA32(vf[1], PAF(0), o1); o0 = MFMA32(vf[2], PAF(1), o0); o1 = MFMA32(vf[3], PAF(1), o1);
      o0 = MFMA32(vf[4], PAF(2), o0); o1 = MFMA32(vf[5], PAF(2), o1); o0 = MFMA32(vf[6], PAF(3), o0); o1 = MFMA32(vf[7], PAF(3), o1); }
    float ltot; { const unsigned u_ = __float_as_uint(l_reg); auto rr_ = __builtin_amdgcn_permlane32_swap(u_, u_, false, false); ltot = __uint_as_float(rr_[0]) + __uint_as_float(rr_[1]); }
    const float il = __builtin_amdgcn_rcpf(ltot);
    bf16* orow = mix + (size_t)(b * T + q0 + qrel) * D + 768 + hq * 64;
#pragma unroll
    for (int g = 0; g < 4; ++g) { v2u w; w.x = cvtpk(o0[4 * g] * il, o0[4 * g + 1] * il); w.y = cvtpk(o0[4 * g + 2] * il, o0[4 * g + 3] * il); *(v2u*)(orow + 8 * g + 4 * h) = w; }
#pragma unroll
    for (int g = 0; g < 4; ++g) { v2u w; w.x = cvtpk(o1[4 * g] * il, o1[4 * g + 1] * il); w.y = cvtpk(o1[4 * g + 2] * il, o1[4 * g + 3] * il); *(v2u*)(orow + 32 + 8 * g + 4 * h) = w; }
#undef RFL
#undef DMA_K
#undef DMA_V
#undef ROT
#undef EX
#undef RESC
#undef PKW
#undef PAF
#undef VOFF
#undef VRD
#undef KRD
#undef GAPA3
#undef GAPB
#undef WAITN
#undef WAIT2
#undef STEP
#undef ENDW
}

constexpr size_t WS_XA = WS_R;
constexpr size_t WS_XL = WS_LW;
constexpr size_t WS_SMALLW = 6 * MiB;
constexpr int O_W2T = 0, O_A2T = 32768, O_G2T = 65536, O_V2T = 147456, O_POOLT = 163840, O_WQT = 180224, O_WKVT = 278528, LAYER_SMALLW = 344064;
constexpr int PZ_XW = 0, PZ_XA = 4096, PZ_XG = 8192  , PZ_XV = 18432  , PZ_PP = 20480  , PZ_QN = 36864  , PZ_KVN = 53248  , PZ_END = 61440;
template <int PITCH> __device__ __forceinline__ int pz_addr(int row, int chunk) {
    if constexpr (PITCH == 128) return row * 128 + ((chunk ^ ((row >> 1) & 7)) << 4);
    else if constexpr (PITCH == 64 || PITCH == 320) return row * PITCH + ((chunk ^ ((row >> 2) & 3)) << 4);
    else return row * PITCH + ((chunk ^ (row & 15)) << 4);
}
template <int PITCH> __device__ __forceinline__ void pz_put(LAS unsigned char* tile, int row, int k, float v) { *(LAS bf16*)(tile + pz_addr<PITCH>(row, k >> 3) + (k & 7) * 2) = (bf16)f2bf(v); }

__device__ __forceinline__ unsigned wfrag_off(int n, int k8, int K) { return (unsigned)(((((n >> 5) * (K >> 4) + (k8 >> 1)) * 2 + (k8 & 1)) * 32 + (n & 31)) * 8); }
__device__ __forceinline__ void small_transpose(const float* src, int K, int N, bf16* dst, int gtid, int GT) {
    const int k8n = K / 8;
    for (int it = gtid; it < N * k8n; it += GT) { const int n = it / k8n, k0 = (it % k8n) * 8;
        v4u o; o.x = pk2(src[(size_t)(k0 + 0) * N + n], src[(size_t)(k0 + 1) * N + n]); o.y = pk2(src[(size_t)(k0 + 2) * N + n], src[(size_t)(k0 + 3) * N + n]);
        o.z = pk2(src[(size_t)(k0 + 4) * N + n], src[(size_t)(k0 + 5) * N + n]); o.w = pk2(src[(size_t)(k0 + 6) * N + n], src[(size_t)(k0 + 7) * N + n]);
        *(v4u*)(dst + wfrag_off(n, k0 >> 3, K)) = o; }
}
__device__ __forceinline__ void ph_small_weights(const Args& a, unsigned char* ws, int gtid, int GT) {
    for (int l = 0; l < 2; ++l) {
        bf16* base = (bf16*)(ws + WS_SMALLW) + (size_t)l * LAYER_SMALLW;
        small_transpose(a.in[I_RW2] + (size_t)l * 64 * RW, 64, RW, base + O_W2T, gtid, GT);
        small_transpose(a.in[I_RA2] + (size_t)l * 64 * RW, 64, RW, base + O_A2T, gtid, GT);
        small_transpose(a.in[I_RG2] + (size_t)l * 160 * RW, 160, RW, base + O_G2T, gtid, GT);
        if (l == 1) small_transpose(a.in[I_RV2], 32, RW, base + O_V2T, gtid, GT);
        for (int g = 0; g < 4; ++g) small_transpose(a.in[I_POOLW] + (size_t)(l * 4 + g) * 4096, 64, 64, base + O_POOLT + g * 4096, gtid, GT);
        small_transpose(a.in[I_WQUP] + (size_t)l * 256 * 384, 256, 384, base + O_WQT, gtid, GT);
        small_transpose(a.in[I_WKVUP] + (size_t)l * 128 * 512, 128, 512, base + O_WKVT, gtid, GT);
    }
}

template <int PITCH, int KSTEPS, int NTILES, int KG = 2>
__device__ __forceinline__ void pz_gemm(f32x16 (&acc)[NTILES], const LAS unsigned char* X, const bf16* WT, int K, int n0, int p, int h, int kc0 = 0) {
    constexpr int NG = KSTEPS / KG;
    static_assert(KSTEPS % KG == 0, "k-steps");
    bf16x8 wb[2][KG][NTILES];
#pragma unroll
    for (int q = 0; q < KG; ++q)
#pragma unroll
        for (int jt = 0; jt < NTILES; ++jt) wb[0][q][jt] = *(const bf16x8*)(WT + wfrag_off(n0 + 32 * jt + (p & 31), 2 * q + (h & 1), K));
#pragma unroll
    for (int g = 0; g < NG; ++g) {
        if (g + 1 < NG) {
#pragma unroll
            for (int q = 0; q < KG; ++q)
#pragma unroll
                for (int jt = 0; jt < NTILES; ++jt) wb[(g + 1) & 1][q][jt] = *(const bf16x8*)(WT + wfrag_off(n0 + 32 * jt + (p & 31), 2 * ((g + 1) * KG + q) + (h & 1), K));
        }
#pragma unroll
        for (int q = 0; q < KG; ++q) {
            const bf16x8 xa = *(const LAS bf16x8*)(X + pz_addr<PITCH>(p, kc0 + 2 * (g * KG + q) + h));
#pragma unroll
            for (int jt = 0; jt < NTILES; ++jt) acc[jt] = MFMA32(xa, wb[g & 1][q][jt], acc[jt]);
        }
        asm volatile("" ::: "memory");
    }
}


template <int WIN>
__device__ __forceinline__ void pool_wave(const bf16* zc, int tt0, int i0, LAS unsigned char* PP, int gi, int lane) {
    float u[16 + WIN - 1];
    bf16 raw[16 + WIN - 1];
#pragma unroll
    for (int k = 0; k < 16 + WIN - 1; ++k) { const int off = i0 + k - (WIN - 1); const int offc = (tt0 + off >= 0) ? off : -tt0; raw[k] = zc[(ptrdiff_t)offc * NZ]; }
    __builtin_amdgcn_sched_barrier(0);
#pragma unroll
    for (int k = 0; k < 16 + WIN - 1; ++k) { const int off = i0 + k - (WIN - 1); u[k] = (tt0 + off >= 0) ? bf2f(raw[k]) : 0.f; }
    float s = 0.f;
#pragma unroll
    for (int k = 0; k < WIN - 1; ++k) s += u[k];
#pragma unroll
    for (int j = 0; j < 16; ++j) { s += u[WIN - 1 + j]; const int tt = tt0 + i0 + j; const int cnt = (tt + 1) < WIN ? (tt + 1) : WIN;
        pz_put<512>(PP, i0 + j, gi * 64 + lane, s * rcp_((float)cnt) - u[WIN - 1 + j]); s -= u[j]; }
}

__device__ __forceinline__ void pool_wave_all(const bf16* zc, int tt0, int i0, LAS unsigned char* PP, int gi, int lane) {
    float u[31], w[31];
    bf16 raw[31];
#pragma unroll
    for (int k = 0; k < 31; ++k) { const int off = i0 + k - 15; const int offc = (tt0 + off >= 0) ? off : -tt0; raw[k] = zc[(ptrdiff_t)offc * NZ]; }
    __builtin_amdgcn_sched_barrier(0);
#pragma unroll
    for (int k = 0; k < 31; ++k) { const int off = i0 + k - 15; u[k] = (tt0 + off >= 0) ? bf2f(raw[k]) : 0.f; w[k] = u[k]; }
#pragma unroll
    for (int k = 30; k >= 1; --k) w[k] += w[k - 1];
    if (gi >= 1) {
#pragma unroll
        for (int k = 30; k >= 3; --k) w[k] += w[k - 2]; }
    if (gi >= 2) {
#pragma unroll
        for (int k = 30; k >= 7; --k) w[k] += w[k - 4]; }
    if (gi >= 3) {
#pragma unroll
        for (int k = 30; k >= 15; --k) w[k] += w[k - 8]; }
    const int win = 2 << gi;
#pragma unroll
    for (int j = 0; j < 16; ++j) { const int tt = tt0 + i0 + j; const int cnt = (tt + 1) < win ? (tt + 1) : win;
        pz_put<512>(PP, i0 + j, gi * 64 + lane, w[15 + j] * rcp_((float)cnt) - u[15 + j]); }
}

#ifndef PZ_ABL
#define PZ_ABL 0
#endif
#ifndef PZ_PART
#define PZ_PART 7
#endif
template <int l>
__device__ __forceinline__ void ph_postz_mfma(const Args& a, unsigned char* ws, LAS unsigned char* lds, int G, int tid, int wave, int lane_in, bool dry) {
    LAS unsigned char* L = lds + RING_OFF;
    const bf16* z = (const bf16*)(ws + WS_Z);
    const float* mu = a.in[I_MU] + l * SHIFT_COLS; const float* muv = a.in[I_MUV];
    const float* rvec = a.in[I_RVEC] + l * 7 * RW; const float* v0p = a.in[I_RV0];
    const bf16* SW = (const bf16*)(ws + WS_SMALLW) + (size_t)l * LAYER_SMALLW;
    bf16* Rr = (bf16*)(ws + WS_R); bf16* Kr = (bf16*)(ws + WS_K); bf16* Vr = (bf16*)(ws + WS_V); bf16* KKr = (bf16*)(ws + WS_KK); bf16* Ar = (bf16*)(ws + WS_A);
    float* LWr = (float*)(ws + WS_LW); bf16* Gr = (bf16*)(ws + WS_G); bf16* VF = (bf16*)(ws + WS_VF); bf16* mix = (bf16*)(ws + WS_MIX); float* BON = (float*)(ws + WS_BON);
    bf16* QM = (bf16*)(ws + WS_QM); bf16* KM = (bf16*)(ws + WS_KM); bf16* VM = (bf16*)(ws + WS_VM);
    const float* pools = a.in[I_POOLS] + l * 256; const float* qlg = a.in[I_QLG] + l * 256; const float* kvlg = a.in[I_KVLG] + l * 128;
    const float* qkg = a.in[I_QKG] + l * 2 * 96; const float* ct = (const float*)(ws + WS_COS); const float* st = (const float*)(ws + WS_SIN);
    const f32x16 zero16 = {0.f, 0.f, 0.f, 0.f, 0.f, 0.f, 0.f, 0.f, 0.f, 0.f, 0.f, 0.f, 0.f, 0.f, 0.f, 0.f};
    for (int unit = blockIdx.x; unit < M / 32; unit += G) {
        const int lane = fresh_lane();
        const int p = lane & 31, h = lane >> 5;
        LAS unsigned char* ST = L + PZ_END + wave * 8192;
        const int t0 = unit * 32; const int tt0 = t0 % T;
        const bf16* zu = z + (size_t)t0 * NZ;
        bf16* Ru = Rr + (size_t)t0 * RW; bf16* Ku = Kr + (size_t)t0 * RW; bf16* Vu = Vr + (size_t)t0 * RW; bf16* KKu = KKr + (size_t)t0 * RW; bf16* Au = Ar + (size_t)t0 * RW;
        float* LWu = LWr + (size_t)t0 * RW; bf16* Gu = Gr + (size_t)t0 * RW; bf16* VFu = VF + (size_t)t0 * RW; bf16* mixu = mix + (size_t)t0 * D; float* BONu = BON + (size_t)t0 * 8;
        bf16* QMu = QM + (size_t)t0 * 384; bf16* KMu = KM + (size_t)t0 * 384; bf16* VMu = VM + (size_t)t0 * 256; const float* ctu = ct + (size_t)t0 * 16; const float* stu = st + (size_t)t0 * 16;
        __syncthreads();
        if (dry && (PZ_ABL & 4)) {} else {
            { const int gi = wave & 3, i0 = (wave >> 2) * 16; const bf16* zc = z + (size_t)t0 * NZ + OFF_POOL + gi * 64 + lane;
              pool_wave_all(zc, tt0, i0, L + PZ_PP, gi, lane); }
            float cW[4], pW[4], cA[4], pA[4], cG0[4], pG0[4], cG1[4], pG1[4], cG2[4], pG2[4], cV[4], pV[4], q4[4][4], k2[4][2];
            int wv; asm volatile("v_mov_b32 %0, %1" : "=v"(wv) : "s"(wave));
#pragma unroll
            for (int t4 = 0; t4 < 4; ++t4) { const int i = wv * 4 + t4; const bool hp = (tt0 + i) > 0;
                const bf16* zb = zu - NZ;
                const unsigned oc = (unsigned)((i + 1) * NZ) + (unsigned)lane, op = hp ? oc - NZ : oc; const unsigned l31 = (unsigned)(lane & 31), oc31 = (unsigned)((i + 1) * NZ) + l31, op31 = hp ? oc31 - NZ : oc31;
                cW[t4] = bf2f(zb[oc + OFF_WD]); pW[t4] = bf2f(zb[op + OFF_WD]); cA[t4] = bf2f(zb[oc + OFF_AD]); pA[t4] = bf2f(zb[op + OFF_AD]);
                cG0[t4] = bf2f(zb[oc + OFF_GD]); pG0[t4] = bf2f(zb[op + OFF_GD]); cG1[t4] = bf2f(zb[oc + OFF_GD + 64]); pG1[t4] = bf2f(zb[op + OFF_GD + 64]);
                cG2[t4] = bf2f(zb[oc31 + OFF_GD + 128]); pG2[t4] = bf2f(zb[op31 + OFF_GD + 128]);
                if (l > 0) { cV[t4] = bf2f(zb[oc31 + OFF_VD]); pV[t4] = bf2f(zb[op31 + OFF_VD]); } else { cV[t4] = 0.f; pV[t4] = 0.f; }
#pragma unroll
                for (int j = 0; j < 4; ++j) q4[t4][j] = bf2f(zb[oc + OFF_QLAT + 64 * j]);
#pragma unroll
                for (int j = 0; j < 2; ++j) k2[t4][j] = bf2f(zb[oc + OFF_KVLAT + 64 * j]); }
            const float muW = mu[OFF_WD + lane], muA = mu[OFF_AD + lane], muG0 = mu[OFF_GD + lane], muG1 = mu[OFF_GD + 64 + lane], muG2 = mu[OFF_GD + 128 + (lane & 31)], muV = l > 0 ? muv[lane & 31] : 0.f;
#pragma unroll
            for (int t4 = 0; t4 < 4; ++t4) { const int i = wv * 4 + t4; const float pm = (tt0 + i) > 0 ? 1.f : 0.f;
#define SH(c_, p_, m_) ((c_) + (m_) * (pm * (p_) - (c_)))
                pz_put<128>(L + PZ_XW, i, lane, tanhf_(SH(cW[t4], pW[t4], muW))); pz_put<128>(L + PZ_XA, i, lane, SH(cA[t4], pA[t4], muA));
                pz_put<320>(L + PZ_XG, i, lane, sigmoidf_(SH(cG0[t4], pG0[t4], muG0))); pz_put<320>(L + PZ_XG, i, lane + 64, sigmoidf_(SH(cG1[t4], pG1[t4], muG1)));
                if (lane < 32) pz_put<320>(L + PZ_XG, i, lane + 128, sigmoidf_(SH(cG2[t4], pG2[t4], muG2)));
                if (l > 0 && lane < 32) pz_put<64>(L + PZ_XV, i, lane, SH(cV[t4], pV[t4], muV));
#undef SH
                float s = 0.f;
#pragma unroll
                for (int j = 0; j < 4; ++j) s += q4[t4][j] * q4[t4][j];
                const float rs = rsq_(wave_sum(s) * (1.f / 256.f) + 1e-6f);
#pragma unroll
                for (int j = 0; j < 4; ++j) pz_put<512>(L + PZ_QN, i, lane + 64 * j, q4[t4][j] * rs * qlg[lane + 64 * j]);
                s = 0.f;
#pragma unroll
                for (int j = 0; j < 2; ++j) s += k2[t4][j] * k2[t4][j];
                const float rk = rsq_(wave_sum(s) * (1.f / 128.f) + 1e-6f);
#pragma unroll
                for (int j = 0; j < 2; ++j) pz_put<256>(L + PZ_KVN, i, lane + 64 * j, k2[t4][j] * rk * kvlg[lane + 64 * j]);
            }
        }
        __syncthreads();
        if (dry && (PZ_ABL & 2)) {} else if ((PZ_PART & 2) && wave < 4) {
            const int hq = wave; const int fi = p & 15;
            { f32x16 aq[3] = {zero16, zero16, zero16};
              { f32x16 a01[2] = {zero16, zero16}; pz_gemm<512, 16, 2, 4>(a01, L + PZ_QN, SW + O_WQT, 256, hq * 96, p, h); aq[0] = a01[0]; aq[1] = a01[1]; }
              { f32x16 a2[1] = {zero16}; pz_gemm<512, 16, 1, 4>(a2, L + PZ_QN, SW + O_WQT, 256, hq * 96 + 64, p, h); aq[2] = a2[0]; }
              const float C2 = 0.10206207261596577f * 1.4426950408889634f; const float gq0 = qkg[p] * C2, gq1 = qkg[32 + p] * C2, gq2 = qkg[64 + p] * C2;
              float csv[16], snv[16];
#pragma unroll
              for (int r = 0; r < 16; ++r) { csv[r] = ctu[qrow(r, h) * 16 + fi]; snv[r] = stu[qrow(r, h) * 16 + fi]; }
#pragma unroll
              for (int r = 0; r < 16; ++r) {
                const int i = qrow(r, h);
                const float cs = csv[r], sn = snv[r];
                const float xq = aq[2][r], xqo = __int_as_float(__builtin_amdgcn_ds_swizzle(__float_as_int(xq), 0x401F));
                const float qpe = p < 16 ? xq * cs - xqo * sn : xqo * sn + xq * cs;
                const float q0 = aq[0][r], q1 = aq[1][r];
                const float rq = rsq_(half_sum32(q0 * q0 + q1 * q1 + qpe * qpe) * (1.f / 96.f) + 1e-6f);
                st_put(ST, i, p, q0 * rq * gq0); st_put(ST, i, 32 + p, q1 * rq * gq1); st_put(ST, i, 64 + p, qpe * rq * gq2);
                if ((r & 3) == 3) asm volatile("" ::: "memory");
              }
              st_flush<96>(ST, QMu + hq * 96, 384, lane, dry); }
        } else if (PZ_PART & 6) {
            const int hq = wave - 4, gi = wave - 4; const int fi = p & 15;
            { f32x16 ak[2] = {zero16, zero16};
              pz_gemm<256, 8, 2, 4>(ak, L + PZ_KVN, SW + O_WKVT, 128, hq * 128, p, h);
              const float gk0 = qkg[96 + p], gk1 = qkg[96 + 32 + p], gk2 = qkg[96 + 64 + p];
              float csv[16], snv[16]; bf16 xkv[16];
#pragma unroll
              for (int r = 0; r < 16; ++r) { csv[r] = ctu[qrow(r, h) * 16 + fi]; snv[r] = stu[qrow(r, h) * 16 + fi]; xkv[r] = zu[(unsigned)(qrow(r, h) * NZ + OFF_KROPE + p)]; }
#pragma unroll
              for (int r = 0; r < 16; ++r) {
                const int i = qrow(r, h);
                const float cs = csv[r], sn = snv[r];
                const float xk = bf2f(xkv[r]), xko = __int_as_float(__builtin_amdgcn_ds_swizzle(__float_as_int(xk), 0x401F));
                const float kpe = p < 16 ? xk * cs - xko * sn : xko * sn + xk * cs;
                const float k0 = ak[0][r], k1 = ak[1][r];
                const float rk = rsq_(half_sum32(k0 * k0 + k1 * k1 + kpe * kpe) * (1.f / 96.f) + 1e-6f);
                st_put(ST, i, p, k0 * rk * gk0); st_put(ST, i, 32 + p, k1 * rk * gk1); st_put(ST, i, 64 + p, kpe * rk * gk2);
                if ((r & 3) == 3) asm volatile("" ::: "memory");
              }
              st_flush_kimg(ST, KM + ((size_t)(((t0 / T) * 4 + hq) * 64 + (tt0 >> 6)) * 6144 + (unsigned)((tt0 & 63) * 8)), lane, dry); }
            { f32x16 av[2] = {zero16, zero16};
              pz_gemm<256, 8, 2, 4>(av, L + PZ_KVN, SW + O_WKVT, 128, hq * 128 + 64, p, h);
              { bf16* vt = (bf16*)(ws + WS_VT) + (size_t)(((t0 / T) * 4 + hq) * 128 + tt0 / 32) * 2048;
#pragma unroll
                for (int jt = 0; jt < 2; ++jt)
#pragma unroll
                    for (int s2 = 0; s2 < 2; ++s2) if (!dry) { *(bf16x8*)(vt + (unsigned)(((jt * 2 + s2) * 64 + (((h & 1) << 5) | p)) * 8)) = accfrag(av[jt], s2); } }
              asm volatile("" ::: "memory"); }

            f32x16 ap[2] = {zero16, zero16};
            pz_gemm<512, 4, 2>(ap, L + PZ_PP, SW + O_POOLT + gi * 4096, 64, 0, p, h, 8 * gi);
            const float ps0 = pools[gi * 64 + p], ps1 = pools[gi * 64 + 32 + p];
#pragma unroll
            for (int r = 0; r < 16; ++r) { st_put(ST, qrow(r, h), p, ap[0][r] * ps0); st_put(ST, qrow(r, h), 32 + p, ap[1][r] * ps1); }
            st_flush<64>(ST, mixu + 512 + gi * 64, D, lane, dry);
        }
        if (!(dry && (PZ_ABL & 1))) {
            const int hh = wave;
            { f32x16 aG[2] = {zero16, zero16};
              pz_gemm<320, 10, 2, 5>(aG, L + PZ_XG, SW + O_G2T, 160, hh * 64, p, h);
              { unsigned char* XGb = ws + WS_G + ((size_t)unit * NH + hh) * (4 * 64 * 16); const unsigned lo16 = (unsigned)lane * 16u;
#pragma unroll
                for (int jt = 0; jt < 2; ++jt)
#pragma unroll
                    for (int hq = 0; hq < 2; ++hq) if (!dry) *(v4u*)(XGb + (lo16 + (unsigned)((jt * 2 + hq) * 1024))) = (v4u){cvtpk(aG[jt][8 * hq], aG[jt][8 * hq + 1]), cvtpk(aG[jt][8 * hq + 2], aG[jt][8 * hq + 3]), cvtpk(aG[jt][8 * hq + 4], aG[jt][8 * hq + 5]), cvtpk(aG[jt][8 * hq + 6], aG[jt][8 * hq + 7])}; }
              asm volatile("" ::: "memory"); }
            float lwv[2][16]; unsigned pkk[2][8], paa[2][8], pkf[2][8], prr[2][8], pvv[2][8], pgv[2][8];
            { f32x16 aA[2] = {zero16, zero16};
              pz_gemm<128, 4, 2>(aA, L + PZ_XA, SW + O_A2T, 64, hh * 64, p, h);
#pragma unroll
              for (int jt = 0; jt < 2; ++jt) { const float a0 = rvec[RW + hh * 64 + 32 * jt + p];
#pragma unroll
                  for (int q = 0; q < 8; ++q) paa[jt][q] = cvtpk(sigmoidf_(a0 + aA[jt][2 * q]), sigmoidf_(a0 + aA[jt][2 * q + 1])); } }
            if (l > 0) { f32x16 aV[2] = {zero16, zero16};
              pz_gemm<64, 2, 2>(aV, L + PZ_XV, SW + O_V2T, 32, hh * 64, p, h);
#pragma unroll
              for (int jt = 0; jt < 2; ++jt) { const float v0c = v0p[hh * 64 + 32 * jt + p];
#pragma unroll
                  for (int q = 0; q < 8; ++q) pgv[jt][q] = cvtpk(sigmoidf_(v0c + aV[jt][2 * q]), sigmoidf_(v0c + aV[jt][2 * q + 1])); } }
            unsigned char* XAb = ws + WS_XV + ((size_t)unit * NH + hh) * (4 * 64 * 16);
            {
            LAS unsigned* stash = (LAS unsigned*)ST + lane;
            float mr[2], mk[2], mv[2], kkc[2], kac[2], rkc[2];
#pragma unroll
            for (int jt = 0; jt < 2; ++jt) { const int c = hh * 64 + 32 * jt + p; mr[jt] = mu[c]; mk[jt] = mu[512 + c]; mv[jt] = mu[1024 + c];
                kkc[jt] = rvec[2 * RW + c]; kac[jt] = rvec[3 * RW + c]; rkc[jt] = rvec[4 * RW + c]; }
            bf16 rw[2][2][7];
#define ZL_LOAD(BUF, R) do { int hv_ = h; asm volatile("" : "+v"(hv_)); const int i_ = qrow((R), hv_); const bool hp_ = (tt0 + i_) > 0; \
                const bf16* zc_ = zu + (i_ * NZ + hh * 64 + p); const bf16* zp_ = hp_ ? zc_ - NZ : zc_; const unsigned ov_ = (unsigned)(i_ * RW + hh * 64 + p); \
                _Pragma("unroll") for (int jt_ = 0; jt_ < 2; ++jt_) { rw[BUF][jt_][0] = zc_[32 * jt_]; rw[BUF][jt_][1] = zc_[512 + 32 * jt_]; rw[BUF][jt_][2] = zc_[1024 + 32 * jt_]; \
                    rw[BUF][jt_][3] = zp_[32 * jt_]; rw[BUF][jt_][4] = zp_[512 + 32 * jt_]; rw[BUF][jt_][5] = zp_[1024 + 32 * jt_]; rw[BUF][jt_][6] = l > 0 ? VFu[ov_ + 32u * jt_] : (bf16)0; } } while (0)
            ZL_LOAD(0, 0);
#pragma unroll
            for (int rp = 0; rp < 8; ++rp) {
                float kk2[2][2], k2[2][2], r2[2][2], v2[2][2];
#pragma unroll
                for (int rr = 0; rr < 2; ++rr) {
                    const int r = 2 * rp + rr;
                    if (r + 1 < 16) ZL_LOAD((r + 1) & 1, r + 1);
                    int hv = h; asm volatile("" : "+v"(hv));
                    const int i = qrow(r, hv); const bool hp = (tt0 + i) > 0;
                    const float pm = hp ? 1.f : 0.f;
                    const unsigned ov = (unsigned)(i * RW + hh * 64 + p);
                    float kkr[2]; float n2 = 0.f, bs = 0.f;
#pragma unroll
                    for (int jt = 0; jt < 2; ++jt) {
                        const bf16* w_ = rw[r & 1][jt];
                        const float zr_ = bf2f(w_[0]), zk_ = bf2f(w_[1]), zv_ = bf2f(w_[2]);
                        const float pr_ = pm * bf2f(w_[3]), pk_ = pm * bf2f(w_[4]), pv_ = pm * bf2f(w_[5]);
                        const float rv = zr_ + mr[jt] * (pr_ - zr_), k0 = zk_ + mk[jt] * (pk_ - zk_), v0 = zv_ + mv[jt] * (pv_ - zv_);
                        float v = v0;
                        if (l == 0) { if (!dry) { VFu[ov + 32u * jt] = (bf16)f2bf(v0); } }
                        else { const float vf = bf2f(w_[6]); v = v0 + (vf - v0) * (rr ? bfhi(pgv[jt][rp]) : bflo(pgv[jt][rp])); }
                        const float aa = rr ? bfhi(paa[jt][rp]) : bflo(paa[jt][rp]);
                        kkr[jt] = k0 * kkc[jt]; n2 += kkr[jt] * kkr[jt];
                        const float k = k0 * (1.f + (aa - 1.f) * kac[jt]);
                        r2[jt][rr] = bf2f((bf16)f2bf(rv)); k2[jt][rr] = bf2f((bf16)f2bf(k)); v2[jt][rr] = bf2f((bf16)f2bf(v));
                        bs += r2[jt][rr] * k2[jt][rr] * rkc[jt];
                    }
                    n2 = half_sum32(n2); bs = half_sum32(bs);
                    const float inv = rsq_(fmaxf(n2, 1e-24f));
                    kk2[0][rr] = kkr[0] * inv; kk2[1][rr] = kkr[1] * inv;
                    if (p == 0) if (!dry) { BONu[(unsigned)(i * 8 + hh)] = bs; }
                }
#pragma unroll
                for (int jt = 0; jt < 2; ++jt) { pkk[jt][rp] = cvtpk(kk2[jt][0], kk2[jt][1]); pkf[jt][rp] = cvtpk(k2[jt][0], k2[jt][1]);
                    prr[jt][rp] = cvtpk(r2[jt][0], r2[jt][1]); pvv[jt][rp] = cvtpk(v2[jt][0], v2[jt][1]); }
                asm volatile("" ::: "memory");
                if (rp == 3) {
#pragma unroll
                    for (int jt = 0; jt < 2; ++jt)
#pragma unroll
                        for (int q = 0; q < 4; ++q) { stash[((jt * 4 + q) * 4 + 0) * 64] = pkk[jt][q]; stash[((jt * 4 + q) * 4 + 1) * 64] = pkf[jt][q]; stash[((jt * 4 + q) * 4 + 2) * 64] = prr[jt][q]; stash[((jt * 4 + q) * 4 + 3) * 64] = pvv[jt][q]; }
                    asm volatile("" ::: "memory");
                }
            }
#undef ZL_LOAD
            LDS_WAIT();
#pragma unroll
            for (int jt = 0; jt < 2; ++jt)
#pragma unroll
                for (int q = 0; q < 4; ++q) { pkk[jt][q] = stash[((jt * 4 + q) * 4 + 0) * 64]; pkf[jt][q] = stash[((jt * 4 + q) * 4 + 1) * 64]; prr[jt][q] = stash[((jt * 4 + q) * 4 + 2) * 64]; pvv[jt][q] = stash[((jt * 4 + q) * 4 + 3) * 64]; }
#pragma unroll
            for (int jt = 0; jt < 2; ++jt) { if (!dry) { const unsigned lo16 = (unsigned)lane * 16u; *(v4u*)(XAb + (lo16 + (unsigned)((jt * 2) * 1024))) = (v4u){pvv[jt][0], pvv[jt][1], pvv[jt][2], pvv[jt][3]}; *(v4u*)(XAb + (lo16 + (unsigned)((jt * 2 + 1) * 1024))) = (v4u){pvv[jt][4], pvv[jt][5], pvv[jt][6], pvv[jt][7]}; } }
            }
            { f32x16 aW[2] = {zero16, zero16};
              int p_ = p, h_ = h; asm volatile("" : "+v"(p_), "+v"(h_));
              pz_gemm<128, 4, 2>(aW, L + PZ_XW, SW + O_W2T, 64, hh * 64, p_, h_);
#pragma unroll
              for (int jt = 0; jt < 2; ++jt) { const float w0 = rvec[hh * 64 + 32 * jt + p];
#pragma unroll
                  for (int r = 0; r < 16; ++r) lwv[jt][r] = -0.6065306597126334f * sigmoidf_(w0 + aW[jt][r]); } }
            __syncthreads();
            if (!dry) {
            const size_t item_ = (size_t)unit * NH + hh;
            LAS unsigned char* TT = L + wave * 16384; LAS float* gC = (LAS float*)(lds + LDSCTL_OFF + 4096) + wave * 64;
            bf16x8 fAT[2][2], fBT[2][2], fKT[2][2], fRT[2][2], fVT[2][2];
#pragma unroll
            for (int jt = 0; jt < 2; ++jt) {
                float cum[16], tot[4], oth[4];
#pragma unroll
                for (int g = 0; g < 4; ++g) { cum[4 * g] = lwv[jt][4 * g]; cum[4 * g + 1] = cum[4 * g] + lwv[jt][4 * g + 1]; cum[4 * g + 2] = cum[4 * g + 1] + lwv[jt][4 * g + 2]; cum[4 * g + 3] = cum[4 * g + 2] + lwv[jt][4 * g + 3];
                    tot[g] = cum[4 * g + 3]; oth[g] = other_half(tot[g]); }
                float run = 0.f;
#pragma unroll
                for (int g = 0; g < 4; ++g) { const float base = run + (h ? oth[g] : 0.f);
#pragma unroll
                    for (int b4 = 0; b4 < 4; ++b4) cum[4 * g + b4] += base;
                    run += tot[g] + oth[g]; }
                gC[32 * jt + p] = __expf(run);
#pragma unroll
                for (int s2 = 0; s2 < 2; ++s2) {
                    unsigned da[4], db[4], dk[4], dr[4];
#pragma unroll
                    for (int qq = 0; qq < 4; ++qq) { const int q = 4 * s2 + qq;
                        float at2[2], bt2[2], kt2[2], rt2[2];
#pragma unroll
                        for (int rr = 0; rr < 2; ++rr) { const int r = 2 * q + rr; const float cv = cum[r], cx = cv - lwv[jt][r];
                            const float ea = __expf(cx), eb = __expf(-cv), er = __expf(cv);
                            const float kk = rr ? bfhi(pkk[jt][q]) : bflo(pkk[jt][q]), aa = rr ? bfhi(paa[jt][q]) : bflo(paa[jt][q]);
                            const float kf = rr ? bfhi(pkf[jt][q]) : bflo(pkf[jt][q]), rv = rr ? bfhi(prr[jt][q]) : bflo(prr[jt][q]);
                            at2[rr] = -kk * ea; bt2[rr] = kk * aa * eb; kt2[rr] = kf * eb; rt2[rr] = rv * er; }
                        da[qq] = cvtpk(at2[0], at2[1]); db[qq] = cvtpk(bt2[0], bt2[1]); dk[qq] = cvtpk(kt2[0], kt2[1]); dr[qq] = cvtpk(rt2[0], rt2[1]); }
                    fAT[jt][s2] = mkfrag(da[0], da[1], da[2], da[3]); fBT[jt][s2] = mkfrag(db[0], db[1], db[2], db[3]); fKT[jt][s2] = mkfrag(dk[0], dk[1], dk[2], dk[3]); fRT[jt][s2] = mkfrag(dr[0], dr[1], dr[2], dr[3]);
                    fVT[jt][s2] = mkfrag(pvv[jt][4 * s2], pvv[jt][4 * s2 + 1], pvv[jt][4 * s2 + 2], pvv[jt][4 * s2 + 3]);
                }
            }
            const int wbase = h * 512 + p * 2, rbase = p * 128 + h * 16;
#define TM_PUT(TILE, ARR) do { _Pragma("unroll") for (int jt = 0; jt < 2; ++jt) _Pragma("unroll") for (int r = 0; r < 16; ++r) \
                *(LAS bf16*)(TT + wbase + ((TILE) * 4096 + ((r & 3) + 8 * (r >> 2)) * 128 + jt * 64)) = (bf16)ARR[jt][r >> 3][r & 7]; } while (0)
            LDS_WAIT();
            TM_PUT(0, fAT); TM_PUT(1, fBT); TM_PUT(2, fKT); TM_PUT(3, fRT);
            LDS_WAIT();
#undef TM_PUT
            f32x16 Aab = zero16, AabT = zero16, Aak = zero16, Arb = zero16, Ark = zero16;
#pragma unroll
            for (int s4 = 0; s4 < 4; ++s4) {
                const bf16x8 fa = *(const LAS bf16x8*)(TT + rbase + s4 * 32), fb = *(const LAS bf16x8*)(TT + rbase + 4096 + s4 * 32), fk = *(const LAS bf16x8*)(TT + rbase + 8192 + s4 * 32), fr = *(const LAS bf16x8*)(TT + rbase + 12288 + s4 * 32);
                Aab = MFMA32(fb, fa, Aab); AabT = MFMA32(fa, fb, AabT); Aak = MFMA32(fk, fa, Aak); Arb = MFMA32(fb, fr, Arb); Ark = MFMA32(fk, fr, Ark);
            }
#pragma unroll
            for (int r = 0; r < 16; ++r) { const int q = qrow(r, h);
                Aab[r] = (q < p) ? Aab[r] : 0.f;  Aak[r] = (q < p) ? Aak[r] : 0.f; AabT[r] = (p < q) ? AabT[r] : 0.f;
                Arb[r] = (q <= p) ? Arb[r] : 0.f; Ark[r] = (q <= p) ? Ark[r] : 0.f; }
            f32x16 Tm = Aab;
#pragma unroll
            for (int r = 0; r < 16; ++r) Tm[r] += (qrow(r, h) == p) ? 1.f : 0.f;
            bf16x8 X0 = accfrag(Aab, 0), X1 = accfrag(Aab, 1), XT0 = accfrag(AabT, 0), XT1 = accfrag(AabT, 1);
#pragma unroll
            for (int it = 0; it < 4; ++it) {
                f32x16 X2T = MFMA32(X0, XT0, zero16); X2T = MFMA32(X1, XT1, X2T);
                const bf16x8 T0 = accfrag(Tm, 0), T1 = accfrag(Tm, 1);
                const bf16x8 Y0 = accfrag(X2T, 0), Y1 = accfrag(X2T, 1);
                Tm = MFMA32(Y0, T0, Tm); Tm = MFMA32(Y1, T1, Tm);
                if (it < 3) { f32x16 X2 = MFMA32(XT0, X0, zero16); X2 = MFMA32(XT1, X1, X2); X0 = accfrag(X2, 0); X1 = accfrag(X2, 1); XT0 = Y0; XT1 = Y1; }
            }
            const bf16x8 Tf0 = accfrag(Tm, 0), Tf1 = accfrag(Tm, 1);
            const bf16x8 Akf0 = accfrag(Aak, 0), Akf1 = accfrag(Aak, 1), Abf0 = accfrag(Arb, 0), Abf1 = accfrag(Arb, 1), Arf0 = accfrag(Ark, 0), Arf1 = accfrag(Ark, 1);
            bf16x8 fPT[2][2], fQT[2][2];
#pragma unroll
            for (int ct = 0; ct < 2; ++ct) {
                f32x16 a_ = MFMA32(Tf0, fAT[ct][0], zero16); a_ = MFMA32(Tf1, fAT[ct][1], a_); fPT[ct][0] = accfrag(a_, 0); fPT[ct][1] = accfrag(a_, 1);
                f32x16 b_ = MFMA32(Akf0, fVT[ct][0], zero16); b_ = MFMA32(Akf1, fVT[ct][1], b_);
                const bf16x8 av0 = accfrag(b_, 0), av1 = accfrag(b_, 1);
                f32x16 c_ = MFMA32(Tf0, av0, zero16); c_ = MFMA32(Tf1, av1, c_); fQT[ct][0] = accfrag(c_, 0); fQT[ct][1] = accfrag(c_, 1);
            }
            const int ln_ = ((h & 1) << 5) | p;
            bf16* RPo = (bf16*)(ws + WS_SRP) + item_ * 2048; bf16* YLo = (bf16*)(ws + WS_SYL) + item_ * 2048;
            bf16* Mo = (bf16*)(ws + WS_SM) + item_ * 4096; bf16* NTo = (bf16*)(ws + WS_SNT) + item_ * 4096;
#pragma unroll
            for (int ct = 0; ct < 2; ++ct) {
                f32x16 a_;
#pragma unroll
                for (int g = 0; g < 4; ++g) { const v2u w = *(const LAS v2u*)(TT + (p * 128 + 8 * h) + (12288 + (4 * ct + g) * 16));
                    a_[4 * g] = bflo(w.x); a_[4 * g + 1] = bfhi(w.x); a_[4 * g + 2] = bflo(w.y); a_[4 * g + 3] = bfhi(w.y); }
                a_ = MFMA32(fPT[ct][0], Abf0, a_); a_ = MFMA32(fPT[ct][1], Abf1, a_);
#pragma unroll
                for (int s2 = 0; s2 < 2; ++s2) *(bf16x8*)(RPo + (unsigned)(((2 * ct + s2) * 64 + ln_) * 8)) = accfrag(a_, s2);
                f32x16 y_ = MFMA32(Abf0, fQT[ct][0], zero16); y_ = MFMA32(Abf1, fQT[ct][1], y_); y_ = MFMA32(Arf0, fVT[ct][0], y_); y_ = MFMA32(Arf1, fVT[ct][1], y_);
#pragma unroll
                for (int s2 = 0; s2 < 2; ++s2) *(bf16x8*)(YLo + (unsigned)(((2 * ct + s2) * 64 + ln_) * 8)) = accfrag(y_, s2);
            }
            LDS_WAIT();
#pragma unroll
            for (int ctp = 0; ctp < 2; ++ctp) {
                const float gl = gC[32 * ctp + p];
#pragma unroll
                for (int ct = 0; ct < 2; ++ct) {
                    f32x16 m_ = MFMA32(fPT[ct][0], fBT[ctp][0], zero16); m_ = MFMA32(fPT[ct][1], fBT[ctp][1], m_);
#pragma unroll
                    for (int r = 0; r < 16; ++r) m_[r] = (m_[r] + ((ct == ctp && qrow(r, h) == p) ? 1.f : 0.f)) * gl;
#pragma unroll
                    for (int s2 = 0; s2 < 2; ++s2) *(bf16x8*)(Mo + (unsigned)(((4 * ctp + 2 * ct + s2) * 64 + ln_) * 8)) = accfrag(m_, s2);
                    __builtin_amdgcn_sched_barrier(0);
                }
            }
#pragma unroll
            for (int ctd = 0; ctd < 2; ++ctd)
#pragma unroll
                for (int ctp = 0; ctp < 2; ++ctp) {
                    f32x16 n_ = MFMA32(fBT[ctp][0], fQT[ctd][0], zero16); n_ = MFMA32(fBT[ctp][1], fQT[ctd][1], n_); n_ = MFMA32(fKT[ctp][0], fVT[ctd][0], n_); n_ = MFMA32(fKT[ctp][1], fVT[ctd][1], n_);
#pragma unroll
                    for (int g = 0; g < 4; ++g) { const f32x4 gv = *(const LAS f32x4*)(gC + 4 * h + (32 * ctp + 8 * g)); n_[4 * g] *= gv.x; n_[4 * g + 1] *= gv.y; n_[4 * g + 2] *= gv.z; n_[4 * g + 3] *= gv.w; }
#pragma unroll
                    for (int s2 = 0; s2 < 2; ++s2) *(bf16x8*)(NTo + (unsigned)(((4 * ctd + 2 * ctp + s2) * 64 + ln_) * 8)) = accfrag(n_, s2);
                    __builtin_amdgcn_sched_barrier(0);
                }

            }
        }
    }
}

__device__ __forceinline__ void scan_local2_item(unsigned char* ws, int item_i, LAS unsigned char* TT, LAS float* gC, int lane) {
    const size_t item = (size_t)item_i; const int p = lane & 31, h = lane >> 5;
    const f32x16 zero16 = {0.f, 0.f, 0.f, 0.f, 0.f, 0.f, 0.f, 0.f, 0.f, 0.f, 0.f, 0.f, 0.f, 0.f, 0.f, 0.f};
    float lwv[2][16]; unsigned pkk[2][8], paa[2][8], pkf[2][8], prr[2][8], pvv[2][8];
    { const v4u* XA = (const v4u*)(ws + WS_XA) + (item * 20) * 64 + lane; const v4u* XL = (const v4u*)(ws + WS_XL) + (item * 8) * 64 + lane;
#pragma unroll
      for (int jt = 0; jt < 2; ++jt)
#pragma unroll
          for (int hq = 0; hq < 2; ++hq) {
              { const v4u w = XA[(0 * 4 + jt * 2 + hq) * 64]; pkk[jt][4 * hq] = w.x; pkk[jt][4 * hq + 1] = w.y; pkk[jt][4 * hq + 2] = w.z; pkk[jt][4 * hq + 3] = w.w; }
              { const v4u w = XA[(1 * 4 + jt * 2 + hq) * 64]; paa[jt][4 * hq] = w.x; paa[jt][4 * hq + 1] = w.y; paa[jt][4 * hq + 2] = w.z; paa[jt][4 * hq + 3] = w.w; }
              { const v4u w = XA[(2 * 4 + jt * 2 + hq) * 64]; pkf[jt][4 * hq] = w.x; pkf[jt][4 * hq + 1] = w.y; pkf[jt][4 * hq + 2] = w.z; pkf[jt][4 * hq + 3] = w.w; }
              { const v4u w = XA[(3 * 4 + jt * 2 + hq) * 64]; prr[jt][4 * hq] = w.x; prr[jt][4 * hq + 1] = w.y; prr[jt][4 * hq + 2] = w.z; prr[jt][4 * hq + 3] = w.w; }
              { const v4u w = XA[(4 * 4 + jt * 2 + hq) * 64]; pvv[jt][4 * hq] = w.x; pvv[jt][4 * hq + 1] = w.y; pvv[jt][4 * hq + 2] = w.z; pvv[jt][4 * hq + 3] = w.w; } }
#pragma unroll
      for (int jt = 0; jt < 2; ++jt)
#pragma unroll
          for (int g = 0; g < 4; ++g) { const v4u w = XL[(jt * 4 + g) * 64]; lwv[jt][4 * g] = __uint_as_float(w.x); lwv[jt][4 * g + 1] = __uint_as_float(w.y); lwv[jt][4 * g + 2] = __uint_as_float(w.z); lwv[jt][4 * g + 3] = __uint_as_float(w.w); } }
    {
            bf16x8 fAT[2][2], fBT[2][2], fKT[2][2], fRT[2][2], fVT[2][2];
#pragma unroll
            for (int jt = 0; jt < 2; ++jt) {
                float cum[16], tot[4], oth[4];
#pragma unroll
                for (int g = 0; g < 4; ++g) { cum[4 * g] = lwv[jt][4 * g]; cum[4 * g + 1] = cum[4 * g] + lwv[jt][4 * g + 1]; cum[4 * g + 2] = cum[4 * g + 1] + lwv[jt][4 * g + 2]; cum[4 * g + 3] = cum[4 * g + 2] + lwv[jt][4 * g + 3];
                    tot[g] = cum[4 * g + 3]; oth[g] = other_half(tot[g]); }
                float run = 0.f;
#pragma unroll
                for (int g = 0; g < 4; ++g) { const float base = run + (h ? oth[g] : 0.f);
#pragma unroll
                    for (int b4 = 0; b4 < 4; ++b4) cum[4 * g + b4] += base;
                    run += tot[g] + oth[g]; }
                gC[32 * jt + p] = __expf(run);
#pragma unroll
                for (int s2 = 0; s2 < 2; ++s2) {
                    unsigned da[4], db[4], dk[4], dr[4];
#pragma unroll
                    for (int qq = 0; qq < 4; ++qq) { const int q = 4 * s2 + qq;
                        float at2[2], bt2[2], kt2[2], rt2[2];
#pragma unroll
                        for (int rr = 0; rr < 2; ++rr) { const int r = 2 * q + rr; const float cv = cum[r], cx = cv - lwv[jt][r];
                            const float ea = __expf(cx), eb = __expf(-cv), er = __expf(cv);
                            const float kk = rr ? bfhi(pkk[jt][q]) : bflo(pkk[jt][q]), aa = rr ? bfhi(paa[jt][q]) : bflo(paa[jt][q]);
                            const float kf = rr ? bfhi(pkf[jt][q]) : bflo(pkf[jt][q]), rv = rr ? bfhi(prr[jt][q]) : bflo(prr[jt][q]);
                            at2[rr] = -kk * ea; bt2[rr] = kk * aa * eb; kt2[rr] = kf * eb; rt2[rr] = rv * er; }
                        da[qq] = cvtpk(at2[0], at2[1]); db[qq] = cvtpk(bt2[0], bt2[1]); dk[qq] = cvtpk(kt2[0], kt2[1]); dr[qq] = cvtpk(rt2[0], rt2[1]); }
                    fAT[jt][s2] = mkfrag(da[0], da[1], da[2], da[3]); fBT[jt][s2] = mkfrag(db[0], db[1], db[2], db[3]); fKT[jt][s2] = mkfrag(dk[0], dk[1], dk[2], dk[3]); fRT[jt][s2] = mkfrag(dr[0], dr[1], dr[2], dr[3]);
                    fVT[jt][s2] = mkfrag(pvv[jt][4 * s2], pvv[jt][4 * s2 + 1], pvv[jt][4 * s2 + 2], pvv[jt][4 * s2 + 3]);
                }
            }
            const int wbase = h * 512 + p * 2, rbase = p * 128 + h * 16;
#define TM_PUT(TILE, ARR) do { _Pragma("unroll") for (int jt = 0; jt < 2; ++jt) _Pragma("unroll") for (int r = 0; r < 16; ++r) \
                *(LAS bf16*)(TT + wbase + ((TILE) * 4096 + ((r & 3) + 8 * (r >> 2)) * 128 + jt * 64)) = (bf16)ARR[jt][r >> 3][r & 7]; } while (0)
            LDS_WAIT();
            TM_PUT(0, fAT); TM_PUT(1, fBT); TM_PUT(2, fKT); TM_PUT(3, fRT);
            LDS_WAIT();
#undef TM_PUT
            f32x16 Aab = zero16, AabT = zero16, Aak = zero16, Arb = zero16, Ark = zero16;
#pragma unroll
            for (int s4 = 0; s4 < 4; ++s4) {
                const bf16x8 fa = *(const LAS bf16x8*)(TT + rbase + s4 * 32), fb = *(const LAS bf16x8*)(TT + rbase + 4096 + s4 * 32), fk = *(const LAS bf16x8*)(TT + rbase + 8192 + s4 * 32), fr = *(const LAS bf16x8*)(TT + rbase + 12288 + s4 * 32);
                Aab = MFMA32(fb, fa, Aab); AabT = MFMA32(fa, fb, AabT); Aak = MFMA32(fk, fa, Aak); Arb = MFMA32(fb, fr, Arb); Ark = MFMA32(fk, fr, Ark);
            }
#pragma unroll
            for (int r = 0; r < 16; ++r) { const int q = qrow(r, h);
                Aab[r] = (q < p) ? Aab[r] : 0.f;  Aak[r] = (q < p) ? Aak[r] : 0.f; AabT[r] = (p < q) ? AabT[r] : 0.f;
                Arb[r] = (q <= p) ? Arb[r] : 0.f; Ark[r] = (q <= p) ? Ark[r] : 0.f; }
            f32x16 Tm = Aab;
#pragma unroll
            for (int r = 0; r < 16; ++r) Tm[r] += (qrow(r, h) == p) ? 1.f : 0.f;
            bf16x8 X0 = accfrag(Aab, 0), X1 = accfrag(Aab, 1), XT0 = accfrag(AabT, 0), XT1 = accfrag(AabT, 1);
#pragma unroll
            for (int it = 0; it < 4; ++it) {
                f32x16 X2T = MFMA32(X0, XT0, zero16); X2T = MFMA32(X1, XT1, X2T);
                const bf16x8 T0 = accfrag(Tm, 0), T1 = accfrag(Tm, 1);
                const bf16x8 Y0 = accfrag(X2T, 0), Y1 = accfrag(X2T, 1);
                Tm = MFMA32(Y0, T0, Tm); Tm = MFMA32(Y1, T1, Tm);
                if (it < 3) { f32x16 X2 = MFMA32(XT0, X0, zero16); X2 = MFMA32(XT1, X1, X2); X0 = accfrag(X2, 0); X1 = accfrag(X2, 1); XT0 = Y0; XT1 = Y1; }
            }
            const bf16x8 Tf0 = accfrag(Tm, 0), Tf1 = accfrag(Tm, 1);
            const bf16x8 Akf0 = accfrag(Aak, 0), Akf1 = accfrag(Aak, 1), Abf0 = accfrag(Arb, 0), Abf1 = accfrag(Arb, 1), Arf0 = accfrag(Ark, 0), Arf1 = accfrag(Ark, 1);
            bf16x8 fPT[2][2], fQT[2][2];
#pragma unroll
            for (int ct = 0; ct < 2; ++ct) {
                f32x16 a_ = MFMA32(Tf0, fAT[ct][0], zero16); a_ = MFMA32(Tf1, fAT[ct][1], a_); fPT[ct][0] = accfrag(a_, 0); fPT[ct][1] = accfrag(a_, 1);
                f32x16 b_ = MFMA32(Akf0, fVT[ct][0], zero16); b_ = MFMA32(Akf1, fVT[ct][1], b_);
                const bf16x8 av0 = accfrag(b_, 0), av1 = accfrag(b_, 1);
                f32x16 c_ = MFMA32(Tf0, av0, zero16); c_ = MFMA32(Tf1, av1, c_); fQT[ct][0] = accfrag(c_, 0); fQT[ct][1] = accfrag(c_, 1);
            }
            bf16* RPo = (bf16*)(ws + WS_SRP) + item * 2048; bf16* YLo = (bf16*)(ws + WS_SYL) + item * 2048;
            bf16* Mo = (bf16*)(ws + WS_SM) + item * 4096; bf16* NTo = (bf16*)(ws + WS_SNT) + item * 4096;
#pragma unroll
            for (int ct = 0; ct < 2; ++ct) {
                f32x16 a_;
#pragma unroll
                for (int g = 0; g < 4; ++g) { const v2u w = *(const LAS v2u*)(TT + (p * 128 + 8 * h) + (12288 + (4 * ct + g) * 16));
                    a_[4 * g] = bflo(w.x); a_[4 * g + 1] = bfhi(w.x); a_[4 * g + 2] = bflo(w.y); a_[4 * g + 3] = bfhi(w.y); }
                a_ = MFMA32(fPT[ct][0], Abf0, a_); a_ = MFMA32(fPT[ct][1], Abf1, a_);
#pragma unroll
                for (int s2 = 0; s2 < 2; ++s2) *(bf16x8*)(RPo + (unsigned)(p * 64 + (4 * ct + 2 * s2 + h) * 8)) = accfrag(a_, s2);
                f32x16 y_ = MFMA32(Abf0, fQT[ct][0], zero16); y_ = MFMA32(Abf1, fQT[ct][1], y_); y_ = MFMA32(Arf0, fVT[ct][0], y_); y_ = MFMA32(Arf1, fVT[ct][1], y_);
#pragma unroll
                for (int s2 = 0; s2 < 2; ++s2) *(bf16x8*)(YLo + (unsigned)((32 * ct + p) * 32 + (2 * s2 + h) * 8)) = accfrag(y_, s2);
            }
            LDS_WAIT();
#pragma unroll
            for (int ctp = 0; ctp < 2; ++ctp) {
                const float gl = gC[32 * ctp + p];
#pragma unroll
                for (int ct = 0; ct < 2; ++ct) {
                    f32x16 m_ = MFMA32(fPT[ct][0], fBT[ctp][0], zero16); m_ = MFMA32(fPT[ct][1], fBT[ctp][1], m_);
#pragma unroll
                    for (int r = 0; r < 16; ++r) m_[r] = (m_[r] + ((ct == ctp && qrow(r, h) == p) ? 1.f : 0.f)) * gl;
#pragma unroll
                    for (int s2 = 0; s2 < 2; ++s2) *(bf16x8*)(Mo + (unsigned)((32 * ctp + p) * 64 + (4 * ct + 2 * s2 + h) * 8)) = accfrag(m_, s2);
                    __builtin_amdgcn_sched_barrier(0);
                }
            }
#pragma unroll
            for (int ctd = 0; ctd < 2; ++ctd)
#pragma unroll
                for (int ctp = 0; ctp < 2; ++ctp) {
                    f32x16 n_ = MFMA32(fBT[ctp][0], fQT[ctd][0], zero16); n_ = MFMA32(fBT[ctp][1], fQT[ctd][1], n_); n_ = MFMA32(fKT[ctp][0], fVT[ctd][0], n_); n_ = MFMA32(fKT[ctp][1], fVT[ctd][1], n_);
#pragma unroll
                    for (int g = 0; g < 4; ++g) { const f32x4 gv = *(const LAS f32x4*)(gC + 4 * h + (32 * ctp + 8 * g)); n_[4 * g] *= gv.x; n_[4 * g + 1] *= gv.y; n_[4 * g + 2] *= gv.z; n_[4 * g + 3] *= gv.w; }
#pragma unroll
                    for (int s2 = 0; s2 < 2; ++s2) *(bf16x8*)(NTo + (unsigned)((32 * ctd + p) * 64 + (4 * ctp + 2 * s2 + h) * 8)) = accfrag(n_, s2);
                    __builtin_amdgcn_sched_barrier(0);
                }
    }
}
__device__ __forceinline__ void ph_scan_local2(unsigned char* ws, LAS unsigned char* lds, int gw, int NGW, int wave, int lane_in) {
    LAS unsigned char* TT = lds + RING_OFF + wave * 16384;
    LAS float* gC = (LAS float*)(lds + LDSCTL_OFF + 4096) + wave * 64;
    for (int item = gw; item < BATCH * NCHK * NH; item += NGW) { int lane = lane_in; asm volatile("" : "+v"(lane)); scan_local2_item(ws, item, TT, gC, lane); }
}
#ifndef DRY_REP
#define DRY_REP 0
#endif
#ifndef ZG_F8
#define ZG_F8 1
#endif
#ifndef ZG_F8_L
#define ZG_F8_L 1
#endif
#ifndef FFO_F8
#define FFO_F8 1
#endif
#ifndef CARRY_ONLY_REP
#define CARRY_ONLY_REP 0
#endif
#ifndef ATTN_ONLY_REP
#define ATTN_ONLY_REP 0
#endif


__device__ __forceinline__ double rope_inv_freq(int i) {
    const double q = (i & 3) == 0 ? 1.0 : (i & 3) == 1 ? 0.5623413251903491 : (i & 3) == 2 ? 0.31622776601683794 : 0.1778279410038923;
    const double p = (i >> 2) == 0 ? 1.0 : (i >> 2) == 1 ? 0.1 : (i >> 2) == 2 ? 0.01 : 0.001;
    return q * p;
}
__device__ __forceinline__ void ph_mod_rope(const Args& a, unsigned char* ws, LAS unsigned char* lds, int gw, int NGW, int tid, int lane, int gtid, int GT) {
    const float* c = a.in[I_C]; const float* wada = a.in[I_WADA]; const float* bada = a.in[I_BADA];
    float* mod = (float*)(ws + WS_MOD);
    LAS float* cs = (LAS float*)(lds + RING_OFF);
    for (int i = tid; i < 8 * 1024; i += NWAVES * 64) { const float cv = c[i]; cs[i] = cv * sigmoidf_(cv); }
    __syncthreads();
    LAS float* red = cs + 8 * 1024;
    const int wave = tid >> 6;
    for (int it = blockIdx.x; it < 2 * 96; it += gridDim.x) {
        const int l = it / 96, jb = it % 96, kc = wave; const int j0 = jb * 64 + lane;
        float acc[8];
#pragma unroll
        for (int b = 0; b < 8; ++b) acc[b] = 0.f;
        const float* wp = wada + ((size_t)l * 1024 + kc * 128) * 6144 + j0;
#pragma unroll 16
        for (int k = 0; k < 128; ++k) { const float w = wp[(size_t)k * 6144];
#pragma unroll
            for (int b = 0; b < 8; ++b) acc[b] += w * cs[b * 1024 + kc * 128 + k]; }
        __syncthreads();
#pragma unroll
        for (int b = 0; b < 8; ++b) red[(wave * 8 + b) * 64 + lane] = acc[b];
        __syncthreads();
        { const int b = tid >> 6, j = tid & 63; float s = bada[l * 6144 + jb * 64 + j];
#pragma unroll
          for (int w = 0; w < 8; ++w) s += red[(w * 8 + b) * 64 + j];
          mod[(size_t)(l * 8 + b) * 6144 + jb * 64 + j] = s; }
    }
    const int* pos = (const int*)a.in[I_POS];
    float* ct = (float*)(ws + WS_COS); float* st = (float*)(ws + WS_SIN);
    for (int it = gtid; it < M * 16; it += GT) {
        const int t = it >> 4, i = it & 15;
        const double inv = rope_inv_freq(i);
        double rev = (double)pos[t] * inv * 0.15915494309189535;
        rev -= floor(rev);
        const float rf = (float)rev;
        ct[it] = __builtin_amdgcn_cosf(rf); st[it] = __builtin_amdgcn_sinf(rf);
    }
}

__device__ __forceinline__ void cvt_item(const float* W, int Nsrc, int K, bf16* WT, int dst_row0, int src_col0, int k0, LAS float* scr, int lane) {
    if (src_col0 >= 0) {
        const int lr = lane >> 3, lc = (lane & 7) * 4; f32x4 v[8];
        const float* src = W + (size_t)(k0 + lr) * Nsrc + src_col0 + lc;
#pragma unroll
        for (int i = 0; i < 8; ++i) v[i] = *(const f32x4*)(src + (size_t)(8 * i) * Nsrc);
#pragma unroll
        for (int i = 0; i < 8; ++i) { LAS float* dd = scr + (8 * i + lr) * 33 + lc; dd[0] = v[i].x; dd[1] = v[i].y; dd[2] = v[i].z; dd[3] = v[i].w; }
    } else {
#pragma unroll 8
        for (int i = 0; i < 32; ++i) { const int kk = 2 * i + (lane >> 5); scr[kk * 33 + (lane & 31)] = 0.f; }
    }
    LDS_WAIT();
    const int c = lane & 7;
#pragma unroll
    for (int j = 0; j < 4; ++j) { const int n = (lane >> 3) + 8 * j; const LAS float* s = scr + (8 * c) * 33 + n;
        v4u o; o.x = pk2(s[0 * 33], s[1 * 33]); o.y = pk2(s[2 * 33], s[3 * 33]); o.z = pk2(s[4 * 33], s[5 * 33]); o.w = pk2(s[6 * 33], s[7 * 33]);
        *(v4u*)(WT + (size_t)(dst_row0 + n) * K + k0 + 8 * c) = o; }
    LDS_WAIT();
}
__device__ __forceinline__ int swiglu_src_col(int nrow, int F) { const int pn = nrow >> 8, within = nrow & 255; return (within >> 7) * F + pn * 128 + (within & 127); }

__device__ __forceinline__ void cvt_item_f8(const float* W, int Nsrc, int K, unsigned char* WT, int dst_row0, int src_col0, int k0, LAS float* scr, int lane) {
    { const int lr = lane >> 3, lc = (lane & 7) * 4; f32x4 v[8];
      const float* src = W + (size_t)(k0 + lr) * Nsrc + src_col0 + lc;
#pragma unroll
      for (int i = 0; i < 8; ++i) v[i] = *(const f32x4*)(src + (size_t)(8 * i) * Nsrc);
#pragma unroll
      for (int i = 0; i < 8; ++i) { LAS float* dd = scr + (8 * i + lr) * 33 + lc; dd[0] = v[i].x * F8_WSCALE; dd[1] = v[i].y * F8_WSCALE; dd[2] = v[i].z * F8_WSCALE; dd[3] = v[i].w * F8_WSCALE; } }
    LDS_WAIT();
    const int c = lane & 3;
#pragma unroll
    for (int j = 0; j < 2; ++j) { const int n = (lane >> 2) + 16 * j; const LAS float* s = scr + (16 * c) * 33 + n;
        v4u o; o.x = f8pk4(s[0 * 33], s[1 * 33], s[2 * 33], s[3 * 33]); o.y = f8pk4(s[4 * 33], s[5 * 33], s[6 * 33], s[7 * 33]);
        o.z = f8pk4(s[8 * 33], s[9 * 33], s[10 * 33], s[11 * 33]); o.w = f8pk4(s[12 * 33], s[13 * 33], s[14 * 33], s[15 * 33]);
        *(v4u*)(WT + (size_t)(dst_row0 + n) * K + k0 + 16 * c) = o; }
    LDS_WAIT();
}
__device__ __forceinline__ void cvt_f8_load(f32x4 (&v)[8], const float* W, int Nsrc, int src_col0, int k0, int lane) {
    const int lr = lane >> 3, lc = (lane & 7) * 4; const float* src = W + (size_t)(k0 + lr) * Nsrc + src_col0 + lc;
#pragma unroll
    for (int i = 0; i < 8; ++i) v[i] = *(const f32x4*)(src + (size_t)(8 * i) * Nsrc);
}
__device__ __forceinline__ void cvt_f8_finish(const f32x4 (&v)[8], int K, unsigned char* WT, int dst_row0, int k0, LAS float* scr, int lane) {
    { const int lr = lane >> 3, lc = (lane & 7) * 4;
#pragma unroll
      for (int i = 0; i < 8; ++i) { LAS float* dd = scr + (8 * i + lr) * 33 + lc; dd[0] = v[i].x * F8_WSCALE; dd[1] = v[i].y * F8_WSCALE; dd[2] = v[i].z * F8_WSCALE; dd[3] = v[i].w * F8_WSCALE; } }
    LDS_WAIT();
    const int c = lane & 3;
#pragma unroll
    for (int j = 0; j < 2; ++j) { const int n = (lane >> 2) + 16 * j; const LAS float* s = scr + (16 * c) * 33 + n;
        v4u o; o.x = f8pk4(s[0 * 33], s[1 * 33], s[2 * 33], s[3 * 33]); o.y = f8pk4(s[4 * 33], s[5 * 33], s[6 * 33], s[7 * 33]);
        o.z = f8pk4(s[8 * 33], s[9 * 33], s[10 * 33], s[11 * 33]); o.w = f8pk4(s[12 * 33], s[13 * 33], s[14 * 33], s[15 * 33]);
        *(v4u*)(WT + (size_t)(dst_row0 + n) * K + k0 + 16 * c) = o; }
    LDS_WAIT();
}
__device__ __forceinline__ void ph_convert(const Args& a, unsigned char* ws, LAS unsigned char* lds, int gw, int NGW, int wave, int lane, int part) {
    LAS float* scr = (LAS float*)(lds + RING_OFF + wave * 16384);
    constexpr int I_WIN = 80 * 16;
    constexpr int I_WO = 32 * 16;
    constexpr int I_FI = 176 * 16;
    constexpr int I_FO = 32 * 44;
    constexpr int I_MI = 224 * 16;
    constexpr int I_MO = 32 * 56;
    constexpr int NITEMS = 2 * I_WIN + 2 * I_WO + I_FI + I_FO + 8 * I_MI + 8 * I_MO;
    constexpr int NDENSE = 2 * I_WIN + 2 * I_WO + I_FI + I_FO, HALFMOE = (NITEMS - NDENSE) / 2;
    static_assert((NITEMS - NDENSE) % 2 == 0, "MoE items");
    constexpr int NMIX = 2 * I_WIN + 2 * I_WO;
    const int lo = part == 0 ? 0 : NDENSE + (part - 1) * HALFMOE, hi = part == 0 ? NMIX : lo + HALFMOE;
    if (part == 1) {
        for (int it = NMIX + gw; it < NDENSE; it += NGW) { int r = it - NMIX;
            if (r < I_FI) { const int nb = r / 16, kb = r % 16;
                cvt_item(a.in[I_FFI], 2 * DFF, 1024, (bf16*)(ws + WS_WFFI), nb * 32, swiglu_src_col(nb * 32, DFF), kb * 64, scr, lane); continue; }
            r -= I_FI;
            { const int nb = r / 44, kb = r % 44;
#if FFO_F8
              cvt_item_f8(a.in[I_FFO], 1024, DFF, ws + WS_WFFO, nb * 32, nb * 32, kb * 64, scr, lane); } }
#else
              cvt_item(a.in[I_FFO], 1024, DFF, (bf16*)(ws + WS_WFFO), nb * 32, nb * 32, kb * 64, scr, lane); } }
#endif
    }
    if (part != 0) {
        const float* Wc; int Nc, Kc, drc, scc, k0c; unsigned char* WTc;
#define MOE_DECODE(it_, W_, N_, K_, WT_, dr_, sc_, k0_) do { int r_ = (it_) - NDENSE; \
            if (r_ < 8 * I_MI) { const int e_ = r_ / I_MI; r_ %= I_MI; const int nb_ = r_ / 16, kb_ = r_ % 16; W_ = a.in[I_MOEI] + (size_t)e_ * 1024 * 2 * DFFE; N_ = 2 * DFFE; K_ = 1024; \
                WT_ = ws + WS_WMI + (size_t)e_ * 2 * DFFE * 1024; dr_ = nb_ * 32; sc_ = swiglu_src_col(nb_ * 32, DFFE); k0_ = kb_ * 64; } \
            else { r_ -= 8 * I_MI; const int e_ = r_ / I_MO; r_ %= I_MO; const int nb_ = r_ / 56, kb_ = r_ % 56; W_ = a.in[I_MOEO] + (size_t)e_ * DFFE * 1024; N_ = 1024; K_ = DFFE; \
                WT_ = ws + WS_WMO + (size_t)e_ * 1024 * DFFE; dr_ = nb_ * 32; sc_ = nb_ * 32; k0_ = kb_ * 64; } } while (0)
        f32x4 b0[8], b1[8], b2[8], b3[8];
#define CV_LOAD(BUF, idx) do { const int it_ = lo + gw + (idx) * NGW; if (it_ < hi) { MOE_DECODE(it_, Wc, Nc, Kc, WTc, drc, scc, k0c); cvt_f8_load(BUF, Wc, Nc, scc, k0c, lane); } } while (0)
#define CV_FIN(BUF, idx) do { const int it_ = lo + gw + (idx) * NGW; if (it_ < hi) { MOE_DECODE(it_, Wc, Nc, Kc, WTc, drc, scc, k0c); cvt_f8_finish(BUF, Kc, WTc, drc, k0c, scr, lane); } } while (0)
        CV_LOAD(b0, 0); CV_LOAD(b1, 1); CV_LOAD(b2, 2);
#pragma unroll 1
        for (int k = 0; lo + gw + k * NGW < hi; k += 4) {
            CV_LOAD(b3, k + 3); CV_FIN(b0, k);
            CV_LOAD(b0, k + 4); CV_FIN(b1, k + 1);
            CV_LOAD(b1, k + 5); CV_FIN(b2, k + 2);
            CV_LOAD(b2, k + 6); CV_FIN(b3, k + 3);
        }
#undef CV_LOAD
#undef CV_FIN
#undef MOE_DECODE
        return;
    }
    for (int it = lo + gw; it < hi; it += NGW) {
        int r = it;
        if (r < 2 * I_WIN) { const int l = r / I_WIN; r %= I_WIN; const int nb = r / 16, kb = r % 16;
            const int nvalid = l == 0 ? N_IN0 / 32 : N_IN1 / 32;
#if ZG_F8
            if (l < ZG_F8_L) { cvt_item(a.in[l == 0 ? I_WIN0 : I_WIN1], l == 0 ? N_IN0 : N_IN1, 1024, (bf16*)(ws + WS_WIN) + (size_t)l * NZ * 1024, nb * 32, nb < nvalid ? nb * 32 : -1, kb * 64, scr, lane); continue; }
            if (nb < nvalid) cvt_item_f8(a.in[l == 0 ? I_WIN0 : I_WIN1], l == 0 ? N_IN0 : N_IN1, 1024, ws + WS_WIN + (size_t)l * NZ * 2048, nb * 32, nb * 32, kb * 64, scr, lane);
            else { unsigned char* WT = ws + WS_WIN + (size_t)l * NZ * 2048; const int c = lane & 3;
                for (int j = 0; j < 2; ++j) { const int n = (lane >> 2) + 16 * j; *(v4u*)(WT + (size_t)(nb * 32 + n) * 1024 + kb * 64 + 16 * c) = (v4u){0u, 0u, 0u, 0u}; } }
            continue; }
#else
            cvt_item(a.in[l == 0 ? I_WIN0 : I_WIN1], l == 0 ? N_IN0 : N_IN1, 1024, (bf16*)(ws + WS_WIN) + (size_t)l * NZ * 1024, nb * 32, nb < nvalid ? nb * 32 : -1, kb * 64, scr, lane); continue; }
#endif
        r -= 2 * I_WIN;
        if (r < 2 * I_WO) { const int l = r / I_WO; r %= I_WO; const int nb = r / 16, kb = r % 16;
            cvt_item(a.in[I_WOUT] + (size_t)l * 1024 * 1024, 1024, 1024, (bf16*)(ws + WS_WOUT) + (size_t)l * 1024 * 1024, nb * 32, nb * 32, kb * 64, scr, lane); continue; }
        r -= 2 * I_WO;
        if (r < I_FI) { const int nb = r / 16, kb = r % 16;
            cvt_item(a.in[I_FFI], 2 * DFF, 1024, (bf16*)(ws + WS_WFFI), nb * 32, swiglu_src_col(nb * 32, DFF), kb * 64, scr, lane); continue; }
        r -= I_FI;
        if (r < I_FO) { const int nb = r / 44, kb = r % 44;
            cvt_item(a.in[I_FFO], 1024, DFF, (bf16*)(ws + WS_WFFO), nb * 32, nb * 32, kb * 64, scr, lane); continue; }
        r -= I_FO;
        if (r < 8 * I_MI) { const int e = r / I_MI; r %= I_MI; const int nb = r / 16, kb = r % 16;
            cvt_item_f8(a.in[I_MOEI] + (size_t)e * 1024 * 2 * DFFE, 2 * DFFE, 1024, ws + WS_WMI + (size_t)e * 2 * DFFE * 1024, nb * 32, swiglu_src_col(nb * 32, DFFE), kb * 64, scr, lane); continue; }
        r -= 8 * I_MI;
        { const int e = r / I_MO; r %= I_MO; const int nb = r / 56, kb = r % 56;
            cvt_item_f8(a.in[I_MOEO] + (size_t)e * DFFE * 1024, 1024, DFFE, ws + WS_WMO + (size_t)e * 1024 * DFFE, nb * 32, nb * 32, kb * 64, scr, lane); }
    }
}

template <bool XB16> __device__ __forceinline__ f32x4 ld_x4(const void* x, size_t row, int idx) {
    if constexpr (XB16) { const v2u r = ((const v2u*)((const bf16*)x + row * D))[idx]; return (f32x4){bflo(r.x), bfhi(r.x), bflo(r.y), bfhi(r.y)}; }
    else return ((const f32x4*)((const float*)x + row * D))[idx];
}
template <bool ROUTE, bool F8OUT = false, bool XB16 = false>
__device__ __forceinline__ void ph_norm(const void* x, const float* gain, const float* mod_shift  , bf16* h,
                                        const float* router, unsigned char* ws, int gw, int NGW, int lane, LAS unsigned char* lds = nullptr) {
    if constexpr (!ROUTE) {
        for (int m0 = gw; m0 < M; m0 += 2 * NGW) {
            const int m1 = m0 + NGW < M ? m0 + NGW : m0;
            f32x4 v0[4], v1[4]; float s0 = 0.f, s1 = 0.f;
#pragma unroll
            for (int j = 0; j < 4; ++j) { v0[j] = ld_x4<XB16>(x, (size_t)m0, lane + 64 * j); v1[j] = ld_x4<XB16>(x, (size_t)m1, lane + 64 * j); }
#pragma unroll
            for (int j = 0; j < 4; ++j) { s0 += (v0[j].x * v0[j].x + v0[j].y * v0[j].y) + (v0[j].z * v0[j].z + v0[j].w * v0[j].w); s1 += (v1[j].x * v1[j].x + v1[j].y * v1[j].y) + (v1[j].z * v1[j].z + v1[j].w * v1[j].w); }
            const int b0 = m0 / T, b1 = m1 / T;
            const f32x4* gp = (const f32x4*)gain + lane;
            const f32x4* sh0 = (const f32x4*)(mod_shift + (size_t)b0 * 6144) + lane; const f32x4* sc0 = (const f32x4*)(mod_shift + (size_t)b0 * 6144 + 1024) + lane;
            const f32x4* sh1 = (const f32x4*)(mod_shift + (size_t)b1 * 6144) + lane; const f32x4* sc1 = (const f32x4*)(mod_shift + (size_t)b1 * 6144 + 1024) + lane;
            f32x4 gq[4], h0[4], c0[4], h1[4], c1[4];
#pragma unroll
            for (int j = 0; j < 4; ++j) { gq[j] = gp[64 * j]; h0[j] = sh0[64 * j]; c0[j] = sc0[64 * j]; h1[j] = sh1[64 * j]; c1[j] = sc1[64 * j]; }
            const float rs0 = 1.f / sqrtf(wave_sum(s0) * (1.f / D) + 1e-6f), rs1 = 1.f / sqrtf(wave_sum(s1) * (1.f / D) + 1e-6f);
            unsigned long long* o0 = (unsigned long long*)(h + (size_t)m0 * D) + lane; unsigned long long* o1 = (unsigned long long*)(h + (size_t)m1 * D) + lane;
#pragma unroll
            for (int j = 0; j < 4; ++j) { const f32x4 g = gq[j];
                const f32x4 a0 = (v0[j] * rs0) * g * (c0[j] + 1.f) + h0[j], a1 = (v1[j] * rs1) * g * (c1[j] + 1.f) + h1[j];
                if constexpr (F8OUT) { ((unsigned*)((unsigned char*)h + (size_t)m0 * D))[lane + 64 * j] = f8pk4(a0.x * F8_HSCALE, a0.y * F8_HSCALE, a0.z * F8_HSCALE, a0.w * F8_HSCALE);
                                       ((unsigned*)((unsigned char*)h + (size_t)m1 * D))[lane + 64 * j] = f8pk4(a1.x * F8_HSCALE, a1.y * F8_HSCALE, a1.z * F8_HSCALE, a1.w * F8_HSCALE); }
                else {
                o0[64 * j] = (unsigned long long)pk2(a0.x, a0.y) | ((unsigned long long)pk2(a0.z, a0.w) << 32);
                o1[64 * j] = (unsigned long long)pk2(a1.x, a1.y) | ((unsigned long long)pk2(a1.z, a1.w) << 32); } }
        }
        return;
    }
    int se0 = 0, se1 = 0, sm = 0, nb = 0; float sg0 = 0.f, sg1 = 0.f;
    LAS float* rt = (LAS float*)(lds + RING_OFF);
    for (int i = tidx_(); i < 1024 * 8 / 4; i += NWAVES * 64) ((LAS f32x4*)rt)[i] = ((const f32x4*)router)[i];
    __syncthreads();
    for (int m = gw; m < M; m += NGW) {
        const int b = m / T;
        const f32x4* gp = (const f32x4*)gain + lane; const f32x4* shp = (const f32x4*)(mod_shift + (size_t)b * 6144) + lane; const f32x4* scp = (const f32x4*)(mod_shift + (size_t)b * 6144 + 1024) + lane;
        f32x4 v[4], gq[4], hq_[4], cq[4]; float s = 0.f;
#pragma unroll
        for (int j = 0; j < 4; ++j) { v[j] = ld_x4<XB16>(x, (size_t)m, lane + 64 * j); gq[j] = gp[64 * j]; hq_[j] = shp[64 * j]; cq[j] = scp[64 * j]; }
#pragma unroll
        for (int j = 0; j < 4; ++j) s += (v[j].x * v[j].x + v[j].y * v[j].y) + (v[j].z * v[j].z + v[j].w * v[j].w);
        const float rs = 1.f / sqrtf(wave_sum(s) * (1.f / D) + 1e-6f);
        unsigned long long* o8 = (unsigned long long*)(h + (size_t)m * D) + lane;
#pragma unroll
        for (int j = 0; j < 4; ++j) { const f32x4 g = gq[j], sh = hq_[j], sc = cq[j];
            v[j] = (v[j] * rs) * g * (sc + 1.f) + sh;
            if constexpr (F8OUT) ((unsigned*)((unsigned char*)h + (size_t)m * D))[lane + 64 * j] = f8pk4(v[j].x * F8_HSCALE, v[j].y * F8_HSCALE, v[j].z * F8_HSCALE, v[j].w * F8_HSCALE);
            else o8[64 * j] = (unsigned long long)pk2(v[j].x, v[j].y) | ((unsigned long long)pk2(v[j].z, v[j].w) << 32); }
        if constexpr (ROUTE) {
            float lg[8];
#pragma unroll
            for (int e = 0; e < 8; ++e) lg[e] = 0.f;
#pragma unroll
            for (int j = 0; j < 4; ++j)
#pragma unroll
                for (int q = 0; q < 4; ++q) { const int d = 256 * j + 4 * lane + q; const f32x4 r0 = *(const LAS f32x4*)(rt + d * 8), r1 = *(const LAS f32x4*)(rt + d * 8 + 4); const float hv = v[j][q];
                    lg[0] += hv * r0.x; lg[1] += hv * r0.y; lg[2] += hv * r0.z; lg[3] += hv * r0.w; lg[4] += hv * r1.x; lg[5] += hv * r1.y; lg[6] += hv * r1.z; lg[7] += hv * r1.w; }
#pragma unroll
            for (int e = 0; e < 8; ++e) lg[e] = wave_sum(lg[e]);
            int i0 = 0; float v0 = lg[0];
#pragma unroll
            for (int e = 1; e < 8; ++e) if (lg[e] > v0) { v0 = lg[e]; i0 = e; }
            int i1 = -1; float v1 = -3.0e38f;
#pragma unroll
            for (int e = 0; e < 8; ++e) if (e != i0 && lg[e] > v1) { v1 = lg[e]; i1 = e; }
            const float e1 = __expf(v1 - v0), g0 = 1.f / (1.f + e1), g1 = e1 / (1.f + e1);
            if (lane == nb) { se0 = i0; se1 = i1; sg0 = g0; sg1 = g1; sm = m; }
            ++nb;
        }
        if constexpr (ROUTE) {
            if (nb == 16 || m + NGW >= M) {
                const bool act = lane < nb; const unsigned long long lt = (1ull << lane) - 1ull;
                unsigned long long m0[8], m1[8]; unsigned myc = 0;
#pragma unroll
                for (int e = 0; e < 8; ++e) { m0[e] = __ballot(act && se0 == e); m1[e] = __ballot(act && se1 == e); const unsigned ce = (unsigned)(__popcll(m0[e]) + __popcll(m1[e])); myc = (lane == e) ? ce : myc; }
                unsigned base = 0;
                if (lane < 8) base = __hip_atomic_fetch_add((unsigned*)ws + CW_MOE + 64 * lane, myc, RLX_AGENT);
                int p0 = 0, p1 = 0;
#pragma unroll
                for (int e = 0; e < 8; ++e) { const unsigned be = (unsigned)__shfl((int)base, e);
                    if (se0 == e) p0 = (int)(be + (unsigned)__popcll(m0[e] & lt));
                    if (se1 == e) p1 = (int)(be + (unsigned)__popcll(m0[e]) + (unsigned)__popcll(m1[e] & lt)); }
                if (act) { ((int*)(ws + WS_TOK))[se0 * MOE_CAP + p0] = sm; ((float*)(ws + WS_GATE))[se0 * MOE_CAP + p0] = sg0; ((int*)(ws + WS_ASG))[sm * 2] = se0 * MOE_CAP + p0;
                           ((int*)(ws + WS_TOK))[se1 * MOE_CAP + p1] = sm; ((float*)(ws + WS_GATE))[se1 * MOE_CAP + p1] = sg1; ((int*)(ws + WS_ASG))[sm * 2 + 1] = se1 * MOE_CAP + p1; }
                nb = 0;
            }
        }
    }
}

__device__ __forceinline__ void ph_postz(const Args& a, unsigned char* ws, LAS unsigned char* lds, int l, int gw, int NGW, int wave, int lane) {
    LAS float* S = (LAS float*)(lds + RING_OFF + wave * 16384);
    LAS float* xw = S, *xa = S + 64, *xg = S + 128, *xv = S + 288, *pp = S + 320, *qn = S + 576, *kvn = S + 832, *qb = S + 960, *kvb = S + 1344, *kpe = S + 1856, *qpe = S + 1888;
    const bf16* z = (const bf16*)(ws + WS_Z);
    const float* mu = a.in[I_MU] + l * SHIFT_COLS; const float* muv = a.in[I_MUV];
    const float* rvec = a.in[I_RVEC] + l * 7 * RW; const float* w2 = a.in[I_RW2] + (size_t)l * 64 * RW; const float* a2 = a.in[I_RA2] + (size_t)l * 64 * RW;
    const float* g2 = a.in[I_RG2] + (size_t)l * 160 * RW; const float* v2 = a.in[I_RV2]; const float* v0p = a.in[I_RV0];
    bf16* Rr = (bf16*)(ws + WS_R); bf16* Kr = (bf16*)(ws + WS_K); bf16* Vr = (bf16*)(ws + WS_V); bf16* KKr = (bf16*)(ws + WS_KK); bf16* Ar = (bf16*)(ws + WS_A);
    float* LWr = (float*)(ws + WS_LW); bf16* Gr = (bf16*)(ws + WS_G); bf16* VF = (bf16*)(ws + WS_VF); bf16* mix = (bf16*)(ws + WS_MIX);
    bf16* QM = (bf16*)(ws + WS_QM); bf16* KM = (bf16*)(ws + WS_KM); bf16* VM = (bf16*)(ws + WS_VM);
    const float* poolw = a.in[I_POOLW] + (size_t)l * 4 * 64 * 64; const float* pools = a.in[I_POOLS] + l * 256;
    const float* qlg = a.in[I_QLG] + l * 256; const float* kvlg = a.in[I_KVLG] + l * 128; const float* wqup = a.in[I_WQUP] + (size_t)l * 256 * 384; const float* wkvup = a.in[I_WKVUP] + (size_t)l * 128 * 512;
    const float* qkg = a.in[I_QKG] + l * 2 * 96; const float* ct = (const float*)(ws + WS_COS); const float* st = (const float*)(ws + WS_SIN);
    for (int m = gw; m < M; m += NGW) {
        const int tt = m % T; const bool hp = tt > 0;
        const bf16* zr = z + (size_t)m * NZ; const bf16* zp = zr - NZ;
#define ZS(col) ({ const int c_ = (col); const float zc_ = bf2f(zr[c_]); const float zq_ = hp ? bf2f(zp[c_]) : 0.f; zc_ + mu[c_] * (zq_ - zc_); })
        LDS_WAIT();
        xw[lane] = tanhf_(ZS(OFF_WD + lane)); xa[lane] = ZS(OFF_AD + lane);
        xg[lane] = sigmoidf_(ZS(OFF_GD + lane)); xg[lane + 64] = sigmoidf_(ZS(OFF_GD + 64 + lane)); if (lane < 32) xg[lane + 128] = sigmoidf_(ZS(OFF_GD + 128 + lane));
        if (l > 0 && lane < 32) { const float zc = bf2f(zr[OFF_VD + lane]); const float zq = hp ? bf2f(zp[OFF_VD + lane]) : 0.f; xv[lane] = zc + muv[lane] * (zq - zc); }
#pragma unroll
        for (int gi = 0; gi < 4; ++gi) { const int win = 2 << gi; const int cnt = (tt + 1) < win ? (tt + 1) : win; const int col = OFF_POOL + gi * 64 + lane;
            float s = 0.f; for (int q = 0; q < cnt; ++q) s += bf2f(zr[col - q * NZ]);
            pp[gi * 64 + lane] = s / (float)cnt - bf2f(zr[col]); }
        { float q4[4]; float s = 0.f;
#pragma unroll
          for (int j = 0; j < 4; ++j) { q4[j] = bf2f(zr[OFF_QLAT + lane + 64 * j]); s += q4[j] * q4[j]; }
          const float rs = 1.f / sqrtf(wave_sum(s) * (1.f / 256.f) + 1e-6f);
#pragma unroll
          for (int j = 0; j < 4; ++j) qn[lane + 64 * j] = q4[j] * rs * qlg[lane + 64 * j];
          float k2[2]; s = 0.f;
#pragma unroll
          for (int j = 0; j < 2; ++j) { k2[j] = bf2f(zr[OFF_KVLAT + lane + 64 * j]); s += k2[j] * k2[j]; }
          const float rk = 1.f / sqrtf(wave_sum(s) * (1.f / 128.f) + 1e-6f);
#pragma unroll
          for (int j = 0; j < 2; ++j) kvn[lane + 64 * j] = k2[j] * rk * kvlg[lane + 64 * j];
          if (lane < 16) { const float x1 = bf2f(zr[OFF_KROPE + lane]), x2 = bf2f(zr[OFF_KROPE + 16 + lane]); const float cs = ct[m * 16 + lane], sn = st[m * 16 + lane];
              kpe[lane] = x1 * cs - x2 * sn; kpe[lane + 16] = x1 * sn + x2 * cs; } }
        LDS_WAIT();
#pragma nounroll
        for (int hh = 0; hh < NH; ++hh) {
            const int c = hh * 64 + lane;
            const float r = ZS(c), k0 = ZS(512 + c), v0 = ZS(1024 + c);
            float wlo = 0.f, alo = 0.f, gg = 0.f;
#pragma unroll 4
            for (int i = 0; i < 64; ++i) { wlo += xw[i] * w2[i * RW + c]; alo += xa[i] * a2[i * RW + c]; }
#pragma unroll 4
            for (int i = 0; i < 160; ++i) gg += xg[i] * g2[i * RW + c];
            float v = v0;
            if (l == 0) { VF[(size_t)m * RW + c] = (bf16)f2bf(v0); }
            else { float vlo = 0.f;
#pragma unroll 4
                for (int i = 0; i < 32; ++i) vlo += xv[i] * v2[i * RW + c]; const float vf = bf2f(VF[(size_t)m * RW + c]); v = v0 + (vf - v0) * sigmoidf_(v0p[c] + vlo); }
            const float lw = -0.6065306597126334f * sigmoidf_(rvec[0 * RW + c] + wlo);
            const float aa = sigmoidf_(rvec[1 * RW + c] + alo);
            const float kkr = k0 * rvec[2 * RW + c];
            const float nrm = sqrtf(wave_sum(kkr * kkr));
            const float kk = kkr / fmaxf(nrm, 1e-12f);
            const float k = k0 * (1.f + (aa - 1.f) * rvec[3 * RW + c]);
            { const float bsum = wave_sum(bf2f((bf16)f2bf(r)) * bf2f((bf16)f2bf(k)) * rvec[4 * RW + c]); if (lane == 0) ((float*)(ws + WS_BON))[(size_t)m * 8 + hh] = bsum; }
            const size_t o = (size_t)m * RW + c;
            Rr[o] = (bf16)f2bf(r); Kr[o] = (bf16)f2bf(k); Vr[o] = (bf16)f2bf(v); KKr[o] = (bf16)f2bf(kk); Ar[o] = (bf16)f2bf(aa); LWr[o] = lw; Gr[o] = (bf16)f2bf(gg);
        }
#pragma nounroll
        for (int gi = 0; gi < 4; ++gi) { float y = 0.f; const float* wp = poolw + gi * 4096 + lane;
#pragma unroll 4
            for (int c = 0; c < 64; ++c) y += pp[gi * 64 + c] * wp[c * 64];
            mix[(size_t)m * D + 512 + gi * 64 + lane] = (bf16)f2bf(y * pools[gi * 64 + lane]); }
        { float ac[6];
#pragma unroll
          for (int j = 0; j < 6; ++j) ac[j] = 0.f;
#pragma unroll 2
          for (int i = 0; i < 256; ++i) { const float xv_ = qn[i];
#pragma unroll
              for (int j = 0; j < 6; ++j) ac[j] += xv_ * wqup[i * 384 + lane + 64 * j]; }
#pragma unroll
          for (int j = 0; j < 6; ++j) qb[lane + 64 * j] = ac[j]; }
        { float ac[8];
#pragma unroll
          for (int j = 0; j < 8; ++j) ac[j] = 0.f;
#pragma unroll 2
          for (int i = 0; i < 128; ++i) { const float xv_ = kvn[i];
#pragma unroll
              for (int j = 0; j < 8; ++j) ac[j] += xv_ * wkvup[i * 512 + lane + 64 * j]; }
#pragma unroll
          for (int j = 0; j < 8; ++j) kvb[lane + 64 * j] = ac[j]; }
        LDS_WAIT();
        { const int hq = lane >> 4, i = lane & 15; const float x1 = qb[hq * 96 + 64 + i], x2 = qb[hq * 96 + 80 + i]; const float cs = ct[m * 16 + i], sn = st[m * 16 + i];
          qpe[hq * 32 + i] = x1 * cs - x2 * sn; qpe[hq * 32 + 16 + i] = x1 * sn + x2 * cs; }
        LDS_WAIT();
#pragma unroll
        for (int hq = 0; hq < MLA_H; ++hq) {
            const float qa = qb[hq * 96 + lane], qr_ = lane < 32 ? qpe[hq * 32 + lane] : 0.f;
            const float ka = kvb[hq * 128 + lane], kr_ = lane < 32 ? kpe[lane] : 0.f;
            const float rq = 1.f / sqrtf(wave_sum(qa * qa + qr_ * qr_) * (1.f / 96.f) + 1e-6f);
            const float rk = 1.f / sqrtf(wave_sum(ka * ka + kr_ * kr_) * (1.f / 96.f) + 1e-6f);
            QM[(size_t)m * 384 + hq * 96 + lane] = (bf16)f2bf(qa * rq * qkg[lane]); KM[(size_t)m * 384 + hq * 96 + lane] = (bf16)f2bf(ka * rk * qkg[96 + lane]);
            if (lane < 32) { QM[(size_t)m * 384 + hq * 96 + 64 + lane] = (bf16)f2bf(qr_ * rq * qkg[64 + lane]); KM[(size_t)m * 384 + hq * 96 + 64 + lane] = (bf16)f2bf(kr_ * rk * qkg[96 + 64 + lane]); }
            VM[(size_t)m * 256 + hq * 64 + lane] = (bf16)f2bf(kvb[hq * 128 + 64 + lane]);
        }
#undef ZS
    }
}

__device__ __forceinline__ void ph_scan_naive(const Args& a, unsigned char* ws, int l, int bh, int lane) {
    const int b = bh / NH, hh = bh % NH; const int c = hh * 64 + lane;
    const bf16* Rr = (const bf16*)(ws + WS_R); const bf16* Kr = (const bf16*)(ws + WS_K); const bf16* Vr = (const bf16*)(ws + WS_V); const bf16* KKr = (const bf16*)(ws + WS_KK); const bf16* Ar = (const bf16*)(ws + WS_A);
    const float* LWr = (const float*)(ws + WS_LW); const bf16* Gr = (const bf16*)(ws + WS_G); bf16* mix = (bf16*)(ws + WS_MIX);
    const float* rvec = a.in[I_RVEC] + l * 7 * RW; const float rk_ = rvec[4 * RW + c], lng = rvec[5 * RW + c], lnb = rvec[6 * RW + c];
    float S[64];
#pragma unroll
    for (int j = 0; j < 64; ++j) S[j] = 0.f;
    size_t o = (size_t)(b * T) * RW + c;
    float r = bf2f(Rr[o]), k = bf2f(Kr[o]), v = bf2f(Vr[o]), kk = bf2f(KKr[o]), aa = bf2f(Ar[o]), lw = LWr[o], g = bf2f(Gr[o]);
    for (int t = 0; t < T; ++t) {
        const size_t on = o + (t + 1 < T ? RW : 0);
        const float rn = bf2f(Rr[on]), kn = bf2f(Kr[on]), vn = bf2f(Vr[on]), kkn = bf2f(KKr[on]), aan = bf2f(Ar[on]), lwn = LWr[on], gn = bf2f(Gr[on]);
        const float w = __expf(lw), na = -kk, bb = kk * aa;
        float sa = 0.f;
#pragma unroll
        for (int j = 0; j < 64; ++j) sa += S[j] * __int_as_float(__builtin_amdgcn_readlane(__float_as_int(na), j));
        float y = 0.f;
#pragma unroll
        for (int j = 0; j < 64; ++j) {
            const float wj = __int_as_float(__builtin_amdgcn_readlane(__float_as_int(w), j)), bj = __int_as_float(__builtin_amdgcn_readlane(__float_as_int(bb), j));
            const float kj = __int_as_float(__builtin_amdgcn_readlane(__float_as_int(k), j)), rj = __int_as_float(__builtin_amdgcn_readlane(__float_as_int(r), j));
            S[j] = S[j] * wj + sa * bj + v * kj; y += S[j] * rj; }
        const float mu = wave_sum(y) * (1.f / 64.f); const float dy = y - mu; const float var = wave_sum(dy * dy) * (1.f / 64.f);
        const float yn = dy * (1.f / sqrtf(var + 64e-5f)) * lng + lnb;
        const float bon = wave_sum(r * k * rk_) * v;
        mix[(size_t)(b * T + t) * D + c] = (bf16)f2bf((yn + bon) * g);
        o = on; r = rn; k = kn; v = vn; kk = kkn; aa = aan; lw = lwn; g = gn;
    }
}

__device__ __forceinline__ void ph_attn_naive(unsigned char* ws, LAS unsigned char* lds, int unit, int tid) {
    const int bh = unit >> 3, qb = unit & 7; const int b = bh >> 2, hq = bh & 3;
    const bf16* QM = (const bf16*)(ws + WS_QM); const bf16* KM = (const bf16*)(ws + WS_KM); const bf16* VM = (const bf16*)(ws + WS_VM); bf16* mix = (bf16*)(ws + WS_MIX);
    LAS float* Ks = (LAS float*)(lds + RING_OFF);
    LAS float* Vs = Ks + 64 * 96;
    const int qpos = qb * 512 + tid; const size_t qrow = (size_t)(b * T + qpos);
    float q[96];
    const float sc = 1.f;
#pragma unroll
    for (int d = 0; d < 96; ++d) q[d] = bf2f(QM[qrow * 384 + hq * 96 + d]) * sc;
    float o[64];
#pragma unroll
    for (int d = 0; d < 64; ++d) o[d] = 0.f;
    float mx = -3.0e38f, lsum = 0.f;
    const int ntile = (qb * 512 + 511) / 64 + 1;
    const int wave_qmax = qb * 512 + (tid | 63);
    for (int kt = 0; kt < ntile; ++kt) {
        __syncthreads();
        for (int i = tid; i < 64 * 96; i += 512) { const int kr = i / 96, d = i % 96; Ks[i] = bf2f(KM[(size_t)(b * T + kt * 64 + kr) * 384 + hq * 96 + d]); }
        for (int i = tid; i < 64 * 64; i += 512) { const int kr = i >> 6, d = i & 63; Vs[i] = bf2f(VM[(size_t)(b * T + kt * 64 + kr) * 256 + hq * 64 + d]); }
        __syncthreads();
        if (kt * 64 > wave_qmax) continue;
        for (int j = 0; j < 64; ++j) {
            const int kpos = kt * 64 + j;
            float s = 0.f;
#pragma unroll
            for (int d = 0; d < 96; d += 4) { const f32x4 kv = *(const LAS f32x4*)(Ks + j * 96 + d); s += q[d] * kv.x + q[d + 1] * kv.y + q[d + 2] * kv.z + q[d + 3] * kv.w; }
            if (kpos > qpos) s = -3.0e38f;
            const float mn = fmaxf(mx, s); const float corr = exp2f(mx - mn), p = exp2f(s - mn);
            lsum = lsum * corr + p; mx = mn;
#pragma unroll
            for (int d = 0; d < 64; d += 4) { const f32x4 vv = *(const LAS f32x4*)(Vs + j * 64 + d); o[d] = o[d] * corr + p * vv.x; o[d + 1] = o[d + 1] * corr + p * vv.y; o[d + 2] = o[d + 2] * corr + p * vv.z; o[d + 3] = o[d + 3] * corr + p * vv.w; }
        }
    }
    const float il = 1.f / lsum;
#pragma unroll
    for (int d = 0; d < 64; d += 2) *(unsigned*)(mix + qrow * D + 768 + hq * 64 + d) = pk2(o[d] * il, o[d + 1] * il);
    __syncthreads();
}

__device__ __forceinline__ unsigned moe_cnt(unsigned char* ws, int e) { return __hip_atomic_load((unsigned*)ws + CW_MOE + 64 * e, RLX_AGENT); }
__device__ __forceinline__ volatile LAS int* moe_tiles_lds(unsigned char* ws, LAS unsigned char* lds) {
    volatile LAS int* TS = (volatile LAS int*)(lds + MISC_OFF) + 16;
    __syncthreads();
    if (tidx_() < 8) TS[9 + tidx_()] = (int)moe_cnt(ws, (int)tidx_());
    __syncthreads();
    if (tidx_() == 0) { int acc = 0; for (int e = 0; e < 8; ++e) { TS[e] = acc; acc += (TS[9 + e] + 255) >> 8; } TS[8] = acc; }
    __syncthreads();
    return TS;
}
__device__ __forceinline__ int exp_of_tile(volatile LAS int* TS, int rt) { int e = 0;
#pragma unroll
    for (int k = 1; k < 8; ++k) e += (rt >= TS[k]);
    return e; }
__device__ __forceinline__ void ph_moe_gather(unsigned char* ws, LAS unsigned char* lds, int gw, int NGW, int lane) {
    volatile LAS int* TS = moe_tiles_lds(ws, lds);
    const int nrows = TS[8] * 256;
    const int* tok = (const int*)(ws + WS_TOK); const unsigned char* h = (const unsigned char*)(ws + WS_H); unsigned char* xg = (unsigned char*)(ws + WS_XG);
    constexpr int GR = 16;
    for (int r0 = gw; r0 < nrows; r0 += GR * NGW) {
        int tk[GR]; bool ok[GR];
#pragma unroll
        for (int j = 0; j < GR; ++j) { const int r = r0 + j * NGW; const int rc = r < nrows ? r : r0; const int rt = rc >> 8; const int e = exp_of_tile(TS, rt);
            const int local = rc - TS[e] * 256; ok[j] = r < nrows && local < TS[9 + e]; tk[j] = tok[e * MOE_CAP + (ok[j] ? local : 0)]; }
        v4u v[GR];
#pragma unroll
        for (int j = 0; j < GR; ++j) v[j] = ((const v4u*)(h + (size_t)(ok[j] ? tk[j] : 0) * D))[lane];
#pragma unroll
        for (int j = 0; j < GR; ++j) { const int r = r0 + j * NGW; if (r < nrows) ((v4u*)(xg + (size_t)r * D))[lane] = ok[j] ? v[j] : (v4u){0u, 0u, 0u, 0u}; }
    }
}
__device__ __forceinline__ void ph_moe_combine(unsigned char* ws, LAS unsigned char* lds, float* out, const float* gate2  , int gw, int NGW, int lane) {
    volatile LAS int* TS = moe_tiles_lds(ws, lds);
    const int* asg = (const int*)(ws + WS_ASG); const float* gt = (const float*)(ws + WS_GATE); const bf16* yr = (const bf16*)(ws + WS_YR);
    constexpr int CT = 4;
    for (int m0 = gw; m0 < M; m0 += CT * NGW) {
        int mm[CT]; size_t ra[CT], rb[CT]; float ga[CT], gbv[CT];
#pragma unroll
        for (int u = 0; u < CT; ++u) { mm[u] = m0 + u * NGW < M ? m0 + u * NGW : m0; const int s0 = asg[mm[u] * 2], s1 = asg[mm[u] * 2 + 1];
            const int e0 = s0 / MOE_CAP, p0 = s0 % MOE_CAP, e1 = s1 / MOE_CAP, p1 = s1 % MOE_CAP;
            ra[u] = (size_t)TS[e0] * 256 + p0; rb[u] = (size_t)TS[e1] * 256 + p1; ga[u] = gt[s0]; gbv[u] = gt[s1]; }
        v4u a0[CT][2], a1[CT][2], xq[CT][2]; const bf16* xb = (const bf16*)(ws + WS_XB);
#pragma unroll
        for (int u = 0; u < CT; ++u)
#pragma unroll
            for (int j = 0; j < 2; ++j) { const int col = (j * 64 + lane) * 8;
                a0[u][j] = *(const v4u*)(yr + ra[u] * D + col); a1[u][j] = *(const v4u*)(yr + rb[u] * D + col);
                xq[u][j] = *(const v4u*)(xb + (size_t)mm[u] * D + col); }
#pragma unroll
        for (int u = 0; u < CT; ++u) { if (u > 0 && m0 + u * NGW >= M) break;
            const float* gb = gate2 + (size_t)(mm[u] / T) * 6144; const float g0 = ga[u], g1 = gbv[u];
#pragma unroll
            for (int j = 0; j < 2; ++j) { const int col = (j * 64 + lane) * 8; const f32x4* gp = (const f32x4*)(gb + col); const f32x4 gg0 = gp[0], gg1 = gp[1];
                const v4u A0 = a0[u][j], A1 = a1[u][j], XQ = xq[u][j]; f32x4 X0 = {bflo(XQ.x), bfhi(XQ.x), bflo(XQ.y), bfhi(XQ.y)}, X1 = {bflo(XQ.z), bfhi(XQ.z), bflo(XQ.w), bfhi(XQ.w)};
                X0.x += gg0.x * (g0 * bflo(A0.x) + g1 * bflo(A1.x)); X0.y += gg0.y * (g0 * bfhi(A0.x) + g1 * bfhi(A1.x)); X0.z += gg0.z * (g0 * bflo(A0.y) + g1 * bflo(A1.y)); X0.w += gg0.w * (g0 * bfhi(A0.y) + g1 * bfhi(A1.y));
                X1.x += gg1.x * (g0 * bflo(A0.z) + g1 * bflo(A1.z)); X1.y += gg1.y * (g0 * bfhi(A0.z) + g1 * bfhi(A1.z)); X1.z += gg1.z * (g0 * bflo(A0.w) + g1 * bflo(A1.w)); X1.w += gg1.w * (g0 * bfhi(A0.w) + g1 * bfhi(A1.w));
                f32x4* op = (f32x4*)(out + (size_t)mm[u] * D + col); op[0] = X0; op[1] = X1; } }
    }
}

#define LANE_ fresh_lane()
#define TID_ tidx_()
constexpr int NPHASE = 23;
#ifndef PH_MASK
#define PH_MASK 0xFFFFFFFFu
#endif
#define EN(b) ((PH_MASK >> (b)) & 1u)

#define IN(k) (lo <= (k) && (k) < hi)
#define SEAM(k) do { if (IN(k) && IN((k) + 1)) xcd_barrier(bar); } while (0)
template <int l>
__device__ __forceinline__ void layer_phases(const Args& args, unsigned char* ws, LAS unsigned char* lds, float* out, const float* mod, bf16* H, const XcdBarrier& bar,
                                             int lo, int hi, int li, int wave, int G, int gw, int NGW) {

        const int pb = 2 + 10 * l;
        const float* modl = mod + (size_t)l * 8 * 6144;
        if (EN(0) && IN(pb + 0)) {
#if ZG_F8
            if constexpr (l >= ZG_F8_L) {
            pg8::Gemm g{H, (const bf16*)(ws + WS_WIN + (size_t)l * NZ * 2048), M, NZ, 1024 / 2}; pg8::StaticOrder S; S.init(M, NZ, G, (int)blockIdx.x);
            pg8::EpiBf16<0> E{(bf16*)(ws + WS_Z), NZ, nullptr, 0, 0, 1.f};
            pg8::gemm_phase_f8<pg8::EpiBf16<0>, pg8::StaticOrder, true, true>(lds + RING_OFF, g, S, E, F8_WEXP, F8_HEXP);
            } else {
            pg8::Gemm g{H, (const bf16*)(ws + WS_WIN) + (size_t)l * NZ * 1024, M, NZ, 1024}; pg8::StaticOrder S; S.init(M, NZ, G, (int)blockIdx.x);
            pg8::EpiBf16<0> E{(bf16*)(ws + WS_Z), NZ, nullptr, 0, 0, 1.f};
            pg8::gemm_phase<pg8::EpiBf16<0>, pg8::StaticOrder, true, true>(lds + RING_OFF, g, S, E);
            }
#else
            pg8::Gemm g{H, (const bf16*)(ws + WS_WIN) + (size_t)l * NZ * 1024, M, NZ, 1024}; pg8::StaticOrder S; S.init(M, NZ, G, (int)blockIdx.x);
            pg8::EpiBf16<0> E{(bf16*)(ws + WS_Z), NZ, nullptr, 0, 0, 1.f};
            pg8::gemm_phase<pg8::EpiBf16<0>, pg8::StaticOrder, true, true>(lds + RING_OFF, g, S, E);
#endif
        } SEAM(pb + 0);
        if (EN(1) && IN(pb + 1)) {
#if POSTZ_NAIVE
            ph_postz(args, ws, lds, l, gw, NGW, wave, LANE_);
#else
            ph_postz_mfma<l>(args, ws, lds, G, TID_, wave, LANE_, DRY_REP && li == 1);
#endif
        } SEAM(pb + 1);
        if (IN(pb + 3)) {
            if (EN(14) && blockIdx.x >= 64 && blockIdx.x < 128) ph_convert(args, ws, lds, ((int)blockIdx.x - 64) * 8 + wave, 64 * 8, wave, LANE_, 1 + l);
            if (EN(2) && blockIdx.x < 64 && wave < 2 && !(ATTN_ONLY_REP && li == 1)) scan_carry(ws, (int)blockIdx.x, wave, LANE_);
            __syncthreads();
            #if ATTN_NAIVE
            if (EN(3)) for (int u = blockIdx.x; u < 256; u += G) ph_attn_naive(ws, lds, u, TID_);
#else
            if (EN(3) && !(CARRY_ONLY_REP && li == 1)) { volatile LAS unsigned* qw = (volatile LAS unsigned*)(lds + MISC_OFF) + 26;
                for (;;) { __syncthreads(); if (TID_ == 0) qw[0] = __hip_atomic_fetch_add((unsigned*)ws + CW_ATQ + 64 * (l + 2 * (li & 1)), 1u, RLX_AGENT); __syncthreads();
                    const unsigned u = qw[0]; if (u >= 512u) break; ph_attn_pipe(ws, lds, (int)(u & 31u), 15 - (int)(u >> 5), wave, LANE_); } }
#endif
        } SEAM(pb + 3);
        if (EN(2) && IN(pb + 4)) { ph_scan_out(args, ws, lds, l, gw, NGW, wave, LANE_); } SEAM(pb + 4);
        if (EN(4) && IN(pb + 5)) {
            pg8::Gemm g{(const bf16*)(ws + WS_MIX), (const bf16*)(ws + WS_WOUT) + (size_t)l * 1024 * 1024, M, D, D}; pg8::StaticOrder S; S.init(M, D, G, (int)blockIdx.x);
            pg8::EpiResB<l == 0> E{l == 0 ? (const void*)args.in[I_X] : (const void*)(ws + WS_XB), (pg8::bf16_t*)(ws + WS_XB), modl + 2 * 1024};
            pg8::gemm_phase<pg8::EpiResB<l == 0>, pg8::StaticOrder, true, true>(lds + RING_OFF, g, S, E);
        } SEAM(pb + 5);
        if constexpr (l == 0) {
            if (EN(5) && IN(pb + 6)) { ph_norm<false, false, true>(ws + WS_XB, args.in[I_NGAIN] + 1024, modl + 3 * 1024, H, nullptr, ws, gw, NGW, LANE_); } SEAM(pb + 6);
            if (EN(6) && IN(pb + 7)) {
                pg8::Gemm g{H, (const bf16*)(ws + WS_WFFI), M, 2 * DFF, D}; pg8::StaticOrder S; S.init(M, 2 * DFF, G, (int)blockIdx.x);
#if FFO_F8
                pg8::EpiSwigluF8 E{ws + WS_ACT, DFF, 1 << 20};
                pg8::gemm_phase<pg8::EpiSwigluF8, pg8::StaticOrder, true, true>(lds + RING_OFF, g, S, E);
#else
                pg8::EpiSwiglu E{(bf16*)(ws + WS_ACT), DFF, 1 << 20};
                pg8::gemm_phase<pg8::EpiSwiglu, pg8::StaticOrder, true, true>(lds + RING_OFF, g, S, E);
#endif
            } SEAM(pb + 7);
            if (EN(7) && IN(pb + 8)) {
#if FFO_F8
                pg8::Gemm g{(const bf16*)(ws + WS_ACT), (const bf16*)(ws + WS_WFFO), M, D, DFF / 2}; pg8::StaticOrder S; S.init(M, D, G, (int)blockIdx.x);
                pg8::EpiResB<false> E{(const void*)(ws + WS_XB), (pg8::bf16_t*)(ws + WS_XB), modl + 5 * 1024};
                pg8::gemm_phase_f8<pg8::EpiResB<false>, pg8::StaticOrder, true, true>(lds + RING_OFF, g, S, E, F8_WEXP, F8_AEXP);
#else
                pg8::Gemm g{(const bf16*)(ws + WS_ACT), (const bf16*)(ws + WS_WFFO), M, D, DFF}; pg8::StaticOrder S; S.init(M, D, G, (int)blockIdx.x);
                pg8::EpiResB<false> E{(const void*)(ws + WS_XB), (pg8::bf16_t*)(ws + WS_XB), modl + 5 * 1024};
                pg8::gemm_phase<pg8::EpiResB<false>, pg8::StaticOrder, true, true>(lds + RING_OFF, g, S, E);
#endif
            } SEAM(pb + 8);
            if (EN(5) && IN(pb + 9)) { ph_norm<false, (ZG_F8 != 0 && ZG_F8_L <= 1), true>(ws + WS_XB, args.in[I_NGAIN] + 2048, mod + (size_t)8 * 6144, H, nullptr, ws, gw, NGW, LANE_); } SEAM(pb + 9);
        } else {
            if (EN(8) && IN(pb + 6)) { ph_norm<true, true, true>(ws + WS_XB, args.in[I_NGAIN] + 3072, modl + 3 * 1024, H, args.in[I_ROUTER], ws, gw, NGW, LANE_, lds); } SEAM(pb + 6);
            if (EN(9) && IN(pb + 7)) { ph_moe_gather(ws, lds, gw, NGW, LANE_); } SEAM(pb + 7);
            if (EN(10) && IN(pb + 8)) {
                volatile LAS int* TS = moe_tiles_lds(ws, lds);
                pg8::Gemm g{(const bf16*)(ws + WS_XG), (const bf16*)(ws + WS_WMI), 0, 0, D / 2};
                pg8::MoeOrder S{28, TS[8] * 28, G, (int)blockIdx.x, TS[1], TS[2], TS[3], TS[4], TS[5], TS[6], TS[7]};
                pg8::EpiSwigluF8 E{ws + WS_MACT, DFFE, 28};
                pg8::gemm_phase_f8<pg8::EpiSwigluF8, pg8::MoeOrder, true, true>(lds + RING_OFF, g, S, E, F8_WEXP, F8_HEXP);
            } SEAM(pb + 8);
            if (EN(11) && IN(pb + 9)) {
                volatile LAS int* TS = moe_tiles_lds(ws, lds);
                pg8::Gemm g{(const bf16*)(ws + WS_MACT), (const bf16*)(ws + WS_WMO), 0, 0, DFFE / 2};
                pg8::MoeOrder S{4, TS[8] * 4, G, (int)blockIdx.x, TS[1], TS[2], TS[3], TS[4], TS[5], TS[6], TS[7]};
                pg8::EpiMoeOut E{(bf16*)(ws + WS_YR)};
                pg8::gemm_phase_f8<pg8::EpiMoeOut, pg8::MoeOrder, true, true>(lds + RING_OFF, g, S, E, F8_WEXP, F8_AEXP);
            } SEAM(pb + 9);
            if (EN(12) && IN(pb + 10)) { ph_moe_combine(ws, lds, out, modl + 5 * 1024, gw, NGW, LANE_); }
        }
    }
#undef IN
#undef SEAM
#ifndef ATTN_NAIVE
#define ATTN_NAIVE 0
#endif
#ifndef POSTZ_NAIVE
#define POSTZ_NAIVE 0
#endif
#ifndef SCAN_NAIVE
#define SCAN_NAIVE 0
#endif
#ifndef MK_SPLIT
#define MK_SPLIT 0
#endif
__global__ void __launch_bounds__(NWAVES * 64, 2) fwd_kernel(Args args) {
    LAS unsigned char* lds = (LAS unsigned char*)lds_raw;
    const int wave = __builtin_amdgcn_readfirstlane((int)threadIdx.x >> 6);
    const int G = gridDim.x, gw = blockIdx.x * NWAVES + wave, NGW = G * NWAVES, GT = G * NWAVES * 64;
#define GTID_ ((int)blockIdx.x * (NWAVES * 64) + TID_)
    unsigned char* ws = args.ws;
    for (int u = threadIdx.x; u < (LDS_BYTES - LDSCTL_OFF) / 4; u += NWAVES * 64) ((LAS unsigned*)(lds + LDSCTL_OFF))[u] = 0u;
    __syncthreads();
    if ((threadIdx.x & 63) == 0) ((volatile LAS int*)(lds + WMAP_OFF))[hw_slot_()] = wave;
    __syncthreads();
    XcdBarrier bar; bar.bar = (unsigned*)ws + CW_BAR + args.li * XCD_BAR_WORDS; bar.x = 0; bar.st = nullptr;
    if (!MK_SPLIT) bar = xcd_barrier_post((unsigned*)ws + CW_BAR + args.li * XCD_BAR_WORDS, (volatile LAS unsigned*)(lds + MISC_OFF) + 8);
    const int lo = args.ph_lo, hi = args.ph_hi;
#define IN(k) (lo <= (k) && (k) < hi)
#define SEAM(k) do { if (IN(k) && IN((k) + 1)) xcd_barrier(bar); } while (0)
    float* out = args.out;
    const float* mod = (const float*)(ws + WS_MOD);
    bf16* H = (bf16*)(ws + WS_H);

    if (IN(0)) { if (EN(13)) ph_mod_rope(args, ws, lds, gw, NGW, TID_, LANE_, GTID_, GT);
                 if (EN(14) && blockIdx.x >= 192) { ph_convert(args, ws, lds, ((int)blockIdx.x - 192) * NWAVES + wave, 64 * NWAVES, wave, LANE_, 0);
                                                    ph_small_weights(args, ws, ((int)blockIdx.x - 192) * (NWAVES * 64) + TID_, 64 * NWAVES * 64); } } SEAM(0);
    if (IN(1)) { if (EN(5)) ph_norm<false, (ZG_F8 != 0 && ZG_F8_L <= 0)>(args.in[I_X], args.in[I_NGAIN], mod, H, nullptr, ws, gw, NGW, LANE_); } SEAM(1);

    layer_phases<0>(args, ws, lds, out, mod, H, bar, lo, hi, args.li, wave, G, gw, NGW);
    layer_phases<1>(args, ws, lds, out, mod, H, bar, lo, hi, args.li, wave, G, gw, NGW);
#undef IN
#undef SEAM
}

extern "C" void kernel_launch(void* const* d_in, const int* in_sizes, int n_in, void* d_out, int out_size, void* d_ws, size_t ws_size, hipStream_t stream) {
    static int grid = 0;
    if (grid == 0) {
        if (n_in != 29 || out_size != M * D || ws_size < WS_END || ws_size < WS_MIX_END) { fprintf(stderr, "kernel_launch: unexpected shapes (n_in %d out %d ws %zu)\n", n_in, out_size, ws_size); grid = -1; return; }
        int dev = 0, cus = 0, per_cu = 0;
        if (hipGetDevice(&dev) != hipSuccess || hipDeviceGetAttribute(&cus, hipDeviceAttributeMultiprocessorCount, dev) != hipSuccess) { grid = -1; return; }
        if (hipFuncSetAttribute((const void*)fwd_kernel, hipFuncAttributeMaxDynamicSharedMemorySize, LDS_BYTES) != hipSuccess) { fprintf(stderr, "kernel_launch: hipFuncSetAttribute failed\n"); grid = -1; return; }
        if (hipOccupancyMaxActiveBlocksPerMultiprocessor(&per_cu, (const void*)fwd_kernel, NWAVES * 64, LDS_BYTES) != hipSuccess || per_cu < 1) fprintf(stderr, "kernel_launch: occupancy query says %d\n", per_cu);
        (void)hipGetLastError();
        grid = cus;
    }
    if (grid < 0) return;
    (void)hipMemsetAsync((char*)d_ws + WS_CTL, 0, CTL_ZERO_BYTES, stream);
    Args a{};
    for (int i = 0; i < 29; ++i) a.in[i] = (const float*)d_in[i];
    a.out = (float*)d_out; a.ws = (unsigned char*)d_ws;
#if defined(TIME_PHASE)
    { const int K = TIME_PHASE; const int cuts[4] = {0, K + 1, K, NPHASE};
      a.ph_lo = 0; a.ph_hi = K + 1; a.li = 0; hipLaunchKernelGGL(fwd_kernel, dim3(grid), dim3(NWAVES * 64), LDS_BYTES, stream, a);
      a.ph_lo = K; a.ph_hi = K + 1; a.li = 1; hipLaunchKernelGGL(fwd_kernel, dim3(grid), dim3(NWAVES * 64), LDS_BYTES, stream, a);
      a.ph_lo = K + 1; a.ph_hi = NPHASE; a.li = 2; hipLaunchKernelGGL(fwd_kernel, dim3(grid), dim3(NWAVES * 64), LDS_BYTES, stream, a); (void)cuts; }
#else
    a.ph_lo = 0; a.ph_hi = NPHASE; a.li = 0;
    hipLaunchKernelGGL(fwd_kernel, dim3(grid), dim3(NWAVES * 64), LDS_BYTES, stream, a);
#endif
}
```
